# Optimizing an MI355X kernel written in HIP

```python
import jax, jax.numpy as jnp
from jax import lax
import numpy as np

D_MODEL = 1024
BATCH = 4
SEQ = 8192
DEPTH = 4

HEAD_DIM = 64
RW_HEADS = 6
SW_HEADS = 6
SW_KV_HEADS = 2
ML_HEADS = 4
RW_DIM = RW_HEADS * HEAD_DIM
SW_DIM = SW_HEADS * HEAD_DIM
SW_KV_DIM = SW_KV_HEADS * HEAD_DIM
ML_DIM = ML_HEADS * HEAD_DIM
D_MIX = RW_DIM + SW_DIM + ML_DIM
RW_LORA_W = 64
RW_LORA_A = 64
RW_LORA_G = 128
RW_COLS = 3 * RW_DIM + RW_LORA_W + RW_LORA_A + RW_LORA_G
SW_COLS = SW_DIM + 2 * SW_KV_DIM
ML_COLS = 4 * ML_DIM + 2 * ML_HEADS
C_IN = RW_COLS + SW_COLS + ML_COLS
WINDOW = 128
ROPE_THETA = 10000.0
ML_CHUNK = 64
CONV_WIDTH = 4
N_EXPERTS = 32
TOP_K = 4
D_EXPERT = 1024
SWIGLU_ALPHA = 1.702
SWIGLU_LIMIT = 7.0
MOE_BLOCK = 128
LN_EPS = 1e-5
RW_GN_EPS = 64e-5
ML_GN_EPS = 1e-6
DN_ALPHA = (2 * DEPTH) ** 0.25
DN_BETA = (8 * DEPTH) ** -0.25

kernel_name = 'hybrid_rwkv7_swa_mlstm_moe_deepnorm'

F32 = jnp.float32


def layer_norm(x, w, b):
    xf = x.astype(F32)
    mu = xf.mean(-1, keepdims=True)
    var = jnp.mean(jnp.square(xf - mu), -1, keepdims=True)
    return ((xf - mu) * lax.rsqrt(var + LN_EPS) * w + b).astype(x.dtype)


def head_norm(x, n_heads, eps):
    B, S, _ = x.shape
    xh = x.astype(F32).reshape(B, S, n_heads, -1)
    mu = xh.mean(-1, keepdims=True)
    var = jnp.mean(jnp.square(xh - mu), -1, keepdims=True)
    return ((xh - mu) * lax.rsqrt(var + eps)).reshape(B, S, -1)


def split_heads(t, n_heads):
    B, S, _ = t.shape
    return t.reshape(B, S, n_heads, -1)


def rope(x):
    S, d = x.shape[1], x.shape[-1]
    half = d // 2
    inv = ROPE_THETA ** (-jnp.arange(half, dtype=F32) / half)
    ang = jnp.arange(S, dtype=F32)[:, None] * inv[None, :]
    cos = jnp.cos(ang)[None, :, None, :]
    sin = jnp.sin(ang)[None, :, None, :]
    xf = x.astype(F32)
    x1, x2 = xf[..., :half], xf[..., half:]
    return jnp.concatenate([x1 * cos - x2 * sin, x2 * cos + x1 * sin], -1)


def causal_depthwise_conv(x, w, b):
    K = w.shape[0]
    xp = jnp.pad(x, ((0, 0), (K - 1, 0), (0, 0)))
    y = lax.conv_general_dilated(xp, w[:, None, :].astype(x.dtype), window_strides=(1,), padding='VALID',
                                 dimension_numbers=('NWC', 'WIO', 'NWC'), feature_group_count=x.shape[-1])
    return y + b


def rwkv7_recurrence(r, w, k, v, a, b):
    B, S, H, N = r.shape

    def step(state, inp):
        r_t, w_t, k_t, v_t, a_t, b_t = inp
        sa = jnp.einsum('bhvk,bhk->bhv', state, a_t)
        state = state * w_t[:, :, None, :] + sa[..., None] * b_t[:, :, None, :] + v_t[..., None] * k_t[:, :, None, :]
        return state, jnp.einsum('bhvk,bhk->bhv', state, r_t)

    xs = tuple(jnp.moveaxis(t, 1, 0) for t in (r, w, k, v, a, b))
    _, ys = lax.scan(step, jnp.zeros((B, H, N, N), F32), xs)
    return jnp.moveaxis(ys, 0, 1)


def rwkv7_mixer(p, shift_mu, w_up, w0, a_up, a0, g_up, k_k, k_a, r_k, ln_w, ln_b):
    B, S, _ = p.shape
    p_prev = jnp.pad(p, ((0, 0), (1, 0), (0, 0)))[:, :-1]
    p = p + (p_prev - p) * shift_mu
    r, k, v, lw, la, lg = jnp.split(p, [RW_DIM, 2 * RW_DIM, 3 * RW_DIM, 3 * RW_DIM + RW_LORA_W,
                                        3 * RW_DIM + RW_LORA_W + RW_LORA_A], axis=-1)
    w_log = -jax.nn.softplus(-(w0 + jnp.tanh(lw) @ w_up).astype(F32)) - 0.5
    decay = jnp.exp(-jnp.exp(w_log))
    a = jax.nn.sigmoid((a0 + la @ a_up).astype(F32))
    g = (jax.nn.sigmoid(lg) @ g_up).astype(F32)
    hd = lambda t: split_heads(t.astype(F32), RW_HEADS)
    kk = hd(k * k_k)
    kk = kk / jnp.maximum(jnp.sqrt(jnp.sum(kk * kk, -1, keepdims=True)), 1e-12)
    k_mod = k.astype(F32) * (1.0 + (a - 1.0) * k_a)
    r_h, k_h, v_h = hd(r), hd(k_mod), hd(v)
    y = rwkv7_recurrence(r_h, hd(decay), k_h, v_h, -kk, kk * hd(a))
    y = head_norm(y.reshape(B, S, RW_DIM), RW_HEADS, RW_GN_EPS) * ln_w + ln_b
    bonus = jnp.sum(r_h * k_h * hd(r_k[None, None, :]), -1, keepdims=True) * v_h
    return ((y + bonus.reshape(B, S, RW_DIM)) * g).astype(p.dtype)


def sliding_window_attention(q, k, v, sinks):
    B, S, Hq, d = q.shape
    Hkv = k.shape[2]
    G = Hq // Hkv
    W = WINDOW
    nb = S // W
    qb = q.reshape(B, nb, W, Hkv, G, d)
    kb = k.astype(F32).reshape(B, nb, W, Hkv, d)
    vb = v.astype(F32).reshape(B, nb, W, Hkv, d)
    pad = ((0, 0), (1, 0), (0, 0), (0, 0), (0, 0))
    kw = jnp.concatenate([jnp.pad(kb, pad)[:, :-1], kb], axis=2)
    vw = jnp.concatenate([jnp.pad(vb, pad)[:, :-1], vb], axis=2)
    scores = jnp.einsum('bnqhgd,bnkhd->bnhgqk', qb, kw) * (d ** -0.5)
    qi = jnp.arange(W)[:, None]
    kj = jnp.arange(2 * W)[None, :]
    band = (kj > qi) & (kj <= qi + W)
    first = (jnp.arange(nb)[:, None, None] == 0) & (kj[None] < W)
    valid = band[None] & ~first
    scores = jnp.where(valid[None, :, None, None], scores, -jnp.inf)
    sink = sinks.astype(F32).reshape(Hkv, G)[None, None, :, :, None, None]
    m = jnp.maximum(scores.max(-1, keepdims=True), sink)
    pr = jnp.exp(scores - m)
    probs = pr / (pr.sum(-1, keepdims=True) + jnp.exp(sink - m))
    out = jnp.einsum('bnhgqk,bnkhd->bnqhgd', probs, vw)
    return out.reshape(B, S, Hq, d)


def swa_mixer(p, sinks):
    B, S, _ = p.shape
    q, k, v = jnp.split(p, [SW_DIM, SW_DIM + SW_KV_DIM], axis=-1)
    q = rope(split_heads(q, SW_HEADS))
    k = rope(split_heads(k, SW_KV_HEADS))
    v = split_heads(v, SW_KV_HEADS)
    return sliding_window_attention(q, k, v, sinks).reshape(B, S, SW_DIM).astype(p.dtype)


def mlstm_chunkwise(q, k, v, i_pre, f_pre):
    B, S, H, d = q.shape
    L = ML_CHUNK
    n = S // L
    chunk4 = lambda t: t.astype(F32).reshape(B, n, L, H, d).transpose(1, 0, 3, 2, 4)
    chunk3 = lambda t: t.astype(F32).reshape(B, n, L, H).transpose(1, 0, 3, 2)
    qc, kc, vc = chunk4(q), chunk4(k * (d ** -0.5)), chunk4(v)
    ic = chunk3(i_pre)
    lfc = chunk3(jax.nn.log_sigmoid(f_pre.astype(F32)))
    causal = jnp.tril(jnp.ones((L, L), bool))

    def step(carry, inp):
        C, nv, m = carry
        q_, k_, v_, i_, lf = inp
        bc = jnp.cumsum(lf, axis=-1)
        D = jnp.where(causal, bc[..., :, None] - bc[..., None, :] + i_[..., None, :], -jnp.inf)
        m_inter = bc + m[..., None]
        m_t = jnp.maximum(m_inter, D.max(-1))
        inter = jnp.exp(m_inter - m_t)
        Sm = jnp.einsum('bhld,bhsd->bhls', q_, k_) * jnp.exp(D - m_t[..., None])
        num = jnp.einsum('bhls,bhsv->bhlv', Sm, v_) + inter[..., None] * jnp.einsum('bhld,bhdv->bhlv', q_, C)
        nq = Sm.sum(-1) + inter * jnp.einsum('bhld,bhd->bhl', q_, nv)
        h = num / jnp.maximum(jnp.abs(nq), jnp.exp(-m_t))[..., None]
        m_new = m_t[..., -1]
        wst = jnp.exp(bc[..., -1:] - bc + i_ - m_new[..., None])
        dec = jnp.exp(bc[..., -1] + m - m_new)
        C = dec[..., None, None] * C + jnp.einsum('bhs,bhsd,bhsv->bhdv', wst, k_, v_)
        nv = dec[..., None] * nv + jnp.einsum('bhs,bhsd->bhd', wst, k_)
        return (C, nv, m_new), h

    init = (jnp.zeros((B, H, d, d), F32), jnp.zeros((B, H, d), F32), jnp.zeros((B, H), F32))
    _, hs = lax.scan(step, init, (qc, kc, vc, ic, lfc))
    return hs.transpose(1, 0, 3, 2, 4).reshape(B, S, H, d)


def mlstm_mixer(p, conv_w, conv_b, norm_w):
    B, S, _ = p.shape
    qk, v, o, i_pre, f_pre = jnp.split(p, [2 * ML_DIM, 3 * ML_DIM, 4 * ML_DIM, 4 * ML_DIM + ML_HEADS], axis=-1)
    qk = jax.nn.silu(causal_depthwise_conv(qk, conv_w, conv_b))
    q, k = jnp.split(qk, 2, axis=-1)
    h = mlstm_chunkwise(split_heads(q, ML_HEADS), split_heads(k, ML_HEADS), split_heads(v, ML_HEADS), i_pre, f_pre)
    h = head_norm(h.reshape(B, S, ML_DIM), ML_HEADS, ML_GN_EPS) * norm_w
    return (jax.nn.sigmoid(o.astype(F32)) * h).astype(p.dtype)


def moe_ffn(x2d, router_w, router_b, w_up, b_up, w_down, b_down):
    M, D = x2d.shape
    logits = (x2d @ router_w + router_b).astype(F32)
    top_val, top_idx = lax.top_k(logits, TOP_K)
    gates = jax.nn.softmax(top_val, axis=-1)
    A = M * TOP_K
    e_flat = top_idx.reshape(A).astype(jnp.int32)
    tok_flat = jnp.arange(A, dtype=jnp.int32) // TOP_K
    g_flat = gates.reshape(A)
    order = jnp.argsort(e_flat)
    e_s, tok_s, g_s = e_flat[order], tok_flat[order], g_flat[order]
    counts = jnp.zeros((N_EXPERTS,), jnp.int32).at[e_flat].add(1)
    padded = (counts + MOE_BLOCK - 1) // MOE_BLOCK * MOE_BLOCK
    start = jnp.cumsum(counts) - counts
    pend = jnp.cumsum(padded)
    pstart = pend - padded
    dest = pstart[e_s] + (jnp.arange(A, dtype=jnp.int32) - start[e_s])
    n_blocks = -(-(A + N_EXPERTS * (MOE_BLOCK - 1)) // MOE_BLOCK)
    P = n_blocks * MOE_BLOCK
    tok_buf = jnp.zeros((P,), jnp.int32).at[dest].set(tok_s)
    g_buf = jnp.zeros((P,), F32).at[dest].set(g_s)
    block_e = jnp.minimum(jnp.searchsorted(pend, jnp.arange(n_blocks, dtype=jnp.int32) * MOE_BLOCK, side='right'),
                          N_EXPERTS - 1).astype(jnp.int32)
    xb = x2d[tok_buf].reshape(n_blocks, MOE_BLOCK, D)

    def expert_block(args):
        xblk, e = args
        h = xblk @ w_up[e] + b_up[e]
        h_glu = jnp.minimum(h[..., ::2], SWIGLU_LIMIT)
        h_lin = jnp.clip(h[..., 1::2], -SWIGLU_LIMIT, SWIGLU_LIMIT)
        act = h_glu * jax.nn.sigmoid(SWIGLU_ALPHA * h_glu) * (h_lin + 1.0)
        return act @ w_down[e] + b_down[e]

    yb = lax.map(expert_block, (xb, block_e)).reshape(P, D)
    y = jnp.zeros((M, D), F32).at[tok_buf].add(yb.astype(F32) * g_buf[:, None])
    return y.astype(x2d.dtype)


def hybrid_mixer(x, w_in, b_in, rw_shift_mu, rw_w_up, rw_w0, rw_a_up, rw_a0, rw_g_up, rw_k_k, rw_k_a, rw_r_k,
                 rw_ln_w, rw_ln_b, sw_sinks, ml_conv_w, ml_conv_b, ml_norm_w, w_out):
    p = x @ w_in + b_in
    p_rw, p_sw, p_ml = jnp.split(p, [RW_COLS, RW_COLS + SW_COLS], axis=-1)
    y = jnp.concatenate([
        rwkv7_mixer(p_rw, rw_shift_mu, rw_w_up, rw_w0, rw_a_up, rw_a0, rw_g_up, rw_k_k, rw_k_a, rw_r_k, rw_ln_w, rw_ln_b),
        swa_mixer(p_sw, sw_sinks),
        mlstm_mixer(p_ml, ml_conv_w, ml_conv_b, ml_norm_w),
    ], axis=-1)
    return y @ w_out


def setup_inputs(seed: int = 0) -> dict:
    key = jax.random.key(seed)
    ks = iter(jax.random.split(key, 40))
    nrm = lambda shape, scale: jax.random.normal(next(ks), shape, F32) * scale
    L = DEPTH
    x = nrm((BATCH, SEQ, D_MODEL), 1.0)
    w_in = nrm((L, D_MODEL, C_IN), D_MODEL ** -0.5)
    b_in = nrm((L, C_IN), 0.02)
    b_in = b_in.at[:, C_IN - ML_HEADS:].add(jnp.linspace(3.0, 6.0, ML_HEADS))
    rw_shift_mu = jax.random.uniform(next(ks), (L, RW_COLS), F32)
    rw_w_up = nrm((L, RW_LORA_W, RW_DIM), RW_LORA_W ** -0.5)
    rw_w0 = jax.random.uniform(next(ks), (L, RW_DIM), F32, -6.0, -0.5)
    rw_a_up = nrm((L, RW_LORA_A, RW_DIM), 0.5 * RW_LORA_A ** -0.5)
    rw_a0 = nrm((L, RW_DIM), 0.1)
    rw_g_up = nrm((L, RW_LORA_G, RW_DIM), 2.0 * RW_LORA_G ** -0.5)
    rw_k_k = 0.85 + nrm((L, RW_DIM), 0.05)
    rw_k_a = 1.0 + nrm((L, RW_DIM), 0.05)
    rw_r_k = nrm((L, RW_DIM), 0.1)
    rw_ln_w = 1.0 + nrm((L, RW_DIM), 0.05)
    rw_ln_b = nrm((L, RW_DIM), 0.02)
    sw_sinks = nrm((L, SW_HEADS), 1.0)
    ml_conv_w = nrm((L, CONV_WIDTH, 2 * ML_DIM), CONV_WIDTH ** -0.5)
    ml_conv_b = nrm((L, 2 * ML_DIM), 0.02)
    ml_norm_w = 1.0 + nrm((L, ML_DIM), 0.05)
    w_out = nrm((L, D_MIX, D_MODEL), DN_BETA * D_MIX ** -0.5)
    ln1_w = 1.0 + nrm((L, D_MODEL), 0.05)
    ln1_b = nrm((L, D_MODEL), 0.02)
    router_w = nrm((L, D_MODEL, N_EXPERTS), D_MODEL ** -0.5)
    router_b = nrm((L, N_EXPERTS), 0.01)
    exp_w_up = nrm((L, N_EXPERTS, D_MODEL, 2 * D_EXPERT), D_MODEL ** -0.5)
    exp_b_up = nrm((L, N_EXPERTS, 2 * D_EXPERT), 0.02)
    exp_w_down = nrm((L, N_EXPERTS, D_EXPERT, D_MODEL), DN_BETA * D_EXPERT ** -0.5)
    exp_b_down = nrm((L, N_EXPERTS, D_MODEL), 0.02)
    ln2_w = 1.0 + nrm((L, D_MODEL), 0.05)
    ln2_b = nrm((L, D_MODEL), 0.02)
    return {'x': x, 'w_in': w_in, 'b_in': b_in, 'rw_shift_mu': rw_shift_mu, 'rw_w_up': rw_w_up, 'rw_w0': rw_w0,
            'rw_a_up': rw_a_up, 'rw_a0': rw_a0, 'rw_g_up': rw_g_up, 'rw_k_k': rw_k_k, 'rw_k_a': rw_k_a,
            'rw_r_k': rw_r_k, 'rw_ln_w': rw_ln_w, 'rw_ln_b': rw_ln_b, 'sw_sinks': sw_sinks, 'ml_conv_w': ml_conv_w,
            'ml_conv_b': ml_conv_b, 'ml_norm_w': ml_norm_w, 'w_out': w_out, 'ln1_w': ln1_w, 'ln1_b': ln1_b,
            'router_w': router_w, 'router_b': router_b, 'exp_w_up': exp_w_up, 'exp_b_up': exp_b_up,
            'exp_w_down': exp_w_down, 'exp_b_down': exp_b_down, 'ln2_w': ln2_w, 'ln2_b': ln2_b}


def reference(x, w_in, b_in, rw_shift_mu, rw_w_up, rw_w0, rw_a_up, rw_a0, rw_g_up, rw_k_k, rw_k_a, rw_r_k,
              rw_ln_w, rw_ln_b, sw_sinks, ml_conv_w, ml_conv_b, ml_norm_w, w_out, ln1_w, ln1_b, router_w, router_b,
              exp_w_up, exp_b_up, exp_w_down, exp_b_down, ln2_w, ln2_b):
    h = x
    B, S, D = x.shape
    for l in range(DEPTH):
        mix = hybrid_mixer(h, w_in[l], b_in[l], rw_shift_mu[l], rw_w_up[l], rw_w0[l], rw_a_up[l], rw_a0[l],
                           rw_g_up[l], rw_k_k[l], rw_k_a[l], rw_r_k[l], rw_ln_w[l], rw_ln_b[l], sw_sinks[l],
                           ml_conv_w[l], ml_conv_b[l], ml_norm_w[l], w_out[l])
        h = layer_norm(DN_ALPHA * h + mix, ln1_w[l], ln1_b[l])
        ffn = moe_ffn(h.reshape(B * S, D), router_w[l], router_b[l], exp_w_up[l], exp_b_up[l],
                      exp_w_down[l], exp_b_down[l]).reshape(B, S, D)
        h = layer_norm(DN_ALPHA * h + ffn, ln2_w[l], ln2_b[l])
    return h
```

```cpp
#include <hip/hip_runtime.h>
#include <cstdio>
#include <cstdint>
#include <cstring>

#define GAS __attribute__((address_space(1)))
#define LAS __attribute__((address_space(3)))
typedef float f32x2 __attribute__((ext_vector_type(2)));
typedef unsigned u32x2 __attribute__((ext_vector_type(2)));

namespace pg8 {
#define PG8_LAS __attribute__((address_space(3)))
typedef unsigned short bf16_t;
typedef short bf16x8 __attribute__((ext_vector_type(8)));
typedef float f32x4 __attribute__((ext_vector_type(4)));
typedef unsigned u32x4 __attribute__((ext_vector_type(4)));
constexpr int BM = 256, BK = 64, HALF = 128, HTB = HALF * BK * 2  , STAGE_BYTES = 8 * HTB, NXCD = 8, WGM = 8;

__host__ __device__ __forceinline__ int lds_byte(int r, int c) { const int st = (r >> 4) * 2 + (c >> 5), rr = r & 15, cc = c & 31, ob = rr * 64 + cc * 2; return st * 1024 + (ob ^ (((ob >> 9) & 1) << 5)); }
__host__ __device__ __forceinline__ void stage_rc(int b, int& R, int& C) { const int st = b / 1024, sb = b % 1024, swz = sb ^ (((sb >> 9) & 1) << 5); R = (st >> 1) * 16 + swz / 64; C = (st & 1) * 32 + (swz % 64) / 2; }
__host__ __device__ __forceinline__ int perm32(int rho) { const int n = rho >> 4, i = rho & 15; return 8 * (i >> 2) + 4 * n + (i & 3); }

struct Unit { int pm, pn; };
struct Gemm { const bf16_t* A; const bf16_t* Bt; int M, N, K; };

struct StaticOrder {
    int nM, nN, nwg, G, c;
    __host__ __device__ void init(int M, int N, int G_, int c_) { nM = M / BM; nN = N / BM; nwg = nM * nN; G = G_; c = c_; }
    __host__ __device__ bool next(int i, Unit& u) const {
        const long L = (long)i * G + c; if (L >= nwg) return false;
        int wgid = (int)L; { const int q = nwg / NXCD, r = nwg % NXCD, xcd = wgid % NXCD, off = wgid / NXCD; wgid = (xcd < r ? xcd * (q + 1) : r * (q + 1) + (xcd - r) * q) + off; }
        const int nig = WGM * nN, gid = wgid / nig, fm = gid * WGM, gsz = (nM - fm) < WGM ? (nM - fm) : WGM;
        u.pm = fm + ((wgid % nig) % gsz); u.pn = (wgid % nig) / gsz; return true;
    }
    __device__ __forceinline__ void a_ready(const Unit&) const {}
    __device__ __forceinline__ void done(const Unit&) const {}
};
template <int NN> struct MoeOrder {
    const PG8_LAS int* tile_e; int G, c;
    __device__ __forceinline__ bool next(int i, Unit& u) const {
        const int s = i * G + c; if (s >= 544 * NN) return false;
        constexpr int per = 8 * NN; const int a = s / per, r = s % per, b = r >> 3, x = r & 7;
        const int pm = 8 * a + x; u.pm = pm; u.pn = tile_e[pm] * NN + b; return true;
    }
    __device__ __forceinline__ void a_ready(const Unit&) const {}
    __device__ __forceinline__ void done(const Unit&) const {}
};

__device__ __forceinline__ unsigned cvt_pk_bf16(float lo, float hi) { unsigned r; asm volatile("v_cvt_pk_bf16_f32 %0, %1, %2" : "=v"(r) : "v"(lo), "v"(hi)); return r; }

struct EpiBf16b {
    static constexpr bool PERM = true, AFTER_DRAIN = false;
    bf16_t* O; int ldc; const float* bias;
    __device__ __forceinline__ void operator()(const f32x4 (&acc)[2][2][4][2], const Unit& u, int wr, int wc, int fr, int fq) const {
        const int row0 = u.pm * BM + wr * 64 + fr; const int col0 = u.pn * BM + wc * 32 + 8 * fq;
        f32x4 bv[2][2];
#pragma unroll
        for (int bj = 0; bj < 2; ++bj)
#pragma unroll
            for (int n = 0; n < 2; ++n) bv[bj][n] = *(const f32x4*)(bias + col0 + bj * HALF + 4 * n);
#pragma unroll
        for (int ai = 0; ai < 2; ++ai)
#pragma unroll
            for (int m = 0; m < 4; ++m) { bf16_t* rowp = O + (size_t)(row0 + ai * HALF + m * 16) * ldc + col0;
#pragma unroll
                for (int bj = 0; bj < 2; ++bj) { const f32x4 v0 = acc[ai][bj][m][0] + bv[bj][0], v1 = acc[ai][bj][m][1] + bv[bj][1];
                    u32x4 w; w.x = cvt_pk_bf16(v0[0], v0[1]); w.y = cvt_pk_bf16(v0[2], v0[3]); w.z = cvt_pk_bf16(v1[0], v1[1]); w.w = cvt_pk_bf16(v1[2], v1[3]);
                    *(u32x4*)(rowp + bj * HALF) = w; } }
    }
};
struct EpiResF32 {
    static constexpr bool PERM = false, AFTER_DRAIN = false;
    float* C; const float* base; int ldc; float alpha;
    __device__ __forceinline__ void operator()(const f32x4 (&acc)[2][2][4][2], const Unit& u, int wr, int wc, int fr, int fq) const {
        const int row0 = u.pm * BM + wr * 64 + fr, col0 = u.pn * BM + wc * 32 + 4 * fq;
#pragma unroll
        for (int ai = 0; ai < 2; ++ai)
#pragma unroll
            for (int m = 0; m < 4; ++m) { const size_t off = (size_t)(row0 + ai * HALF + m * 16) * ldc + col0;
#pragma unroll
                for (int bj = 0; bj < 2; ++bj)
#pragma unroll
                    for (int n = 0; n < 2; ++n) { const f32x4 bs = *(const f32x4*)(base + off + bj * HALF + n * 16); *(f32x4*)(C + off + bj * HALF + n * 16) = acc[ai][bj][m][n] + alpha * bs; }
                asm volatile("" ::: "memory"); }
    }
};
struct EpiSwiglu {
    static constexpr bool PERM = true, AFTER_DRAIN = false;
    bf16_t* O; const float* bias;
    __device__ __forceinline__ void operator()(const f32x4 (&acc)[2][2][4][2], const Unit& u, int wr, int wc, int fr, int fq) const {
        const int row0 = u.pm * BM + wr * 64 + fr; const int bcol0 = u.pn * BM + wc * 32 + 8 * fq;
        const int ocol0 = ((u.pn & 7) * BM + wc * 32 + 8 * fq) >> 1;
        f32x4 bv[2][2];
#pragma unroll
        for (int bj = 0; bj < 2; ++bj)
#pragma unroll
            for (int n = 0; n < 2; ++n) bv[bj][n] = *(const f32x4*)(bias + bcol0 + bj * HALF + 4 * n);
#pragma unroll
        for (int ai = 0; ai < 2; ++ai)
#pragma unroll
            for (int m = 0; m < 4; ++m) { bf16_t* rowp = O + (size_t)(row0 + ai * HALF + m * 16) * 1024 + ocol0;
#pragma unroll
                for (int bj = 0; bj < 2; ++bj) { const f32x4 v0 = acc[ai][bj][m][0] + bv[bj][0], v1 = acc[ai][bj][m][1] + bv[bj][1];
                    float o[4];
#pragma unroll
                    for (int q = 0; q < 4; ++q) { const float gl = (q < 2) ? v0[2 * q] : v1[2 * q - 4], li = (q < 2) ? v0[2 * q + 1] : v1[2 * q - 3];
                        const float hg = fminf(gl, 7.0f), hl = fminf(fmaxf(li, -7.0f), 7.0f);
                        o[q] = hg * (hl + 1.0f) * __builtin_amdgcn_rcpf(1.0f + __expf(-1.702f * hg)); }
                    u32x2 w; w.x = cvt_pk_bf16(o[0], o[1]); w.y = cvt_pk_bf16(o[2], o[3]);
                    *(u32x2*)(rowp + bj * (HALF / 2)) = w; } }
    }
};
struct EpiDown {
    static constexpr bool PERM = true, AFTER_DRAIN = false;
    bf16_t* O; const float* bias; const int* dest; const float* gate;
    __device__ __forceinline__ void operator()(const f32x4 (&acc)[2][2][4][2], const Unit& u, int wr, int wc, int fr, int fq) const {
        const int row0 = u.pm * BM + wr * 64 + fr; const int bcol0 = u.pn * BM + wc * 32 + 8 * fq;
        const int ocol0 = (u.pn & 3) * BM + wc * 32 + 8 * fq;
        f32x4 bv[2][2];
#pragma unroll
        for (int bj = 0; bj < 2; ++bj)
#pragma unroll
            for (int n = 0; n < 2; ++n) bv[bj][n] = *(const f32x4*)(bias + bcol0 + bj * HALF + 4 * n);
#pragma unroll
        for (int ai = 0; ai < 2; ++ai)
#pragma unroll
            for (int m = 0; m < 4; ++m) { const int pos = row0 + ai * HALF + m * 16; const int d = dest[pos]; const float gt = gate[pos];
                if (d >= 0) { bf16_t* rowp = O + (size_t)d * 1024 + ocol0;
#pragma unroll
                    for (int bj = 0; bj < 2; ++bj) { const f32x4 v0 = (acc[ai][bj][m][0] + bv[bj][0]) * gt, v1 = (acc[ai][bj][m][1] + bv[bj][1]) * gt;
                        u32x4 w; w.x = cvt_pk_bf16(v0[0], v0[1]); w.y = cvt_pk_bf16(v0[2], v0[3]); w.z = cvt_pk_bf16(v1[0], v1[1]); w.w = cvt_pk_bf16(v1[2], v1[3]);
                        *(u32x4*)(rowp + bj * HALF) = w; } } }
    }
};

template <class Epi, class Sched, bool STAMP = false>
__device__ __forceinline__ void gemm_phase(PG8_LAS unsigned char* lds, const Gemm g, const Sched& S, const Epi& E, unsigned long long* stamps, const int tid_in) {
    const int tid = tid_in, wid = __builtin_amdgcn_readfirstlane(tid >> 6), lane = tid & 63, wr = wid >> 2, wc = wid & 3, fr = lane & 15, fq = lane >> 4;
    const int K = g.K, nt = K / BK;
    int ts_lo = 0, ts_hi = 0, nts = 0; const unsigned long long rt_entry = STAMP ? (unsigned long long)wall_clock64() : 0ull;
#define PG8_STAMP() do { if (STAMP && wid == 0 && nts < 64) { const unsigned long long _c = (unsigned long long)clock64(); \
        ts_lo = (lane == nts) ? (int)(unsigned)_c : ts_lo; ts_hi = (lane == nts) ? (int)(unsigned)(_c >> 32) : ts_hi; ++nts; } } while (0)
    PG8_STAMP();
    unsigned voffA[2], voffB[2];
#pragma unroll
    for (int i = 0; i < 2; ++i) { int R, C; stage_rc(tid * 16 + i * 8192, R, C); const int Rb = Epi::PERM ? ((R & ~31) + perm32(R & 31)) : R;
        voffA[i] = (unsigned)(R * K + C) * 2u; voffB[i] = (unsigned)(Rb * K + C) * 2u; }
    const size_t kstep = (size_t)(BK * 2);
    const size_t hstep = (size_t)HALF * K * 2;
    const size_t tstep = 2 * hstep;
    const unsigned ldsw = (unsigned)wid * 1024u;
    const int aoff = lds_byte(wr * 64 + fr, fq * 8), boff = lds_byte(wc * 32 + fr, fq * 8);
#define PG8_SA(b, h) (((b) * 2 + (h)) * HTB)
#define PG8_SB(b, h) ((4 + (b) * 2 + (h)) * HTB)
#define PG8_STAGE(bufoff, gbase, voff) do { _Pragma("unroll") for (int _i = 0; _i < 2; ++_i) \
        __builtin_amdgcn_global_load_lds((const unsigned*)((const char*)(gbase) + (voff)[_i]), (PG8_LAS unsigned*)(lds + (bufoff) + ldsw + _i * 8192), 16, 0, 0); } while (0)
#define PG8_LDA(dst, b, h) do { _Pragma("unroll") for (int m = 0; m < 4; ++m) _Pragma("unroll") for (int k = 0; k < 2; ++k) dst[m][k] = *(const PG8_LAS bf16x8*)(lds + PG8_SA(b, h) + aoff + m * 2048 + k * 1024); } while (0)
#define PG8_LDB(dst, b, h) do { _Pragma("unroll") for (int n = 0; n < 2; ++n) _Pragma("unroll") for (int k = 0; k < 2; ++k) dst[n][k] = *(const PG8_LAS bf16x8*)(lds + PG8_SB(b, h) + boff + n * 2048 + k * 1024); } while (0)
#define PG8_MMA(ai, bj, At, Bt) do { __builtin_amdgcn_s_setprio(1); _Pragma("unroll") for (int m = 0; m < 4; ++m) _Pragma("unroll") for (int n = 0; n < 2; ++n) _Pragma("unroll") for (int k = 0; k < 2; ++k) \
        acc[ai][bj][m][n] = __builtin_amdgcn_mfma_f32_16x16x32_bf16(Bt[n][k], At[m][k], acc[ai][bj][m][n], 0, 0, 0); __builtin_amdgcn_s_setprio(0); } while (0)
#define PG8_WAIT_V(n) asm volatile("s_waitcnt vmcnt(" #n ")" ::: "memory")
#define PG8_WAIT_L(n) asm volatile("s_waitcnt lgkmcnt(" #n ")" ::: "memory")
#define PG8_BAR __builtin_amdgcn_s_barrier()
#define PG8_SCHED __builtin_amdgcn_sched_barrier(0)
    Unit cur, nxt; int ui = 0;
    if (!S.next(0, cur)) return;
    f32x4 acc[2][2][4][2];
#pragma unroll
    for (int a = 0; a < 2; ++a)
#pragma unroll
        for (int b = 0; b < 2; ++b)
#pragma unroll
            for (int m = 0; m < 4; ++m)
#pragma unroll
                for (int n = 0; n < 2; ++n) acc[a][b][m][n] = (f32x4){0.f, 0.f, 0.f, 0.f};
    bf16x8 At[4][2], B0[2][2], B1[2][2];
    const char* cA = (const char*)g.A + (size_t)cur.pm * tstep; const char* cB = (const char*)g.Bt + (size_t)cur.pn * tstep;
    S.a_ready(cur);
    PG8_STAGE(PG8_SB(0, 0), cB, voffB); PG8_STAGE(PG8_SA(0, 0), cA, voffA); PG8_STAGE(PG8_SB(0, 1), cB + hstep, voffB); PG8_STAGE(PG8_SA(0, 1), cA + hstep, voffA);
    if (wr == 1) PG8_BAR;
    PG8_WAIT_V(4); PG8_BAR;
    PG8_STAGE(PG8_SB(1, 0), cB + kstep, voffB); PG8_STAGE(PG8_SA(1, 0), cA + kstep, voffA); PG8_STAGE(PG8_SB(1, 1), cB + hstep + kstep, voffB);
    PG8_WAIT_V(6); PG8_BAR;
    PG8_STAMP();
    for (;;) {
        const bool has_next = S.next(ui + 1, nxt);
        const char* nA = has_next ? (const char*)g.A + (size_t)nxt.pm * tstep : cA; const char* nB = has_next ? (const char*)g.Bt + (size_t)nxt.pn * tstep : cB;
        for (int t = 0; t < nt; t += 2) {
            const bool last = (t == nt - 2);
            const char* a1 = cA + (size_t)(t + 1) * kstep;
            const char* a2 = last ? nA : cA + (size_t)(t + 2) * kstep; const char* b2 = last ? nB : cB + (size_t)(t + 2) * kstep;
            const char* a3 = a2 + kstep; const char* b3 = b2 + kstep;
            if (last && has_next) S.a_ready(nxt);
            PG8_LDB(B0, 0, 0); PG8_SCHED; PG8_LDA(At, 0, 0); PG8_STAGE(PG8_SA(1, 1), a1 + hstep, voffA);
            PG8_WAIT_L(8); PG8_BAR; PG8_WAIT_L(0); PG8_MMA(0, 0, At, B0); PG8_BAR; PG8_SCHED;
            PG8_LDB(B1, 0, 1); PG8_STAGE(PG8_SB(0, 0), b2, voffB);
            PG8_BAR; PG8_WAIT_L(0); PG8_MMA(0, 1, At, B1); PG8_BAR;
            PG8_LDA(At, 0, 1); PG8_STAGE(PG8_SA(0, 0), a2, voffA);
            PG8_BAR; PG8_WAIT_L(0); PG8_MMA(1, 0, At, B0); PG8_BAR; PG8_SCHED;
            PG8_STAGE(PG8_SB(0, 1), b2 + hstep, voffB);
            PG8_WAIT_V(6); PG8_BAR; PG8_MMA(1, 1, At, B1); PG8_BAR;
            PG8_LDB(B0, 1, 0); PG8_SCHED; PG8_LDA(At, 1, 0); PG8_STAGE(PG8_SA(0, 1), a2 + hstep, voffA);
            PG8_WAIT_L(8); PG8_BAR; PG8_WAIT_L(0); PG8_MMA(0, 0, At, B0); PG8_BAR; PG8_SCHED;
            PG8_LDB(B1, 1, 1); PG8_STAGE(PG8_SB(1, 0), b3, voffB);
            PG8_BAR; PG8_WAIT_L(0); PG8_MMA(0, 1, At, B1); PG8_BAR;
            PG8_LDA(At, 1, 1); PG8_STAGE(PG8_SA(1, 0), a3, voffA);
            PG8_BAR; PG8_WAIT_L(0); PG8_MMA(1, 0, At, B0); PG8_BAR; PG8_SCHED;
            PG8_STAGE(PG8_SB(1, 1), b3 + hstep, voffB);
            PG8_WAIT_V(6); PG8_BAR; PG8_MMA(1, 1, At, B1); PG8_BAR;
        }
        PG8_STAMP();
        if constexpr (!Epi::AFTER_DRAIN) { E(acc, cur, wr, wc, fr, fq); S.done(cur); }
        PG8_STAMP();
        if (!has_next) break;
#pragma unroll
        for (int a = 0; a < 2; ++a)
#pragma unroll
            for (int b = 0; b < 2; ++b)
#pragma unroll
                for (int m = 0; m < 4; ++m)
#pragma unroll
                    for (int n = 0; n < 2; ++n) acc[a][b][m][n] = (f32x4){0.f, 0.f, 0.f, 0.f};
        cur = nxt; cA = nA; cB = nB; ++ui;
    }
    PG8_WAIT_V(0);
    if (wr == 0) PG8_BAR;
    PG8_BAR;
    if constexpr (Epi::AFTER_DRAIN) { E.fused(acc, cur, wr, wc, fr, fq, lds, wid, lane); S.done(cur); }
    PG8_STAMP();
    if (STAMP && wid == 0) { stamps[lane] = lane < nts ? (((unsigned long long)(unsigned)ts_hi << 32) | (unsigned)ts_lo) : 0ull;
        if (lane == 62) stamps[62] = rt_entry; if (lane == 63) stamps[63] = (unsigned long long)wall_clock64(); }
#undef PG8_STAMP
#undef PG8_SA
#undef PG8_SB
#undef PG8_STAGE
#undef PG8_LDA
#undef PG8_LDB
#undef PG8_MMA
#undef PG8_WAIT_V
#undef PG8_WAIT_L
#undef PG8_BAR
#undef PG8_SCHED
}
}
using pg8::bf16_t; using pg8::bf16x8; using pg8::f32x4; using pg8::u32x4;

constexpr int NB = 4, SEQ = 8192, MTOK = NB * SEQ, DM = 1024, NLAYER = 4, CIN = 3080, NPROJ = 3072, NEXP = 32, DEXP = 1024, NUP = 2048;
constexpr int RWD = 384, RW_COLS = 1408;
constexpr int NT_MAX = 544, POS_MAX = NT_MAX * 256;
constexpr float DN_ALPHA = 1.6817928305074290861f;
constexpr float LN_EPS = 1e-5f;
constexpr int NPH = 10;
constexpr int NPHASE_TOTAL = 1 + NLAYER * NPH;

constexpr size_t MiB = 1u << 20;
constexpr size_t WS_CTL = 0, CTL_ZERO_BYTES = 65536;
constexpr size_t WS_WIN = 1 * MiB;
constexpr size_t WS_WOUT = 25 * MiB;
constexpr size_t WS_WUP = 33 * MiB;
constexpr size_t WS_WDN = 545 * MiB;
constexpr size_t WS_ROPE = 801 * MiB;
constexpr size_t WS_HB = 803 * MiB;
constexpr size_t WS_HF = 867 * MiB;
constexpr size_t WS_H1F = 995 * MiB;
constexpr size_t WS_T1 = 1123 * MiB;
constexpr size_t WS_P = 1251 * MiB;
constexpr size_t WS_PG = 1443 * MiB;
constexpr size_t WS_YMIX = 1444 * MiB;
constexpr size_t WS_RWIN = 1508 * MiB;
constexpr size_t WS_RWG = 1796 * MiB;
constexpr size_t WS_RWY = 1844 * MiB;
constexpr size_t WS_MLIN = 1892 * MiB;
constexpr size_t WS_MLG = 1988 * MiB;
constexpr size_t WS_MLH = 1989 * MiB;
constexpr size_t WS_XPERM = 2021 * MiB;
constexpr size_t WS_ACT = 2293 * MiB;
constexpr size_t WS_YB = 2565 * MiB;
constexpr size_t WS_TOKE = 2821 * MiB;
constexpr size_t WS_TOKG = 2822 * MiB;
constexpr size_t WS_TOKLR = 2823 * MiB;
constexpr size_t WS_PDEST = 2824 * MiB;
constexpr size_t WS_PGATE = 2825 * MiB;
constexpr size_t WS_BBASE = 2826 * MiB;
constexpr size_t WS_END = 2827 * MiB;
constexpr int CW_CNT = 1024;
constexpr int CW_BAR = 4096;
constexpr int LDS_BYTES = 147456;
constexpr int MISC_OFF = 143360;
constexpr int TILEE_OFF = 133120;

#define LDS_WAIT() asm volatile("s_waitcnt lgkmcnt(0)" ::: "memory")
#define VM_WAIT() asm volatile("s_waitcnt vmcnt(0)" ::: "memory")
__device__ __forceinline__ unsigned f2bf(float f) { unsigned u = __builtin_bit_cast(unsigned, f); return (u + 0x7fffu + ((u >> 16) & 1u)) >> 16; }
__device__ __forceinline__ unsigned pk2(float lo, float hi) { return f2bf(lo) | (f2bf(hi) << 16); }
__device__ __forceinline__ float bf2f(unsigned short b) { return __builtin_bit_cast(float, ((unsigned)b) << 16); }
__device__ __forceinline__ float bflo(unsigned w) { return __builtin_bit_cast(float, w << 16); }
__device__ __forceinline__ float bfhi(unsigned w) { return __builtin_bit_cast(float, w & 0xffff0000u); }
__device__ __forceinline__ float wave_sum(float v) {
#pragma unroll
    for (int o = 1; o < 64; o <<= 1) v += __shfl_xor(v, o);
    return v;
}
__device__ __forceinline__ float sigmoidf_(float x) { return 1.0f / (1.0f + __expf(-x)); }

#define XB_TMO      128
#define XB_XCNT(j)  (256  + 64 * (j))
#define XB_XSUB(j)  (1280 + 64 * (j))
#define XB_XGEN(j)  (2304 + 64 * (j))
#define XB_TOP      3328
#define XB_TOPGEN   3392
#define XCD_BAR_WORDS 3456
#define XB_SPIN_CAP (1u << 22)
__device__ __forceinline__ unsigned xb_ld(unsigned* p)              { return __hip_atomic_load(p, __ATOMIC_RELAXED, __HIP_MEMORY_SCOPE_AGENT); }
__device__ __forceinline__ unsigned xb_add(unsigned* p, unsigned v) { return __hip_atomic_fetch_add(p, v, __ATOMIC_RELAXED, __HIP_MEMORY_SCOPE_AGENT); }
__device__ __forceinline__ unsigned xb_xcc_id() { return (unsigned)__builtin_amdgcn_s_getreg((3 << 11) | 20) & 0xFu; }
#define XB_SPIN(cond, bar) do { unsigned _sp = 0; while (cond) { __builtin_amdgcn_s_sleep(1); \
    if ((++_sp & 255u) == 0u) { if (xb_ld(&(bar)[XB_TMO])) break; if (_sp > XB_SPIN_CAP) { atomicAdd(&(bar)[XB_TMO], 1u); break; } } } } while (0)

struct XcdBarrier {
    unsigned* bar; unsigned x;
    volatile LAS unsigned* st;
};

__device__ __forceinline__ XcdBarrier xcd_barrier_post(unsigned* bar, volatile LAS unsigned* st) {
    XcdBarrier b; b.bar = bar; b.x = xb_xcc_id(); b.st = st;
    if (threadIdx.x == 0) (void)xb_add(&bar[XB_XCNT(b.x)], 1u);
    return b;
}
__device__ __forceinline__ void xcd_barrier_complete(unsigned* bar, unsigned x, unsigned& nloc, unsigned& nx) {
    const unsigned G = gridDim.x * gridDim.y * gridDim.z;
    unsigned sum, cnt, mine, sp = 0u;
    for (;;) {
        sum = 0u; cnt = 0u; mine = 0u;
#pragma unroll
        for (unsigned j = 0; j < 16; ++j) { const unsigned c = xb_ld(&bar[XB_XCNT(j)]); sum += c; cnt += (c > 0u) ? 1u : 0u; mine = (j == x) ? c : mine; }
        if (sum == G) break;
        __builtin_amdgcn_s_sleep(1);
        if ((++sp & 255u) == 0u) { if (xb_ld(&bar[XB_TMO])) break; if (sp > XB_SPIN_CAP) { atomicAdd(&bar[XB_TMO], 1u); break; } }
    }
    nloc = mine > 0u ? mine : 1u; nx = cnt > 0u ? cnt : 1u;
}

__device__ __forceinline__ void xcd_barrier(const XcdBarrier& b) {
    asm volatile("s_waitcnt vmcnt(0)" ::: "memory");
    __syncthreads();
    if (threadIdx.x == 0) {
        unsigned* bar = b.bar;
        __builtin_amdgcn_s_waitcnt(0);
        unsigned nloc = b.st[0], nx = b.st[1];
        if (nloc == 0u) { xcd_barrier_complete(bar, b.x, nloc, nx); b.st[0] = nloc; b.st[1] = nx; }
        const unsigned old = xb_add(&bar[XB_XSUB(b.x)], 1u);
        const unsigned gen = old / nloc;
        if (old + 1u == (gen + 1u) * nloc) {
            __builtin_amdgcn_fence(__ATOMIC_RELEASE, "agent");
            asm volatile("s_waitcnt vmcnt(0)" ::: "memory");
            const unsigned og = xb_add(&bar[XB_TOP], 1u);
            const unsigned tg = og / nx;
            if (og + 1u == (tg + 1u) * nx) xb_add(&bar[XB_TOPGEN], 1u);
            else XB_SPIN(xb_ld(&bar[XB_TOPGEN]) == tg, bar);
            __builtin_amdgcn_fence(__ATOMIC_ACQUIRE, "agent");
            xb_add(&bar[XB_XGEN(b.x)], 1u);
            asm volatile("s_waitcnt vmcnt(0)" ::: "memory");
        } else {
            XB_SPIN(xb_ld(&bar[XB_XGEN(b.x)]) == gen, bar);
            __builtin_amdgcn_fence(__ATOMIC_ACQUIRE, "agent");
            asm volatile("s_waitcnt vmcnt(0)" ::: "memory");
        }
    }
    __syncthreads();
}
struct Params {
    const float* in[29];
    float* out; unsigned char* ws;
    int ph_lo, ph_hi;
    int pad0, pad1;
};
enum { I_X = 0, I_WIN, I_BIN, I_MU, I_WUP, I_W0, I_AUP, I_A0, I_GUP, I_KK, I_KA, I_RK, I_LNW, I_LNB, I_SINK, I_CONVW, I_CONVB, I_MLNW, I_WOUT,
       I_LN1W, I_LN1B, I_RW, I_RB, I_EWUP, I_EBUP, I_EWDN, I_EBDN, I_LN2W, I_LN2B };

struct Ctx {
    LAS unsigned char* lds; int tid, lane, wave, blk, G;
    unsigned char* ws;
};

__device__ __forceinline__ void tr_item(const float* W, int ldw, int K, bf16_t* WT, LAS float* scr, int kb, int nb, int lane) {
    const int k0 = 64 * kb, n0 = 32 * nb;
#pragma unroll 8
    for (int i = 0; i < 32; ++i) { const int kk = 2 * i + (lane >> 5); scr[kk * 33 + (lane & 31)] = W[(size_t)(k0 + kk) * ldw + n0 + (lane & 31)]; }
    LDS_WAIT();
    const int c = lane & 7;
#pragma unroll
    for (int j = 0; j < 4; ++j) { const int n = (lane >> 3) + 8 * j; const LAS float* s = scr + (8 * c) * 33 + n;
        u32x4 o; o.x = pk2(s[0 * 33], s[1 * 33]); o.y = pk2(s[2 * 33], s[3 * 33]); o.z = pk2(s[4 * 33], s[5 * 33]); o.w = pk2(s[6 * 33], s[7 * 33]);
        *(u32x4*)(WT + (size_t)(n0 + n) * K + k0 + 8 * c) = o; }
    LDS_WAIT();
}
__device__ __forceinline__ void gate_cols(const f32x4 (&v)[4], const float (&wg)[16][8], const float* bg, float* pgrow, int lane) {
    float acc[8];
#pragma unroll
    for (int c = 0; c < 8; ++c) acc[c] = 0.f;
#pragma unroll
    for (int j = 0; j < 4; ++j)
#pragma unroll
        for (int q = 0; q < 4; ++q)
#pragma unroll
            for (int c = 0; c < 8; ++c) acc[c] += v[j][q] * wg[j * 4 + q][c];
#pragma unroll
    for (int c = 0; c < 8; ++c) acc[c] = wave_sum(acc[c]);
    if (lane < 8) { float r = acc[0];
#pragma unroll
        for (int c = 1; c < 8; ++c) r = (lane == c) ? acc[c] : r;
        pgrow[lane] = r + bg[lane]; }
}
__device__ __forceinline__ void load_wg(float (&wg)[16][8], const float* win_l, int lane) {
#pragma unroll
    for (int j = 0; j < 4; ++j)
#pragma unroll
        for (int q = 0; q < 4; ++q) { const int d = 4 * (lane + 64 * j) + q; const f32x4 a = *(const f32x4*)(win_l + (size_t)d * CIN + NPROJ), b = *(const f32x4*)(win_l + (size_t)d * CIN + NPROJ + 4);
            wg[j * 4 + q][0] = a[0]; wg[j * 4 + q][1] = a[1]; wg[j * 4 + q][2] = a[2]; wg[j * 4 + q][3] = a[3]; wg[j * 4 + q][4] = b[0]; wg[j * 4 + q][5] = b[1]; wg[j * 4 + q][6] = b[2]; wg[j * 4 + q][7] = b[3]; }
}
__device__ __forceinline__ void p0_prologue(const Params& P, const Ctx& C) {
    LAS float* scr = (LAS float*)(C.lds + C.wave * 16384);
    const int gw = C.blk * 8 + C.wave, NGW = C.G * 8;
    bf16_t* win_t = (bf16_t*)(C.ws + WS_WIN); bf16_t* wout_t = (bf16_t*)(C.ws + WS_WOUT); bf16_t* wup_t = (bf16_t*)(C.ws + WS_WUP); bf16_t* wdn_t = (bf16_t*)(C.ws + WS_WDN);
    constexpr int I_IN = 16 * 96, I_OUT = 16 * 32, I_UP = 16 * 64, I_DN = 16 * 32;
    constexpr int N1 = NLAYER * I_IN, N2 = NLAYER * I_OUT, N3 = NLAYER * NEXP * I_UP, N4 = NLAYER * NEXP * I_DN;
    for (int it = gw; it < N1 + N2 + N3 + N4; it += NGW) {
        int r = it;
        if (r < N1) { const int l = r / I_IN; r %= I_IN; tr_item(P.in[I_WIN] + (size_t)l * DM * CIN, CIN, DM, win_t + (size_t)l * NPROJ * DM, scr, r / 96, r % 96, C.lane); continue; } r -= N1;
        if (r < N2) { const int l = r / I_OUT; r %= I_OUT; tr_item(P.in[I_WOUT] + (size_t)l * DM * DM, DM, DM, wout_t + (size_t)l * DM * DM, scr, r / 32, r % 32, C.lane); continue; } r -= N2;
        if (r < N3) { const int le = r / I_UP; r %= I_UP; tr_item(P.in[I_EWUP] + (size_t)le * DM * NUP, NUP, DM, wup_t + (size_t)le * NUP * DM, scr, r / 64, r % 64, C.lane); continue; } r -= N3;
        { const int le = r / I_DN; r %= I_DN; tr_item(P.in[I_EWDN] + (size_t)le * DEXP * DM, DM, DEXP, wdn_t + (size_t)le * DM * DEXP, scr, r / 32, r % 32, C.lane); }
    }
    f32x2* rope = (f32x2*)(C.ws + WS_ROPE);
    for (int idx = C.blk * 512 + C.tid; idx < SEQ * 32; idx += C.G * 512) { const int t = idx >> 5, i = idx & 31;
        const float inv = powf(10000.0f, -(float)i / 32.0f); const float ang = (float)t * inv;
        const double rev = (double)ang * 0.15915494309189533577; const float fr = (float)(rev - __builtin_rint(rev));
        rope[idx] = (f32x2){__builtin_amdgcn_cosf(fr), __builtin_amdgcn_sinf(fr)}; }
    float wg[16][8]; load_wg(wg, P.in[I_WIN], C.lane);
    bf16_t* hb = (bf16_t*)(C.ws + WS_HB); float* pg = (float*)(C.ws + WS_PG);
    for (int m = gw; m < MTOK; m += NGW) {
        const f32x4* xr = (const f32x4*)(P.in[I_X] + (size_t)m * DM) + C.lane; f32x4 v[4];
#pragma unroll
        for (int j = 0; j < 4; ++j) v[j] = xr[64 * j];
        u32x2* o8 = (u32x2*)(hb + (size_t)m * DM) + C.lane;
#pragma unroll
        for (int j = 0; j < 4; ++j) o8[64 * j] = (u32x2){pk2(v[j][0], v[j][1]), pk2(v[j][2], v[j][3])};
        gate_cols(v, wg, P.in[I_BIN] + NPROJ, pg + (size_t)m * 8, C.lane);
    }
}

__device__ __forceinline__ void swa_unit(const Params& P, const Ctx& C, int l, int u) {
    const int tid = C.tid; const int b = u >> 7, n = (u >> 1) & 63, hk = u & 1;
    LAS float* Ks = (LAS float*)C.lds; LAS float* Vs = Ks + 256 * 68;
    const bf16_t* p = (const bf16_t*)(C.ws + WS_P); const f32x2* rope = (const f32x2*)(C.ws + WS_ROPE);
    const int t_base = n * 128 - 128;
    for (int idx = tid; idx < 256 * 32; idx += 512) { const int row = idx >> 5, i = idx & 31; const int t = t_base + row;
        float k1 = 0.f, k2 = 0.f, v1 = 0.f, v2 = 0.f;
        if (t >= 0) { const bf16_t* pr = p + (size_t)(b * SEQ + t) * NPROJ;
            const float x1 = bf2f(pr[1792 + hk * 64 + i]), x2 = bf2f(pr[1792 + hk * 64 + 32 + i]); const f32x2 cs = rope[t * 32 + i];
            k1 = x1 * cs[0] - x2 * cs[1]; k2 = x2 * cs[0] + x1 * cs[1]; v1 = bf2f(pr[1920 + hk * 64 + i]); v2 = bf2f(pr[1920 + hk * 64 + 32 + i]); }
        Ks[row * 68 + i] = k1; Ks[row * 68 + 32 + i] = k2; Vs[row * 68 + i] = v1; Vs[row * 68 + 32 + i] = v2; }
    __syncthreads();
    if (tid < 384) {
        const int g = tid >> 7, qi = tid & 127, hq = hk * 3 + g, t = n * 128 + qi;
        const bf16_t* pr = p + (size_t)(b * SEQ + t) * NPROJ + RW_COLS + hq * 64;
        float q[64];
#pragma unroll
        for (int i = 0; i < 32; ++i) { const float x1 = bf2f(pr[i]), x2 = bf2f(pr[32 + i]); const f32x2 cs = rope[t * 32 + i];
            q[i] = (x1 * cs[0] - x2 * cs[1]) * 0.125f; q[32 + i] = (x2 * cs[0] + x1 * cs[1]) * 0.125f; }
        float m = P.in[I_SINK][l * 6 + hq], ls = 1.0f; float o[64];
#pragma unroll
        for (int d = 0; d < 64; ++d) o[d] = 0.f;
        for (int jj = 0; jj < 128; ++jj) { const int kj = qi + 1 + jj; const LAS float* kr = Ks + kj * 68;
            float s = 0.f;
#pragma unroll
            for (int d = 0; d < 64; d += 4) { const f32x4 kv = *(const LAS f32x4*)(kr + d); s += q[d] * kv[0] + q[d + 1] * kv[1] + q[d + 2] * kv[2] + q[d + 3] * kv[3]; }
            const bool valid = (n != 0) || (kj >= 128);
            s = valid ? s : -__builtin_inff();
            const float mn = fmaxf(m, s); const float sc = __expf(m - mn), pe = __expf(s - mn); ls = ls * sc + pe; m = mn;
            const LAS float* vr = Vs + kj * 68;
#pragma unroll
            for (int d = 0; d < 64; d += 4) { const f32x4 vv = *(const LAS f32x4*)(vr + d); o[d] = o[d] * sc + pe * vv[0]; o[d + 1] = o[d + 1] * sc + pe * vv[1]; o[d + 2] = o[d + 2] * sc + pe * vv[2]; o[d + 3] = o[d + 3] * sc + pe * vv[3]; } }
        const float inv = 1.0f / ls;
        bf16_t* yr = (bf16_t*)(C.ws + WS_YMIX) + (size_t)(b * SEQ + t) * DM + RWD + hq * 64;
#pragma unroll
        for (int d = 0; d < 64; d += 8) { u32x4 w; w.x = pk2(o[d] * inv, o[d + 1] * inv); w.y = pk2(o[d + 2] * inv, o[d + 3] * inv); w.z = pk2(o[d + 4] * inv, o[d + 5] * inv); w.w = pk2(o[d + 6] * inv, o[d + 7] * inv);
            *(u32x4*)(yr + d) = w; }
    }
    __syncthreads();
}
__device__ __forceinline__ void rwprep_unit(const Params& P, const Ctx& C, int l, int u) {
    const int tid = C.tid; const int tok0 = u * 16, b = tok0 / SEQ, t0 = tok0 % SEQ;
    LAS float* sl = (LAS float*)C.lds;
    const bf16_t* p = (const bf16_t*)(C.ws + WS_P); const float* mu = P.in[I_MU] + l * RW_COLS;
    for (int idx = tid; idx < 4096; idx += 512) { const int tk = idx >> 8, c = idx & 255, col = 1152 + c;
        const float cur = bf2f(p[(size_t)(tok0 + tk) * NPROJ + col]); const float prev = (t0 + tk > 0) ? bf2f(p[(size_t)(tok0 + tk - 1) * NPROJ + col]) : 0.f;
        float x = cur + (prev - cur) * mu[col];
        if (c < 64) x = tanhf(x); else if (c >= 128) x = sigmoidf_(x);
        sl[tk * 256 + c] = x; }
    __syncthreads();
    if (tid < RWD) { const int j = tid, h = j >> 6, lane = j & 63;
        float aw[16], aa[16], ag[16];
#pragma unroll
        for (int k = 0; k < 16; ++k) { aw[k] = 0.f; aa[k] = 0.f; ag[k] = 0.f; }
        const float* wup = P.in[I_WUP] + (size_t)l * 64 * RWD + j; const float* aup = P.in[I_AUP] + (size_t)l * 64 * RWD + j; const float* gup = P.in[I_GUP] + (size_t)l * 128 * RWD + j;
        for (int i = 0; i < 64; ++i) { const float w = wup[i * RWD], a = aup[i * RWD];
#pragma unroll
            for (int k = 0; k < 16; ++k) { aw[k] += sl[k * 256 + i] * w; aa[k] += sl[k * 256 + 64 + i] * a; } }
        for (int i = 0; i < 128; ++i) { const float gg = gup[i * RWD];
#pragma unroll
            for (int k = 0; k < 16; ++k) ag[k] += sl[k * 256 + 128 + i] * gg; }
        const float w0 = P.in[I_W0][l * RWD + j], a0 = P.in[I_A0][l * RWD + j], kkc = P.in[I_KK][l * RWD + j], kac = P.in[I_KA][l * RWD + j];
        const float mur = mu[j], muk = mu[RWD + j], muv = mu[2 * RWD + j];
        float pr = 0.f, pk = 0.f, pv = 0.f;
        if (t0 > 0) { const bf16_t* q = p + (size_t)(tok0 - 1) * NPROJ; pr = bf2f(q[j]); pk = bf2f(q[RWD + j]); pv = bf2f(q[2 * RWD + j]); }
        float* rwin = (float*)(C.ws + WS_RWIN) + ((size_t)(b * 6 + h) * SEQ + t0) * 384 + lane; float* rwg = (float*)(C.ws + WS_RWG) + (size_t)tok0 * RWD + j;
#pragma unroll
        for (int k = 0; k < 16; ++k) { const bf16_t* q = p + (size_t)(tok0 + k) * NPROJ; const float cr = bf2f(q[j]), ck = bf2f(q[RWD + j]), cv = bf2f(q[2 * RWD + j]);
            const float rs = cr + (pr - cr) * mur, ks = ck + (pk - ck) * muk, vs = cv + (pv - cv) * muv; pr = cr; pk = ck; pv = cv;
            const float z = -(w0 + aw[k]); const float sp = (z > 20.f) ? z : log1pf(__expf(z)); const float dec = __expf(-__expf(-sp - 0.5f));
            const float a = sigmoidf_(a0 + aa[k]);
            const float kkv = ks * kkc; const float nrm = sqrtf(wave_sum(kkv * kkv)); const float kkn = kkv / fmaxf(nrm, 1e-12f);
            const float kmod = ks * (1.0f + (a - 1.0f) * kac);
            float* o = rwin + (size_t)k * 384;
            o[0] = rs; o[64] = dec; o[128] = kmod; o[192] = vs; o[256] = -kkn; o[320] = kkn * a;
            rwg[(size_t)k * RWD] = ag[k]; }
    }
    __syncthreads();
}
__device__ __forceinline__ void mlprep_unit(const Params& P, const Ctx& C, int l, int u) {
    const int c = C.tid; const int tok0 = u * 16, b = tok0 / SEQ, t0 = tok0 % SEQ;
    const bf16_t* p = (const bf16_t*)(C.ws + WS_P);
    const float* cw = P.in[I_CONVW] + (size_t)l * 4 * 512; const float w0 = cw[c], w1 = cw[512 + c], w2 = cw[1024 + c], w3 = cw[1536 + c], cb = P.in[I_CONVB][l * 512 + c];
    float xm3 = 0.f, xm2 = 0.f, xm1 = 0.f;
    if (t0 > 0) { xm3 = bf2f(p[(size_t)(tok0 - 3) * NPROJ + 2048 + c]); xm2 = bf2f(p[(size_t)(tok0 - 2) * NPROJ + 2048 + c]); xm1 = bf2f(p[(size_t)(tok0 - 1) * NPROJ + 2048 + c]); }
    const int head = (c & 255) >> 6, d = c & 63, isk = c >> 8;
    float* mlin = (float*)(C.ws + WS_MLIN) + ((size_t)(b * 4 + head) * SEQ + t0) * 192;
#pragma unroll
    for (int k = 0; k < 16; ++k) { const float x0 = bf2f(p[(size_t)(tok0 + k) * NPROJ + 2048 + c]);
        const float y = w0 * xm3 + w1 * xm2 + w2 * xm1 + w3 * x0 + cb; const float s = y * sigmoidf_(y);
        mlin[(size_t)k * 192 + isk * 64 + d] = isk ? s * 0.125f : s; xm3 = xm2; xm2 = xm1; xm1 = x0; }
    if (c < 256) {
#pragma unroll
        for (int k = 0; k < 16; ++k) mlin[(size_t)k * 192 + 128 + d] = bf2f(p[(size_t)(tok0 + k) * NPROJ + 2560 + c]); }
    if (c < 64) { const int tk = c >> 2, hh = c & 3; const float* pg = (const float*)(C.ws + WS_PG) + (size_t)(tok0 + tk) * 8;
        const float ig = pg[hh], f = pg[4 + hh]; const float lf = fminf(f, 0.f) - log1pf(__expf(-fabsf(f)));
        float* mlg = (float*)(C.ws + WS_MLG) + ((size_t)(b * 4 + hh) * SEQ + t0 + tk) * 2; mlg[0] = ig; mlg[1] = lf; }
}

__device__ __forceinline__ void rwkv_scan(const Ctx& C, int bh) {
    const int tid = C.tid, w = C.wave, lane = C.lane, r = lane >> 3, q = lane & 7; const int b = bh / 6, h = bh % 6;
    const float* src = (const float*)(C.ws + WS_RWIN) + (size_t)bh * SEQ * 384; float* ydst = (float*)(C.ws + WS_RWY);
    LAS float* buf = (LAS float*)C.lds; LAS float* ybuf = buf + 32 * 384;
    float s[8];
#pragma unroll
    for (int i = 0; i < 8; ++i) s[i] = 0.f;
    f32x4 pre[6];
#pragma unroll
    for (int k = 0; k < 6; ++k) pre[k] = ((const f32x4*)src)[tid + 512 * k];
    for (int nb = 0; nb < SEQ / 32; ++nb) {
        __syncthreads();
#pragma unroll
        for (int k = 0; k < 6; ++k) ((LAS f32x4*)buf)[tid + 512 * k] = pre[k];
        __syncthreads();
        if (nb + 1 < SEQ / 32) {
#pragma unroll
            for (int k = 0; k < 6; ++k) pre[k] = ((const f32x4*)(src + (size_t)(nb + 1) * 32 * 384))[tid + 512 * k]; }
        for (int tt = 0; tt < 32; ++tt) { const LAS float* row = buf + tt * 384 + 8 * q;
            const f32x4 r0 = *(const LAS f32x4*)(row), r1 = *(const LAS f32x4*)(row + 4), w0 = *(const LAS f32x4*)(row + 64), w1 = *(const LAS f32x4*)(row + 68), k0 = *(const LAS f32x4*)(row + 128), k1 = *(const LAS f32x4*)(row + 132);
            const f32x4 a0 = *(const LAS f32x4*)(row + 256), a1 = *(const LAS f32x4*)(row + 260), b0 = *(const LAS f32x4*)(row + 320), b1 = *(const LAS f32x4*)(row + 324);
            const float vv = buf[tt * 384 + 192 + 8 * w + r];
            float sa = s[0] * a0[0] + s[1] * a0[1] + s[2] * a0[2] + s[3] * a0[3] + s[4] * a1[0] + s[5] * a1[1] + s[6] * a1[2] + s[7] * a1[3];
            sa += __shfl_xor(sa, 1); sa += __shfl_xor(sa, 2); sa += __shfl_xor(sa, 4);
#pragma unroll
            for (int i = 0; i < 4; ++i) { s[i] = s[i] * w0[i] + sa * b0[i] + vv * k0[i]; s[4 + i] = s[4 + i] * w1[i] + sa * b1[i] + vv * k1[i]; }
            float y = s[0] * r0[0] + s[1] * r0[1] + s[2] * r0[2] + s[3] * r0[3] + s[4] * r1[0] + s[5] * r1[1] + s[6] * r1[2] + s[7] * r1[3];
            y += __shfl_xor(y, 1); y += __shfl_xor(y, 2); y += __shfl_xor(y, 4);
            if (q == 0) ybuf[tt * 64 + 8 * w + r] = y; }
        __syncthreads();
        { const int idx = tid * 4, tt = idx >> 6, v = idx & 63; *(f32x4*)(ydst + (size_t)(b * SEQ + nb * 32 + tt) * RWD + h * 64 + v) = *(const LAS f32x4*)(ybuf + idx); }
    }
}
__device__ __forceinline__ void mlstm_scan(const Ctx& C, int bh) {
    const int tid = C.tid, w = C.wave, lane = C.lane, r = lane >> 3, q = lane & 7; const int b = bh >> 2, hh = bh & 3;
    const float* src = (const float*)(C.ws + WS_MLIN) + (size_t)bh * SEQ * 192; const float* gsrc = (const float*)(C.ws + WS_MLG) + (size_t)bh * SEQ * 2; float* hdst = (float*)(C.ws + WS_MLH);
    LAS float* buf = (LAS float*)C.lds; LAS float* gbuf = buf + 32 * 192; LAS float* hbuf = gbuf + 64;
    float s[8], nv[8]; float m = 0.f;
#pragma unroll
    for (int i = 0; i < 8; ++i) { s[i] = 0.f; nv[i] = 0.f; }
    f32x4 pre[3], preg = (f32x4){0.f, 0.f, 0.f, 0.f};
#pragma unroll
    for (int k = 0; k < 3; ++k) pre[k] = ((const f32x4*)src)[tid + 512 * k];
    if (tid < 16) preg = ((const f32x4*)gsrc)[tid];
    for (int nb = 0; nb < SEQ / 32; ++nb) {
        __syncthreads();
#pragma unroll
        for (int k = 0; k < 3; ++k) ((LAS f32x4*)buf)[tid + 512 * k] = pre[k];
        if (tid < 16) ((LAS f32x4*)gbuf)[tid] = preg;
        __syncthreads();
        if (nb + 1 < SEQ / 32) {
#pragma unroll
            for (int k = 0; k < 3; ++k) pre[k] = ((const f32x4*)(src + (size_t)(nb + 1) * 32 * 192))[tid + 512 * k];
            if (tid < 16) preg = ((const f32x4*)(gsrc + (size_t)(nb + 1) * 64))[tid]; }
        for (int tt = 0; tt < 32; ++tt) { const LAS float* row = buf + tt * 192 + 8 * q;
            const f32x4 q0 = *(const LAS f32x4*)(row), q1 = *(const LAS f32x4*)(row + 4), k0 = *(const LAS f32x4*)(row + 64), k1 = *(const LAS f32x4*)(row + 68);
            const float vv = buf[tt * 192 + 128 + 8 * w + r]; const float ig = gbuf[2 * tt], lf = gbuf[2 * tt + 1];
            const float mn = fmaxf(lf + m, ig); const float fd = __expf(lf + m - mn), iw = __expf(ig - mn); m = mn;
            float num = 0.f, qn = 0.f;
#pragma unroll
            for (int i = 0; i < 4; ++i) { const float ka = iw * k0[i], kb = iw * k1[i];
                s[i] = fd * s[i] + ka * vv; nv[i] = fd * nv[i] + ka; s[4 + i] = fd * s[4 + i] + kb * vv; nv[4 + i] = fd * nv[4 + i] + kb;
                num += q0[i] * s[i] + q1[i] * s[4 + i]; qn += q0[i] * nv[i] + q1[i] * nv[4 + i]; }
            num += __shfl_xor(num, 1); num += __shfl_xor(num, 2); num += __shfl_xor(num, 4);
            qn += __shfl_xor(qn, 1); qn += __shfl_xor(qn, 2); qn += __shfl_xor(qn, 4);
            const float hv = num / fmaxf(fabsf(qn), __expf(-mn));
            if (q == 0) hbuf[tt * 64 + 8 * w + r] = hv; }
        __syncthreads();
        { const int idx = tid * 4, tt = idx >> 6, v = idx & 63; *(f32x4*)(hdst + (size_t)(b * SEQ + nb * 32 + tt) * 256 + hh * 64 + v) = *(const LAS f32x4*)(hbuf + idx); }
    }
}

__device__ __forceinline__ void post_unit(const Params& P, const Ctx& C, int l, int u) {
    const int tok = u * 8 + C.wave, b = tok / SEQ, t = tok % SEQ, lane = C.lane;
    bf16_t* ym = (bf16_t*)(C.ws + WS_YMIX) + (size_t)tok * DM; const float* rwy = (const float*)(C.ws + WS_RWY) + (size_t)tok * RWD; const float* rwg = (const float*)(C.ws + WS_RWG) + (size_t)tok * RWD;
    for (int h = 0; h < 6; ++h) { const int j = h * 64 + lane; const float y = rwy[j];
        const float mean = wave_sum(y) * (1.f / 64.f); const float dd = y - mean; const float var = wave_sum(dd * dd) * (1.f / 64.f);
        const float yn = dd * rsqrtf(var + 64e-5f) * P.in[I_LNW][l * RWD + j] + P.in[I_LNB][l * RWD + j];
        const float* ri = (const float*)(C.ws + WS_RWIN) + ((size_t)(b * 6 + h) * SEQ + t) * 384 + lane;
        const float rr = ri[0], kk = ri[128], vv = ri[192];
        const float dot = wave_sum(rr * kk * P.in[I_RK][l * RWD + j]);
        ym[j] = (bf16_t)f2bf((yn + dot * vv) * rwg[j]); }
    const float* mlh = (const float*)(C.ws + WS_MLH) + (size_t)tok * 256; const bf16_t* prow = (const bf16_t*)(C.ws + WS_P) + (size_t)tok * NPROJ + 2816;
    for (int hh = 0; hh < 4; ++hh) { const int c = hh * 64 + lane; const float hv = mlh[c];
        const float mean = wave_sum(hv) * (1.f / 64.f); const float dd = hv - mean; const float var = wave_sum(dd * dd) * (1.f / 64.f);
        const float hn = dd * rsqrtf(var + 1e-6f) * P.in[I_MLNW][l * 256 + c];
        ym[768 + c] = (bf16_t)f2bf(hn * sigmoidf_(bf2f(prow[c]))); }
}

__device__ __forceinline__ void ln1_router_phase(const Params& P, const Ctx& C, int l) {
    const int tid = C.tid, wave = C.wave, lane = C.lane; const int e = tid & 31, ds = tid >> 5;
    LAS float* htile = (LAS float*)C.lds;
    LAS float* part = htile + 8 * 1024;
    LAS int* lcnt = (LAS int*)(part + 8 * 8 * 32);
    float wr[64];
    { const float* rw = P.in[I_RW] + ((size_t)l * DM + ds * 64) * NEXP + e;
#pragma unroll
      for (int i = 0; i < 64; ++i) wr[i] = rw[i * NEXP]; }
    if (tid < 32) lcnt[tid] = 0;
    { int* pdest = (int*)(C.ws + WS_PDEST); for (int i = C.blk * 512 + tid; i < POS_MAX; i += C.G * 512) pdest[i] = -1; }
    __syncthreads();
    const int tpb = (MTOK + C.G - 1) / C.G, tok_lo = C.blk * tpb, tok_hi = (tok_lo + tpb < MTOK) ? tok_lo + tpb : MTOK;
    const float* t1 = (const float*)(C.ws + WS_T1); float* h1f = (float*)(C.ws + WS_H1F); bf16_t* hb = (bf16_t*)(C.ws + WS_HB);
    int* toke = (int*)(C.ws + WS_TOKE); float* tokg = (float*)(C.ws + WS_TOKG); int* toklr = (int*)(C.ws + WS_TOKLR);
    const f32x4* lw4 = (const f32x4*)(P.in[I_LN1W] + (size_t)l * DM) + lane; const f32x4* lb4 = (const f32x4*)(P.in[I_LN1B] + (size_t)l * DM) + lane;
    for (int base = tok_lo; base < tok_hi; base += 8) {
        const int tok = base + wave;
        if (tok < tok_hi) {
            const f32x4* xr = (const f32x4*)(t1 + (size_t)tok * DM) + lane; f32x4 v[4]; float s = 0.f;
#pragma unroll
            for (int j = 0; j < 4; ++j) { v[j] = xr[64 * j]; s += (v[j][0] + v[j][1]) + (v[j][2] + v[j][3]); }
            const float mean = wave_sum(s) * (1.f / DM); float s2 = 0.f;
#pragma unroll
            for (int j = 0; j < 4; ++j) { v[j] = v[j] - mean; s2 += (v[j][0] * v[j][0] + v[j][1] * v[j][1]) + (v[j][2] * v[j][2] + v[j][3] * v[j][3]); }
            const float rstd = rsqrtf(wave_sum(s2) * (1.f / DM) + LN_EPS);
            f32x4* of = (f32x4*)(h1f + (size_t)tok * DM) + lane; u32x2* ob = (u32x2*)(hb + (size_t)tok * DM) + lane; LAS f32x4* ht = (LAS f32x4*)(htile + wave * 1024) + lane;
#pragma unroll
            for (int j = 0; j < 4; ++j) { const f32x4 y = v[j] * rstd * lw4[64 * j] + lb4[64 * j]; of[64 * j] = y; ob[64 * j] = (u32x2){pk2(y[0], y[1]), pk2(y[2], y[3])}; ht[64 * j] = y; }
        }
        __syncthreads();
#pragma unroll
        for (int tk = 0; tk < 8; ++tk) { float acc = 0.f; const LAS float* hr = htile + tk * 1024 + ds * 64;
#pragma unroll
            for (int i = 0; i < 64; i += 4) { const f32x4 hv = *(const LAS f32x4*)(hr + i); acc += hv[0] * wr[i] + hv[1] * wr[i + 1] + hv[2] * wr[i + 2] + hv[3] * wr[i + 3]; }
            acc += __shfl_xor(acc, 32);
            if (lane < 32) part[(wave * 8 + tk) * 32 + e] = acc; }
        __syncthreads();
        if (tid < 8 && base + tid < tok_hi) { const int tk = tid, tok2 = base + tk;
            float b0 = -__builtin_inff(), b1 = b0, b2 = b0, b3 = b0; int i0 = 0, i1 = 0, i2 = 0, i3 = 0;
            for (int ee = 0; ee < 32; ++ee) { float lg = P.in[I_RB][l * NEXP + ee];
#pragma unroll
                for (int w8 = 0; w8 < 8; ++w8) lg += part[(w8 * 8 + tk) * 32 + ee];
                if (lg > b0) { b3 = b2; i3 = i2; b2 = b1; i2 = i1; b1 = b0; i1 = i0; b0 = lg; i0 = ee; }
                else if (lg > b1) { b3 = b2; i3 = i2; b2 = b1; i2 = i1; b1 = lg; i1 = ee; }
                else if (lg > b2) { b3 = b2; i3 = i2; b2 = lg; i2 = ee; }
                else if (lg > b3) { b3 = lg; i3 = ee; } }
            const float e1 = __expf(b1 - b0), e2 = __expf(b2 - b0), e3 = __expf(b3 - b0); const float inv = 1.0f / (1.0f + e1 + e2 + e3);
            const int l0 = __hip_atomic_fetch_add(&lcnt[i0], 1, __ATOMIC_RELAXED, __HIP_MEMORY_SCOPE_WORKGROUP), l1 = __hip_atomic_fetch_add(&lcnt[i1], 1, __ATOMIC_RELAXED, __HIP_MEMORY_SCOPE_WORKGROUP), l2 = __hip_atomic_fetch_add(&lcnt[i2], 1, __ATOMIC_RELAXED, __HIP_MEMORY_SCOPE_WORKGROUP), l3 = __hip_atomic_fetch_add(&lcnt[i3], 1, __ATOMIC_RELAXED, __HIP_MEMORY_SCOPE_WORKGROUP);
            toke[tok2 * 4 + 0] = i0; toke[tok2 * 4 + 1] = i1; toke[tok2 * 4 + 2] = i2; toke[tok2 * 4 + 3] = i3;
            tokg[tok2 * 4 + 0] = inv; tokg[tok2 * 4 + 1] = e1 * inv; tokg[tok2 * 4 + 2] = e2 * inv; tokg[tok2 * 4 + 3] = e3 * inv;
            toklr[tok2 * 4 + 0] = l0; toklr[tok2 * 4 + 1] = l1; toklr[tok2 * 4 + 2] = l2; toklr[tok2 * 4 + 3] = l3; }
        __syncthreads();
    }
    if (tid < 32) { unsigned* gc = (unsigned*)(C.ws + WS_CTL) + CW_CNT + l * 32 + tid;
        const unsigned bb = __hip_atomic_fetch_add(gc, (unsigned)lcnt[tid], __ATOMIC_RELAXED, __HIP_MEMORY_SCOPE_AGENT);
        ((int*)(C.ws + WS_BBASE))[C.blk * 32 + tid] = (int)bb; }
    __syncthreads();
}
__device__ __forceinline__ void permute_phase(const Params& P, const Ctx& C, int l) {
    const int tid = C.tid, wave = C.wave, lane = C.lane;
    LAS int* pst = (LAS int*)C.lds;
    if (tid == 0) { const unsigned* gc = (const unsigned*)(C.ws + WS_CTL) + CW_CNT + l * 32; int ps = 0;
        for (int e = 0; e < 32; ++e) { pst[e] = ps; ps += ((int)__hip_atomic_load(gc + e, __ATOMIC_RELAXED, __HIP_MEMORY_SCOPE_AGENT) + 255) & ~255; } }
    __syncthreads();
    const int tpb = (MTOK + C.G - 1) / C.G, tok_lo = C.blk * tpb, tok_hi = (tok_lo + tpb < MTOK) ? tok_lo + tpb : MTOK;
    const int* toke = (const int*)(C.ws + WS_TOKE); const float* tokg = (const float*)(C.ws + WS_TOKG); const int* toklr = (const int*)(C.ws + WS_TOKLR); const int* bbase = (const int*)(C.ws + WS_BBASE) + C.blk * 32;
    const bf16_t* hb = (const bf16_t*)(C.ws + WS_HB); bf16_t* xp = (bf16_t*)(C.ws + WS_XPERM); int* pdest = (int*)(C.ws + WS_PDEST); float* pgate = (float*)(C.ws + WS_PGATE);
    for (int a = wave; a < 4 * (tok_hi - tok_lo); a += 8) { const int tok = tok_lo + (a >> 2), as = tok * 4 + (a & 3);
        const int e = toke[as]; const int pos = pst[e] + bbase[e] + toklr[as];
        const u32x4* src = (const u32x4*)(hb + (size_t)tok * DM) + lane; u32x4* dst = (u32x4*)(xp + (size_t)pos * DM) + lane;
        dst[0] = src[0]; dst[64] = src[64];
        if (lane == 0) { pdest[pos] = as; pgate[pos] = tokg[as]; } }
    __syncthreads();
}
__device__ __forceinline__ void build_tile_e(const Ctx& C, int l) {
    LAS int* te = (LAS int*)(C.lds + TILEE_OFF);
    if (C.tid == 0) { const unsigned* gc = (const unsigned*)(C.ws + WS_CTL) + CW_CNT + l * 32; int t = 0;
        for (int e = 0; e < 32; ++e) { const int nt = ((int)__hip_atomic_load(gc + e, __ATOMIC_RELAXED, __HIP_MEMORY_SCOPE_AGENT) + 255) >> 8; for (int k = 0; k < nt && t < NT_MAX; ++k) te[t++] = e; }
        for (; t < NT_MAX; ++t) te[t] = 0; }
    __syncthreads();
}
__device__ __forceinline__ void combine_ln2_phase(const Params& P, const Ctx& C, int l) {
    const int lane = C.lane; const int gw = C.blk * 8 + C.wave, NGW = C.G * 8;
    const bool last = (l == NLAYER - 1);
    float wg[16][8];
    if (!last) load_wg(wg, P.in[I_WIN] + (size_t)(l + 1) * DM * CIN, lane);
    const float* h1f = (const float*)(C.ws + WS_H1F); const bf16_t* yb = (const bf16_t*)(C.ws + WS_YB);
    float* hf = last ? P.out : (float*)(C.ws + WS_HF); bf16_t* hb = (bf16_t*)(C.ws + WS_HB); float* pg = (float*)(C.ws + WS_PG);
    const f32x4* lw4 = (const f32x4*)(P.in[I_LN2W] + (size_t)l * DM) + lane; const f32x4* lb4 = (const f32x4*)(P.in[I_LN2B] + (size_t)l * DM) + lane;
    for (int tok = gw; tok < MTOK; tok += NGW) {
        const f32x4* xr = (const f32x4*)(h1f + (size_t)tok * DM) + lane; f32x4 v[4]; float s = 0.f;
#pragma unroll
        for (int j = 0; j < 4; ++j) v[j] = xr[64 * j] * DN_ALPHA;
#pragma unroll
        for (int sl = 0; sl < 4; ++sl) { const u32x2* yr = (const u32x2*)(yb + (size_t)(tok * 4 + sl) * DM) + lane;
#pragma unroll
            for (int j = 0; j < 4; ++j) { const u32x2 w = yr[64 * j]; v[j][0] += bflo(w[0]); v[j][1] += bfhi(w[0]); v[j][2] += bflo(w[1]); v[j][3] += bfhi(w[1]); } }
#pragma unroll
        for (int j = 0; j < 4; ++j) s += (v[j][0] + v[j][1]) + (v[j][2] + v[j][3]);
        const float mean = wave_sum(s) * (1.f / DM); float s2 = 0.f;
#pragma unroll
        for (int j = 0; j < 4; ++j) { v[j] = v[j] - mean; s2 += (v[j][0] * v[j][0] + v[j][1] * v[j][1]) + (v[j][2] * v[j][2] + v[j][3] * v[j][3]); }
        const float rstd = rsqrtf(wave_sum(s2) * (1.f / DM) + LN_EPS);
        f32x4* of = (f32x4*)(hf + (size_t)tok * DM) + lane;
#pragma unroll
        for (int j = 0; j < 4; ++j) { v[j] = v[j] * rstd * lw4[64 * j] + lb4[64 * j]; of[64 * j] = v[j]; }
        if (!last) { u32x2* ob = (u32x2*)(hb + (size_t)tok * DM) + lane;
#pragma unroll
            for (int j = 0; j < 4; ++j) ob[64 * j] = (u32x2){pk2(v[j][0], v[j][1]), pk2(v[j][2], v[j][3])};
            gate_cols(v, wg, P.in[I_BIN] + (size_t)(l + 1) * CIN + NPROJ, pg + (size_t)tok * 8, lane); }
    }
}

typedef const __attribute__((address_space(4))) Params* CParamsPtr;
__device__ __forceinline__ const Params* kparams() {
    const unsigned long long a = (unsigned long long)__builtin_amdgcn_kernarg_segment_ptr(); unsigned lo = (unsigned)a, hi = (unsigned)(a >> 32);
    asm volatile("" : "+v"(lo), "+v"(hi));
    lo = __builtin_amdgcn_readfirstlane(lo); hi = __builtin_amdgcn_readfirstlane(hi);
    return (const Params*)(CParamsPtr)(((unsigned long long)hi << 32) | lo);
}
__device__ __forceinline__ Ctx make_ctx(const Params& P, LAS unsigned char* lds) {
    Ctx C; C.lds = lds; int t_ = threadIdx.x, b_ = blockIdx.x, g_ = gridDim.x; asm volatile("" : "+v"(t_), "+v"(b_), "+v"(g_)); b_ = __builtin_amdgcn_readfirstlane(b_); g_ = __builtin_amdgcn_readfirstlane(g_);
    C.tid = t_; C.lane = C.tid & 63; C.wave = __builtin_amdgcn_readfirstlane(C.tid >> 6); C.blk = b_; C.G = g_; C.ws = P.ws; return C; }
__global__ void __launch_bounds__(512, 2) hybrid_fwd(Params Punused) {
    extern __shared__ __attribute__((aligned(16))) unsigned char lds_raw[];
    LAS unsigned char* const lds = (LAS unsigned char*)lds_raw;
    volatile LAS unsigned* MISC = (volatile LAS unsigned*)(lds + MISC_OFF);
    for (int u = threadIdx.x; u < (LDS_BYTES - MISC_OFF) / 4; u += 512) MISC[u] = 0u;
    __syncthreads();
    const int lo = __builtin_amdgcn_readfirstlane(kparams()->ph_lo), hi = __builtin_amdgcn_readfirstlane(kparams()->ph_hi);
    if (hi - lo > 1) (void)xcd_barrier_post((unsigned*)(kparams()->ws + WS_CTL) + CW_BAR, MISC + 8);
#ifndef PHMASK
#define PHMASK 0x7ff
#endif
#define PH_EN(k) (((PHMASK) >> (k)) & 1)
#define RUN(gid) ((gid) >= lo && (gid) < hi)
#define SEAM(gid) do { if ((gid) + 1 < hi) { XcdBarrier bar_; bar_.bar = (unsigned*)(kparams()->ws + WS_CTL) + CW_BAR; bar_.x = xb_xcc_id(); bar_.st = (volatile LAS unsigned*)(lds + MISC_OFF) + 8; xcd_barrier(bar_); } } while (0)
#define PHASE_BEGIN const Params& P = *kparams(); const Ctx C = make_ctx(P, lds);
    if (PH_EN(0) && RUN(0)) { { PHASE_BEGIN p0_prologue(P, C); } SEAM(0); }
#pragma unroll 1
    for (int l = 0; l < NLAYER; ++l) {
        const int g0 = 1 + l * NPH;
        if (g0 + NPH <= lo || g0 >= hi) continue;
        if (PH_EN(1) && RUN(g0 + 0)) {
            { PHASE_BEGIN
            pg8::Gemm g{(const bf16_t*)(C.ws + WS_HB), (const bf16_t*)(C.ws + WS_WIN) + (size_t)l * NPROJ * DM, MTOK, NPROJ, DM}; pg8::StaticOrder S; S.init(MTOK, NPROJ, C.G, C.blk);
            pg8::EpiBf16b E{(bf16_t*)(C.ws + WS_P), NPROJ, P.in[I_BIN] + (size_t)l * CIN};
            pg8::gemm_phase<pg8::EpiBf16b, pg8::StaticOrder>(C.lds, g, S, E, nullptr, C.tid); }
            SEAM(g0 + 0); }
        if (PH_EN(2) && RUN(g0 + 1)) {
            { PHASE_BEGIN
            constexpr int NU_SWA = 512, NU_RW = MTOK / 16, NU_ML = MTOK / 16;
            for (int u = C.blk; u < NU_SWA + NU_RW + NU_ML; u += C.G) {
                if (u < NU_SWA) swa_unit(P, C, l, u);
                else if (u < NU_SWA + NU_RW) rwprep_unit(P, C, l, u - NU_SWA);
                else mlprep_unit(P, C, l, u - NU_SWA - NU_RW); } }
            SEAM(g0 + 1); }
        if (PH_EN(3) && RUN(g0 + 2)) {
            { PHASE_BEGIN
            for (int u = C.blk; u < 40; u += C.G) { if (u < 24) rwkv_scan(C, u); else mlstm_scan(C, u - 24); __syncthreads(); } }
            SEAM(g0 + 2); }
        if (PH_EN(4) && RUN(g0 + 3)) {
            { PHASE_BEGIN
            for (int u = C.blk; u < MTOK / 8; u += C.G) post_unit(P, C, l, u); }
            SEAM(g0 + 3); }
        if (PH_EN(5) && RUN(g0 + 4)) {
            { PHASE_BEGIN
            pg8::Gemm g{(const bf16_t*)(C.ws + WS_YMIX), (const bf16_t*)(C.ws + WS_WOUT) + (size_t)l * DM * DM, MTOK, DM, DM}; pg8::StaticOrder S; S.init(MTOK, DM, C.G, C.blk);
            pg8::EpiResF32 E{(float*)(C.ws + WS_T1), (l == 0) ? P.in[I_X] : (const float*)(C.ws + WS_HF), DM, DN_ALPHA};
            pg8::gemm_phase<pg8::EpiResF32, pg8::StaticOrder>(C.lds, g, S, E, nullptr, C.tid); }
            SEAM(g0 + 4); }
        if (PH_EN(6) && RUN(g0 + 5)) { { PHASE_BEGIN ln1_router_phase(P, C, l); } SEAM(g0 + 5); }
        if (PH_EN(7) && RUN(g0 + 6)) { { PHASE_BEGIN permute_phase(P, C, l); } SEAM(g0 + 6); }
        if (PH_EN(8) && RUN(g0 + 7)) {
            { PHASE_BEGIN
            build_tile_e(C, l);
            pg8::Gemm g{(const bf16_t*)(C.ws + WS_XPERM), (const bf16_t*)(C.ws + WS_WUP) + (size_t)l * NEXP * NUP * DM, POS_MAX, NUP, DM};
            pg8::MoeOrder<8> S{(const LAS int*)(C.lds + TILEE_OFF), C.G, C.blk};
            pg8::EpiSwiglu E{(bf16_t*)(C.ws + WS_ACT), P.in[I_EBUP] + (size_t)l * NEXP * NUP};
            pg8::gemm_phase<pg8::EpiSwiglu, pg8::MoeOrder<8>>(C.lds, g, S, E, nullptr, C.tid); }
            SEAM(g0 + 7); }
        if (PH_EN(9) && RUN(g0 + 8)) {
            { PHASE_BEGIN
            build_tile_e(C, l);
            pg8::Gemm g{(const bf16_t*)(C.ws + WS_ACT), (const bf16_t*)(C.ws + WS_WDN) + (size_t)l * NEXP * DM * DEXP, POS_MAX, DM, DEXP};
            pg8::MoeOrder<4> S{(const LAS int*)(C.lds + TILEE_OFF), C.G, C.blk};
            pg8::EpiDown E{(bf16_t*)(C.ws + WS_YB), P.in[I_EBDN] + (size_t)l * NEXP * DM, (const int*)(C.ws + WS_PDEST), (const float*)(C.ws + WS_PGATE)};
            pg8::gemm_phase<pg8::EpiDown, pg8::MoeOrder<4>>(C.lds, g, S, E, nullptr, C.tid); }
            SEAM(g0 + 8); }
        if (PH_EN(10) && RUN(g0 + 9)) { { PHASE_BEGIN combine_ln2_phase(P, C, l); } SEAM(g0 + 9); }
    }
#undef RUN
#undef SEAM
}

#ifndef MK_PER_PHASE
#define MK_PER_PHASE 0
#endif
extern "C" void kernel_launch(void* const* d_in, const int* in_sizes, int n_in, void* d_out, int out_size, void* d_ws, size_t ws_size, hipStream_t stream) {
    static int grid = 0;
    if (grid == 0) {
        if (n_in != 29 || out_size != MTOK * DM || ws_size < WS_END) { fprintf(stderr, "kernel_launch: unexpected shapes (n_in %d out %d ws %zu)\n", n_in, out_size, ws_size); grid = -1; return; }
        int dev = 0, cus = 0;
        if (hipGetDevice(&dev) != hipSuccess || hipDeviceGetAttribute(&cus, hipDeviceAttributeMultiprocessorCount, dev) != hipSuccess) { grid = -1; return; }
        if (hipFuncSetAttribute((const void*)hybrid_fwd, hipFuncAttributeMaxDynamicSharedMemorySize, LDS_BYTES) != hipSuccess) { fprintf(stderr, "kernel_launch: hipFuncSetAttribute failed\n"); grid = -1; return; }
        int per_cu = 0;
        if (hipOccupancyMaxActiveBlocksPerMultiprocessor(&per_cu, (const void*)hybrid_fwd, 512, LDS_BYTES) != hipSuccess || per_cu < 1) { fprintf(stderr, "kernel_launch: occupancy query says %d\n", per_cu); }
        (void)hipGetLastError();
        grid = cus;
    }
    if (grid < 0) return;
    (void)hipMemsetAsync((char*)d_ws + WS_CTL, 0, CTL_ZERO_BYTES, stream);
    Params p; memset(&p, 0, sizeof(p));
    for (int i = 0; i < 29; ++i) p.in[i] = (const float*)d_in[i];
    p.out = (float*)d_out; p.ws = (unsigned char*)d_ws;
#if MK_PER_PHASE
    for (int ph = 0; ph < NPHASE_TOTAL; ++ph) { p.ph_lo = ph; p.ph_hi = ph + 1; hipLaunchKernelGGL(hybrid_fwd, dim3(grid), dim3(512), LDS_BYTES, stream, p); }
#else
    p.ph_lo = 0; p.ph_hi = NPHASE_TOTAL;
    hipLaunchKernelGGL(hybrid_fwd, dim3(grid), dim3(512), LDS_BYTES, stream, p);
#endif
}
```

```cpp
#include <hip/hip_runtime.h>
#include <cstdio>
#include <cstdint>
#include <cstring>

#define GAS __attribute__((address_space(1)))
#define LAS __attribute__((address_space(3)))
typedef float f32x2 __attribute__((ext_vector_type(2)));
typedef unsigned u32x2 __attribute__((ext_vector_type(2)));

namespace pg8 {
constexpr int EPI_BTAB = 140288, EPI_DTAB = 138240, EPI_GTAB = 139264;
#define PG8_LAS __attribute__((address_space(3)))
typedef unsigned short bf16_t;
typedef short bf16x8 __attribute__((ext_vector_type(8)));
typedef float f32x4 __attribute__((ext_vector_type(4)));
typedef unsigned u32x4 __attribute__((ext_vector_type(4)));
constexpr int BM = 256, BK = 64, HALF = 128, HTB = HALF * BK * 2  , STAGE_BYTES = 8 * HTB, NXCD = 8, WGM = 8;

__host__ __device__ __forceinline__ int lds_byte(int r, int c) { const int st = (r >> 4) * 2 + (c >> 5), rr = r & 15, cc = c & 31, ob = rr * 64 + cc * 2; return st * 1024 + (ob ^ (((ob >> 9) & 1) << 5)); }
__host__ __device__ __forceinline__ void stage_rc(int b, int& R, int& C) { const int st = b / 1024, sb = b % 1024, swz = sb ^ (((sb >> 9) & 1) << 5); R = (st >> 1) * 16 + swz / 64; C = (st & 1) * 32 + (swz % 64) / 2; }
__host__ __device__ __forceinline__ int perm32(int rho) { const int n = rho >> 4, i = rho & 15; return 8 * (i >> 2) + 4 * n + (i & 3); }

struct Unit { int pm, pn; };
struct Gemm { const bf16_t* A; const bf16_t* Bt; int M, N, K; };

struct StaticOrder {
    int nM, nN, nwg, G, c;
    __host__ __device__ void init(int M, int N, int G_, int c_) { nM = M / BM; nN = N / BM; nwg = nM * nN; G = G_; c = c_; }
    __host__ __device__ bool next(int i, Unit& u) const {
        const long L = (long)i * G + c; if (L >= nwg) return false;
        int wgid = (int)L; { const int q = nwg / NXCD, r = nwg % NXCD, xcd = wgid % NXCD, off = wgid / NXCD; wgid = (xcd < r ? xcd * (q + 1) : r * (q + 1) + (xcd - r) * q) + off; }
        const int nig = WGM * nN, gid = wgid / nig, fm = gid * WGM, gsz = (nM - fm) < WGM ? (nM - fm) : WGM;
        u.pm = fm + ((wgid % nig) % gsz); u.pn = (wgid % nig) / gsz; return true;
    }
    __device__ __forceinline__ void a_ready(const Unit&) const {}
    __device__ __forceinline__ void done(const Unit&) const {}
};
template <int NN> struct MoeOrder {
    const PG8_LAS int* tile_e; int G, c; const int* rowtok;
    __device__ __forceinline__ bool next(int i, Unit& u) const {
        const int s = i * G + c; if (s >= 544 * NN) return false;
        constexpr int per = 8 * NN; const int a = s / per, r = s % per, b = r >> 3, x = r & 7;
        const int pm = 68 * x + a; u.pm = pm; u.pn = tile_e[pm] * NN + b; return true;
    }
    __device__ __forceinline__ void a_ready(const Unit&) const {}
    __device__ __forceinline__ void done(const Unit&) const {}
};

__device__ __forceinline__ unsigned cvt_pk_bf16(float lo, float hi) { unsigned r; asm volatile("v_cvt_pk_bf16_f32 %0, %1, %2" : "=v"(r) : "v"(lo), "v"(hi)); return r; }

struct EpiBf16b {
    static constexpr bool PERM = true, AFTER_DRAIN = false;
    bf16_t* O; int ldc; const float* bias;
    __device__ __forceinline__ void prefetch(PG8_LAS unsigned char* lds, const Unit& u, int wid, int lane) const {
        if (wid < 4) __builtin_amdgcn_global_load_lds((const unsigned*)(bias + u.pn * BM + 64 * wid + lane), (PG8_LAS unsigned*)(lds + EPI_BTAB + wid * 256), 4, 0, 0); }
    __device__ __forceinline__ void operator()(const f32x4 (&acc)[2][2][4][2], const Unit& u, int wr, int wc, int fr, int fq, PG8_LAS unsigned char* lds) const {
        const int row0 = u.pm * BM + wr * 64 + fr; const int col0 = u.pn * BM + wc * 32 + 8 * fq;
        const PG8_LAS float* bt = (const PG8_LAS float*)(lds + EPI_BTAB) + wc * 32 + 8 * fq;
        f32x4 bv[2][2];
#pragma unroll
        for (int bj = 0; bj < 2; ++bj)
#pragma unroll
            for (int n = 0; n < 2; ++n) bv[bj][n] = *(const PG8_LAS f32x4*)(bt + bj * HALF + 4 * n);
#pragma unroll
        for (int ai = 0; ai < 2; ++ai)
#pragma unroll
            for (int m = 0; m < 4; ++m) { bf16_t* rowp = O + (size_t)(row0 + ai * HALF + m * 16) * ldc + col0;
#pragma unroll
                for (int bj = 0; bj < 2; ++bj) { const f32x4 v0 = acc[ai][bj][m][0] + bv[bj][0], v1 = acc[ai][bj][m][1] + bv[bj][1];
                    u32x4 w; w.x = cvt_pk_bf16(v0[0], v0[1]); w.y = cvt_pk_bf16(v0[2], v0[3]); w.z = cvt_pk_bf16(v1[0], v1[1]); w.w = cvt_pk_bf16(v1[2], v1[3]);
                    *(u32x4*)(rowp + bj * HALF) = w; } }
    }
};
struct EpiPlainBf16 {
    static constexpr bool PERM = true, AFTER_DRAIN = false;
    bf16_t* O; int ldc;
    __device__ __forceinline__ void prefetch(PG8_LAS unsigned char*, const Unit&, int, int) const {}
    __device__ __forceinline__ void operator()(const f32x4 (&acc)[2][2][4][2], const Unit& u, int wr, int wc, int fr, int fq, PG8_LAS unsigned char*) const {
        const int row0 = u.pm * BM + wr * 64 + fr, col0 = u.pn * BM + wc * 32 + 8 * fq;
#pragma unroll
        for (int ai = 0; ai < 2; ++ai)
#pragma unroll
            for (int m = 0; m < 4; ++m) { bf16_t* rowp = O + (size_t)(row0 + ai * HALF + m * 16) * ldc + col0;
#pragma unroll
                for (int bj = 0; bj < 2; ++bj) { const f32x4 v0 = acc[ai][bj][m][0], v1 = acc[ai][bj][m][1];
                    u32x4 w; w.x = cvt_pk_bf16(v0[0], v0[1]); w.y = cvt_pk_bf16(v0[2], v0[3]); w.z = cvt_pk_bf16(v1[0], v1[1]); w.w = cvt_pk_bf16(v1[2], v1[3]);
                    *(u32x4*)(rowp + bj * HALF) = w; } }
    }
};
struct EpiSwiglu {
    static constexpr bool PERM = true, AFTER_DRAIN = false;
    bf16_t* O; const float* bias;
    __device__ __forceinline__ void prefetch(PG8_LAS unsigned char* lds, const Unit& u, int wid, int lane) const {
        if (wid < 4) __builtin_amdgcn_global_load_lds((const unsigned*)(bias + u.pn * BM + 64 * wid + lane), (PG8_LAS unsigned*)(lds + EPI_BTAB + wid * 256), 4, 0, 0); }
    __device__ __forceinline__ void operator()(const f32x4 (&acc)[2][2][4][2], const Unit& u, int wr, int wc, int fr, int fq, PG8_LAS unsigned char* lds) const {
        const int row0 = u.pm * BM + wr * 64 + fr;
        const int ocol0 = ((u.pn & 7) * BM + wc * 32 + 8 * fq) >> 1;
        const PG8_LAS float* bt = (const PG8_LAS float*)(lds + EPI_BTAB) + wc * 32 + 8 * fq;
        f32x4 bv[2][2];
#pragma unroll
        for (int bj = 0; bj < 2; ++bj)
#pragma unroll
            for (int n = 0; n < 2; ++n) bv[bj][n] = *(const PG8_LAS f32x4*)(bt + bj * HALF + 4 * n);
#pragma unroll
        for (int ai = 0; ai < 2; ++ai)
#pragma unroll
            for (int m = 0; m < 4; ++m) { bf16_t* rowp = O + (size_t)(row0 + ai * HALF + m * 16) * 1024 + ocol0;
#pragma unroll
                for (int bj = 0; bj < 2; ++bj) { const f32x4 v0 = acc[ai][bj][m][0] + bv[bj][0], v1 = acc[ai][bj][m][1] + bv[bj][1];
                    float o[4];
#pragma unroll
                    for (int q = 0; q < 4; ++q) { const float gl = (q < 2) ? v0[2 * q] : v1[2 * q - 4], li = (q < 2) ? v0[2 * q + 1] : v1[2 * q - 3];
                        const float hg = fminf(gl, 7.0f), hl = fminf(fmaxf(li, -7.0f), 7.0f);
                        o[q] = hg * (hl + 1.0f) * __builtin_amdgcn_rcpf(1.0f + __expf(-1.702f * hg)); }
                    u32x2 w; w.x = cvt_pk_bf16(o[0], o[1]); w.y = cvt_pk_bf16(o[2], o[3]);
                    *(u32x2*)(rowp + bj * (HALF / 2)) = w; } }
    }
};
struct EpiDown {
    static constexpr bool PERM = true, AFTER_DRAIN = false;
    bf16_t* O; const float* bias; const int* dest; const float* gate;
    __device__ __forceinline__ void prefetch(PG8_LAS unsigned char* lds, const Unit& u, int wid, int lane) const {
        if (wid < 4) { __builtin_amdgcn_global_load_lds((const unsigned*)(bias + u.pn * BM + 64 * wid + lane), (PG8_LAS unsigned*)(lds + EPI_BTAB + wid * 256), 4, 0, 0);
                       __builtin_amdgcn_global_load_lds((const unsigned*)(dest + u.pm * BM + 64 * wid + lane), (PG8_LAS unsigned*)(lds + EPI_DTAB + wid * 256), 4, 0, 0); }
        else __builtin_amdgcn_global_load_lds((const unsigned*)(gate + u.pm * BM + 64 * (wid - 4) + lane), (PG8_LAS unsigned*)(lds + EPI_GTAB + (wid - 4) * 256), 4, 0, 0); }
    __device__ __forceinline__ void operator()(const f32x4 (&acc)[2][2][4][2], const Unit& u, int wr, int wc, int fr, int fq, PG8_LAS unsigned char* lds) const {
        const int rloc = wr * 64 + fr;
        const int ocol0 = (u.pn & 3) * BM + wc * 32 + 8 * fq;
        const PG8_LAS float* bt = (const PG8_LAS float*)(lds + EPI_BTAB) + wc * 32 + 8 * fq; const PG8_LAS int* dt = (const PG8_LAS int*)(lds + EPI_DTAB); const PG8_LAS float* gtb = (const PG8_LAS float*)(lds + EPI_GTAB);
#pragma unroll
        for (int ai = 0; ai < 2; ++ai)
#pragma unroll
            for (int m = 0; m < 4; ++m) { const int pl = rloc + ai * HALF + m * 16; const int d = dt[pl]; const float gt = gtb[pl];
                if (d >= 0) { bf16_t* rowp = O + (size_t)d * 1024 + ocol0;
#pragma unroll
                    for (int bj = 0; bj < 2; ++bj) { const f32x4 b0 = *(const PG8_LAS f32x4*)(bt + bj * HALF), b1 = *(const PG8_LAS f32x4*)(bt + bj * HALF + 4); const f32x4 v0 = (acc[ai][bj][m][0] + b0) * gt, v1 = (acc[ai][bj][m][1] + b1) * gt;
                        u32x4 w; w.x = cvt_pk_bf16(v0[0], v0[1]); w.y = cvt_pk_bf16(v0[2], v0[3]); w.z = cvt_pk_bf16(v1[0], v1[1]); w.w = cvt_pk_bf16(v1[2], v1[3]);
                        *(u32x4*)(rowp + bj * HALF) = w; } } }
    }
};

template <class Epi, class Sched, bool STAMP = false, bool GATHER = false>
__device__ __forceinline__ void gemm_phase(PG8_LAS unsigned char* lds, const Gemm g, const Sched& S, const Epi& E, unsigned long long* stamps, const int tid_in) {
    const int tid = tid_in, wid = __builtin_amdgcn_readfirstlane(tid >> 6), lane = tid & 63, wr = wid >> 2, wc = wid & 3, fr = lane & 15, fq = lane >> 4;
    const int K = g.K, nt = K / BK;
    int ts_lo = 0, ts_hi = 0, nts = 0; const unsigned long long rt_entry = STAMP ? (unsigned long long)wall_clock64() : 0ull;
#define PG8_STAMP() do { if (STAMP && wid == 0 && nts < 64) { const unsigned long long _c = (unsigned long long)clock64(); \
        ts_lo = (lane == nts) ? (int)(unsigned)_c : ts_lo; ts_hi = (lane == nts) ? (int)(unsigned)(_c >> 32) : ts_hi; ++nts; } } while (0)
    PG8_STAMP();
    unsigned voffA[2], voffB[2];
#pragma unroll
    for (int i = 0; i < 2; ++i) { int R, C; stage_rc(tid * 16 + i * 8192, R, C); const int Rb = Epi::PERM ? ((R & ~31) + perm32(R & 31)) : R;
        voffA[i] = (unsigned)(R * K + C) * 2u; voffB[i] = (unsigned)(Rb * K + C) * 2u; }
    unsigned gc[2][2], gn[2][2];
    PG8_LAS int* rowtab = (PG8_LAS int*)(lds + 137216);
    const size_t kstep = (size_t)(BK * 2);
    const size_t hstep = (size_t)HALF * K * 2;
    const size_t tstep = 2 * hstep;
    const unsigned ldsw = (unsigned)wid * 1024u;
    const int aoff = lds_byte(wr * 64 + fr, fq * 8), boff = lds_byte(wc * 32 + fr, fq * 8);
#define PG8_SA(b, h) (((b) * 2 + (h)) * HTB)
#define PG8_SB(b, h) ((4 + (b) * 2 + (h)) * HTB)
#define PG8_STAGE(bufoff, gbase, voff) do { _Pragma("unroll") for (int _i = 0; _i < 2; ++_i) \
        __builtin_amdgcn_global_load_lds((const unsigned*)((const char*)(gbase) + (voff)[_i]), (PG8_LAS unsigned*)(lds + (bufoff) + ldsw + _i * 8192), 16, 0, 0); } while (0)
#define PG8_LDA(dst, b, h) do { _Pragma("unroll") for (int m = 0; m < 4; ++m) _Pragma("unroll") for (int k = 0; k < 2; ++k) dst[m][k] = *(const PG8_LAS bf16x8*)(lds + PG8_SA(b, h) + aoff + m * 2048 + k * 1024); } while (0)
#define PG8_LDB(dst, b, h) do { _Pragma("unroll") for (int n = 0; n < 2; ++n) _Pragma("unroll") for (int k = 0; k < 2; ++k) dst[n][k] = *(const PG8_LAS bf16x8*)(lds + PG8_SB(b, h) + boff + n * 2048 + k * 1024); } while (0)
#define PG8_MMA(ai, bj, At, Bt) do { __builtin_amdgcn_s_setprio(1); _Pragma("unroll") for (int m = 0; m < 4; ++m) _Pragma("unroll") for (int n = 0; n < 2; ++n) _Pragma("unroll") for (int k = 0; k < 2; ++k) \
        acc[ai][bj][m][n] = __builtin_amdgcn_mfma_f32_16x16x32_bf16(Bt[n][k], At[m][k], acc[ai][bj][m][n], 0, 0, 0); __builtin_amdgcn_s_setprio(0); } while (0)
#define PG8_WAIT_V(n) asm volatile("s_waitcnt vmcnt(" #n ")" ::: "memory")
#define PG8_WAIT_L(n) asm volatile("s_waitcnt lgkmcnt(" #n ")" ::: "memory")
#define PG8_BAR __builtin_amdgcn_s_barrier()
#define PG8_SCHED __builtin_amdgcn_sched_barrier(0)
    Unit cur, nxt; int ui = 0;
    if (!S.next(0, cur)) return;
    f32x4 acc[2][2][4][2];
#pragma unroll
    for (int a = 0; a < 2; ++a)
#pragma unroll
        for (int b = 0; b < 2; ++b)
#pragma unroll
            for (int m = 0; m < 4; ++m)
#pragma unroll
                for (int n = 0; n < 2; ++n) acc[a][b][m][n] = (f32x4){0.f, 0.f, 0.f, 0.f};
    bf16x8 At[4][2], B0[2][2], B1[2][2];
    const char* cA = GATHER ? (const char*)g.A : (const char*)g.A + (size_t)cur.pm * tstep; const char* cB = (const char*)g.Bt + (size_t)cur.pn * tstep;
    if constexpr (GATHER) {
#pragma unroll
        for (int h = 0; h < 2; ++h)
#pragma unroll
            for (int i = 0; i < 2; ++i) { int R, C; stage_rc(tid * 16 + i * 8192, R, C); gc[h][i] = (unsigned)S.rowtok[256 * cur.pm + 128 * h + R] * (unsigned)(K * 2) + (unsigned)(C * 2); gn[h][i] = gc[h][i]; } }
    S.a_ready(cur);
    PG8_STAGE(PG8_SB(0, 0), cB, voffB); if constexpr (GATHER) PG8_STAGE(PG8_SA(0, 0), cA, gc[0]); else PG8_STAGE(PG8_SA(0, 0), cA, voffA); PG8_STAGE(PG8_SB(0, 1), cB + hstep, voffB); if constexpr (GATHER) PG8_STAGE(PG8_SA(0, 1), cA, gc[1]); else PG8_STAGE(PG8_SA(0, 1), cA + hstep, voffA);
    if (wr == 1) PG8_BAR;
    PG8_WAIT_V(4); PG8_BAR;
    PG8_STAGE(PG8_SB(1, 0), cB + kstep, voffB); if constexpr (GATHER) PG8_STAGE(PG8_SA(1, 0), cA + kstep, gc[0]); else PG8_STAGE(PG8_SA(1, 0), cA + kstep, voffA); PG8_STAGE(PG8_SB(1, 1), cB + hstep + kstep, voffB);
    PG8_WAIT_V(6); PG8_BAR;
    PG8_STAMP();
    for (;;) {
        const bool has_next = S.next(ui + 1, nxt);
        const char* nA = GATHER ? cA : (has_next ? (const char*)g.A + (size_t)nxt.pm * tstep : cA); const char* nB = has_next ? (const char*)g.Bt + (size_t)nxt.pn * tstep : cB;
        for (int t = 0; t < nt; t += 2) {
            const bool last = (t == nt - 2);
            const char* a1 = cA + (size_t)(t + 1) * kstep;
            const char* a2 = last ? nA : cA + (size_t)(t + 2) * kstep; const char* b2 = last ? nB : cB + (size_t)(t + 2) * kstep;
            const char* a3 = a2 + kstep; const char* b3 = b2 + kstep;
            if (last && has_next) S.a_ready(nxt);
            if (t == nt - 4) { int ln_ = lane; asm volatile("" : "+v"(ln_)); E.prefetch(lds, cur, wid, ln_); }
            if constexpr (GATHER) {
                if (t == nt - 4 && has_next && wid < 4)
                    __builtin_amdgcn_global_load_lds((const unsigned*)(S.rowtok + 256 * nxt.pm + 64 * wid + lane), (PG8_LAS unsigned*)((PG8_LAS unsigned char*)rowtab + wid * 256), 4, 0, 0);
                if (last && has_next) { int tz = tid; asm volatile("" : "+v"(tz));
#pragma unroll
                    for (int h = 0; h < 2; ++h)
#pragma unroll
                        for (int i = 0; i < 2; ++i) { int R, C; stage_rc(tz * 16 + i * 8192, R, C); gn[h][i] = (unsigned)rowtab[128 * h + R] * (unsigned)(K * 2) + (unsigned)(C * 2); } } }
            unsigned g0x[2], g1x[2];
#pragma unroll
            for (int i = 0; i < 2; ++i) { g0x[i] = last ? gn[0][i] : gc[0][i]; g1x[i] = last ? gn[1][i] : gc[1][i]; }
            PG8_LDB(B0, 0, 0); PG8_SCHED; PG8_LDA(At, 0, 0); if constexpr (GATHER) PG8_STAGE(PG8_SA(1, 1), a1, gc[1]); else PG8_STAGE(PG8_SA(1, 1), a1 + hstep, voffA);
            PG8_WAIT_L(8); PG8_BAR; PG8_WAIT_L(0); PG8_MMA(0, 0, At, B0); PG8_BAR; PG8_SCHED;
            PG8_LDB(B1, 0, 1); PG8_STAGE(PG8_SB(0, 0), b2, voffB);
            PG8_BAR; PG8_WAIT_L(0); PG8_MMA(0, 1, At, B1); PG8_BAR;
            PG8_LDA(At, 0, 1); if constexpr (GATHER) PG8_STAGE(PG8_SA(0, 0), a2, g0x); else PG8_STAGE(PG8_SA(0, 0), a2, voffA);
            PG8_BAR; PG8_WAIT_L(0); PG8_MMA(1, 0, At, B0); PG8_BAR; PG8_SCHED;
            PG8_STAGE(PG8_SB(0, 1), b2 + hstep, voffB);
            PG8_WAIT_V(6); PG8_BAR; PG8_MMA(1, 1, At, B1); PG8_BAR;
            PG8_LDB(B0, 1, 0); PG8_SCHED; PG8_LDA(At, 1, 0); if constexpr (GATHER) PG8_STAGE(PG8_SA(0, 1), a2, g1x); else PG8_STAGE(PG8_SA(0, 1), a2 + hstep, voffA);
            PG8_WAIT_L(8); PG8_BAR; PG8_WAIT_L(0); PG8_MMA(0, 0, At, B0); PG8_BAR; PG8_SCHED;
            PG8_LDB(B1, 1, 1); PG8_STAGE(PG8_SB(1, 0), b3, voffB);
            PG8_BAR; PG8_WAIT_L(0); PG8_MMA(0, 1, At, B1); PG8_BAR;
            PG8_LDA(At, 1, 1); if constexpr (GATHER) PG8_STAGE(PG8_SA(1, 0), a3, g0x); else PG8_STAGE(PG8_SA(1, 0), a3, voffA);
            PG8_BAR; PG8_WAIT_L(0); PG8_MMA(1, 0, At, B0); PG8_BAR; PG8_SCHED;
            PG8_STAGE(PG8_SB(1, 1), b3 + hstep, voffB);
            PG8_WAIT_V(6); PG8_BAR; PG8_MMA(1, 1, At, B1); PG8_BAR;
        }
        PG8_STAMP();
        if constexpr (!Epi::AFTER_DRAIN) { E(acc, cur, wr, wc, fr, fq, lds); S.done(cur); }
        PG8_STAMP();
        if (!has_next) break;
#pragma unroll
        for (int a = 0; a < 2; ++a)
#pragma unroll
            for (int b = 0; b < 2; ++b)
#pragma unroll
                for (int m = 0; m < 4; ++m)
#pragma unroll
                    for (int n = 0; n < 2; ++n) acc[a][b][m][n] = (f32x4){0.f, 0.f, 0.f, 0.f};
        cur = nxt; cA = nA; cB = nB; ++ui;
        if constexpr (GATHER) {
#pragma unroll
            for (int h = 0; h < 2; ++h)
#pragma unroll
                for (int i = 0; i < 2; ++i) gc[h][i] = gn[h][i]; }
    }
    PG8_WAIT_V(0);
    if (wr == 0) PG8_BAR;
    PG8_BAR;
    if constexpr (Epi::AFTER_DRAIN) { E.fused(acc, cur, wr, wc, fr, fq, lds, wid, lane); S.done(cur); }
    PG8_STAMP();
    if (STAMP && wid == 0) { stamps[lane] = lane < nts ? (((unsigned long long)(unsigned)ts_hi << 32) | (unsigned)ts_lo) : 0ull;
        if (lane == 62) stamps[62] = rt_entry; if (lane == 63) stamps[63] = (unsigned long long)wall_clock64(); }
#undef PG8_STAMP
#undef PG8_SA
#undef PG8_SB
#undef PG8_STAGE
#undef PG8_LDA
#undef PG8_LDB
#undef PG8_MMA
#undef PG8_WAIT_V
#undef PG8_WAIT_L
#undef PG8_BAR
#undef PG8_SCHED
}
}
using pg8::bf16_t; using pg8::bf16x8; using pg8::f32x4; using pg8::u32x4;

constexpr int NB = 4, SEQ = 8192, MTOK = NB * SEQ, DM = 1024, NLAYER = 4, CIN = 3080, NPROJ = 3072, NEXP = 32, DEXP = 1024, NUP = 2048;
constexpr int RWD = 384, RW_COLS = 1408;
constexpr int NT_MAX = 544, POS_MAX = NT_MAX * 256;
constexpr float DN_ALPHA = 1.6817928305074290861f;
constexpr float LN_EPS = 1e-5f;
constexpr int NPH = 10;
constexpr int NPHASE_TOTAL = 1 + NLAYER * NPH;

constexpr size_t MiB = 1u << 20;
constexpr size_t WS_CTL = 0, CTL_ZERO_BYTES = 65536;
constexpr size_t WS_WIN = 1 * MiB;
constexpr size_t WS_WOUT = 25 * MiB;
constexpr size_t WS_WUP = 33 * MiB;
constexpr size_t WS_WDN = 545 * MiB;
constexpr size_t WS_ROPE = 801 * MiB;
constexpr size_t WS_HB = 803 * MiB;
constexpr size_t WS_HF = 867 * MiB;
constexpr size_t WS_H1F = 995 * MiB;
constexpr size_t WS_T1 = 1123 * MiB;
constexpr size_t WS_P = 1251 * MiB;
constexpr size_t WS_PG = 1443 * MiB;
constexpr size_t WS_YMIX = 1444 * MiB;
constexpr size_t WS_RWM = 1508 * MiB;
constexpr size_t WS_RWNT = 1532 * MiB;
constexpr size_t WS_RWQH = 1580 * MiB;
constexpr size_t WS_RWYL = 1604 * MiB;
constexpr size_t WS_RWS = 1652 * MiB;
constexpr size_t WS_RWAUX = 1676 * MiB;
constexpr size_t WS_MLQ = 1724 * MiB;
constexpr size_t WS_MLNL = 1740 * MiB;
constexpr size_t WS_MLVEC = 1780 * MiB;
constexpr size_t WS_MLSC = 1781 * MiB;
constexpr size_t WS_MLKL = 1782 * MiB;
constexpr size_t WS_MLCT = 1822 * MiB;
constexpr size_t WS_MLM = 1842 * MiB;
constexpr size_t WS_WUPT = 1843 * MiB;
constexpr size_t WS_AUPT = 1843 * MiB + 256 * 1024;
constexpr size_t WS_GUPT = 1843 * MiB + 512 * 1024;
constexpr size_t WS_WRH = 1844 * MiB;
constexpr size_t WS_WRL = 1844 * MiB + 256 * 1024;
constexpr size_t WS_XPERM = 2021 * MiB;
constexpr size_t WS_ACT = 2293 * MiB;
constexpr size_t WS_YB = 2565 * MiB;
constexpr size_t WS_TOKE = 2821 * MiB;
constexpr size_t WS_TOKG = 2822 * MiB;
constexpr size_t WS_TOKLR = 2823 * MiB;
constexpr size_t WS_PDEST = 2824 * MiB;
constexpr size_t WS_PGATE = 2825 * MiB;
constexpr size_t WS_BBASE = 2826 * MiB;
constexpr size_t WS_PTOK = 2827 * MiB;
constexpr size_t WS_END = 2828 * MiB;
constexpr int CW_CNT = 1024;
constexpr int CW_SWAQ = 2048;
constexpr int CW_BAR = 4096;
constexpr int LDS_BYTES = 147456;
constexpr int MISC_OFF = 143360;
constexpr int TILEE_OFF = 133120;

#define LDS_WAIT() asm volatile("s_waitcnt lgkmcnt(0)" ::: "memory")
#define LDS_BARRIER() do { asm volatile("s_waitcnt lgkmcnt(0)" ::: "memory"); __builtin_amdgcn_s_barrier(); asm volatile("" ::: "memory"); } while (0)
#define VM_WAIT() asm volatile("s_waitcnt vmcnt(0)" ::: "memory")
__device__ __forceinline__ unsigned f2bf(float f) { unsigned u = __builtin_bit_cast(unsigned, f); return (u + 0x7fffu + ((u >> 16) & 1u)) >> 16; }
typedef __bf16 bf16v2_t __attribute__((ext_vector_type(2)));
__device__ __forceinline__ unsigned pk2(float lo, float hi) { const f32x2 v = (f32x2){lo, hi}; return __builtin_bit_cast(unsigned, __builtin_convertvector(v, bf16v2_t)); }
__device__ __forceinline__ float bf2f(unsigned short b) { return __builtin_bit_cast(float, ((unsigned)b) << 16); }
__device__ __forceinline__ float bflo(unsigned w) { return __builtin_bit_cast(float, w << 16); }
__device__ __forceinline__ float bfhi(unsigned w) { return __builtin_bit_cast(float, w & 0xffff0000u); }
template <int CTRL, int RMASK> __device__ __forceinline__ float dpp_add(float v) { return v + __builtin_bit_cast(float, __builtin_amdgcn_update_dpp(0, __builtin_bit_cast(int, v), CTRL, RMASK, 0xF, false)); }
__device__ __forceinline__ float wave_sum(float v) {
    v = dpp_add<0xB1, 0xF>(v); v = dpp_add<0x4E, 0xF>(v); v = dpp_add<0x141, 0xF>(v); v = dpp_add<0x140, 0xF>(v);
    v = dpp_add<0x142, 0xA>(v); v = dpp_add<0x143, 0xC>(v);
    return __builtin_bit_cast(float, __builtin_amdgcn_readlane(__builtin_bit_cast(int, v), 63));
}
template <int CTRL> __device__ __forceinline__ float dpp_mov(float x) { return __builtin_bit_cast(float, __builtin_amdgcn_update_dpp(0, __builtin_bit_cast(int, x), CTRL, 0xF, 0xF, true)); }
__device__ __forceinline__ float sum8(float x) { x += dpp_mov<0xB1>(x); x += dpp_mov<0x4E>(x); x += dpp_mov<0x141>(x); return x; }
__device__ __forceinline__ float sigmoidf_(float x) { return __builtin_amdgcn_rcpf(1.0f + __expf(-x)); }

#define XB_TMO      128
#define XB_XCNT(j)  (256  + 64 * (j))
#define XB_XSUB(j)  (1280 + 64 * (j))
#define XB_XGEN(j)  (2304 + 64 * (j))
#define XB_TOP      3328
#define XB_TOPGEN   3392
#define XCD_BAR_WORDS 3456
#define XB_SPIN_CAP (1u << 22)
__device__ __forceinline__ unsigned xb_ld(unsigned* p)              { return __hip_atomic_load(p, __ATOMIC_RELAXED, __HIP_MEMORY_SCOPE_AGENT); }
__device__ __forceinline__ unsigned xb_add(unsigned* p, unsigned v) { return __hip_atomic_fetch_add(p, v, __ATOMIC_RELAXED, __HIP_MEMORY_SCOPE_AGENT); }
__device__ __forceinline__ unsigned xb_xcc_id() { return (unsigned)__builtin_amdgcn_s_getreg((3 << 11) | 20) & 0xFu; }
#define XB_SPIN(cond, bar) do { unsigned _sp = 0; while (cond) { __builtin_amdgcn_s_sleep(1); \
    if ((++_sp & 255u) == 0u) { if (xb_ld(&(bar)[XB_TMO])) break; if (_sp > XB_SPIN_CAP) { atomicAdd(&(bar)[XB_TMO], 1u); break; } } } } while (0)

struct XcdBarrier {
    unsigned* bar; unsigned x;
    volatile LAS unsigned* st;
};

__device__ __forceinline__ XcdBarrier xcd_barrier_post(unsigned* bar, volatile LAS unsigned* st, bool t0  ) {
    XcdBarrier b; b.bar = bar; b.x = xb_xcc_id(); b.st = st;
    if (t0) (void)xb_add(&bar[XB_XCNT(b.x)], 1u);
    return b;
}
__device__ __forceinline__ void xcd_barrier_complete(unsigned* bar, unsigned x, unsigned& nloc, unsigned& nx) {
    const unsigned G = gridDim.x * gridDim.y * gridDim.z;
    unsigned sum, cnt, mine, sp = 0u;
    for (;;) {
        sum = 0u; cnt = 0u; mine = 0u;
#pragma unroll
        for (unsigned j = 0; j < 16; ++j) { const unsigned c = xb_ld(&bar[XB_XCNT(j)]); sum += c; cnt += (c > 0u) ? 1u : 0u; mine = (j == x) ? c : mine; }
        if (sum == G) break;
        __builtin_amdgcn_s_sleep(1);
        if ((++sp & 255u) == 0u) { if (xb_ld(&bar[XB_TMO])) break; if (sp > XB_SPIN_CAP) { atomicAdd(&bar[XB_TMO], 1u); break; } }
    }
    nloc = mine > 0u ? mine : 1u; nx = cnt > 0u ? cnt : 1u;
}

__device__ __forceinline__ void xcd_barrier(const XcdBarrier& b, bool t0  ) {
    asm volatile("s_waitcnt vmcnt(0)" ::: "memory");
    __syncthreads();
    if (t0) {
        unsigned* bar = b.bar;
        __builtin_amdgcn_s_waitcnt(0);
        unsigned nloc = b.st[0], nx = b.st[1];
        if (nloc == 0u) { xcd_barrier_complete(bar, b.x, nloc, nx); b.st[0] = nloc; b.st[1] = nx; }
        const unsigned old = xb_add(&bar[XB_XSUB(b.x)], 1u);
        const unsigned gen = old / nloc;
        if (old + 1u == (gen + 1u) * nloc) {
            __builtin_amdgcn_fence(__ATOMIC_RELEASE, "agent");
            asm volatile("s_waitcnt vmcnt(0)" ::: "memory");
            const unsigned og = xb_add(&bar[XB_TOP], 1u);
            const unsigned tg = og / nx;
            if (og + 1u == (tg + 1u) * nx) xb_add(&bar[XB_TOPGEN], 1u);
            else XB_SPIN(xb_ld(&bar[XB_TOPGEN]) == tg, bar);
            __builtin_amdgcn_fence(__ATOMIC_ACQUIRE, "agent");
            xb_add(&bar[XB_XGEN(b.x)], 1u);
            asm volatile("s_waitcnt vmcnt(0)" ::: "memory");
        } else {
            XB_SPIN(xb_ld(&bar[XB_XGEN(b.x)]) == gen, bar);
            __builtin_amdgcn_fence(__ATOMIC_ACQUIRE, "agent");
            asm volatile("s_waitcnt vmcnt(0)" ::: "memory");
        }
    }
    __syncthreads();
}
struct Params {
    const float* in[29];
    float* out; unsigned char* ws;
    int ph_lo, ph_hi;
    int pad0, pad1;
};
enum { I_X = 0, I_WIN, I_BIN, I_MU, I_WUP, I_W0, I_AUP, I_A0, I_GUP, I_KK, I_KA, I_RK, I_LNW, I_LNB, I_SINK, I_CONVW, I_CONVB, I_MLNW, I_WOUT,
       I_LN1W, I_LN1B, I_RW, I_RB, I_EWUP, I_EBUP, I_EWDN, I_EBDN, I_LN2W, I_LN2B };

struct Ctx {
    LAS unsigned char* lds; int tid, lane, wave, blk, G;
    unsigned char* ws;
};

__device__ __forceinline__ void tr_item(const float* W, int ldw, int K, bf16_t* WT, LAS float* scr, int kb, int nb, int lane) {
    const int k0 = 64 * kb, n0 = 32 * nb;
#pragma unroll 8
    for (int i = 0; i < 32; ++i) { const int kk = 2 * i + (lane >> 5); scr[kk * 33 + (lane & 31)] = W[(size_t)(k0 + kk) * ldw + n0 + (lane & 31)]; }
    LDS_WAIT();
    const int c = lane & 7;
#pragma unroll
    for (int j = 0; j < 4; ++j) { const int n = (lane >> 3) + 8 * j; const LAS float* s = scr + (8 * c) * 33 + n;
        u32x4 o; o.x = pk2(s[0 * 33], s[1 * 33]); o.y = pk2(s[2 * 33], s[3 * 33]); o.z = pk2(s[4 * 33], s[5 * 33]); o.w = pk2(s[6 * 33], s[7 * 33]);
        *(u32x4*)(WT + (size_t)(n0 + n) * K + k0 + 8 * c) = o; }
    LDS_WAIT();
}
__device__ __forceinline__ void gate_cols(const f32x4 (&v)[4], const LAS float* tab, const float* bg, float* pgrow, int lane) {
    float acc[8];
#pragma unroll
    for (int c = 0; c < 8; ++c) acc[c] = 0.f;
#pragma unroll
    for (int j = 0; j < 4; ++j)
#pragma unroll
        for (int q = 0; q < 4; ++q) { const LAS f32x4* tp = (const LAS f32x4*)(tab + ((j * 4 + q) * 64 + lane) * 8); const f32x4 a = tp[0], b = tp[1]; const float x = v[j][q];
            acc[0] += x * a[0]; acc[1] += x * a[1]; acc[2] += x * a[2]; acc[3] += x * a[3]; acc[4] += x * b[0]; acc[5] += x * b[1]; acc[6] += x * b[2]; acc[7] += x * b[3]; }
#pragma unroll
    for (int c = 0; c < 8; ++c) acc[c] = wave_sum(acc[c]);
    if (lane < 8) { float r = acc[0];
#pragma unroll
        for (int c = 1; c < 8; ++c) r = (lane == c) ? acc[c] : r;
        pgrow[lane] = r + bg[lane]; }
}
__device__ __forceinline__ void load_wg(LAS float* tab, const float* win_l, int tid) {
    for (int d = tid; d < DM; d += 512) { const int j = d >> 8, ln = (d >> 2) & 63, q = d & 3; const f32x4 a = *(const f32x4*)(win_l + (size_t)d * CIN + NPROJ), b = *(const f32x4*)(win_l + (size_t)d * CIN + NPROJ + 4);
        LAS f32x4* tp = (LAS f32x4*)(tab + ((j * 4 + q) * 64 + ln) * 8); tp[0] = a; tp[1] = b; }
    __syncthreads();
}
__device__ __forceinline__ void p0_prologue(const Params& P, const Ctx& C) {
    LAS float* scr = (LAS float*)(C.lds + C.wave * 16384);
    const int gw = C.blk * 8 + C.wave, NGW = C.G * 8;
    bf16_t* win_t = (bf16_t*)(C.ws + WS_WIN); bf16_t* wout_t = (bf16_t*)(C.ws + WS_WOUT); bf16_t* wup_t = (bf16_t*)(C.ws + WS_WUP); bf16_t* wdn_t = (bf16_t*)(C.ws + WS_WDN);
    constexpr int I_IN = 16 * 96, I_OUT = 16 * 32, I_UP = 16 * 64, I_DN = 16 * 32;
    constexpr int N1 = NLAYER * I_IN, N2 = NLAYER * I_OUT, N3 = NLAYER * NEXP * I_UP, N4 = NLAYER * NEXP * I_DN;
    for (int it = gw; it < N1 + N2 + N3 + N4; it += NGW) {
        int r = it;
        if (r < N1) { const int l = r / I_IN; r %= I_IN; tr_item(P.in[I_WIN] + (size_t)l * DM * CIN, CIN, DM, win_t + (size_t)l * NPROJ * DM, scr, r / 96, r % 96, C.lane); continue; } r -= N1;
        if (r < N2) { const int l = r / I_OUT; r %= I_OUT; tr_item(P.in[I_WOUT] + (size_t)l * DM * DM, DM, DM, wout_t + (size_t)l * DM * DM, scr, r / 32, r % 32, C.lane); continue; } r -= N2;
        if (r < N3) { const int le = r / I_UP; r %= I_UP; tr_item(P.in[I_EWUP] + (size_t)le * DM * NUP, NUP, DM, wup_t + (size_t)le * NUP * DM, scr, r / 64, r % 64, C.lane); continue; } r -= N3;
        { const int le = r / I_DN; r %= I_DN; tr_item(P.in[I_EWDN] + (size_t)le * DEXP * DM, DM, DEXP, wdn_t + (size_t)le * DM * DEXP, scr, r / 32, r % 32, C.lane); }
    }
    f32x2* rope = (f32x2*)(C.ws + WS_ROPE);
    for (int idx = C.blk * 512 + C.tid; idx < SEQ * 32; idx += C.G * 512) { const int t = idx >> 5, i = idx & 31;
        const float inv = powf(10000.0f, -(float)i / 32.0f); const float ang = (float)t * inv;
        const double rev = (double)ang * 0.15915494309189533577; const float fr = (float)(rev - __builtin_rint(rev));
        rope[idx] = (f32x2){__builtin_amdgcn_cosf(fr), __builtin_amdgcn_sinf(fr)}; }
    { bf16_t* wt = (bf16_t*)(C.ws + WS_WUPT); bf16_t* at = (bf16_t*)(C.ws + WS_AUPT); bf16_t* gt = (bf16_t*)(C.ws + WS_GUPT);
      for (int idx = C.blk * 512 + C.tid; idx < NLAYER * RWD * 64; idx += C.G * 512) { const int ll = idx / (RWD * 64), rem = idx % (RWD * 64), j = rem >> 6, i = rem & 63;
          wt[idx] = (bf16_t)f2bf(P.in[I_WUP][((size_t)ll * 64 + i) * RWD + j]); at[idx] = (bf16_t)f2bf(P.in[I_AUP][((size_t)ll * 64 + i) * RWD + j]); }
      for (int idx = C.blk * 512 + C.tid; idx < NLAYER * RWD * 128; idx += C.G * 512) { const int ll = idx / (RWD * 128), rem = idx % (RWD * 128), j = rem >> 7, i = rem & 127;
          gt[idx] = (bf16_t)f2bf(P.in[I_GUP][((size_t)ll * 128 + i) * RWD + j]); } }
    { bf16_t* wh = (bf16_t*)(C.ws + WS_WRH); bf16_t* wl = (bf16_t*)(C.ws + WS_WRL);
      for (int idx = C.blk * 512 + C.tid; idx < NLAYER * NEXP * DM; idx += C.G * 512) { const int ll = idx / (NEXP * DM), rem = idx % (NEXP * DM), e = rem >> 10, d = rem & 1023;
          const float w = P.in[I_RW][((size_t)ll * DM + d) * NEXP + e]; const unsigned hi = f2bf(w); const float lo = w - bflo(hi); wh[idx] = (bf16_t)hi; wl[idx] = (bf16_t)f2bf(lo); } }
    __syncthreads(); LAS float* wg = (LAS float*)C.lds; load_wg(wg, P.in[I_WIN], C.tid);
    bf16_t* hb = (bf16_t*)(C.ws + WS_HB); float* pg = (float*)(C.ws + WS_PG);
    for (int m = gw; m < MTOK; m += NGW) {
        const f32x4* xr = (const f32x4*)(P.in[I_X] + (size_t)m * DM) + C.lane; f32x4 v[4];
#pragma unroll
        for (int j = 0; j < 4; ++j) v[j] = xr[64 * j];
        u32x2* o8 = (u32x2*)(hb + (size_t)m * DM) + C.lane;
#pragma unroll
        for (int j = 0; j < 4; ++j) o8[64 * j] = (u32x2){pk2(v[j][0], v[j][1]), pk2(v[j][2], v[j][3])};
        gate_cols(v, wg, P.in[I_BIN] + NPROJ, pg + (size_t)m * 8, C.lane);
    }
}

constexpr int LD = 72;
constexpr int BUFB = 64 * LD * 2;
__device__ __forceinline__ f32x4 mfma16(bf16x8 a, bf16x8 b, f32x4 c) { return __builtin_amdgcn_mfma_f32_16x16x32_bf16(a, b, c, 0, 0, 0); }
constexpr int SWA_VLD = 264;
__device__ __forceinline__ void swa_unit(const Params& P, const Ctx& C, int l, int u) {
    const int tid = C.tid, wave = C.wave, lane = C.lane, r = lane & 15, g = lane >> 4; const int b = u >> 7, n = (u >> 1) & 63, hk = u & 1;
    LAS bf16_t* Ks = (LAS bf16_t*)C.lds; LAS bf16_t* VT = Ks + 256 * LD;
    const bf16_t* p = (const bf16_t*)(C.ws + WS_P); const f32x2* rope = (const f32x2*)(C.ws + WS_ROPE);
    const int t_base = n * 128 - 128;
#pragma unroll
    for (int it = 0; it < 2; ++it) { const int q = tid + 512 * it, row = q >> 2, c8 = q & 3; const int t = t_base + row;
        u32x4 o1 = (u32x4){0u, 0u, 0u, 0u}, o2 = o1;
        if (t >= 0) { const bf16_t* pr = p + (size_t)(b * SEQ + t) * NPROJ + 1792 + hk * 64 + 8 * c8; const u32x4 a1 = *(const u32x4*)pr, a2 = *(const u32x4*)(pr + 32);
            const f32x4* rp = (const f32x4*)(rope + t * 32 + 8 * c8); float y1[8], y2[8];
#pragma unroll
            for (int e = 0; e < 4; ++e) { const f32x4 cs = rp[e];
                const float x1a = bflo(a1[e]), x1b = bfhi(a1[e]), x2a = bflo(a2[e]), x2b = bfhi(a2[e]);
                y1[2 * e] = x1a * cs[0] - x2a * cs[1]; y2[2 * e] = x2a * cs[0] + x1a * cs[1]; y1[2 * e + 1] = x1b * cs[2] - x2b * cs[3]; y2[2 * e + 1] = x2b * cs[2] + x1b * cs[3]; }
            o1 = (u32x4){pk2(y1[0], y1[1]), pk2(y1[2], y1[3]), pk2(y1[4], y1[5]), pk2(y1[6], y1[7])}; o2 = (u32x4){pk2(y2[0], y2[1]), pk2(y2[2], y2[3]), pk2(y2[4], y2[5]), pk2(y2[6], y2[7])}; }
        *(LAS u32x4*)(Ks + row * LD + 8 * c8) = o1; *(LAS u32x4*)(Ks + row * LD + 32 + 8 * c8) = o2; }
    if (tid < 256) { const int kg = tid >> 3, c8 = tid & 7; u32x4 in[8];
#pragma unroll
        for (int k = 0; k < 8; ++k) { const int t = t_base + 8 * kg + k; in[k] = (t >= 0) ? *(const u32x4*)(p + (size_t)(b * SEQ + t) * NPROJ + 1920 + hk * 64 + 8 * c8) : (u32x4){0u, 0u, 0u, 0u}; }
#pragma unroll
        for (int d = 0; d < 8; ++d) { unsigned hv[8];
#pragma unroll
            for (int k = 0; k < 8; ++k) { const unsigned w = in[k][d >> 1]; hv[k] = (d & 1) ? (w >> 16) : (w & 0xffffu); }
            *(LAS u32x4*)(VT + (8 * c8 + d) * SWA_VLD + 8 * kg) = (u32x4){hv[0] | (hv[1] << 16), hv[2] | (hv[3] << 16), hv[4] | (hv[5] << 16), hv[6] | (hv[7] << 16)}; } }
    LDS_BARRIER();
    const int qi = 16 * wave + r, t = n * 128 + qi;
    const f32x4* rq = (const f32x4*)(rope + t * 32 + 8 * g);
#pragma unroll 1
    for (int gq = 0; gq < 3; ++gq) { const int hq = hk * 3 + gq; int wave = C.wave; asm volatile("" : "+s"(wave));
        bf16x8 qf0, qf1;
        { const bf16_t* pr = p + (size_t)(b * SEQ + t) * NPROJ + RW_COLS + hq * 64 + 8 * g; const u32x4 a1 = *(const u32x4*)pr, a2 = *(const u32x4*)(pr + 32); float y1[8], y2[8];
#pragma unroll
          for (int e = 0; e < 4; ++e) { const f32x4 cs = rq[e]; const float x1a = bflo(a1[e]), x1b = bfhi(a1[e]), x2a = bflo(a2[e]), x2b = bfhi(a2[e]);
              y1[2 * e] = (x1a * cs[0] - x2a * cs[1]) * 0.125f; y2[2 * e] = (x2a * cs[0] + x1a * cs[1]) * 0.125f; y1[2 * e + 1] = (x1b * cs[2] - x2b * cs[3]) * 0.125f; y2[2 * e + 1] = (x2b * cs[2] + x1b * cs[3]) * 0.125f; }
          const u32x4 w1 = (u32x4){pk2(y1[0], y1[1]), pk2(y1[2], y1[3]), pk2(y1[4], y1[5]), pk2(y1[6], y1[7])}, w2 = (u32x4){pk2(y2[0], y2[1]), pk2(y2[2], y2[3]), pk2(y2[4], y2[5]), pk2(y2[6], y2[7])};
          qf0 = __builtin_bit_cast(bf16x8, w1); qf1 = __builtin_bit_cast(bf16x8, w2); }
        f32x4 sc[10]; const float sink = P.in[I_SINK][l * 6 + hq]; float mx = sink;
        int qiv = qi; asm volatile("" : "+v"(qiv));
#pragma unroll
        for (int kt = 0; kt < 10; ++kt) { const int kb = 16 * (wave + kt); f32x4 a = (f32x4){0.f, 0.f, 0.f, 0.f};
            if (kb < 256) { const LAS bf16_t* kp = Ks + (kb + r) * LD + 8 * g; a = mfma16(*(const LAS bf16x8*)kp, qf0, a); a = mfma16(*(const LAS bf16x8*)(kp + 32), qf1, a); }
#pragma unroll
            for (int j = 0; j < 4; ++j) { const int kj = kb + 4 * g + j; const bool valid = (kj > qiv) && (kj <= qiv + 128) && (kj < 256) && ((n != 0) || (kj >= 128)); a[j] = valid ? a[j] : -__builtin_inff(); mx = fmaxf(mx, a[j]); }
            sc[kt] = a; }
        mx = fmaxf(mx, __shfl_xor(mx, 16)); mx = fmaxf(mx, __shfl_xor(mx, 32));
        float sum = 0.f;
#pragma unroll
        for (int kt = 0; kt < 10; ++kt) {
#pragma unroll
            for (int j = 0; j < 4; ++j) { const float e = __expf(sc[kt][j] - mx); sc[kt][j] = e; sum += e; } }
        sum += __shfl_xor(sum, 16); sum += __shfl_xor(sum, 32); sum += __expf(sink - mx);
        const float inv = 1.0f / sum;
        f32x4 o[4];
#pragma unroll
        for (int dt = 0; dt < 4; ++dt) o[dt] = (f32x4){0.f, 0.f, 0.f, 0.f};
#pragma unroll
        for (int s = 0; s < 5; ++s) { const int kb = 16 * (wave + 2 * s);
            if (kb < 256) { const u32x4 pw = (u32x4){pk2(sc[2 * s][0], sc[2 * s][1]), pk2(sc[2 * s][2], sc[2 * s][3]), pk2(sc[2 * s + 1][0], sc[2 * s + 1][1]), pk2(sc[2 * s + 1][2], sc[2 * s + 1][3])};
                const bf16x8 pf = __builtin_bit_cast(bf16x8, pw); const bool two = (kb + 16 < 256);
#pragma unroll
                for (int dt = 0; dt < 4; ++dt) { const LAS bf16_t* vp = VT + (16 * dt + r) * SWA_VLD + kb + 4 * g; const u32x2 lo = *(const LAS u32x2*)vp; u32x2 hi = (u32x2){0u, 0u}; if (two) hi = *(const LAS u32x2*)(vp + 16);
                    const u32x4 af = (u32x4){lo[0], lo[1], hi[0], hi[1]}; o[dt] = mfma16(__builtin_bit_cast(bf16x8, af), pf, o[dt]); } } }
        bf16_t* yr = (bf16_t*)(C.ws + WS_YMIX) + (size_t)(b * SEQ + t) * DM + RWD + hq * 64 + 4 * g;
#pragma unroll
        for (int dt = 0; dt < 4; ++dt) *(u32x2*)(yr + 16 * dt) = (u32x2){pk2(o[dt][0] * inv, o[dt][1] * inv), pk2(o[dt][2] * inv, o[dt][3] * inv)};
    }
    LDS_BARRIER();
}
__device__ __forceinline__ f32x4 mm64(const LAS bf16_t* X, const LAS bf16_t* Y, int ti, int tj, f32x4 acc, int lane) {
    const int r = lane & 15, g = lane >> 4;
    const LAS bf16_t* xp = X + (16 * ti + r) * LD + 8 * g; const LAS bf16_t* yp = Y + (16 * tj + r) * LD + 8 * g;
    acc = mfma16(*(const LAS bf16x8*)xp, *(const LAS bf16x8*)yp, acc);
    acc = mfma16(*(const LAS bf16x8*)(xp + 32), *(const LAS bf16x8*)(yp + 32), acc);
    return acc;
}
__device__ __forceinline__ void storeT(LAS bf16_t* D, int ti, int tj, f32x4 v, int lane) {
    const int r = lane & 15, g = lane >> 4;
    *(LAS u32x2*)(D + (16 * tj + r) * LD + 16 * ti + 4 * g) = (u32x2){pk2(v[0], v[1]), pk2(v[2], v[3])};
}
template <int MODE> __device__ __forceinline__ f32x4 maskT(f32x4 v, int ti, int tj, int lane) {
    const int rho = 16 * tj + (lane & 15), kap = 16 * ti + 4 * (lane >> 4);
#pragma unroll
    for (int j = 0; j < 4; ++j) { const bool keep = (MODE == 0) ? (kap + j < rho) : (MODE == 1) ? (kap + j <= rho) : (kap + j > rho); v[j] = keep ? v[j] : 0.f; }
    return v;
}
__device__ __forceinline__ float wave_max(float v) {
#pragma unroll
    for (int o = 1; o < 64; o <<= 1) v = fmaxf(v, __shfl_xor(v, o));
    return v;
}

__device__ __forceinline__ void rwb_unit(const Params& P, const Ctx& C, int l, int u) {
    const int tid = C.tid, wave = C.wave, lane = C.lane, r = lane & 15, g = lane >> 4;
    const int h = u % 6, bcx = u / 6, b = bcx >> 7, c = bcx & 127; const int tok0 = b * SEQ + c * 64; const int ch = (b * 6 + h) * 128 + c;
    LAS unsigned char* L = C.lds;
#define RB(i) ((LAS bf16_t*)(L + (i) * BUFB))
    LAS bf16_t* X1 = RB(0); LAS bf16_t* X1T = RB(1); LAS bf16_t* Aak = RB(2); LAS bf16_t* Arb = RB(3); LAS bf16_t* Ark = RB(4); LAS bf16_t* Pb = RB(5);
    LAS bf16_t* At = RB(6); LAS bf16_t* AtT = RB(7); LAS bf16_t* Bt = RB(8); LAS bf16_t* BtT = RB(9); LAS bf16_t* Kt = RB(10); LAS bf16_t* KtT = RB(11); LAS bf16_t* Rt = RB(12); LAS bf16_t* VT = RB(13);
    LAS float* XW = (LAS float*)L; LAS float* XA = XW + 64 * 65; LAS float* XG = XA + 64 * 65;
    LAS bf16_t* LI = (LAS bf16_t*)(L + 6 * BUFB);
    LAS float* segtot = (LAS float*)(L + 14 * BUFB); LAS float* gamL = segtot + 512;
    const bf16_t* p = (const bf16_t*)(C.ws + WS_P); const float* mu = P.in[I_MU] + l * RW_COLS;
    float cr9[9], ck9[9], cv9[9];
    { const int jc0 = 64 * h + lane;
#pragma unroll
      for (int i = 0; i < 9; ++i) { const int row = 8 * wave - 1 + i; const bool ok = (c * 64 + row >= 0); const bf16_t* q = p + (size_t)(tok0 + (ok ? row : 0)) * NPROJ;
          const float a_ = bf2f(q[jc0]), b_ = bf2f(q[RWD + jc0]), c_ = bf2f(q[2 * RWD + jc0]); cr9[i] = ok ? a_ : 0.f; ck9[i] = ok ? b_ : 0.f; cv9[i] = ok ? c_ : 0.f; } }
    { u32x4 cu[4], pv[4]; f32x4 m0[4], m1[4];
#pragma unroll
      for (int i = 0; i < 4; ++i) { const int q = tid + 512 * i, t = q >> 5, c8 = q & 31; const bf16_t* src = p + (size_t)(tok0 + t) * NPROJ + 1152 + 8 * c8; const bool ok = (c * 64 + t > 0);
          cu[i] = *(const u32x4*)src; pv[i] = *(const u32x4*)(ok ? src - NPROJ : src); if (!ok) pv[i] = (u32x4){0u, 0u, 0u, 0u};
          m0[i] = *(const f32x4*)(mu + 1152 + 8 * c8); m1[i] = *(const f32x4*)(mu + 1152 + 8 * c8 + 4); }
#pragma unroll
      for (int i = 0; i < 4; ++i) { const int q = tid + 512 * i, t = q >> 5, c8 = q & 31; float x[8];
#pragma unroll
          for (int e = 0; e < 4; ++e) { const float c0 = bflo(cu[i][e]), c1 = bfhi(cu[i][e]), p0 = bflo(pv[i][e]), p1 = bfhi(pv[i][e]);
              const float mm0 = (e < 2) ? m0[i][2 * e] : m1[i][2 * e - 4], mm1 = (e < 2) ? m0[i][2 * e + 1] : m1[i][2 * e - 3];
              x[2 * e] = c0 + (p0 - c0) * mm0; x[2 * e + 1] = c1 + (p1 - c1) * mm1; }
          if (c8 < 8) {
#pragma unroll
              for (int e = 0; e < 8; ++e) x[e] = 1.0f - 2.0f * __builtin_amdgcn_rcpf(__expf(2.0f * x[e]) + 1.0f); }
          else if (c8 >= 16) {
#pragma unroll
              for (int e = 0; e < 8; ++e) x[e] = sigmoidf_(x[e]); }
          *(LAS u32x4*)(LI + t * 264 + 8 * c8) = (u32x4){pk2(x[0], x[1]), pk2(x[2], x[3]), pk2(x[4], x[5]), pk2(x[6], x[7])}; } }
    LDS_BARRIER();
    { bf16x8 bw[1][2], ba[1][2], bg[1][4];
      const int tj = wave & 3;
      const bf16_t* Ww = (const bf16_t*)(C.ws + WS_WUPT) + ((size_t)l * RWD + 64 * h + 16 * tj + r) * 64 + 8 * g;
      const bf16_t* Wa = (const bf16_t*)(C.ws + WS_AUPT) + ((size_t)l * RWD + 64 * h + 16 * tj + r) * 64 + 8 * g;
      const bf16_t* Wg = (const bf16_t*)(C.ws + WS_GUPT) + ((size_t)l * RWD + 64 * h + 16 * tj + r) * 128 + 8 * g;
#pragma unroll
      for (int ks = 0; ks < 2; ++ks) { bw[0][ks] = *(const bf16x8*)(Ww + 32 * ks); ba[0][ks] = *(const bf16x8*)(Wa + 32 * ks); }
#pragma unroll
      for (int ks = 0; ks < 4; ++ks) bg[0][ks] = *(const bf16x8*)(Wg + 32 * ks);
#pragma unroll
      for (int n = 0; n < 6; ++n) { const int o = n >> 1, ti = ((wave >> 2) + 2 * n) & 3; const int xoff = (o == 0) ? 0 : (o == 1) ? 64 : 128;
          const LAS bf16_t* xp = LI + (16 * ti + r) * 264 + xoff + 8 * g; f32x4 acc = (f32x4){0.f, 0.f, 0.f, 0.f};
          if (o == 0) { acc = mfma16(*(const LAS bf16x8*)xp, bw[0][0], acc); acc = mfma16(*(const LAS bf16x8*)(xp + 32), bw[0][1], acc); }
          else if (o == 1) { acc = mfma16(*(const LAS bf16x8*)xp, ba[0][0], acc); acc = mfma16(*(const LAS bf16x8*)(xp + 32), ba[0][1], acc); }
          else {
#pragma unroll
              for (int ks = 0; ks < 4; ++ks) acc = mfma16(*(const LAS bf16x8*)(xp + 32 * ks), bg[0][ks], acc); }
          LAS float* XO = (o == 0) ? XW : (o == 1) ? XA : XG;
#pragma unroll
          for (int j = 0; j < 4; ++j) XO[(16 * ti + 4 * g + j) * 65 + 16 * tj + r] = acc[j]; } }
    LDS_BARRIER();
    {
        const int jc = 64 * h + lane, tg = wave;
        const float w0 = P.in[I_W0][l * RWD + jc], a0 = P.in[I_A0][l * RWD + jc], kkc = P.in[I_KK][l * RWD + jc], kac = P.in[I_KA][l * RWD + jc], rkc = P.in[I_RK][l * RWD + jc];
        const float mur = mu[jc], muk = mu[RWD + jc], muv = mu[2 * RWD + jc];
        float pr = cr9[0], pk = ck9[0], pv = cv9[0];
        float ld[8], av[8], kn[8], km[8], rs[8], vs[8];
        bf16_t* aux = (bf16_t*)(C.ws + WS_RWAUX) + (size_t)(tok0 + 8 * tg) * 768;
#pragma unroll
        for (int i = 0; i < 8; ++i) { const int t = 8 * tg + i; const float cr = cr9[i + 1], ck = ck9[i + 1], cv = cv9[i + 1];
            rs[i] = cr + (pr - cr) * mur; const float ks = ck + (pk - ck) * muk; vs[i] = cv + (pv - cv) * muv; pr = cr; pk = ck; pv = cv;
            const float z = -(w0 + XW[t * 65 + lane]); const float sp = (z > 20.f) ? z : __logf(1.0f + __expf(z)); ld[i] = -__expf(-sp - 0.5f);
            const float a = sigmoidf_(a0 + XA[t * 65 + lane]); av[i] = a;
            const float kkv = ks * kkc; kn[i] = kkv * rsqrtf(fmaxf(wave_sum(kkv * kkv), 1e-24f));
            km[i] = ks * (1.0f + (a - 1.0f) * kac);
            const float dot = wave_sum(rs[i] * km[i] * rkc);
            aux[(size_t)i * 768 + jc] = (bf16_t)f2bf(dot * vs[i]); aux[(size_t)i * 768 + RWD + jc] = (bf16_t)f2bf(XG[t * 65 + lane]); }
        float cs[8]; cs[0] = ld[0];
#pragma unroll
        for (int i = 1; i < 8; ++i) cs[i] = cs[i - 1] + ld[i];
        segtot[tg * 64 + lane] = cs[7];
        LDS_BARRIER();
        float off = 0.f, tot = 0.f;
#pragma unroll
        for (int k = 0; k < 8; ++k) { const float sv = segtot[k * 64 + lane]; tot += sv; off += (k < tg) ? sv : 0.f; }
        if (wave == 0) gamL[lane] = __expf(tot);
        float oa[8], ob[8], ok[8], orr[8];
#pragma unroll
        for (int i = 0; i < 8; ++i) { const int t = 8 * tg + i; const float cum = off + cs[i]; const float gam = __expf(cum), gin = __expf(-cum), gpr = __expf(cum - ld[i]);
            oa[i] = -gpr * kn[i]; ob[i] = kn[i] * av[i] * gin; ok[i] = km[i] * gin; orr[i] = gam * rs[i];
            At[t * LD + lane] = (bf16_t)f2bf(oa[i]); Bt[t * LD + lane] = (bf16_t)f2bf(ob[i]); Kt[t * LD + lane] = (bf16_t)f2bf(ok[i]); Rt[t * LD + lane] = (bf16_t)f2bf(orr[i]); }
        *(LAS u32x4*)(AtT + lane * LD + 8 * tg) = (u32x4){pk2(oa[0], oa[1]), pk2(oa[2], oa[3]), pk2(oa[4], oa[5]), pk2(oa[6], oa[7])};
        *(LAS u32x4*)(BtT + lane * LD + 8 * tg) = (u32x4){pk2(ob[0], ob[1]), pk2(ob[2], ob[3]), pk2(ob[4], ob[5]), pk2(ob[6], ob[7])};
        *(LAS u32x4*)(KtT + lane * LD + 8 * tg) = (u32x4){pk2(ok[0], ok[1]), pk2(ok[2], ok[3]), pk2(ok[4], ok[5]), pk2(ok[6], ok[7])};
        *(LAS u32x4*)(VT + lane * LD + 8 * tg) = (u32x4){pk2(vs[0], vs[1]), pk2(vs[2], vs[3]), pk2(vs[4], vs[5]), pk2(vs[6], vs[7])};
    }
    LDS_BARRIER();
    const f32x4 Z4 = (f32x4){0.f, 0.f, 0.f, 0.f};
    const int wq = wave >> 2, tj = wave & 3;
    { f32x4 res[10];
#pragma unroll
      for (int n_ = 0; n_ < 10; ++n_) { const int o = n_ >> 1, ti = wq + 2 * (n_ & 1);
          if (o == 0) res[n_] = maskT<2>(mm64(At, Bt, ti, tj, Z4, lane), ti, tj, lane);
          else if (o == 1) res[n_] = maskT<0>(mm64(Bt, At, ti, tj, Z4, lane), ti, tj, lane);
          else if (o == 2) res[n_] = maskT<0>(mm64(Kt, At, ti, tj, Z4, lane), ti, tj, lane);
          else if (o == 3) res[n_] = maskT<1>(mm64(Bt, Rt, ti, tj, Z4, lane), ti, tj, lane);
          else res[n_] = maskT<1>(mm64(Kt, Rt, ti, tj, Z4, lane), ti, tj, lane); }
#pragma unroll
      for (int n_ = 0; n_ < 10; ++n_) { const int o = n_ >> 1, ti = wq + 2 * (n_ & 1);
          if (o == 0) storeT(X1T, ti, tj, res[n_], lane);
          else if (o == 1) { storeT(X1, ti, tj, res[n_], lane); f32x4 v = res[n_]; const int rho = 16 * tj + r, kap = 16 * ti + 4 * g;
#pragma unroll
              for (int j = 0; j < 4; ++j) v[j] += (kap + j == rho) ? 1.0f : 0.f;
              storeT(Pb, ti, tj, v, lane); }
          else if (o == 2) storeT(Aak, ti, tj, res[n_], lane);
          else if (o == 3) storeT(Arb, ti, tj, res[n_], lane);
          else storeT(Ark, ti, tj, res[n_], lane); } }
    LDS_BARRIER();
    f32x4 pacc[2];
#pragma unroll
    for (int q = 0; q < 2; ++q) { const int ti = wq + 2 * q; const u32x2 w = *(const LAS u32x2*)(Pb + (16 * tj + r) * LD + 16 * ti + 4 * g);
        pacc[q] = (f32x4){bflo(w[0]), bfhi(w[0]), bflo(w[1]), bfhi(w[1])}; }
#pragma unroll 1
    for (int rnd = 0; rnd < 6; ++rnd) {
        LAS bf16_t* Xn = (rnd & 1) ? RB(6) : RB(0); LAS bf16_t* XnT = (rnd & 1) ? RB(8) : RB(1);
        LAS bf16_t* Yn = (rnd & 1) ? RB(0) : RB(6); LAS bf16_t* YnT = (rnd & 1) ? RB(1) : RB(8);
        LAS bf16_t* Pold = (rnd & 1) ? RB(5) : RB(10); LAS bf16_t* Pnew = (rnd & 1) ? RB(10) : RB(5);
        f32x4 sq[4];
        if (rnd < 5) {
#pragma unroll
            for (int n_ = 0; n_ < 4; ++n_) { const int ti = wq + 2 * (n_ & 1); sq[n_] = (n_ < 2) ? mm64(Xn, XnT, ti, tj, Z4, lane) : mm64(XnT, Xn, ti, tj, Z4, lane); } }
        if (rnd > 0) {
#pragma unroll
            for (int q = 0; q < 2; ++q) pacc[q] = mm64(XnT, Pold, wq + 2 * q, tj, pacc[q], lane); }
        if (rnd < 5) {
#pragma unroll
            for (int n_ = 0; n_ < 4; ++n_) storeT((n_ < 2) ? YnT : Yn, wq + 2 * (n_ & 1), tj, sq[n_], lane); }
        if (rnd > 0) {
#pragma unroll
            for (int q = 0; q < 2; ++q) storeT(Pnew, wq + 2 * q, tj, pacc[q], lane); }
        LDS_BARRIER();
    }
    LAS bf16_t* Tm = RB(10);
    LAS bf16_t* AhT = RB(0); LAS bf16_t* W1T = RB(1); LAS bf16_t* UlT = RB(6);
    { f32x4 res[4];
#pragma unroll
      for (int n_ = 0; n_ < 4; ++n_) { const int ti = wq + 2 * (n_ & 1); res[n_] = (n_ < 2) ? mm64(Tm, AtT, ti, tj, Z4, lane) : mm64(Aak, VT, ti, tj, Z4, lane); }
#pragma unroll
      for (int n_ = 0; n_ < 4; ++n_) storeT((n_ < 2) ? AhT : W1T, wq + 2 * (n_ & 1), tj, res[n_], lane); }
    LDS_BARRIER();
    { f32x4 res[2];
#pragma unroll
      for (int n_ = 0; n_ < 2; ++n_) res[n_] = mm64(Tm, W1T, wq + 2 * n_, tj, Z4, lane);
#pragma unroll
      for (int n_ = 0; n_ < 2; ++n_) storeT(UlT, wq + 2 * n_, tj, res[n_], lane); }
    LDS_BARRIER();
    bf16_t* gM = (bf16_t*)(C.ws + WS_RWM) + (size_t)ch * 4096; bf16_t* gNT = (bf16_t*)(C.ws + WS_RWNT) + (size_t)ch * 4096; bf16_t* gQ = (bf16_t*)(C.ws + WS_RWQH) + (size_t)ch * 4096; bf16_t* gY = (bf16_t*)(C.ws + WS_RWYL) + (size_t)ch * 4096;
#pragma unroll
    for (int n_ = 0; n_ < 8; ++n_) { const int o = n_ >> 1, ti = wq + 2 * (n_ & 1); const int rho = 16 * tj + r, kap = 16 * ti + 4 * g;
        if (o == 0) {
            const u32x2 w = *(const LAS u32x2*)(Rt + rho * LD + kap); f32x4 v = (f32x4){bflo(w[0]), bfhi(w[0]), bflo(w[1]), bfhi(w[1])};
            v = mm64(AhT, Arb, ti, tj, v, lane); *(u32x2*)(gQ + rho * 64 + kap) = (u32x2){pk2(v[0], v[1]), pk2(v[2], v[3])}; }
        else if (o == 1) {
            f32x4 v = mm64(UlT, Arb, ti, tj, Z4, lane); v = mm64(VT, Ark, ti, tj, v, lane); *(u32x2*)(gY + rho * 64 + kap) = (u32x2){pk2(v[0], v[1]), pk2(v[2], v[3])}; }
        else if (o == 2) {
            f32x4 v = mm64(AhT, BtT, ti, tj, Z4, lane); const float gl = gamL[rho];
#pragma unroll
            for (int j = 0; j < 4; ++j) v[j] = gl * (v[j] + ((kap + j == rho) ? 1.0f : 0.f));
            *(u32x2*)(gM + rho * 64 + kap) = (u32x2){pk2(v[0], v[1]), pk2(v[2], v[3])}; }
        else {
            f32x4 v = mm64(BtT, UlT, ti, tj, Z4, lane); v = mm64(KtT, VT, ti, tj, v, lane);
#pragma unroll
            for (int j = 0; j < 4; ++j) v[j] *= gamL[kap + j];
            *(u32x2*)(gNT + rho * 64 + kap) = (u32x2){pk2(v[0], v[1]), pk2(v[2], v[3])}; } }
    LDS_BARRIER();
#undef RB
}

__device__ __forceinline__ void mlb_unit(const Params& P, const Ctx& C, int l, int u) {
    const int tid = C.tid, wave = C.wave, lane = C.lane, r = lane & 15, g = lane >> 4;
    const int hh = u & 3, bcx = u >> 2, b = bcx >> 7, c = bcx & 127; const int tok0 = b * SEQ + c * 64; const int ch = (b * 4 + hh) * 128 + c;
    LAS unsigned char* L = C.lds;
    LAS bf16_t* Qs = (LAS bf16_t*)L; LAS bf16_t* Ks = (LAS bf16_t*)(L + BUFB); LAS bf16_t* KhT = (LAS bf16_t*)(L + 2 * BUFB); LAS bf16_t* Sm = (LAS bf16_t*)(L + 3 * BUFB); LAS bf16_t* VTe = (LAS bf16_t*)(L + 4 * BUFB);
    LAS float* vbc = (LAS float*)(L + 4 * BUFB + 80 * LD * 2); LAS float* vig = vbc + 64; LAS float* vmd = vig + 64; LAS float* vws = vmd + 64;
    const bf16_t* p = (const bf16_t*)(C.ws + WS_P);
    unsigned xr[19], vr[8];
    { const int cq = tid & 127, tg = tid >> 7, isk = cq >> 6, d = cq & 63; const int col = 2048 + isk * 256 + hh * 64 + d; const int t0 = 16 * tg; const bool okp = (c * 64 + t0 > 0);
#pragma unroll
      for (int k = 0; k < 19; ++k) xr[k] = p[(size_t)(tok0 + ((k < 3 && !okp) ? 0 : t0 + k - 3)) * NPROJ + col];
      const int v = tid & 63, sg = tid >> 6;
#pragma unroll
      for (int k = 0; k < 8; ++k) vr[k] = p[(size_t)(tok0 + 8 * sg + k) * NPROJ + 2560 + hh * 64 + v]; }
    if (wave == 0) { const float* pg = (const float*)(C.ws + WS_PG) + (size_t)(tok0 + lane) * 8; const float ig = pg[hh], f = pg[4 + hh];
        const float lf = fminf(f, 0.f) - __logf(1.0f + __expf(-fabsf(f)));
        float bcv = lf;
#pragma unroll
        for (int o = 1; o < 64; o <<= 1) { const float t = __shfl_up(bcv, o); bcv += (lane >= o) ? t : 0.f; }
        float pm = ig - bcv;
#pragma unroll
        for (int o = 1; o < 64; o <<= 1) { const float t = __shfl_up(pm, o); pm = (lane >= o) ? fmaxf(pm, t) : pm; }
        const float md = bcv + pm; const float bcL = __shfl(bcv, 63); const float as = bcL - bcv + ig; const float mloc = wave_max(as); const float ws = __expf(as - mloc);
        vbc[lane] = bcv; vig[lane] = ig; vmd[lane] = md; vws[lane] = ws;
        float* vec = (float*)(C.ws + WS_MLVEC) + ((size_t)ch * 64 + lane) * 2; vec[0] = bcv; vec[1] = md;
        if (lane == 0) { float* sc = (float*)(C.ws + WS_MLSC) + (size_t)ch * 2; sc[0] = bcL; sc[1] = mloc; } }
    LDS_BARRIER();
    { const int cq = tid & 127, tg = tid >> 7, isk = cq >> 6, d = cq & 63; const int col = 2048 + isk * 256 + hh * 64 + d; const int cw = isk * 256 + hh * 64 + d;
      const float* cwp = P.in[I_CONVW] + (size_t)l * 4 * 512; const float w0 = cwp[cw], w1 = cwp[512 + cw], w2 = cwp[1024 + cw], w3 = cwp[1536 + cw], cb = P.in[I_CONVB][l * 512 + cw];
      float xm3 = 0.f, xm2 = 0.f, xm1 = 0.f; const int t0 = 16 * tg;
      if (c * 64 + t0 > 0) { xm3 = bf2f((unsigned short)xr[0]); xm2 = bf2f((unsigned short)xr[1]); xm1 = bf2f((unsigned short)xr[2]); }
      float o16[16];
#pragma unroll
      for (int k = 0; k < 16; ++k) { const float x0 = bf2f((unsigned short)xr[k + 3]); const float y = w0 * xm3 + w1 * xm2 + w2 * xm1 + w3 * x0 + cb; const float s = y * sigmoidf_(y);
          o16[k] = isk ? s * 0.125f : s; xm3 = xm2; xm2 = xm1; xm1 = x0; }
      if (!isk) { bf16_t* gq = (bf16_t*)(C.ws + WS_MLQ) + (size_t)ch * 4096;
#pragma unroll
          for (int k = 0; k < 16; ++k) { const bf16_t v = (bf16_t)f2bf(o16[k]); Qs[(t0 + k) * LD + d] = v; gq[(t0 + k) * 64 + d] = v; } }
      else {
#pragma unroll
          for (int k = 0; k < 16; ++k) { Ks[(t0 + k) * LD + d] = (bf16_t)f2bf(o16[k]); o16[k] *= vws[t0 + k]; }
          *(LAS u32x4*)(KhT + d * LD + t0) = (u32x4){pk2(o16[0], o16[1]), pk2(o16[2], o16[3]), pk2(o16[4], o16[5]), pk2(o16[6], o16[7])};
          *(LAS u32x4*)(KhT + d * LD + t0 + 8) = (u32x4){pk2(o16[8], o16[9]), pk2(o16[10], o16[11]), pk2(o16[12], o16[13]), pk2(o16[14], o16[15])}; }
      { const int v = tid & 63, sg = tid >> 6; float vv[8];
#pragma unroll
        for (int k = 0; k < 8; ++k) vv[k] = bf2f((unsigned short)vr[k]);
        *(LAS u32x4*)(VTe + v * LD + 8 * sg) = (u32x4){pk2(vv[0], vv[1]), pk2(vv[2], vv[3]), pk2(vv[4], vv[5]), pk2(vv[6], vv[7])}; }
      if (tid < 128) { const int row = 64 + (tid >> 3), pc = tid & 7; const unsigned one2 = 0x3f803f80u; const unsigned val = (row == 64) ? one2 : 0u; *(LAS u32x4*)(VTe + row * LD + 8 * pc) = (u32x4){val, val, val, val}; }
    }
    LDS_BARRIER();
    const f32x4 Z4 = (f32x4){0.f, 0.f, 0.f, 0.f};
    bf16_t* gKL = (bf16_t*)(C.ws + WS_MLKL) + (size_t)ch * 5120; bf16_t* gNL = (bf16_t*)(C.ws + WS_MLNL) + (size_t)ch * 5120;
    for (int task = wave; task < 36; task += 8) {
        if (task < 16) { const int ti = task >> 2, tj = task & 3; f32x4 v = mm64(Ks, Qs, ti, tj, Z4, lane);
            const int rho = 16 * tj + r, kap = 16 * ti + 4 * g; const float bl = vbc[rho] - vmd[rho];
#pragma unroll
            for (int j = 0; j < 4; ++j) { const int s = kap + j; v[j] = (s <= rho) ? v[j] * __expf(bl - vbc[s] + vig[s]) : 0.f; }
            storeT(Sm, ti, tj, v, lane); }
        else { const int t2 = task - 16, ti = t2 / 5, tj = t2 % 5;
            const f32x4 v = mm64(KhT, VTe, ti, tj, Z4, lane); *(u32x2*)(gKL + (16 * tj + r) * 64 + 16 * ti + 4 * g) = (u32x2){pk2(v[0], v[1]), pk2(v[2], v[3])}; } }
    LDS_BARRIER();
    for (int task = wave; task < 20; task += 8) { const int ti = task >> 2, tj = task & 3; const f32x4 v = mm64(VTe, Sm, ti, tj, Z4, lane); *(u32x2*)(gNL + (16 * tj + r) * 80 + 16 * ti + 4 * g) = (u32x2){pk2(v[0], v[1]), pk2(v[2], v[3])}; }
    LDS_BARRIER();
}

__device__ __forceinline__ void rwkv_chain(const Ctx& C, int bh, int vh) {
    const int tid = C.tid, wave = C.wave, lane = C.lane, r = lane & 15, g = lane >> 4; const size_t ch0 = (size_t)bh * 128;
    LAS unsigned char* L = C.lds; LAS unsigned char* Mb = L; LAS unsigned char* Nb = L + 8 * BUFB; LAS unsigned char* Sb = Nb + 8 * (32 * LD * 2);
    static_assert(8 * BUFB + 8 * 32 * LD * 2 + 8 * 32 * 128 <= MISC_OFF, "chain LDS");
    const bf16_t* gM = (const bf16_t*)(C.ws + WS_RWM) + ch0 * 4096; const bf16_t* gN = (const bf16_t*)(C.ws + WS_RWNT) + ch0 * 4096 + (size_t)vh * 32 * 64; bf16_t* gS = (bf16_t*)(C.ws + WS_RWS) + ch0 * 4096;
    u32x4 pmA[8], pnA4[4];
#define CH_LOAD(pm, pn, nbx) do { const bf16_t* m_ = gM + (size_t)(nbx) * 8 * 4096; \
        _Pragma("unroll") for (int i = 0; i < 8; ++i) pm[i] = ((const u32x4*)m_)[tid + 512 * i]; \
        _Pragma("unroll") for (int i = 0; i < 4; ++i) { const int q = tid + 512 * i, chunk = q >> 8, within = q & 255; pn[i] = ((const u32x4*)(gN + ((size_t)(nbx) * 8 + chunk) * 4096))[within]; } } while (0)
#define CH_PUT(pm, pn) do { \
        _Pragma("unroll") for (int i = 0; i < 8; ++i) { const int q = tid + 512 * i, chunk = q >> 9, within = q & 511, row = within >> 3, pc = within & 7; *(LAS u32x4*)(Mb + chunk * BUFB + row * (LD * 2) + pc * 16) = pm[i]; } \
        _Pragma("unroll") for (int i = 0; i < 4; ++i) { const int q = tid + 512 * i, chunk = q >> 8, within = q & 255, row = within >> 3, pc = within & 7; *(LAS u32x4*)(Nb + chunk * (32 * LD * 2) + row * (LD * 2) + pc * 16) = pn[i]; } } while (0)
    CH_LOAD(pmA, pnA4, 0);
    f32x4 acc[4];
#pragma unroll
    for (int t = 0; t < 4; ++t) acc[t] = (f32x4){0.f, 0.f, 0.f, 0.f};
#define CH_FRAGS(cc_, mf_, nf_) do { const LAS unsigned char* mc = Mb + (cc_) * BUFB; const LAS unsigned char* nc = Nb + (cc_) * (32 * LD * 2); \
        _Pragma("unroll") for (int t = 0; t < 4; ++t) { nf_[t] = *(const LAS u32x2*)(nc + (16 * wave + r) * (LD * 2) + (16 * t + 4 * g) * 2); \
            const LAS unsigned char* mp = mc + (16 * t + r) * (LD * 2) + (4 * g) * 2; const u32x2 lo = *(const LAS u32x2*)mp, hi = *(const LAS u32x2*)(mp + 32); mf_[t] = (u32x4){lo[0], lo[1], hi[0], hi[1]}; } } while (0)
#define CH_ONE(cc_, mf_, nf_) do { \
            u32x4 m2[4]; { const LAS unsigned char* mc = Mb + (cc_) * BUFB; \
            _Pragma("unroll") for (int t = 0; t < 4; ++t) { const LAS unsigned char* mp = mc + (16 * t + r) * (LD * 2) + (32 + 4 * g) * 2; const u32x2 lo = *(const LAS u32x2*)mp, hi = *(const LAS u32x2*)(mp + 32); m2[t] = (u32x4){lo[0], lo[1], hi[0], hi[1]}; } } \
            u32x2 pk[4]; \
            _Pragma("unroll") for (int t = 0; t < 4; ++t) pk[t] = (u32x2){pk2(acc[t][0], acc[t][1]), pk2(acc[t][2], acc[t][3])}; \
            LAS unsigned char* sg = Sb + (cc_) * 4096 + (16 * wave + r) * 128 + (4 * g) * 2; \
            _Pragma("unroll") for (int t = 0; t < 4; ++t) *(LAS u32x2*)(sg + 32 * t) = pk[t]; \
            bf16x8 zb[2]; \
            _Pragma("unroll") for (int s = 0; s < 2; ++s) { const u32x4 z = (u32x4){pk[2 * s][0], pk[2 * s][1], pk[2 * s + 1][0], pk[2 * s + 1][1]}; zb[s] = __builtin_bit_cast(bf16x8, z); } \
            _Pragma("unroll") for (int t = 0; t < 4; ++t) { const u32x2 nw = nf_[t]; const f32x4 a0 = (f32x4){bflo(nw[0]), bfhi(nw[0]), bflo(nw[1]), bfhi(nw[1])}; \
                acc[t] = mfma16(__builtin_bit_cast(bf16x8, mf_[t]), zb[0], a0); } \
            _Pragma("unroll") for (int t = 0; t < 4; ++t) acc[t] = mfma16(__builtin_bit_cast(bf16x8, m2[t]), zb[1], acc[t]); } while (0)
#define CH_STEP(nbx) do { if (wave < 2) { u32x4 mf0[4], mf1[4]; u32x2 nf0[4], nf1[4]; CH_FRAGS(0, mf0, nf0); \
        _Pragma("unroll 1") for (int cc = 0; cc < 8; cc += 2) { \
            CH_FRAGS(cc + 1, mf1, nf1); CH_ONE(cc, mf0, nf0); \
            if (cc + 2 < 8) CH_FRAGS(cc + 2, mf0, nf0); CH_ONE(cc + 1, mf1, nf1); } } } while (0)
#define CH_SOUT(nbx) do { _Pragma("unroll") for (int i = 0; i < 4; ++i) { const int q = tid + 512 * i, chunk = q >> 8, within = q & 255, row = within >> 3, pc = within & 7; \
        const u32x4 v = *(const LAS u32x4*)(Sb + chunk * 4096 + row * 128 + pc * 16); *(u32x4*)(gS + ((size_t)(nbx) * 8 + chunk) * 4096 + (32 * vh + row) * 64 + pc * 8) = v; } } while (0)
    for (int nb = 0; nb < 16; ++nb) {
        LDS_BARRIER(); if (nb > 0) CH_SOUT(nb - 1); CH_PUT(pmA, pnA4); LDS_BARRIER();
        if (nb + 1 < 16) CH_LOAD(pmA, pnA4, nb + 1);
        CH_STEP(nb);
    }
    LDS_BARRIER(); CH_SOUT(15);
#undef CH_SOUT
#undef CH_LOAD
#undef CH_PUT
#undef CH_STEP
#undef CH_FRAGS
#undef CH_ONE
}
__device__ __forceinline__ void mlstm_cscan(const Ctx& C, int bh, int part) {
    const int tid = C.tid; const size_t ch0 = (size_t)bh * 128; const int e0 = 10 * (part * 128 + (tid & 127));
    const bf16_t* KL = (const bf16_t*)(C.ws + WS_MLKL) + ch0 * 5120 + e0; bf16_t* CT = (bf16_t*)(C.ws + WS_MLCT) + ch0 * 5120 + e0; float* MM = (float*)(C.ws + WS_MLM) + ch0; const float* SC = (const float*)(C.ws + WS_MLSC) + ch0 * 2;
    float st[10]; unsigned ring[8][5]; float m = 0.f;
    LAS float* scl = (LAS float*)C.lds; if (tid < 256) scl[tid] = SC[tid];
    __syncthreads();
    if (tid >= 128) return;
#pragma unroll
    for (int i = 0; i < 10; ++i) st[i] = 0.f;
#pragma unroll
    for (int k = 0; k < 8; ++k)
#pragma unroll
        for (int i = 0; i < 5; ++i) ring[k][i] = *(const unsigned*)(KL + (size_t)k * 5120 + 2 * i);
    for (int c0 = 0; c0 < 128; c0 += 8) {
#pragma unroll
        for (int k = 0; k < 8; ++k) { const int c = c0 + k; unsigned cur[5];
#pragma unroll
            for (int i = 0; i < 5; ++i) cur[i] = ring[k][i];
            if (c + 8 < 128) {
#pragma unroll
                for (int i = 0; i < 5; ++i) ring[k][i] = *(const unsigned*)(KL + (size_t)(c + 8) * 5120 + 2 * i); }
            const float bcL = scl[2 * c], mloc = scl[2 * c + 1];
            unsigned* ct = (unsigned*)(CT + (size_t)c * 5120);
#pragma unroll
            for (int i = 0; i < 5; ++i) ct[i] = pk2(st[2 * i], st[2 * i + 1]);
            if (tid == 0 && part == 0) MM[c] = m;
            const float mn = fmaxf(bcL + m, mloc); const float dec = __expf(bcL + m - mn), sc = __expf(mloc - mn); m = mn;
#pragma unroll
            for (int i = 0; i < 5; ++i) { st[2 * i] = dec * st[2 * i] + sc * bflo(cur[i]); st[2 * i + 1] = dec * st[2 * i + 1] + sc * bfhi(cur[i]); } }
    }
}

__device__ __forceinline__ void passd_unit(const Params& P, const Ctx& C, int l, int u) {
    const int wave = C.wave, lane = C.lane, r = lane & 15, g = lane >> 4; const int b = u >> 7, c = u & 127; const int tok0 = b * SEQ + c * 64;
    bf16_t* ymix = (bf16_t*)(C.ws + WS_YMIX);
    {
        bf16x8 qf[3][2], sf[3][4][2]; u32x2 yl[3][4], bo[3][4], gg[3][4];
#pragma unroll
        for (int n_ = 0; n_ < 3; ++n_) { const int task = wave + 8 * n_, h = task >> 2, tb = task & 3; const size_t ch = (size_t)(b * 6 + h) * 128 + c; const int t = 16 * tb + r; const int tok = tok0 + t;
            const bf16_t* gS = (const bf16_t*)(C.ws + WS_RWS) + ch * 4096; const bf16_t* gQ = (const bf16_t*)(C.ws + WS_RWQH) + ch * 4096 + t * 64 + 8 * g; const bf16_t* gY = (const bf16_t*)(C.ws + WS_RWYL) + ch * 4096 + t * 64 + 4 * g;
            const bf16_t* aux = (const bf16_t*)(C.ws + WS_RWAUX) + (size_t)tok * 768 + 64 * h + 4 * g;
            qf[n_][0] = *(const bf16x8*)gQ; qf[n_][1] = *(const bf16x8*)(gQ + 32);
#pragma unroll
            for (int ti = 0; ti < 4; ++ti) { const bf16_t* sp = gS + (16 * ti + r) * 64 + 8 * g; sf[n_][ti][0] = *(const bf16x8*)sp; sf[n_][ti][1] = *(const bf16x8*)(sp + 32);
                yl[n_][ti] = *(const u32x2*)(gY + 16 * ti); bo[n_][ti] = *(const u32x2*)(aux + 16 * ti); gg[n_][ti] = *(const u32x2*)(aux + RWD + 16 * ti); } }
#pragma unroll
        for (int n_ = 0; n_ < 3; ++n_) { const int task = wave + 8 * n_, h = task >> 2, tb = task & 3; const int t = 16 * tb + r; const int tok = tok0 + t;
            f32x4 y[4]; float s = 0.f;
#pragma unroll
            for (int ti = 0; ti < 4; ++ti) { const u32x2 yw = yl[n_][ti]; f32x4 a = (f32x4){bflo(yw[0]), bfhi(yw[0]), bflo(yw[1]), bfhi(yw[1])};
                a = mfma16(sf[n_][ti][0], qf[n_][0], a); a = mfma16(sf[n_][ti][1], qf[n_][1], a); y[ti] = a; s += (a[0] + a[1]) + (a[2] + a[3]); }
            s += __shfl_xor(s, 16); s += __shfl_xor(s, 32); const float mean = s * (1.f / 64.f); float s2 = 0.f;
#pragma unroll
            for (int ti = 0; ti < 4; ++ti) { y[ti] = y[ti] - mean; s2 += (y[ti][0] * y[ti][0] + y[ti][1] * y[ti][1]) + (y[ti][2] * y[ti][2] + y[ti][3] * y[ti][3]); }
            s2 += __shfl_xor(s2, 16); s2 += __shfl_xor(s2, 32); const float rstd = rsqrtf(s2 * (1.f / 64.f) + 64e-5f);
            bf16_t* yo = ymix + (size_t)tok * DM + 64 * h + 4 * g;
            const float* lw = P.in[I_LNW] + l * RWD + 64 * h + 4 * g; const float* lb = P.in[I_LNB] + l * RWD + 64 * h + 4 * g;
#pragma unroll
            for (int ti = 0; ti < 4; ++ti) { const u32x2 bo_ = bo[n_][ti], gg_ = gg[n_][ti]; const f32x4 w4 = *(const f32x4*)(lw + 16 * ti), b4 = *(const f32x4*)(lb + 16 * ti);
                const float o0 = (y[ti][0] * rstd * w4[0] + b4[0] + bflo(bo_[0])) * bflo(gg_[0]), o1 = (y[ti][1] * rstd * w4[1] + b4[1] + bfhi(bo_[0])) * bfhi(gg_[0]);
                const float o2 = (y[ti][2] * rstd * w4[2] + b4[2] + bflo(bo_[1])) * bflo(gg_[1]), o3 = (y[ti][3] * rstd * w4[3] + b4[3] + bfhi(bo_[1])) * bfhi(gg_[1]);
                *(u32x2*)(yo + 16 * ti) = (u32x2){pk2(o0, o1), pk2(o2, o3)}; } }
    }
    {
        bf16x8 qf[2][2], cf[2][5][2]; u32x2 nl[2][5], og[2][4]; float bcl[2], mdl[2], mcv[2];
#pragma unroll
        for (int n_ = 0; n_ < 2; ++n_) { const int task = wave + 8 * (n_ + 3), hh = (task - 24) >> 2, tb = task & 3; const size_t ch = (size_t)(b * 4 + hh) * 128 + c; const int t = 16 * tb + r; const int tok = tok0 + t;
            const bf16_t* gC = (const bf16_t*)(C.ws + WS_MLCT) + ch * 5120; const bf16_t* gQ = (const bf16_t*)(C.ws + WS_MLQ) + ch * 4096 + t * 64 + 8 * g; const bf16_t* gNL = (const bf16_t*)(C.ws + WS_MLNL) + ch * 5120 + t * 80 + 4 * g;
            const bf16_t* ogp = (const bf16_t*)(C.ws + WS_P) + (size_t)tok * NPROJ + 2816 + 64 * hh + 4 * g;
            qf[n_][0] = *(const bf16x8*)gQ; qf[n_][1] = *(const bf16x8*)(gQ + 32);
            const float* vec = (const float*)(C.ws + WS_MLVEC) + (ch * 64 + t) * 2; bcl[n_] = vec[0]; mdl[n_] = vec[1]; mcv[n_] = ((const float*)(C.ws + WS_MLM))[ch];
#pragma unroll
            for (int ti = 0; ti < 5; ++ti) { const bf16_t* cp = gC + (16 * ti + r) * 64 + 8 * g; cf[n_][ti][0] = *(const bf16x8*)cp; cf[n_][ti][1] = *(const bf16x8*)(cp + 32); nl[n_][ti] = *(const u32x2*)(gNL + 16 * ti); }
#pragma unroll
            for (int ti = 0; ti < 4; ++ti) og[n_][ti] = *(const u32x2*)(ogp + 16 * ti); }
#pragma unroll
        for (int n_ = 0; n_ < 2; ++n_) { const int task = wave + 8 * (n_ + 3), hh = (task - 24) >> 2, tb = task & 3; const int t = 16 * tb + r; const int tok = tok0 + t;
            const float mint = bcl[n_] + mcv[n_], mt = fmaxf(mint, mdl[n_]); const float inter = __expf(mint - mt), fl = __expf(mdl[n_] - mt);
            f32x4 y[5];
#pragma unroll
            for (int ti = 0; ti < 5; ++ti) { f32x4 a = (f32x4){0.f, 0.f, 0.f, 0.f};
                a = mfma16(cf[n_][ti][0], qf[n_][0], a); a = mfma16(cf[n_][ti][1], qf[n_][1], a); const u32x2 nw = nl[n_][ti]; const f32x4 nlv = (f32x4){bflo(nw[0]), bfhi(nw[0]), bflo(nw[1]), bfhi(nw[1])}; y[ti] = fl * nlv + inter * a; }
            const float nq = __shfl(y[4][0], r);
            const float inv = 1.0f / fmaxf(fabsf(nq), __expf(-mt));
            float s = 0.f;
#pragma unroll
            for (int ti = 0; ti < 4; ++ti) { y[ti] = y[ti] * inv; s += (y[ti][0] + y[ti][1]) + (y[ti][2] + y[ti][3]); }
            s += __shfl_xor(s, 16); s += __shfl_xor(s, 32); const float mean = s * (1.f / 64.f); float s2 = 0.f;
#pragma unroll
            for (int ti = 0; ti < 4; ++ti) { y[ti] = y[ti] - mean; s2 += (y[ti][0] * y[ti][0] + y[ti][1] * y[ti][1]) + (y[ti][2] * y[ti][2] + y[ti][3] * y[ti][3]); }
            s2 += __shfl_xor(s2, 16); s2 += __shfl_xor(s2, 32); const float rstd = rsqrtf(s2 * (1.f / 64.f) + 1e-6f);
            bf16_t* yo = ymix + (size_t)tok * DM + 768 + 64 * hh + 4 * g; const float* nw = P.in[I_MLNW] + l * 256 + 64 * hh + 4 * g;
#pragma unroll
            for (int ti = 0; ti < 4; ++ti) { const u32x2 oo = og[n_][ti]; const f32x4 w4 = *(const f32x4*)(nw + 16 * ti);
                const float o0 = y[ti][0] * rstd * w4[0] * sigmoidf_(bflo(oo[0])), o1 = y[ti][1] * rstd * w4[1] * sigmoidf_(bfhi(oo[0])), o2 = y[ti][2] * rstd * w4[2] * sigmoidf_(bflo(oo[1])), o3 = y[ti][3] * rstd * w4[3] * sigmoidf_(bfhi(oo[1]));
                *(u32x2*)(yo + 16 * ti) = (u32x2){pk2(o0, o1), pk2(o2, o3)}; } }
    }
}

__device__ __forceinline__ void ln1_router_phase(const Params& P, const Ctx& C, int l, int cnt_off) {
    const int tid = C.tid, wave = C.wave, lane = C.lane, r = lane & 15, g = lane >> 4;
    constexpr int HS = 1032;
    LAS bf16_t* hhi = (LAS bf16_t*)C.lds;
    LAS bf16_t* hlo = hhi + 16 * HS;
    LAS float* part = (LAS float*)(hlo + 16 * HS);
    LAS int* lcnt = (LAS int*)(part + 8 * 8 * 32);
    bf16x8 bh[4][2], bl[4][2];
#pragma unroll
    for (int ks = 0; ks < 4; ++ks)
#pragma unroll
        for (int nt = 0; nt < 2; ++nt) { const size_t off = ((size_t)l * NEXP + 16 * nt + r) * DM + 32 * (4 * wave + ks) + 8 * g;
            bh[ks][nt] = *(const bf16x8*)((const bf16_t*)(C.ws + WS_WRH) + off); bl[ks][nt] = *(const bf16x8*)((const bf16_t*)(C.ws + WS_WRL) + off); }
    for (int i = tid; i < 16 * HS; i += 512) { hhi[i] = 0; hlo[i] = 0; }
    if (tid < 32) lcnt[tid] = 0;
    { int* pdest = (int*)(C.ws + WS_PDEST); int* ptok = (int*)(C.ws + WS_PTOK); for (int i = C.blk * 512 + tid; i < POS_MAX; i += C.G * 512) { pdest[i] = -1; ptok[i] = 0; } }
    __syncthreads();
    const int tpb = (MTOK + C.G - 1) / C.G, tok_lo = C.blk * tpb, tok_hi = (tok_lo + tpb < MTOK) ? tok_lo + tpb : MTOK;
    const bf16_t* t1 = (const bf16_t*)(C.ws + WS_T1); bf16_t* hb = (bf16_t*)(C.ws + WS_HB);
    int* toke = (int*)(C.ws + WS_TOKE); float* tokg = (float*)(C.ws + WS_TOKG); int* toklr = (int*)(C.ws + WS_TOKLR);
    const f32x4* lw4 = (const f32x4*)(P.in[I_LN1W] + (size_t)l * DM) + lane; const f32x4* lb4 = (const f32x4*)(P.in[I_LN1B] + (size_t)l * DM) + lane;
    u32x2 vn[4], rn[4];
    { const int tok = tok_lo + wave; const size_t ro = (size_t)((tok < tok_hi) ? tok : tok_lo) * DM; const u32x2* xr = (const u32x2*)(t1 + ro) + lane; const u32x2* rr = (const u32x2*)(hb + ro) + lane;
#pragma unroll
      for (int j = 0; j < 4; ++j) { vn[j] = xr[64 * j]; rn[j] = rr[64 * j]; } }
    const float rbias = P.in[I_RB][l * NEXP + (lane & 31)];
    for (int base = tok_lo; base < tok_hi; base += 8) {
        const int tok = base + wave;
        f32x4 v[4];
#pragma unroll
        for (int j = 0; j < 4; ++j) v[j] = (f32x4){bflo(vn[j][0]), bfhi(vn[j][0]), bflo(vn[j][1]), bfhi(vn[j][1])} + DN_ALPHA * (f32x4){bflo(rn[j][0]), bfhi(rn[j][0]), bflo(rn[j][1]), bfhi(rn[j][1])};
        { const int tn = base + 8 + wave; const size_t ro = (size_t)((tn < tok_hi) ? tn : tok_lo) * DM; const u32x2* xr = (const u32x2*)(t1 + ro) + lane; const u32x2* rr = (const u32x2*)(hb + ro) + lane;
#pragma unroll
          for (int j = 0; j < 4; ++j) { vn[j] = xr[64 * j]; rn[j] = rr[64 * j]; } }
        if (tok < tok_hi) {
            float s = 0.f;
#pragma unroll
            for (int j = 0; j < 4; ++j) s += (v[j][0] + v[j][1]) + (v[j][2] + v[j][3]);
            const float mean = wave_sum(s) * (1.f / DM); float s2 = 0.f;
#pragma unroll
            for (int j = 0; j < 4; ++j) { v[j] = v[j] - mean; s2 += (v[j][0] * v[j][0] + v[j][1] * v[j][1]) + (v[j][2] * v[j][2] + v[j][3] * v[j][3]); }
            const float rstd = rsqrtf(wave_sum(s2) * (1.f / DM) + LN_EPS);
            u32x2* ob = (u32x2*)(hb + (size_t)tok * DM) + lane;
#pragma unroll
            for (int j = 0; j < 4; ++j) { const f32x4 y = v[j] * rstd * lw4[64 * j] + lb4[64 * j]; const u32x2 hi = (u32x2){pk2(y[0], y[1]), pk2(y[2], y[3])}; ob[64 * j] = hi;
                const u32x2 lo = (u32x2){pk2(y[0] - bflo(hi[0]), y[1] - bfhi(hi[0])), pk2(y[2] - bflo(hi[1]), y[3] - bfhi(hi[1]))};
                *(LAS u32x2*)(hhi + wave * HS + 4 * (lane + 64 * j)) = hi; *(LAS u32x2*)(hlo + wave * HS + 4 * (lane + 64 * j)) = lo; }
        }
        __syncthreads();
        { f32x4 acc[2]; acc[0] = (f32x4){0.f, 0.f, 0.f, 0.f}; acc[1] = acc[0];
#pragma unroll
          for (int ks = 0; ks < 4; ++ks) { const int ko = r * HS + 32 * (4 * wave + ks) + 8 * g; const bf16x8 ah = *(const LAS bf16x8*)(hhi + ko), al = *(const LAS bf16x8*)(hlo + ko);
#pragma unroll
              for (int nt = 0; nt < 2; ++nt) { acc[nt] = mfma16(ah, bh[ks][nt], acc[nt]); acc[nt] = mfma16(ah, bl[ks][nt], acc[nt]); acc[nt] = mfma16(al, bh[ks][nt], acc[nt]); } }
          if (g < 2) {
#pragma unroll
              for (int nt = 0; nt < 2; ++nt)
#pragma unroll
                  for (int j = 0; j < 4; ++j) part[(wave * 8 + 4 * g + j) * 32 + 16 * nt + r] = acc[nt][j]; } }
        __syncthreads();
        if (tok < tok_hi) { const int ee = lane & 31; float lg = rbias;
#pragma unroll
            for (int w8 = 0; w8 < 8; ++w8) lg += part[(w8 * 8 + wave) * 32 + ee];
            float bv[4]; int bi[4];
#pragma unroll
            for (int rd = 0; rd < 4; ++rd) { float mv = lg; int mi = ee;
#pragma unroll
                for (int o = 1; o < 32; o <<= 1) { const float ov = __shfl_xor(mv, o); const int oi = __shfl_xor(mi, o); const bool take = (ov > mv) || (ov == mv && oi < mi); mv = take ? ov : mv; mi = take ? oi : mi; }
                bv[rd] = mv; bi[rd] = mi; lg = (ee == mi) ? -__builtin_inff() : lg; }
            if (lane == 0) { const float e1 = __expf(bv[1] - bv[0]), e2 = __expf(bv[2] - bv[0]), e3 = __expf(bv[3] - bv[0]); const float inv = 1.0f / (1.0f + e1 + e2 + e3);
                const int l0 = __hip_atomic_fetch_add(&lcnt[bi[0]], 1, __ATOMIC_RELAXED, __HIP_MEMORY_SCOPE_WORKGROUP), l1 = __hip_atomic_fetch_add(&lcnt[bi[1]], 1, __ATOMIC_RELAXED, __HIP_MEMORY_SCOPE_WORKGROUP), l2 = __hip_atomic_fetch_add(&lcnt[bi[2]], 1, __ATOMIC_RELAXED, __HIP_MEMORY_SCOPE_WORKGROUP), l3 = __hip_atomic_fetch_add(&lcnt[bi[3]], 1, __ATOMIC_RELAXED, __HIP_MEMORY_SCOPE_WORKGROUP);
                *(int4*)(toke + tok * 4) = make_int4(bi[0], bi[1], bi[2], bi[3]); *(f32x4*)(tokg + tok * 4) = (f32x4){inv, e1 * inv, e2 * inv, e3 * inv}; *(int4*)(toklr + tok * 4) = make_int4(l0, l1, l2, l3); } }
        __syncthreads();
    }
    if (tid < 32) { unsigned* gc = (unsigned*)(C.ws + WS_CTL) + CW_CNT + cnt_off + l * 32 + tid;
        const unsigned bb = __hip_atomic_fetch_add(gc, (unsigned)lcnt[tid], __ATOMIC_RELAXED, __HIP_MEMORY_SCOPE_AGENT);
        ((int*)(C.ws + WS_BBASE))[C.blk * 32 + tid] = (int)bb; }
    __syncthreads();
}
__device__ __forceinline__ void permute_phase(const Params& P, const Ctx& C, int l) {
    const int tid = C.tid, wave = C.wave, lane = C.lane;
    LAS int* pst = (LAS int*)C.lds;
    if (tid == 0) { const unsigned* gc = (const unsigned*)(C.ws + WS_CTL) + CW_CNT + l * 32; int ps = 0;
        for (int e = 0; e < 32; ++e) { pst[e] = ps; ps += ((int)__hip_atomic_load(gc + e, __ATOMIC_RELAXED, __HIP_MEMORY_SCOPE_AGENT) + 255) & ~255; } }
    __syncthreads();
    const int tpb = (MTOK + C.G - 1) / C.G, tok_lo = C.blk * tpb, tok_hi = (tok_lo + tpb < MTOK) ? tok_lo + tpb : MTOK;
    const int* toke = (const int*)(C.ws + WS_TOKE); const float* tokg = (const float*)(C.ws + WS_TOKG); const int* toklr = (const int*)(C.ws + WS_TOKLR); const int* bbase = (const int*)(C.ws + WS_BBASE) + C.blk * 32;
    const bf16_t* hb = (const bf16_t*)(C.ws + WS_HB); bf16_t* xp = (bf16_t*)(C.ws + WS_XPERM); int* pdest = (int*)(C.ws + WS_PDEST); float* pgate = (float*)(C.ws + WS_PGATE);
    int* ptok = (int*)(C.ws + WS_PTOK);
    for (int a = tid; a < 4 * (tok_hi - tok_lo); a += 512) { const int tok = tok_lo + (a >> 2), as = tok * 4 + (a & 3);
        const int e = toke[as]; const int pos = pst[e] + bbase[e] + toklr[as];
        pdest[pos] = as; pgate[pos] = tokg[as]; ptok[pos] = tok; }
    __syncthreads();
}
__device__ __forceinline__ void build_tile_e(const Ctx& C, int l) {
    LAS int* te = (LAS int*)(C.lds + TILEE_OFF);
    if (C.tid == 0) { const unsigned* gc = (const unsigned*)(C.ws + WS_CTL) + CW_CNT + l * 32; int t = 0;
        for (int e = 0; e < 32; ++e) { const int nt = ((int)__hip_atomic_load(gc + e, __ATOMIC_RELAXED, __HIP_MEMORY_SCOPE_AGENT) + 255) >> 8; for (int k = 0; k < nt && t < NT_MAX; ++k) te[t++] = e; }
        for (; t < NT_MAX; ++t) te[t] = 0; }
    __syncthreads();
}
__device__ __forceinline__ void combine_ln2_phase(const Params& P, const Ctx& C, int l) {
    const int lane = C.lane; const int gw = C.blk * 8 + C.wave, NGW = C.G * 8;
    const bool last = (l == NLAYER - 1);
    LAS float* wg = (LAS float*)C.lds;
    if (!last) load_wg(wg, P.in[I_WIN] + (size_t)(l + 1) * DM * CIN, C.tid);
    const bf16_t* yb = (const bf16_t*)(C.ws + WS_YB);
    float* hf = P.out; bf16_t* hb = (bf16_t*)(C.ws + WS_HB); float* pg = (float*)(C.ws + WS_PG);
    const f32x4* lw4 = (const f32x4*)(P.in[I_LN2W] + (size_t)l * DM) + lane; const f32x4* lb4 = (const f32x4*)(P.in[I_LN2B] + (size_t)l * DM) + lane;
    u32x2 nh[4], ny[4][4];
    { const int tok = (gw < MTOK) ? gw : 0; const u32x2* xr = (const u32x2*)(hb + (size_t)tok * DM) + lane;
#pragma unroll
      for (int j = 0; j < 4; ++j) nh[j] = xr[64 * j];
#pragma unroll
      for (int sl = 0; sl < 4; ++sl) { const u32x2* yr = (const u32x2*)(yb + (size_t)(tok * 4 + sl) * DM) + lane;
#pragma unroll
          for (int j = 0; j < 4; ++j) ny[sl][j] = yr[64 * j]; } }
    for (int tok = gw; tok < MTOK; tok += NGW) {
        f32x4 v[4]; float s = 0.f;
#pragma unroll
        for (int j = 0; j < 4; ++j) { v[j] = (f32x4){bflo(nh[j][0]), bfhi(nh[j][0]), bflo(nh[j][1]), bfhi(nh[j][1])} * DN_ALPHA;
#pragma unroll
            for (int sl = 0; sl < 4; ++sl) { const u32x2 w = ny[sl][j]; v[j][0] += bflo(w[0]); v[j][1] += bfhi(w[0]); v[j][2] += bflo(w[1]); v[j][3] += bfhi(w[1]); } }
        { const int tn = (tok + NGW < MTOK) ? tok + NGW : tok; const u32x2* xr = (const u32x2*)(hb + (size_t)tn * DM) + lane;
#pragma unroll
          for (int j = 0; j < 4; ++j) nh[j] = xr[64 * j];
#pragma unroll
          for (int sl = 0; sl < 4; ++sl) { const u32x2* yr = (const u32x2*)(yb + (size_t)(tn * 4 + sl) * DM) + lane;
#pragma unroll
              for (int j = 0; j < 4; ++j) ny[sl][j] = yr[64 * j]; } }
#pragma unroll
        for (int j = 0; j < 4; ++j) s += (v[j][0] + v[j][1]) + (v[j][2] + v[j][3]);
        const float mean = wave_sum(s) * (1.f / DM); float s2 = 0.f;
#pragma unroll
        for (int j = 0; j < 4; ++j) { v[j] = v[j] - mean; s2 += (v[j][0] * v[j][0] + v[j][1] * v[j][1]) + (v[j][2] * v[j][2] + v[j][3] * v[j][3]); }
        const float rstd = rsqrtf(wave_sum(s2) * (1.f / DM) + LN_EPS);
#pragma unroll
        for (int j = 0; j < 4; ++j) v[j] = v[j] * rstd * lw4[64 * j] + lb4[64 * j];
        if (last) { f32x4* of = (f32x4*)(hf + (size_t)tok * DM) + lane;
#pragma unroll
            for (int j = 0; j < 4; ++j) of[64 * j] = v[j]; }
        if (!last) { u32x2* ob = (u32x2*)(hb + (size_t)tok * DM) + lane;
#pragma unroll
            for (int j = 0; j < 4; ++j) ob[64 * j] = (u32x2){pk2(v[j][0], v[j][1]), pk2(v[j][2], v[j][3])};
            gate_cols(v, wg, P.in[I_BIN] + (size_t)(l + 1) * CIN + NPROJ, pg + (size_t)tok * 8, lane); }
    }
}

typedef const __attribute__((address_space(4))) Params* CParamsPtr;
__device__ __forceinline__ const Params* kparams() {
    const unsigned long long a = (unsigned long long)__builtin_amdgcn_kernarg_segment_ptr(); unsigned lo = (unsigned)a, hi = (unsigned)(a >> 32);
    asm volatile("" : "+v"(lo), "+v"(hi));
    lo = __builtin_amdgcn_readfirstlane(lo); hi = __builtin_amdgcn_readfirstlane(hi);
    return (const Params*)(CParamsPtr)(((unsigned long long)hi << 32) | lo);
}
__device__ __forceinline__ Ctx make_ctx(const Params& P, LAS unsigned char* lds, int wv0) {
    Ctx C; C.lds = lds; unsigned ones_ = ~0u; asm volatile("" : "+s"(ones_)); int t_ = wv0 * 64 + (int)__builtin_amdgcn_mbcnt_hi(ones_, __builtin_amdgcn_mbcnt_lo(ones_, 0u)), b_ = blockIdx.x, g_ = gridDim.x; asm volatile("" : "+v"(t_), "+v"(b_), "+v"(g_)); b_ = __builtin_amdgcn_readfirstlane(b_); g_ = __builtin_amdgcn_readfirstlane(g_);
    C.tid = t_; C.lane = C.tid & 63; C.wave = __builtin_amdgcn_readfirstlane(C.tid >> 6); C.blk = b_; C.G = g_; C.ws = P.ws; return C; }
__global__ void __launch_bounds__(512, 2) hybrid_fwd(Params Punused) {
    extern __shared__ __attribute__((aligned(16))) unsigned char lds_raw[];
    LAS unsigned char* const lds = (LAS unsigned char*)lds_raw;
    const int wv0 = __builtin_amdgcn_readfirstlane((int)threadIdx.x >> 6);
    volatile LAS unsigned* MISC = (volatile LAS unsigned*)(lds + MISC_OFF);
    for (int u = threadIdx.x; u < (LDS_BYTES - MISC_OFF) / 4; u += 512) MISC[u] = 0u;
    __syncthreads();
    const int lo = __builtin_amdgcn_readfirstlane(kparams()->ph_lo), hi = __builtin_amdgcn_readfirstlane(kparams()->ph_hi);
    #define IS_T0 (wv0 == 0 && __builtin_amdgcn_mbcnt_hi(~0u, __builtin_amdgcn_mbcnt_lo(~0u, 0u)) == 0u)
    if (hi - lo > 1) (void)xcd_barrier_post((unsigned*)(kparams()->ws + WS_CTL) + CW_BAR, MISC + 8, IS_T0);
#ifndef PHMASK
#define PHMASK 0x7ff
#endif
#define PH_EN(k) (((PHMASK) >> (k)) & 1)
#define RUN(gid) ((gid) >= lo && (gid) < hi)
#define SEAM(gid) do { if ((gid) + 1 < hi) { XcdBarrier bar_; bar_.bar = (unsigned*)(kparams()->ws + WS_CTL) + CW_BAR; bar_.x = xb_xcc_id(); bar_.st = (volatile LAS unsigned*)(lds + MISC_OFF) + 8; xcd_barrier(bar_, IS_T0); if (DUPBAR) xcd_barrier(bar_, IS_T0); } } while (0)
#ifndef DUPMASK
#define DUPMASK 0
#endif
#ifndef DUPBAR
#define DUPBAR 0
#endif
#define DUP(k) for (int rep_ = 0; rep_ < 1 + (((DUPMASK) >> (k)) & 1); ++rep_)
#define PHASE_BEGIN const Params& P = *kparams(); const Ctx C = make_ctx(P, lds, wv0);
    if (PH_EN(0) && RUN(0)) { DUP(0) { PHASE_BEGIN p0_prologue(P, C); } SEAM(0); }
#pragma unroll 1
    for (int l = 0; l < NLAYER; ++l) {
        const int g0 = 1 + l * NPH;
        if (g0 + NPH <= lo || g0 >= hi) continue;
        if (PH_EN(1) && RUN(g0 + 0)) {
            DUP(1) { PHASE_BEGIN
            pg8::Gemm g{(const bf16_t*)(C.ws + WS_HB), (const bf16_t*)(C.ws + WS_WIN) + (size_t)l * NPROJ * DM, MTOK, NPROJ, DM}; pg8::StaticOrder S; S.init(MTOK, NPROJ, C.G, C.blk);
            pg8::EpiBf16b E{(bf16_t*)(C.ws + WS_P), NPROJ, P.in[I_BIN] + (size_t)l * CIN};
            pg8::gemm_phase<pg8::EpiBf16b, pg8::StaticOrder>(C.lds, g, S, E, nullptr, C.tid); }
            SEAM(g0 + 0); }
        if (PH_EN(2) && RUN(g0 + 1)) {
            DUP(2) { PHASE_BEGIN
            constexpr int NU_SWA = 512, NU_RW = NB * 128 * 6, NU_ML = NB * 128 * 4;
#ifndef DUP2
#define DUP2 0
#endif
            for (int rp = 0; rp < 1 + ((DUP2 >> 1) & 1); ++rp) for (int u = C.blk; u < NU_RW; u += C.G) rwb_unit(P, C, l, u);
            for (int rp = 0; rp < 1 + ((DUP2 >> 2) & 1); ++rp) for (int u = C.blk; u < NU_ML; u += C.G) mlb_unit(P, C, l, u); }
            SEAM(g0 + 1); }
        if (PH_EN(3) && RUN(g0 + 2)) {
            DUP(3) { PHASE_BEGIN
            {
#ifndef P3DUP
#define P3DUP 0
#endif
                if (C.blk < 48) { for (int rp = 0; rp < 1 + (P3DUP & 1); ++rp) { rwkv_chain(C, C.blk >> 1, C.blk & 1); __syncthreads(); } } else if (C.blk < 112) { for (int rp = 0; rp < 1 + ((P3DUP >> 1) & 1); ++rp) { mlstm_cscan(C, (C.blk - 48) >> 2, (C.blk - 48) & 3); __syncthreads(); } }
                LAS int* qslot = (LAS int*)(C.lds + MISC_OFF + 64); unsigned* qctr = (unsigned*)(C.ws + WS_CTL) + CW_SWAQ + l * 64;
                for (;;) { __syncthreads();
                    if (C.tid == 0) *qslot = (int)__hip_atomic_fetch_add(qctr, 1u, __ATOMIC_RELAXED, __HIP_MEMORY_SCOPE_AGENT);
                    __syncthreads();
                    const int u = *qslot; if (u >= 512) break;
                    swa_unit(P, C, l, u); } } }
            SEAM(g0 + 2); }
        if (PH_EN(4) && RUN(g0 + 3)) {
            DUP(4) { PHASE_BEGIN
            for (int u = C.blk; u < NB * 128; u += C.G) passd_unit(P, C, l, u); }
            SEAM(g0 + 3); }
        if (PH_EN(5) && RUN(g0 + 4)) {
            DUP(5) { PHASE_BEGIN
            pg8::Gemm g{(const bf16_t*)(C.ws + WS_YMIX), (const bf16_t*)(C.ws + WS_WOUT) + (size_t)l * DM * DM, MTOK, DM, DM}; pg8::StaticOrder S; S.init(MTOK, DM, C.G, C.blk);
            pg8::EpiPlainBf16 E{(bf16_t*)(C.ws + WS_T1), DM};
            pg8::gemm_phase<pg8::EpiPlainBf16, pg8::StaticOrder>(C.lds, g, S, E, nullptr, C.tid); }
            SEAM(g0 + 4); }
        if (PH_EN(6) && RUN(g0 + 5)) { DUP(6) { PHASE_BEGIN ln1_router_phase(P, C, l, (rep_ + 1 < 1 + (((DUPMASK) >> 6) & 1)) ? 512 : 0); } SEAM(g0 + 5); }
        if (PH_EN(7) && RUN(g0 + 6)) { DUP(7) { PHASE_BEGIN permute_phase(P, C, l); } SEAM(g0 + 6); }
        if (PH_EN(8) && RUN(g0 + 7)) {
            DUP(8) { PHASE_BEGIN
            build_tile_e(C, l);
            pg8::Gemm g{(const bf16_t*)(C.ws + WS_HB), (const bf16_t*)(C.ws + WS_WUP) + (size_t)l * NEXP * NUP * DM, POS_MAX, NUP, DM};
            pg8::MoeOrder<8> S{(const LAS int*)(C.lds + TILEE_OFF), C.G, C.blk, (const int*)(C.ws + WS_PTOK)};
            pg8::EpiSwiglu E{(bf16_t*)(C.ws + WS_ACT), P.in[I_EBUP] + (size_t)l * NEXP * NUP};
            pg8::gemm_phase<pg8::EpiSwiglu, pg8::MoeOrder<8>, false, true>(C.lds, g, S, E, nullptr, C.tid); }
            SEAM(g0 + 7); }
        if (PH_EN(9) && RUN(g0 + 8)) {
            DUP(9) { PHASE_BEGIN
            build_tile_e(C, l);
            pg8::Gemm g{(const bf16_t*)(C.ws + WS_ACT), (const bf16_t*)(C.ws + WS_WDN) + (size_t)l * NEXP * DM * DEXP, POS_MAX, DM, DEXP};
            pg8::MoeOrder<4> S{(const LAS int*)(C.lds + TILEE_OFF), C.G, C.blk, nullptr};
            pg8::EpiDown E{(bf16_t*)(C.ws + WS_YB), P.in[I_EBDN] + (size_t)l * NEXP * DM, (const int*)(C.ws + WS_PDEST), (const float*)(C.ws + WS_PGATE)};
            pg8::gemm_phase<pg8::EpiDown, pg8::MoeOrder<4>>(C.lds, g, S, E, nullptr, C.tid); }
            SEAM(g0 + 8); }
        if (PH_EN(10) && RUN(g0 + 9)) { DUP(10) { PHASE_BEGIN combine_ln2_phase(P, C, l); } SEAM(g0 + 9); }
    }
#undef RUN
#undef SEAM
}

#ifndef MK_PER_PHASE
#define MK_PER_PHASE 0
#endif
extern "C" void kernel_launch(void* const* d_in, const int* in_sizes, int n_in, void* d_out, int out_size, void* d_ws, size_t ws_size, hipStream_t stream) {
    static int grid = 0;
    if (grid == 0) {
        if (n_in != 29 || out_size != MTOK * DM || ws_size < WS_END) { fprintf(stderr, "kernel_launch: unexpected shapes (n_in %d out %d ws %zu)\n", n_in, out_size, ws_size); grid = -1; return; }
        int dev = 0, cus = 0;
        if (hipGetDevice(&dev) != hipSuccess || hipDeviceGetAttribute(&cus, hipDeviceAttributeMultiprocessorCount, dev) != hipSuccess) { grid = -1; return; }
        if (hipFuncSetAttribute((const void*)hybrid_fwd, hipFuncAttributeMaxDynamicSharedMemorySize, LDS_BYTES) != hipSuccess) { fprintf(stderr, "kernel_launch: hipFuncSetAttribute failed\n"); grid = -1; return; }
        int per_cu = 0;
        if (hipOccupancyMaxActiveBlocksPerMultiprocessor(&per_cu, (const void*)hybrid_fwd, 512, LDS_BYTES) != hipSuccess || per_cu < 1) { fprintf(stderr, "kernel_launch: occupancy query says %d\n", per_cu); }
        (void)hipGetLastError();
        grid = cus;
    }
    if (grid < 0) return;
    (void)hipMemsetAsync((char*)d_ws + WS_CTL, 0, CTL_ZERO_BYTES, stream);
    Params p; memset(&p, 0, sizeof(p));
    for (int i = 0; i < 29; ++i) p.in[i] = (const float*)d_in[i];
    p.out = (float*)d_out; p.ws = (unsigned char*)d_ws;
#if MK_PER_PHASE
    for (int ph = 0; ph < NPHASE_TOTAL; ++ph) { p.ph_lo = ph; p.ph_hi = ph + 1; hipLaunchKernelGGL(hybrid_fwd, dim3(grid), dim3(512), LDS_BYTES, stream, p); }
#else
    p.ph_lo = 0; p.ph_hi = NPHASE_TOTAL;
    hipLaunchKernelGGL(hybrid_fwd, dim3(grid), dim3(512), LDS_BYTES, stream, p);
#endif
}
```

```cpp
#include <hip/hip_runtime.h>
#include <cstdio>
#include <cstdint>
#include <cstring>

#define GAS __attribute__((address_space(1)))
#define LAS __attribute__((address_space(3)))
typedef float f32x2 __attribute__((ext_vector_type(2)));
typedef unsigned u32x2 __attribute__((ext_vector_type(2)));

namespace pg8 {
constexpr int EPI_BTAB = 140288, EPI_DTAB = 138240, EPI_GTAB = 139264;
#define PG8_LAS __attribute__((address_space(3)))
typedef unsigned short bf16_t;
typedef short bf16x8 __attribute__((ext_vector_type(8)));
typedef float f32x4 __attribute__((ext_vector_type(4)));
typedef unsigned u32x4 __attribute__((ext_vector_type(4)));
constexpr int BM = 256, BK = 64, HALF = 128, HTB = HALF * BK * 2  , STAGE_BYTES = 8 * HTB, NXCD = 8, WGM = 8;

__host__ __device__ __forceinline__ int lds_byte(int r, int c) { const int st = (r >> 4) * 2 + (c >> 5), rr = r & 15, cc = c & 31, ob = rr * 64 + cc * 2; return st * 1024 + (ob ^ (((ob >> 9) & 1) << 5)); }
__host__ __device__ __forceinline__ void stage_rc(int b, int& R, int& C) { const int st = b / 1024, sb = b % 1024, swz = sb ^ (((sb >> 9) & 1) << 5); R = (st >> 1) * 16 + swz / 64; C = (st & 1) * 32 + (swz % 64) / 2; }
__host__ __device__ __forceinline__ int perm32(int rho) { const int n = rho >> 4, i = rho & 15; return 8 * (i >> 2) + 4 * n + (i & 3); }

struct Unit { int pm, pn; };
struct Gemm { const bf16_t* A; const bf16_t* Bt; int M, N, K; };

struct StaticOrder {
    int nM, nN, nwg, G, c;
    __host__ __device__ void init(int M, int N, int G_, int c_) { nM = M / BM; nN = N / BM; nwg = nM * nN; G = G_; c = c_; }
    __host__ __device__ bool next(int i, Unit& u) const {
        const long L = (long)i * G + c; if (L >= nwg) return false;
        int wgid = (int)L; { const int q = nwg / NXCD, r = nwg % NXCD, xcd = wgid % NXCD, off = wgid / NXCD; wgid = (xcd < r ? xcd * (q + 1) : r * (q + 1) + (xcd - r) * q) + off; }
        const int nig = WGM * nN, gid = wgid / nig, fm = gid * WGM, gsz = (nM - fm) < WGM ? (nM - fm) : WGM;
        u.pm = fm + ((wgid % nig) % gsz); u.pn = (wgid % nig) / gsz; return true;
    }
    __device__ __forceinline__ void a_ready(const Unit&) const {}
    __device__ __forceinline__ void done(const Unit&) const {}
};
template <int NN> struct MoeOrder {
    const PG8_LAS int* tile_e; int G, c; const int* rowtok;
    __device__ __forceinline__ bool next(int i, Unit& u) const {
        const int s = i * G + c; if (s >= 544 * NN) return false;
        constexpr int per = 8 * NN; const int a = s / per, r = s % per, b = r >> 3, x = r & 7;
        const int pm = 68 * x + a; u.pm = pm; u.pn = tile_e[pm] * NN + b; return true;
    }
    __device__ __forceinline__ void a_ready(const Unit&) const {}
    __device__ __forceinline__ void done(const Unit&) const {}
};

__device__ __forceinline__ unsigned cvt_pk_bf16(float lo, float hi) { unsigned r; asm volatile("v_cvt_pk_bf16_f32 %0, %1, %2" : "=v"(r) : "v"(lo), "v"(hi)); return r; }

struct EpiBf16b {
    static constexpr bool PERM = true, AFTER_DRAIN = false;
    bf16_t* O; int ldc; const float* bias;
    __device__ __forceinline__ void prefetch(PG8_LAS unsigned char* lds, const Unit& u, int wid, int lane) const {
        if (wid < 4) __builtin_amdgcn_global_load_lds((const unsigned*)(bias + u.pn * BM + 64 * wid + lane), (PG8_LAS unsigned*)(lds + EPI_BTAB + wid * 256), 4, 0, 0); }
    __device__ __forceinline__ void operator()(const f32x4 (&acc)[2][2][4][2], const Unit& u, int wr, int wc, int fr, int fq, PG8_LAS unsigned char* lds) const {
        const int row0 = u.pm * BM + wr * 64 + fr; const int col0 = u.pn * BM + wc * 32 + 8 * fq;
        const PG8_LAS float* bt = (const PG8_LAS float*)(lds + EPI_BTAB) + wc * 32 + 8 * fq;
        f32x4 bv[2][2];
#pragma unroll
        for (int bj = 0; bj < 2; ++bj)
#pragma unroll
            for (int n = 0; n < 2; ++n) bv[bj][n] = *(const PG8_LAS f32x4*)(bt + bj * HALF + 4 * n);
#pragma unroll
        for (int ai = 0; ai < 2; ++ai)
#pragma unroll
            for (int m = 0; m < 4; ++m) { bf16_t* rowp = O + (size_t)(row0 + ai * HALF + m * 16) * ldc + col0;
#pragma unroll
                for (int bj = 0; bj < 2; ++bj) { const f32x4 v0 = acc[ai][bj][m][0] + bv[bj][0], v1 = acc[ai][bj][m][1] + bv[bj][1];
                    u32x4 w; w.x = cvt_pk_bf16(v0[0], v0[1]); w.y = cvt_pk_bf16(v0[2], v0[3]); w.z = cvt_pk_bf16(v1[0], v1[1]); w.w = cvt_pk_bf16(v1[2], v1[3]);
                    *(u32x4*)(rowp + bj * HALF) = w; } }
    }
};
struct EpiPlainBf16 {
    static constexpr bool PERM = true, AFTER_DRAIN = false;
    bf16_t* O; int ldc;
    __device__ __forceinline__ void prefetch(PG8_LAS unsigned char*, const Unit&, int, int) const {}
    __device__ __forceinline__ void operator()(const f32x4 (&acc)[2][2][4][2], const Unit& u, int wr, int wc, int fr, int fq, PG8_LAS unsigned char*) const {
        const int row0 = u.pm * BM + wr * 64 + fr, col0 = u.pn * BM + wc * 32 + 8 * fq;
#pragma unroll
        for (int ai = 0; ai < 2; ++ai)
#pragma unroll
            for (int m = 0; m < 4; ++m) { bf16_t* rowp = O + (size_t)(row0 + ai * HALF + m * 16) * ldc + col0;
#pragma unroll
                for (int bj = 0; bj < 2; ++bj) { const f32x4 v0 = acc[ai][bj][m][0], v1 = acc[ai][bj][m][1];
                    u32x4 w; w.x = cvt_pk_bf16(v0[0], v0[1]); w.y = cvt_pk_bf16(v0[2], v0[3]); w.z = cvt_pk_bf16(v1[0], v1[1]); w.w = cvt_pk_bf16(v1[2], v1[3]);
                    *(u32x4*)(rowp + bj * HALF) = w; } }
    }
};
struct EpiSwiglu {
    static constexpr bool PERM = true, AFTER_DRAIN = false;
    bf16_t* O; const float* bias;
    __device__ __forceinline__ void prefetch(PG8_LAS unsigned char* lds, const Unit& u, int wid, int lane) const {
        if (wid < 4) __builtin_amdgcn_global_load_lds((const unsigned*)(bias + u.pn * BM + 64 * wid + lane), (PG8_LAS unsigned*)(lds + EPI_BTAB + wid * 256), 4, 0, 0); }
    __device__ __forceinline__ void operator()(const f32x4 (&acc)[2][2][4][2], const Unit& u, int wr, int wc, int fr, int fq, PG8_LAS unsigned char* lds) const {
        const int row0 = u.pm * BM + wr * 64 + fr;
        const int ocol0 = ((u.pn & 7) * BM + wc * 32 + 8 * fq) >> 1;
        const PG8_LAS float* bt = (const PG8_LAS float*)(lds + EPI_BTAB) + wc * 32 + 8 * fq;
        f32x4 bv[2][2];
#pragma unroll
        for (int bj = 0; bj < 2; ++bj)
#pragma unroll
            for (int n = 0; n < 2; ++n) bv[bj][n] = *(const PG8_LAS f32x4*)(bt + bj * HALF + 4 * n);
#pragma unroll
        for (int ai = 0; ai < 2; ++ai)
#pragma unroll
            for (int m = 0; m < 4; ++m) { bf16_t* rowp = O + (size_t)(row0 + ai * HALF + m * 16) * 1024 + ocol0;
#pragma unroll
                for (int bj = 0; bj < 2; ++bj) { const f32x4 v0 = acc[ai][bj][m][0] + bv[bj][0], v1 = acc[ai][bj][m][1] + bv[bj][1];
                    float o[4];
#pragma unroll
                    for (int q = 0; q < 4; ++q) { const float gl = (q < 2) ? v0[2 * q] : v1[2 * q - 4], li = (q < 2) ? v0[2 * q + 1] : v1[2 * q - 3];
                        const float hg = fminf(gl, 7.0f), hl = fminf(fmaxf(li, -7.0f), 7.0f);
                        o[q] = hg * (hl + 1.0f) * __builtin_amdgcn_rcpf(1.0f + __expf(-1.702f * hg)); }
                    u32x2 w; w.x = cvt_pk_bf16(o[0], o[1]); w.y = cvt_pk_bf16(o[2], o[3]);
                    *(u32x2*)(rowp + bj * (HALF / 2)) = w; } }
    }
};
struct EpiDown {
    static constexpr bool PERM = true, AFTER_DRAIN = false;
    bf16_t* O; const float* bias; const int* dest; const float* gate;
    __device__ __forceinline__ void prefetch(PG8_LAS unsigned char* lds, const Unit& u, int wid, int lane) const {
        if (wid < 4) { __builtin_amdgcn_global_load_lds((const unsigned*)(bias + u.pn * BM + 64 * wid + lane), (PG8_LAS unsigned*)(lds + EPI_BTAB + wid * 256), 4, 0, 0);
                       __builtin_amdgcn_global_load_lds((const unsigned*)(dest + u.pm * BM + 64 * wid + lane), (PG8_LAS unsigned*)(lds + EPI_DTAB + wid * 256), 4, 0, 0); }
        else __builtin_amdgcn_global_load_lds((const unsigned*)(gate + u.pm * BM + 64 * (wid - 4) + lane), (PG8_LAS unsigned*)(lds + EPI_GTAB + (wid - 4) * 256), 4, 0, 0); }
    __device__ __forceinline__ void operator()(const f32x4 (&acc)[2][2][4][2], const Unit& u, int wr, int wc, int fr, int fq, PG8_LAS unsigned char* lds) const {
        const int rloc = wr * 64 + fr;
        const int ocol0 = (u.pn & 3) * BM + wc * 32 + 8 * fq;
        const PG8_LAS float* bt = (const PG8_LAS float*)(lds + EPI_BTAB) + wc * 32 + 8 * fq; const PG8_LAS int* dt = (const PG8_LAS int*)(lds + EPI_DTAB); const PG8_LAS float* gtb = (const PG8_LAS float*)(lds + EPI_GTAB);
#pragma unroll
        for (int ai = 0; ai < 2; ++ai)
#pragma unroll
            for (int m = 0; m < 4; ++m) { const int pl = rloc + ai * HALF + m * 16; const int d = dt[pl]; const float gt = gtb[pl];
                if (d >= 0) { bf16_t* rowp = O + (size_t)d * 1024 + ocol0;
#pragma unroll
                    for (int bj = 0; bj < 2; ++bj) { const f32x4 b0 = *(const PG8_LAS f32x4*)(bt + bj * HALF), b1 = *(const PG8_LAS f32x4*)(bt + bj * HALF + 4); const f32x4 v0 = (acc[ai][bj][m][0] + b0) * gt, v1 = (acc[ai][bj][m][1] + b1) * gt;
                        u32x4 w; w.x = cvt_pk_bf16(v0[0], v0[1]); w.y = cvt_pk_bf16(v0[2], v0[3]); w.z = cvt_pk_bf16(v1[0], v1[1]); w.w = cvt_pk_bf16(v1[2], v1[3]);
                        *(u32x4*)(rowp + bj * HALF) = w; } } }
    }
};

template <class Epi, class Sched, bool STAMP = false, bool GATHER = false>
__device__ __forceinline__ void gemm_phase(PG8_LAS unsigned char* lds, const Gemm g, const Sched& S, const Epi& E, unsigned long long* stamps, const int tid_in) {
    const int tid = tid_in, wid = __builtin_amdgcn_readfirstlane(tid >> 6), lane = tid & 63, wr = wid >> 2, wc = wid & 3, fr = lane & 15, fq = lane >> 4;
    const int K = g.K, nt = K / BK;
    int ts_lo = 0, ts_hi = 0, nts = 0; const unsigned long long rt_entry = STAMP ? (unsigned long long)wall_clock64() : 0ull;
#define PG8_STAMP() do { if (STAMP && wid == 0 && nts < 64) { const unsigned long long _c = (unsigned long long)clock64(); \
        ts_lo = (lane == nts) ? (int)(unsigned)_c : ts_lo; ts_hi = (lane == nts) ? (int)(unsigned)(_c >> 32) : ts_hi; ++nts; } } while (0)
    PG8_STAMP();
    unsigned voffA[2], voffB[2];
#pragma unroll
    for (int i = 0; i < 2; ++i) { int R, C; stage_rc(tid * 16 + i * 8192, R, C); const int Rb = Epi::PERM ? ((R & ~31) + perm32(R & 31)) : R;
        voffA[i] = (unsigned)(R * K + C) * 2u; voffB[i] = (unsigned)(Rb * K + C) * 2u; }
    unsigned gc[2][2], gn[2][2];
    PG8_LAS int* rowtab = (PG8_LAS int*)(lds + 137216);
    const size_t kstep = (size_t)(BK * 2);
    const size_t hstep = (size_t)HALF * K * 2;
    const size_t tstep = 2 * hstep;
    const unsigned ldsw = (unsigned)wid * 1024u;
    const int aoff = lds_byte(wr * 64 + fr, fq * 8), boff = lds_byte(wc * 32 + fr, fq * 8);
#define PG8_SA(b, h) (((b) * 2 + (h)) * HTB)
#define PG8_SB(b, h) ((4 + (b) * 2 + (h)) * HTB)
#define PG8_STAGE(bufoff, gbase, voff) do { _Pragma("unroll") for (int _i = 0; _i < 2; ++_i) \
        __builtin_amdgcn_global_load_lds((const unsigned*)((const char*)(gbase) + (voff)[_i]), (PG8_LAS unsigned*)(lds + (bufoff) + ldsw + _i * 8192), 16, 0, 0); } while (0)
#define PG8_LDA(dst, b, h) do { _Pragma("unroll") for (int m = 0; m < 4; ++m) _Pragma("unroll") for (int k = 0; k < 2; ++k) dst[m][k] = *(const PG8_LAS bf16x8*)(lds + PG8_SA(b, h) + aoff + m * 2048 + k * 1024); } while (0)
#define PG8_LDB(dst, b, h) do { _Pragma("unroll") for (int n = 0; n < 2; ++n) _Pragma("unroll") for (int k = 0; k < 2; ++k) dst[n][k] = *(const PG8_LAS bf16x8*)(lds + PG8_SB(b, h) + boff + n * 2048 + k * 1024); } while (0)
#define PG8_MMA(ai, bj, At, Bt) do { __builtin_amdgcn_s_setprio(1); _Pragma("unroll") for (int m = 0; m < 4; ++m) _Pragma("unroll") for (int n = 0; n < 2; ++n) _Pragma("unroll") for (int k = 0; k < 2; ++k) \
        acc[ai][bj][m][n] = __builtin_amdgcn_mfma_f32_16x16x32_bf16(Bt[n][k], At[m][k], acc[ai][bj][m][n], 0, 0, 0); __builtin_amdgcn_s_setprio(0); } while (0)
#define PG8_WAIT_V(n) asm volatile("s_waitcnt vmcnt(" #n ")" ::: "memory")
#define PG8_WAIT_L(n) asm volatile("s_waitcnt lgkmcnt(" #n ")" ::: "memory")
#define PG8_BAR __builtin_amdgcn_s_barrier()
#define PG8_SCHED __builtin_amdgcn_sched_barrier(0)
    Unit cur, nxt; int ui = 0;
    if (!S.next(0, cur)) return;
    f32x4 acc[2][2][4][2];
#pragma unroll
    for (int a = 0; a < 2; ++a)
#pragma unroll
        for (int b = 0; b < 2; ++b)
#pragma unroll
            for (int m = 0; m < 4; ++m)
#pragma unroll
                for (int n = 0; n < 2; ++n) acc[a][b][m][n] = (f32x4){0.f, 0.f, 0.f, 0.f};
    bf16x8 At[4][2], B0[2][2], B1[2][2];
    const char* cA = GATHER ? (const char*)g.A : (const char*)g.A + (size_t)cur.pm * tstep; const char* cB = (const char*)g.Bt + (size_t)cur.pn * tstep;
    if constexpr (GATHER) {
#pragma unroll
        for (int h = 0; h < 2; ++h)
#pragma unroll
            for (int i = 0; i < 2; ++i) { int R, C; stage_rc(tid * 16 + i * 8192, R, C); gc[h][i] = (unsigned)S.rowtok[256 * cur.pm + 128 * h + R] * (unsigned)(K * 2) + (unsigned)(C * 2); gn[h][i] = gc[h][i]; } }
    S.a_ready(cur);
    PG8_STAGE(PG8_SB(0, 0), cB, voffB); if constexpr (GATHER) PG8_STAGE(PG8_SA(0, 0), cA, gc[0]); else PG8_STAGE(PG8_SA(0, 0), cA, voffA); PG8_STAGE(PG8_SB(0, 1), cB + hstep, voffB); if constexpr (GATHER) PG8_STAGE(PG8_SA(0, 1), cA, gc[1]); else PG8_STAGE(PG8_SA(0, 1), cA + hstep, voffA);
    if (wr == 1) PG8_BAR;
    PG8_WAIT_V(4); PG8_BAR;
    PG8_STAGE(PG8_SB(1, 0), cB + kstep, voffB); if constexpr (GATHER) PG8_STAGE(PG8_SA(1, 0), cA + kstep, gc[0]); else PG8_STAGE(PG8_SA(1, 0), cA + kstep, voffA); PG8_STAGE(PG8_SB(1, 1), cB + hstep + kstep, voffB);
    PG8_WAIT_V(6); PG8_BAR;
    PG8_STAMP();
    for (;;) {
        const bool has_next = S.next(ui + 1, nxt);
        const char* nA = GATHER ? cA : (has_next ? (const char*)g.A + (size_t)nxt.pm * tstep : cA); const char* nB = has_next ? (const char*)g.Bt + (size_t)nxt.pn * tstep : cB;
        for (int t = 0; t < nt; t += 2) {
            const bool last = (t == nt - 2);
            const char* a1 = cA + (size_t)(t + 1) * kstep;
            const char* a2 = last ? nA : cA + (size_t)(t + 2) * kstep; const char* b2 = last ? nB : cB + (size_t)(t + 2) * kstep;
            const char* a3 = a2 + kstep; const char* b3 = b2 + kstep;
            if (last && has_next) S.a_ready(nxt);
            if (t == nt - 4) { int ln_ = lane; asm volatile("" : "+v"(ln_)); E.prefetch(lds, cur, wid, ln_); }
            if constexpr (GATHER) {
                if (t == nt - 4 && has_next && wid < 4)
                    __builtin_amdgcn_global_load_lds((const unsigned*)(S.rowtok + 256 * nxt.pm + 64 * wid + lane), (PG8_LAS unsigned*)((PG8_LAS unsigned char*)rowtab + wid * 256), 4, 0, 0);
                if (last && has_next) { int tz = tid; asm volatile("" : "+v"(tz));
#pragma unroll
                    for (int h = 0; h < 2; ++h)
#pragma unroll
                        for (int i = 0; i < 2; ++i) { int R, C; stage_rc(tz * 16 + i * 8192, R, C); gn[h][i] = (unsigned)rowtab[128 * h + R] * (unsigned)(K * 2) + (unsigned)(C * 2); } } }
            unsigned g0x[2], g1x[2];
#pragma unroll
            for (int i = 0; i < 2; ++i) { g0x[i] = last ? gn[0][i] : gc[0][i]; g1x[i] = last ? gn[1][i] : gc[1][i]; }
            PG8_LDB(B0, 0, 0); PG8_SCHED; PG8_LDA(At, 0, 0); if constexpr (GATHER) PG8_STAGE(PG8_SA(1, 1), a1, gc[1]); else PG8_STAGE(PG8_SA(1, 1), a1 + hstep, voffA);
            PG8_WAIT_L(8); PG8_BAR; PG8_WAIT_L(0); PG8_MMA(0, 0, At, B0); PG8_BAR; PG8_SCHED;
            PG8_LDB(B1, 0, 1); PG8_STAGE(PG8_SB(0, 0), b2, voffB);
            PG8_BAR; PG8_WAIT_L(0); PG8_MMA(0, 1, At, B1); PG8_BAR;
            PG8_LDA(At, 0, 1); if constexpr (GATHER) PG8_STAGE(PG8_SA(0, 0), a2, g0x); else PG8_STAGE(PG8_SA(0, 0), a2, voffA);
            PG8_BAR; PG8_WAIT_L(0); PG8_MMA(1, 0, At, B0); PG8_BAR; PG8_SCHED;
            PG8_STAGE(PG8_SB(0, 1), b2 + hstep, voffB);
            PG8_WAIT_V(6); PG8_BAR; PG8_MMA(1, 1, At, B1); PG8_BAR;
            PG8_LDB(B0, 1, 0); PG8_SCHED; PG8_LDA(At, 1, 0); if constexpr (GATHER) PG8_STAGE(PG8_SA(0, 1), a2, g1x); else PG8_STAGE(PG8_SA(0, 1), a2 + hstep, voffA);
            PG8_WAIT_L(8); PG8_BAR; PG8_WAIT_L(0); PG8_MMA(0, 0, At, B0); PG8_BAR; PG8_SCHED;
            PG8_LDB(B1, 1, 1); PG8_STAGE(PG8_SB(1, 0), b3, voffB);
            PG8_BAR; PG8_WAIT_L(0); PG8_MMA(0, 1, At, B1); PG8_BAR;
            PG8_LDA(At, 1, 1); if constexpr (GATHER) PG8_STAGE(PG8_SA(1, 0), a3, g0x); else PG8_STAGE(PG8_SA(1, 0), a3, voffA);
            PG8_BAR; PG8_WAIT_L(0); PG8_MMA(1, 0, At, B0); PG8_BAR; PG8_SCHED;
            PG8_STAGE(PG8_SB(1, 1), b3 + hstep, voffB);
            PG8_WAIT_V(6); PG8_BAR; PG8_MMA(1, 1, At, B1); PG8_BAR;
        }
        PG8_STAMP();
        if constexpr (!Epi::AFTER_DRAIN) { E(acc, cur, wr, wc, fr, fq, lds); S.done(cur); }
        PG8_STAMP();
        if (!has_next) break;
#pragma unroll
        for (int a = 0; a < 2; ++a)
#pragma unroll
            for (int b = 0; b < 2; ++b)
#pragma unroll
                for (int m = 0; m < 4; ++m)
#pragma unroll
                    for (int n = 0; n < 2; ++n) acc[a][b][m][n] = (f32x4){0.f, 0.f, 0.f, 0.f};
        cur = nxt; cA = nA; cB = nB; ++ui;
        if constexpr (GATHER) {
#pragma unroll
            for (int h = 0; h < 2; ++h)
#pragma unroll
                for (int i = 0; i < 2; ++i) gc[h][i] = gn[h][i]; }
    }
    PG8_WAIT_V(0);
    if (wr == 0) PG8_BAR;
    PG8_BAR;
    if constexpr (Epi::AFTER_DRAIN) { E.fused(acc, cur, wr, wc, fr, fq, lds, wid, lane); S.done(cur); }
    PG8_STAMP();
    if (STAMP && wid == 0) { stamps[lane] = lane < nts ? (((unsigned long long)(unsigned)ts_hi << 32) | (unsigned)ts_lo) : 0ull;
        if (lane == 62) stamps[62] = rt_entry; if (lane == 63) stamps[63] = (unsigned long long)wall_clock64(); }
#undef PG8_STAMP
#undef PG8_SA
#undef PG8_SB
#undef PG8_STAGE
#undef PG8_LDA
#undef PG8_LDB
#undef PG8_MMA
#undef PG8_WAIT_V
#undef PG8_WAIT_L
#undef PG8_BAR
#undef PG8_SCHED
}
}
using pg8::bf16_t; using pg8::bf16x8; using pg8::f32x4; using pg8::u32x4;

constexpr int NB = 4, SEQ = 8192, MTOK = NB * SEQ, DM = 1024, NLAYER = 4, CIN = 3080, NPROJ = 3072, NEXP = 32, DEXP = 1024, NUP = 2048;
constexpr int RWD = 384, RW_COLS = 1408;
constexpr int NT_MAX = 544, POS_MAX = NT_MAX * 256;
constexpr float DN_ALPHA = 1.6817928305074290861f;
constexpr float LN_EPS = 1e-5f;
constexpr int NPH = 10;
constexpr int NPHASE_TOTAL = 1 + NLAYER * NPH;

constexpr size_t MiB = 1u << 20;
constexpr size_t WS_CTL = 0, CTL_ZERO_BYTES = 65536;
constexpr size_t WS_WIN = 1 * MiB;
constexpr size_t WS_WOUT = 25 * MiB;
constexpr size_t WS_WUP = 33 * MiB;
constexpr size_t WS_WDN = 545 * MiB;
constexpr size_t WS_ROPE = 801 * MiB;
constexpr size_t WS_HB = 803 * MiB;
constexpr size_t WS_HF = 867 * MiB;
constexpr size_t WS_H1F = 995 * MiB;
constexpr size_t WS_T1 = 1123 * MiB;
constexpr size_t WS_P = 1251 * MiB;
constexpr size_t WS_PG = 1443 * MiB;
constexpr size_t WS_YMIX = 1444 * MiB;
constexpr size_t WS_RWM = 1508 * MiB;
constexpr size_t WS_RWNT = 1532 * MiB;
constexpr size_t WS_RWQH = 1580 * MiB;
constexpr size_t WS_RWYL = 1604 * MiB;
constexpr size_t WS_RWS = 1652 * MiB;
constexpr size_t WS_RWAUX = 1676 * MiB;
constexpr size_t WS_MLQ = 1724 * MiB;
constexpr size_t WS_MLNL = 1740 * MiB;
constexpr size_t WS_MLVEC = 1780 * MiB;
constexpr size_t WS_MLSC = 1781 * MiB;
constexpr size_t WS_MLKL = 1782 * MiB;
constexpr size_t WS_MLCT = 1822 * MiB;
constexpr size_t WS_MLM = 1842 * MiB;
constexpr size_t WS_WUPT = 1843 * MiB;
constexpr size_t WS_AUPT = 1843 * MiB + 256 * 1024;
constexpr size_t WS_GUPT = 1843 * MiB + 512 * 1024;
constexpr size_t WS_LISCR = 1845 * MiB;
constexpr size_t WS_WRH = 1844 * MiB;
constexpr size_t WS_WRL = 1844 * MiB + 256 * 1024;
constexpr size_t WS_XPERM = 2021 * MiB;
constexpr size_t WS_ACT = 2293 * MiB;
constexpr size_t WS_YB = 2565 * MiB;
constexpr size_t WS_TOKE = 2821 * MiB;
constexpr size_t WS_TOKG = 2822 * MiB;
constexpr size_t WS_TOKLR = 2823 * MiB;
constexpr size_t WS_PDEST = 2824 * MiB;
constexpr size_t WS_PGATE = 2825 * MiB;
constexpr size_t WS_BBASE = 2826 * MiB;
constexpr size_t WS_PTOK = 2827 * MiB;
constexpr size_t WS_END = 2828 * MiB;
constexpr int CW_CNT = 1024;
constexpr int CW_SWAQ = 2048;
constexpr int CW_BAR = 4096;
constexpr int LDS_BYTES = 147456;
constexpr int MISC_OFF = 143360;
constexpr int TILEE_OFF = 133120;

#define LDS_WAIT() asm volatile("s_waitcnt lgkmcnt(0)" ::: "memory")
#define LDS_BARRIER() do { asm volatile("s_waitcnt lgkmcnt(0)" ::: "memory"); __builtin_amdgcn_s_barrier(); asm volatile("" ::: "memory"); } while (0)
#define VM_WAIT() asm volatile("s_waitcnt vmcnt(0)" ::: "memory")
__device__ __forceinline__ unsigned f2bf(float f) { unsigned u = __builtin_bit_cast(unsigned, f); return (u + 0x7fffu + ((u >> 16) & 1u)) >> 16; }
typedef __bf16 bf16v2_t __attribute__((ext_vector_type(2)));
__device__ __forceinline__ unsigned pk2(float lo, float hi) { const f32x2 v = (f32x2){lo, hi}; return __builtin_bit_cast(unsigned, __builtin_convertvector(v, bf16v2_t)); }
__device__ __forceinline__ float bf2f(unsigned short b) { return __builtin_bit_cast(float, ((unsigned)b) << 16); }
__device__ __forceinline__ float bflo(unsigned w) { return __builtin_bit_cast(float, w << 16); }
__device__ __forceinline__ float bfhi(unsigned w) { return __builtin_bit_cast(float, w & 0xffff0000u); }
template <int CTRL, int RMASK> __device__ __forceinline__ float dpp_add(float v) { return v + __builtin_bit_cast(float, __builtin_amdgcn_update_dpp(0, __builtin_bit_cast(int, v), CTRL, RMASK, 0xF, false)); }
__device__ __forceinline__ float wave_sum(float v) {
    v = dpp_add<0xB1, 0xF>(v); v = dpp_add<0x4E, 0xF>(v); v = dpp_add<0x141, 0xF>(v); v = dpp_add<0x140, 0xF>(v);
    v = dpp_add<0x142, 0xA>(v); v = dpp_add<0x143, 0xC>(v);
    return __builtin_bit_cast(float, __builtin_amdgcn_readlane(__builtin_bit_cast(int, v), 63));
}
template <int CTRL> __device__ __forceinline__ float dpp_mov(float x) { return __builtin_bit_cast(float, __builtin_amdgcn_update_dpp(0, __builtin_bit_cast(int, x), CTRL, 0xF, 0xF, true)); }
__device__ __forceinline__ float sum8(float x) { x += dpp_mov<0xB1>(x); x += dpp_mov<0x4E>(x); x += dpp_mov<0x141>(x); return x; }
__device__ __forceinline__ float sigmoidf_(float x) { return __builtin_amdgcn_rcpf(1.0f + __expf(-x)); }

#define XB_TMO      128
#define XB_XCNT(j)  (256  + 64 * (j))
#define XB_XSUB(j)  (1280 + 64 * (j))
#define XB_XGEN(j)  (2304 + 64 * (j))
#define XB_TOP      3328
#define XB_TOPGEN   3392
#define XCD_BAR_WORDS 3456
#define XB_SPIN_CAP (1u << 22)
__device__ __forceinline__ unsigned xb_ld(unsigned* p)              { return __hip_atomic_load(p, __ATOMIC_RELAXED, __HIP_MEMORY_SCOPE_AGENT); }
__device__ __forceinline__ unsigned xb_add(unsigned* p, unsigned v) { return __hip_atomic_fetch_add(p, v, __ATOMIC_RELAXED, __HIP_MEMORY_SCOPE_AGENT); }
__device__ __forceinline__ unsigned xb_xcc_id() { return (unsigned)__builtin_amdgcn_s_getreg((3 << 11) | 20) & 0xFu; }
#define XB_SPIN(cond, bar) do { unsigned _sp = 0; while (cond) { __builtin_amdgcn_s_sleep(1); \
    if ((++_sp & 255u) == 0u) { if (xb_ld(&(bar)[XB_TMO])) break; if (_sp > XB_SPIN_CAP) { atomicAdd(&(bar)[XB_TMO], 1u); break; } } } } while (0)

struct XcdBarrier {
    unsigned* bar; unsigned x;
    volatile LAS unsigned* st;
};

__device__ __forceinline__ XcdBarrier xcd_barrier_post(unsigned* bar, volatile LAS unsigned* st, bool t0  ) {
    XcdBarrier b; b.bar = bar; b.x = xb_xcc_id(); b.st = st;
    if (t0) (void)xb_add(&bar[XB_XCNT(b.x)], 1u);
    return b;
}
__device__ __forceinline__ void xcd_barrier_complete(unsigned* bar, unsigned x, unsigned& nloc, unsigned& nx) {
    const unsigned G = gridDim.x * gridDim.y * gridDim.z;
    unsigned sum, cnt, mine, sp = 0u;
    for (;;) {
        sum = 0u; cnt = 0u; mine = 0u;
#pragma unroll
        for (unsigned j = 0; j < 16; ++j) { const unsigned c = xb_ld(&bar[XB_XCNT(j)]); sum += c; cnt += (c > 0u) ? 1u : 0u; mine = (j == x) ? c : mine; }
        if (sum == G) break;
        __builtin_amdgcn_s_sleep(1);
        if ((++sp & 255u) == 0u) { if (xb_ld(&bar[XB_TMO])) break; if (sp > XB_SPIN_CAP) { atomicAdd(&bar[XB_TMO], 1u); break; } }
    }
    nloc = mine > 0u ? mine : 1u; nx = cnt > 0u ? cnt : 1u;
}

__device__ __forceinline__ void xcd_barrier(const XcdBarrier& b, bool t0  ) {
    asm volatile("s_waitcnt vmcnt(0)" ::: "memory");
    __syncthreads();
    if (t0) {
        unsigned* bar = b.bar;
        __builtin_amdgcn_s_waitcnt(0);
        unsigned nloc = b.st[0], nx = b.st[1];
        if (nloc == 0u) { xcd_barrier_complete(bar, b.x, nloc, nx); b.st[0] = nloc; b.st[1] = nx; }
        const unsigned old = xb_add(&bar[XB_XSUB(b.x)], 1u);
        const unsigned gen = old / nloc;
        if (old + 1u == (gen + 1u) * nloc) {
            __builtin_amdgcn_fence(__ATOMIC_RELEASE, "agent");
            asm volatile("s_waitcnt vmcnt(0)" ::: "memory");
            const unsigned og = xb_add(&bar[XB_TOP], 1u);
            const unsigned tg = og / nx;
            if (og + 1u == (tg + 1u) * nx) xb_add(&bar[XB_TOPGEN], 1u);
            else XB_SPIN(xb_ld(&bar[XB_TOPGEN]) == tg, bar);
            __builtin_amdgcn_fence(__ATOMIC_ACQUIRE, "agent");
            xb_add(&bar[XB_XGEN(b.x)], 1u);
            asm volatile("s_waitcnt vmcnt(0)" ::: "memory");
        } else {
            XB_SPIN(xb_ld(&bar[XB_XGEN(b.x)]) == gen, bar);
            __builtin_amdgcn_fence(__ATOMIC_ACQUIRE, "agent");
            asm volatile("s_waitcnt vmcnt(0)" ::: "memory");
        }
    }
    __syncthreads();
}
struct Params {
    const float* in[29];
    float* out; unsigned char* ws;
    int ph_lo, ph_hi;
    int pad0, pad1;
};
enum { I_X = 0, I_WIN, I_BIN, I_MU, I_WUP, I_W0, I_AUP, I_A0, I_GUP, I_KK, I_KA, I_RK, I_LNW, I_LNB, I_SINK, I_CONVW, I_CONVB, I_MLNW, I_WOUT,
       I_LN1W, I_LN1B, I_RW, I_RB, I_EWUP, I_EBUP, I_EWDN, I_EBDN, I_LN2W, I_LN2B };

struct Ctx {
    LAS unsigned char* lds; int tid, lane, wave, blk, G;
    unsigned char* ws;
};

__device__ __forceinline__ void tr_item(const float* W, int ldw, int K, bf16_t* WT, LAS float* scr, int kb, int nb, int lane) {
    const int k0 = 64 * kb, n0 = 32 * nb;
#pragma unroll 8
    for (int i = 0; i < 32; ++i) { const int kk = 2 * i + (lane >> 5); scr[kk * 33 + (lane & 31)] = W[(size_t)(k0 + kk) * ldw + n0 + (lane & 31)]; }
    LDS_WAIT();
    const int c = lane & 7;
#pragma unroll
    for (int j = 0; j < 4; ++j) { const int n = (lane >> 3) + 8 * j; const LAS float* s = scr + (8 * c) * 33 + n;
        u32x4 o; o.x = pk2(s[0 * 33], s[1 * 33]); o.y = pk2(s[2 * 33], s[3 * 33]); o.z = pk2(s[4 * 33], s[5 * 33]); o.w = pk2(s[6 * 33], s[7 * 33]);
        *(u32x4*)(WT + (size_t)(n0 + n) * K + k0 + 8 * c) = o; }
    LDS_WAIT();
}
__device__ __forceinline__ void gate_cols(const f32x4 (&v)[4], const LAS float* tab, const float* bg, float* pgrow, int lane) {
    float acc[8];
#pragma unroll
    for (int c = 0; c < 8; ++c) acc[c] = 0.f;
#pragma unroll
    for (int j = 0; j < 4; ++j)
#pragma unroll
        for (int q = 0; q < 4; ++q) { const LAS f32x4* tp = (const LAS f32x4*)(tab + ((j * 4 + q) * 64 + lane) * 8); const f32x4 a = tp[0], b = tp[1]; const float x = v[j][q];
            acc[0] += x * a[0]; acc[1] += x * a[1]; acc[2] += x * a[2]; acc[3] += x * a[3]; acc[4] += x * b[0]; acc[5] += x * b[1]; acc[6] += x * b[2]; acc[7] += x * b[3]; }
#pragma unroll
    for (int c = 0; c < 8; ++c) acc[c] = wave_sum(acc[c]);
    if (lane < 8) { float r = acc[0];
#pragma unroll
        for (int c = 1; c < 8; ++c) r = (lane == c) ? acc[c] : r;
        pgrow[lane] = r + bg[lane]; }
}
__device__ __forceinline__ void load_wg(LAS float* tab, const float* win_l, int tid) {
    for (int d = tid; d < DM; d += 512) { const int j = d >> 8, ln = (d >> 2) & 63, q = d & 3; const f32x4 a = *(const f32x4*)(win_l + (size_t)d * CIN + NPROJ), b = *(const f32x4*)(win_l + (size_t)d * CIN + NPROJ + 4);
        LAS f32x4* tp = (LAS f32x4*)(tab + ((j * 4 + q) * 64 + ln) * 8); tp[0] = a; tp[1] = b; }
    __syncthreads();
}
__device__ __forceinline__ void p0_prologue(const Params& P, const Ctx& C) {
    LAS float* scr = (LAS float*)(C.lds + C.wave * 16384);
    const int gw = C.blk * 8 + C.wave, NGW = C.G * 8;
    bf16_t* win_t = (bf16_t*)(C.ws + WS_WIN); bf16_t* wout_t = (bf16_t*)(C.ws + WS_WOUT); bf16_t* wup_t = (bf16_t*)(C.ws + WS_WUP); bf16_t* wdn_t = (bf16_t*)(C.ws + WS_WDN);
    constexpr int I_IN = 16 * 96, I_OUT = 16 * 32, I_UP = 16 * 64, I_DN = 16 * 32;
    constexpr int N1 = NLAYER * I_IN, N2 = NLAYER * I_OUT, N3 = NLAYER * NEXP * I_UP, N4 = NLAYER * NEXP * I_DN;
    for (int it = gw; it < N1 + N2 + N3 + N4; it += NGW) {
        int r = it;
        if (r < N1) { const int l = r / I_IN; r %= I_IN; tr_item(P.in[I_WIN] + (size_t)l * DM * CIN, CIN, DM, win_t + (size_t)l * NPROJ * DM, scr, r / 96, r % 96, C.lane); continue; } r -= N1;
        if (r < N2) { const int l = r / I_OUT; r %= I_OUT; tr_item(P.in[I_WOUT] + (size_t)l * DM * DM, DM, DM, wout_t + (size_t)l * DM * DM, scr, r / 32, r % 32, C.lane); continue; } r -= N2;
        if (r < N3) { const int le = r / I_UP; r %= I_UP; tr_item(P.in[I_EWUP] + (size_t)le * DM * NUP, NUP, DM, wup_t + (size_t)le * NUP * DM, scr, r / 64, r % 64, C.lane); continue; } r -= N3;
        { const int le = r / I_DN; r %= I_DN; tr_item(P.in[I_EWDN] + (size_t)le * DEXP * DM, DM, DEXP, wdn_t + (size_t)le * DM * DEXP, scr, r / 32, r % 32, C.lane); }
    }
    f32x2* rope = (f32x2*)(C.ws + WS_ROPE);
    for (int idx = C.blk * 512 + C.tid; idx < SEQ * 32; idx += C.G * 512) { const int t = idx >> 5, i = idx & 31;
        const float inv = powf(10000.0f, -(float)i / 32.0f); const float ang = (float)t * inv;
        const double rev = (double)ang * 0.15915494309189533577; const float fr = (float)(rev - __builtin_rint(rev));
        rope[idx] = (f32x2){__builtin_amdgcn_cosf(fr), __builtin_amdgcn_sinf(fr)}; }
    { bf16_t* wt = (bf16_t*)(C.ws + WS_WUPT); bf16_t* at = (bf16_t*)(C.ws + WS_AUPT); bf16_t* gt = (bf16_t*)(C.ws + WS_GUPT);
      for (int idx = C.blk * 512 + C.tid; idx < NLAYER * RWD * 64; idx += C.G * 512) { const int ll = idx / (RWD * 64), rem = idx % (RWD * 64), j = rem >> 6, i = rem & 63;
          wt[idx] = (bf16_t)f2bf(P.in[I_WUP][((size_t)ll * 64 + i) * RWD + j]); at[idx] = (bf16_t)f2bf(P.in[I_AUP][((size_t)ll * 64 + i) * RWD + j]); }
      for (int idx = C.blk * 512 + C.tid; idx < NLAYER * RWD * 128; idx += C.G * 512) { const int ll = idx / (RWD * 128), rem = idx % (RWD * 128), j = rem >> 7, i = rem & 127;
          gt[idx] = (bf16_t)f2bf(P.in[I_GUP][((size_t)ll * 128 + i) * RWD + j]); } }
    { bf16_t* wh = (bf16_t*)(C.ws + WS_WRH); bf16_t* wl = (bf16_t*)(C.ws + WS_WRL);
      for (int idx = C.blk * 512 + C.tid; idx < NLAYER * NEXP * DM; idx += C.G * 512) { const int ll = idx / (NEXP * DM), rem = idx % (NEXP * DM), e = rem >> 10, d = rem & 1023;
          const float w = P.in[I_RW][((size_t)ll * DM + d) * NEXP + e]; const unsigned hi = f2bf(w); const float lo = w - bflo(hi); wh[idx] = (bf16_t)hi; wl[idx] = (bf16_t)f2bf(lo); } }
    __syncthreads(); LAS float* wg = (LAS float*)C.lds; load_wg(wg, P.in[I_WIN], C.tid);
    bf16_t* hb = (bf16_t*)(C.ws + WS_HB); float* pg = (float*)(C.ws + WS_PG);
    for (int m = gw; m < MTOK; m += NGW) {
        const f32x4* xr = (const f32x4*)(P.in[I_X] + (size_t)m * DM) + C.lane; f32x4 v[4];
#pragma unroll
        for (int j = 0; j < 4; ++j) v[j] = xr[64 * j];
        u32x2* o8 = (u32x2*)(hb + (size_t)m * DM) + C.lane;
#pragma unroll
        for (int j = 0; j < 4; ++j) o8[64 * j] = (u32x2){pk2(v[j][0], v[j][1]), pk2(v[j][2], v[j][3])};
        gate_cols(v, wg, P.in[I_BIN] + NPROJ, pg + (size_t)m * 8, C.lane);
    }
}

constexpr int LD = 72;
constexpr int BUFB = 64 * LD * 2;
__device__ __forceinline__ f32x4 mfma16(bf16x8 a, bf16x8 b, f32x4 c) { return __builtin_amdgcn_mfma_f32_16x16x32_bf16(a, b, c, 0, 0, 0); }
constexpr int SWA_VLD = 264;
__device__ __forceinline__ void swa_unit(const Params& P, const Ctx& C, int l, int u) {
    const int tid = C.tid, wave = C.wave, lane = C.lane, r = lane & 15, g = lane >> 4; const int b = u >> 7, n = (u >> 1) & 63, hk = u & 1;
    LAS bf16_t* Ks = (LAS bf16_t*)C.lds; LAS bf16_t* VT = Ks + 256 * LD;
    const bf16_t* p = (const bf16_t*)(C.ws + WS_P); const f32x2* rope = (const f32x2*)(C.ws + WS_ROPE);
    const int t_base = n * 128 - 128;
#pragma unroll
    for (int it = 0; it < 2; ++it) { const int q = tid + 512 * it, row = q >> 2, c8 = q & 3; const int t = t_base + row;
        u32x4 o1 = (u32x4){0u, 0u, 0u, 0u}, o2 = o1;
        if (t >= 0) { const bf16_t* pr = p + (size_t)(b * SEQ + t) * NPROJ + 1792 + hk * 64 + 8 * c8; const u32x4 a1 = *(const u32x4*)pr, a2 = *(const u32x4*)(pr + 32);
            const f32x4* rp = (const f32x4*)(rope + t * 32 + 8 * c8); float y1[8], y2[8];
#pragma unroll
            for (int e = 0; e < 4; ++e) { const f32x4 cs = rp[e];
                const float x1a = bflo(a1[e]), x1b = bfhi(a1[e]), x2a = bflo(a2[e]), x2b = bfhi(a2[e]);
                y1[2 * e] = x1a * cs[0] - x2a * cs[1]; y2[2 * e] = x2a * cs[0] + x1a * cs[1]; y1[2 * e + 1] = x1b * cs[2] - x2b * cs[3]; y2[2 * e + 1] = x2b * cs[2] + x1b * cs[3]; }
            o1 = (u32x4){pk2(y1[0], y1[1]), pk2(y1[2], y1[3]), pk2(y1[4], y1[5]), pk2(y1[6], y1[7])}; o2 = (u32x4){pk2(y2[0], y2[1]), pk2(y2[2], y2[3]), pk2(y2[4], y2[5]), pk2(y2[6], y2[7])}; }
        *(LAS u32x4*)(Ks + row * LD + 8 * c8) = o1; *(LAS u32x4*)(Ks + row * LD + 32 + 8 * c8) = o2; }
    if (tid < 256) { const int kg = tid >> 3, c8 = tid & 7; u32x4 in[8];
#pragma unroll
        for (int k = 0; k < 8; ++k) { const int t = t_base + 8 * kg + k; in[k] = (t >= 0) ? *(const u32x4*)(p + (size_t)(b * SEQ + t) * NPROJ + 1920 + hk * 64 + 8 * c8) : (u32x4){0u, 0u, 0u, 0u}; }
#pragma unroll
        for (int d = 0; d < 8; ++d) { unsigned hv[8];
#pragma unroll
            for (int k = 0; k < 8; ++k) { const unsigned w = in[k][d >> 1]; hv[k] = (d & 1) ? (w >> 16) : (w & 0xffffu); }
            *(LAS u32x4*)(VT + (8 * c8 + d) * SWA_VLD + 8 * kg) = (u32x4){hv[0] | (hv[1] << 16), hv[2] | (hv[3] << 16), hv[4] | (hv[5] << 16), hv[6] | (hv[7] << 16)}; } }
    LDS_BARRIER();
    const int qi = 16 * wave + r, t = n * 128 + qi;
    const f32x4* rq = (const f32x4*)(rope + t * 32 + 8 * g);
#pragma unroll 1
    for (int gq = 0; gq < 3; ++gq) { const int hq = hk * 3 + gq; int wave = C.wave; asm volatile("" : "+s"(wave));
        bf16x8 qf0, qf1;
        { const bf16_t* pr = p + (size_t)(b * SEQ + t) * NPROJ + RW_COLS + hq * 64 + 8 * g; const u32x4 a1 = *(const u32x4*)pr, a2 = *(const u32x4*)(pr + 32); float y1[8], y2[8];
#pragma unroll
          for (int e = 0; e < 4; ++e) { const f32x4 cs = rq[e]; const float x1a = bflo(a1[e]), x1b = bfhi(a1[e]), x2a = bflo(a2[e]), x2b = bfhi(a2[e]);
              y1[2 * e] = (x1a * cs[0] - x2a * cs[1]) * 0.125f; y2[2 * e] = (x2a * cs[0] + x1a * cs[1]) * 0.125f; y1[2 * e + 1] = (x1b * cs[2] - x2b * cs[3]) * 0.125f; y2[2 * e + 1] = (x2b * cs[2] + x1b * cs[3]) * 0.125f; }
          const u32x4 w1 = (u32x4){pk2(y1[0], y1[1]), pk2(y1[2], y1[3]), pk2(y1[4], y1[5]), pk2(y1[6], y1[7])}, w2 = (u32x4){pk2(y2[0], y2[1]), pk2(y2[2], y2[3]), pk2(y2[4], y2[5]), pk2(y2[6], y2[7])};
          qf0 = __builtin_bit_cast(bf16x8, w1); qf1 = __builtin_bit_cast(bf16x8, w2); }
        f32x4 sc[10]; const float sink = P.in[I_SINK][l * 6 + hq]; float mx = sink;
        int qiv = qi; asm volatile("" : "+v"(qiv));
#pragma unroll
        for (int kt = 0; kt < 10; ++kt) { const int kb = 16 * (wave + kt); f32x4 a = (f32x4){0.f, 0.f, 0.f, 0.f};
            if (kb < 256) { const LAS bf16_t* kp = Ks + (kb + r) * LD + 8 * g; a = mfma16(*(const LAS bf16x8*)kp, qf0, a); a = mfma16(*(const LAS bf16x8*)(kp + 32), qf1, a); }
#pragma unroll
            for (int j = 0; j < 4; ++j) { const int kj = kb + 4 * g + j; const bool valid = (kj > qiv) && (kj <= qiv + 128) && (kj < 256) && ((n != 0) || (kj >= 128)); a[j] = valid ? a[j] : -__builtin_inff(); mx = fmaxf(mx, a[j]); }
            sc[kt] = a; }
        mx = fmaxf(mx, __shfl_xor(mx, 16)); mx = fmaxf(mx, __shfl_xor(mx, 32));
        float sum = 0.f;
#pragma unroll
        for (int kt = 0; kt < 10; ++kt) {
#pragma unroll
            for (int j = 0; j < 4; ++j) { const float e = __expf(sc[kt][j] - mx); sc[kt][j] = e; sum += e; } }
        sum += __shfl_xor(sum, 16); sum += __shfl_xor(sum, 32); sum += __expf(sink - mx);
        const float inv = 1.0f / sum;
        f32x4 o[4];
#pragma unroll
        for (int dt = 0; dt < 4; ++dt) o[dt] = (f32x4){0.f, 0.f, 0.f, 0.f};
#pragma unroll
        for (int s = 0; s < 5; ++s) { const int kb = 16 * (wave + 2 * s);
            if (kb < 256) { const u32x4 pw = (u32x4){pk2(sc[2 * s][0], sc[2 * s][1]), pk2(sc[2 * s][2], sc[2 * s][3]), pk2(sc[2 * s + 1][0], sc[2 * s + 1][1]), pk2(sc[2 * s + 1][2], sc[2 * s + 1][3])};
                const bf16x8 pf = __builtin_bit_cast(bf16x8, pw); const bool two = (kb + 16 < 256);
#pragma unroll
                for (int dt = 0; dt < 4; ++dt) { const LAS bf16_t* vp = VT + (16 * dt + r) * SWA_VLD + kb + 4 * g; const u32x2 lo = *(const LAS u32x2*)vp; u32x2 hi = (u32x2){0u, 0u}; if (two) hi = *(const LAS u32x2*)(vp + 16);
                    const u32x4 af = (u32x4){lo[0], lo[1], hi[0], hi[1]}; o[dt] = mfma16(__builtin_bit_cast(bf16x8, af), pf, o[dt]); } } }
        bf16_t* yr = (bf16_t*)(C.ws + WS_YMIX) + (size_t)(b * SEQ + t) * DM + RWD + hq * 64 + 4 * g;
#pragma unroll
        for (int dt = 0; dt < 4; ++dt) *(u32x2*)(yr + 16 * dt) = (u32x2){pk2(o[dt][0] * inv, o[dt][1] * inv), pk2(o[dt][2] * inv, o[dt][3] * inv)};
    }
    LDS_BARRIER();
}
__device__ __forceinline__ f32x4 mm64(const LAS bf16_t* X, const LAS bf16_t* Y, int ti, int tj, f32x4 acc, int lane) {
    const int r = lane & 15, g = lane >> 4;
    const LAS bf16_t* xp = X + (16 * ti + r) * LD + 8 * g; const LAS bf16_t* yp = Y + (16 * tj + r) * LD + 8 * g;
    acc = mfma16(*(const LAS bf16x8*)xp, *(const LAS bf16x8*)yp, acc);
    acc = mfma16(*(const LAS bf16x8*)(xp + 32), *(const LAS bf16x8*)(yp + 32), acc);
    return acc;
}
__device__ __forceinline__ void storeT(LAS bf16_t* D, int ti, int tj, f32x4 v, int lane) {
    const int r = lane & 15, g = lane >> 4;
    *(LAS u32x2*)(D + (16 * tj + r) * LD + 16 * ti + 4 * g) = (u32x2){pk2(v[0], v[1]), pk2(v[2], v[3])};
}
template <int MODE> __device__ __forceinline__ f32x4 maskT(f32x4 v, int ti, int tj, int lane) {
    const int rho = 16 * tj + (lane & 15), kap = 16 * ti + 4 * (lane >> 4);
#pragma unroll
    for (int j = 0; j < 4; ++j) { const bool keep = (MODE == 0) ? (kap + j < rho) : (MODE == 1) ? (kap + j <= rho) : (kap + j > rho); v[j] = keep ? v[j] : 0.f; }
    return v;
}
__device__ __forceinline__ float wave_max(float v) {
#pragma unroll
    for (int o = 1; o < 64; o <<= 1) v = fmaxf(v, __shfl_xor(v, o));
    return v;
}

__device__ __forceinline__ void rwb_unit(const Params& P, const Ctx& C, int l, int u, bool reuse) {
    const int tid = C.tid, wave = C.wave, lane = C.lane, r = lane & 15, g = lane >> 4;
    const int h = u % 6, bcx = u / 6, b = bcx >> 7, c = bcx & 127; const int tok0 = b * SEQ + c * 64; const int ch = (b * 6 + h) * 128 + c;
    LAS unsigned char* L = C.lds;
#define RB(i) ((LAS bf16_t*)(L + (i) * BUFB))
    LAS bf16_t* X1 = RB(0); LAS bf16_t* X1T = RB(1); LAS bf16_t* Aak = RB(2); LAS bf16_t* Arb = RB(3); LAS bf16_t* Ark = RB(4); LAS bf16_t* Pb = RB(5);
    LAS bf16_t* At = RB(6); LAS bf16_t* AtT = RB(7); LAS bf16_t* Bt = RB(8); LAS bf16_t* BtT = RB(9); LAS bf16_t* Kt = RB(10); LAS bf16_t* KtT = RB(11); LAS bf16_t* Rt = RB(12); LAS bf16_t* VT = RB(13);
    LAS float* XW = (LAS float*)L; LAS float* XA = XW + 64 * 65; LAS float* XG = XA + 64 * 65;
    LAS bf16_t* LI = (LAS bf16_t*)(L + 6 * BUFB);
    LAS float* segtot = (LAS float*)(L + 14 * BUFB); LAS float* gamL = segtot + 512;
    const bf16_t* p = (const bf16_t*)(C.ws + WS_P); const float* mu = P.in[I_MU] + l * RW_COLS;
    float cr9[9], ck9[9], cv9[9];
    { const int jc0 = 64 * h + lane;
#pragma unroll
      for (int i = 0; i < 9; ++i) { const int row = 8 * wave - 1 + i; const bool ok = (c * 64 + row >= 0); const bf16_t* q = p + (size_t)(tok0 + (ok ? row : 0)) * NPROJ;
          const float a_ = bf2f(q[jc0]), b_ = bf2f(q[RWD + jc0]), c_ = bf2f(q[2 * RWD + jc0]); cr9[i] = ok ? a_ : 0.f; ck9[i] = ok ? b_ : 0.f; cv9[i] = ok ? c_ : 0.f; } }
    bf16_t* liscr = (bf16_t*)(C.ws + WS_LISCR) + (size_t)C.blk * (64 * 264);
    if (!reuse) { u32x4 cu[4], pv[4]; f32x4 m0[4], m1[4];
#pragma unroll
      for (int i = 0; i < 4; ++i) { const int q = tid + 512 * i, t = q >> 5, c8 = q & 31; const bf16_t* src = p + (size_t)(tok0 + t) * NPROJ + 1152 + 8 * c8; const bool ok = (c * 64 + t > 0);
          cu[i] = *(const u32x4*)src; pv[i] = *(const u32x4*)(ok ? src - NPROJ : src); if (!ok) pv[i] = (u32x4){0u, 0u, 0u, 0u};
          m0[i] = *(const f32x4*)(mu + 1152 + 8 * c8); m1[i] = *(const f32x4*)(mu + 1152 + 8 * c8 + 4); }
#pragma unroll
      for (int i = 0; i < 4; ++i) { const int q = tid + 512 * i, t = q >> 5, c8 = q & 31; float x[8];
#pragma unroll
          for (int e = 0; e < 4; ++e) { const float c0 = bflo(cu[i][e]), c1 = bfhi(cu[i][e]), p0 = bflo(pv[i][e]), p1 = bfhi(pv[i][e]);
              const float mm0 = (e < 2) ? m0[i][2 * e] : m1[i][2 * e - 4], mm1 = (e < 2) ? m0[i][2 * e + 1] : m1[i][2 * e - 3];
              x[2 * e] = c0 + (p0 - c0) * mm0; x[2 * e + 1] = c1 + (p1 - c1) * mm1; }
          if (c8 < 8) {
#pragma unroll
              for (int e = 0; e < 8; ++e) x[e] = 1.0f - 2.0f * __builtin_amdgcn_rcpf(__expf(2.0f * x[e]) + 1.0f); }
          else if (c8 >= 16) {
#pragma unroll
              for (int e = 0; e < 8; ++e) x[e] = sigmoidf_(x[e]); }
          const u32x4 w = (u32x4){pk2(x[0], x[1]), pk2(x[2], x[3]), pk2(x[4], x[5]), pk2(x[6], x[7])};
          *(LAS u32x4*)(LI + t * 264 + 8 * c8) = w; *(u32x4*)(liscr + t * 264 + 8 * c8) = w; } }
    else {
#pragma unroll
      for (int i = 0; i < 4; ++i) { const int q = tid + 512 * i, t = q >> 5, c8 = q & 31; *(LAS u32x4*)(LI + t * 264 + 8 * c8) = *(const u32x4*)(liscr + t * 264 + 8 * c8); } }
    LDS_BARRIER();
    { bf16x8 bw[1][2], ba[1][2], bg[1][4];
      const int tj = wave & 3;
      const bf16_t* Ww = (const bf16_t*)(C.ws + WS_WUPT) + ((size_t)l * RWD + 64 * h + 16 * tj + r) * 64 + 8 * g;
      const bf16_t* Wa = (const bf16_t*)(C.ws + WS_AUPT) + ((size_t)l * RWD + 64 * h + 16 * tj + r) * 64 + 8 * g;
      const bf16_t* Wg = (const bf16_t*)(C.ws + WS_GUPT) + ((size_t)l * RWD + 64 * h + 16 * tj + r) * 128 + 8 * g;
#pragma unroll
      for (int ks = 0; ks < 2; ++ks) { bw[0][ks] = *(const bf16x8*)(Ww + 32 * ks); ba[0][ks] = *(const bf16x8*)(Wa + 32 * ks); }
#pragma unroll
      for (int ks = 0; ks < 4; ++ks) bg[0][ks] = *(const bf16x8*)(Wg + 32 * ks);
#pragma unroll
      for (int n = 0; n < 6; ++n) { const int o = n >> 1, ti = ((wave >> 2) + 2 * n) & 3; const int xoff = (o == 0) ? 0 : (o == 1) ? 64 : 128;
          const LAS bf16_t* xp = LI + (16 * ti + r) * 264 + xoff + 8 * g; f32x4 acc = (f32x4){0.f, 0.f, 0.f, 0.f};
          if (o == 0) { acc = mfma16(*(const LAS bf16x8*)xp, bw[0][0], acc); acc = mfma16(*(const LAS bf16x8*)(xp + 32), bw[0][1], acc); }
          else if (o == 1) { acc = mfma16(*(const LAS bf16x8*)xp, ba[0][0], acc); acc = mfma16(*(const LAS bf16x8*)(xp + 32), ba[0][1], acc); }
          else {
#pragma unroll
              for (int ks = 0; ks < 4; ++ks) acc = mfma16(*(const LAS bf16x8*)(xp + 32 * ks), bg[0][ks], acc); }
          LAS float* XO = (o == 0) ? XW : (o == 1) ? XA : XG;
#pragma unroll
          for (int j = 0; j < 4; ++j) XO[(16 * ti + 4 * g + j) * 65 + 16 * tj + r] = acc[j]; } }
    LDS_BARRIER();
    {
        const int jc = 64 * h + lane, tg = wave;
        const float w0 = P.in[I_W0][l * RWD + jc], a0 = P.in[I_A0][l * RWD + jc], kkc = P.in[I_KK][l * RWD + jc], kac = P.in[I_KA][l * RWD + jc], rkc = P.in[I_RK][l * RWD + jc];
        const float mur = mu[jc], muk = mu[RWD + jc], muv = mu[2 * RWD + jc];
        float pr = cr9[0], pk = ck9[0], pv = cv9[0];
        float ld[8], av[8], kn[8], km[8], rs[8], vs[8];
        bf16_t* aux = (bf16_t*)(C.ws + WS_RWAUX) + (size_t)(tok0 + 8 * tg) * 768;
#pragma unroll
        for (int i = 0; i < 8; ++i) { const int t = 8 * tg + i; const float cr = cr9[i + 1], ck = ck9[i + 1], cv = cv9[i + 1];
            rs[i] = cr + (pr - cr) * mur; const float ks = ck + (pk - ck) * muk; vs[i] = cv + (pv - cv) * muv; pr = cr; pk = ck; pv = cv;
            const float z = -(w0 + XW[t * 65 + lane]); const float sp = (z > 20.f) ? z : __logf(1.0f + __expf(z)); ld[i] = -__expf(-sp - 0.5f);
            const float a = sigmoidf_(a0 + XA[t * 65 + lane]); av[i] = a;
            const float kkv = ks * kkc; kn[i] = kkv * rsqrtf(fmaxf(wave_sum(kkv * kkv), 1e-24f));
            km[i] = ks * (1.0f + (a - 1.0f) * kac);
            const float dot = wave_sum(rs[i] * km[i] * rkc);
            aux[(size_t)i * 768 + jc] = (bf16_t)f2bf(dot * vs[i]); aux[(size_t)i * 768 + RWD + jc] = (bf16_t)f2bf(XG[t * 65 + lane]); }
        float cs[8]; cs[0] = ld[0];
#pragma unroll
        for (int i = 1; i < 8; ++i) cs[i] = cs[i - 1] + ld[i];
        segtot[tg * 64 + lane] = cs[7];
        LDS_BARRIER();
        float off = 0.f, tot = 0.f;
#pragma unroll
        for (int k = 0; k < 8; ++k) { const float sv = segtot[k * 64 + lane]; tot += sv; off += (k < tg) ? sv : 0.f; }
        if (wave == 0) gamL[lane] = __expf(tot);
        float oa[8], ob[8], ok[8], orr[8];
#pragma unroll
        for (int i = 0; i < 8; ++i) { const int t = 8 * tg + i; const float cum = off + cs[i]; const float gam = __expf(cum), gin = __expf(-cum), gpr = __expf(cum - ld[i]);
            oa[i] = -gpr * kn[i]; ob[i] = kn[i] * av[i] * gin; ok[i] = km[i] * gin; orr[i] = gam * rs[i];
            At[t * LD + lane] = (bf16_t)f2bf(oa[i]); Bt[t * LD + lane] = (bf16_t)f2bf(ob[i]); Kt[t * LD + lane] = (bf16_t)f2bf(ok[i]); Rt[t * LD + lane] = (bf16_t)f2bf(orr[i]); }
        *(LAS u32x4*)(AtT + lane * LD + 8 * tg) = (u32x4){pk2(oa[0], oa[1]), pk2(oa[2], oa[3]), pk2(oa[4], oa[5]), pk2(oa[6], oa[7])};
        *(LAS u32x4*)(BtT + lane * LD + 8 * tg) = (u32x4){pk2(ob[0], ob[1]), pk2(ob[2], ob[3]), pk2(ob[4], ob[5]), pk2(ob[6], ob[7])};
        *(LAS u32x4*)(KtT + lane * LD + 8 * tg) = (u32x4){pk2(ok[0], ok[1]), pk2(ok[2], ok[3]), pk2(ok[4], ok[5]), pk2(ok[6], ok[7])};
        *(LAS u32x4*)(VT + lane * LD + 8 * tg) = (u32x4){pk2(vs[0], vs[1]), pk2(vs[2], vs[3]), pk2(vs[4], vs[5]), pk2(vs[6], vs[7])};
    }
    LDS_BARRIER();
    const f32x4 Z4 = (f32x4){0.f, 0.f, 0.f, 0.f};
    const int wq = wave >> 2, tj = wave & 3;
    { f32x4 res[10];
#pragma unroll
      for (int n_ = 0; n_ < 10; ++n_) { const int o = n_ >> 1, ti = wq + 2 * (n_ & 1);
          if (o == 0) res[n_] = maskT<2>(mm64(At, Bt, ti, tj, Z4, lane), ti, tj, lane);
          else if (o == 1) res[n_] = maskT<0>(mm64(Bt, At, ti, tj, Z4, lane), ti, tj, lane);
          else if (o == 2) res[n_] = maskT<0>(mm64(Kt, At, ti, tj, Z4, lane), ti, tj, lane);
          else if (o == 3) res[n_] = maskT<1>(mm64(Bt, Rt, ti, tj, Z4, lane), ti, tj, lane);
          else res[n_] = maskT<1>(mm64(Kt, Rt, ti, tj, Z4, lane), ti, tj, lane); }
#pragma unroll
      for (int n_ = 0; n_ < 10; ++n_) { const int o = n_ >> 1, ti = wq + 2 * (n_ & 1);
          if (o == 0) storeT(X1T, ti, tj, res[n_], lane);
          else if (o == 1) { storeT(X1, ti, tj, res[n_], lane); f32x4 v = res[n_]; const int rho = 16 * tj + r, kap = 16 * ti + 4 * g;
#pragma unroll
              for (int j = 0; j < 4; ++j) v[j] += (kap + j == rho) ? 1.0f : 0.f;
              storeT(Pb, ti, tj, v, lane); }
          else if (o == 2) storeT(Aak, ti, tj, res[n_], lane);
          else if (o == 3) storeT(Arb, ti, tj, res[n_], lane);
          else storeT(Ark, ti, tj, res[n_], lane); } }
    LDS_BARRIER();
    f32x4 pacc[2];
#pragma unroll
    for (int q = 0; q < 2; ++q) { const int ti = wq + 2 * q; const u32x2 w = *(const LAS u32x2*)(Pb + (16 * tj + r) * LD + 16 * ti + 4 * g);
        pacc[q] = (f32x4){bflo(w[0]), bfhi(w[0]), bflo(w[1]), bfhi(w[1])}; }
#pragma unroll 1
    for (int rnd = 0; rnd < 6; ++rnd) {
        LAS bf16_t* Xn = (rnd & 1) ? RB(6) : RB(0); LAS bf16_t* XnT = (rnd & 1) ? RB(8) : RB(1);
        LAS bf16_t* Yn = (rnd & 1) ? RB(0) : RB(6); LAS bf16_t* YnT = (rnd & 1) ? RB(1) : RB(8);
        LAS bf16_t* Pold = (rnd & 1) ? RB(5) : RB(10); LAS bf16_t* Pnew = (rnd & 1) ? RB(10) : RB(5);
        f32x4 sq[4];
        if (rnd < 5) {
#pragma unroll
            for (int n_ = 0; n_ < 4; ++n_) { const int ti = wq + 2 * (n_ & 1); sq[n_] = (n_ < 2) ? mm64(Xn, XnT, ti, tj, Z4, lane) : mm64(XnT, Xn, ti, tj, Z4, lane); } }
        if (rnd > 0) {
#pragma unroll
            for (int q = 0; q < 2; ++q) pacc[q] = mm64(XnT, Pold, wq + 2 * q, tj, pacc[q], lane); }
        if (rnd < 5) {
#pragma unroll
            for (int n_ = 0; n_ < 4; ++n_) storeT((n_ < 2) ? YnT : Yn, wq + 2 * (n_ & 1), tj, sq[n_], lane); }
        if (rnd > 0) {
#pragma unroll
            for (int q = 0; q < 2; ++q) storeT(Pnew, wq + 2 * q, tj, pacc[q], lane); }
        LDS_BARRIER();
    }
    LAS bf16_t* Tm = RB(10);
    LAS bf16_t* AhT = RB(0); LAS bf16_t* W1T = RB(1); LAS bf16_t* UlT = RB(6);
    { f32x4 res[4];
#pragma unroll
      for (int n_ = 0; n_ < 4; ++n_) { const int ti = wq + 2 * (n_ & 1); res[n_] = (n_ < 2) ? mm64(Tm, AtT, ti, tj, Z4, lane) : mm64(Aak, VT, ti, tj, Z4, lane); }
#pragma unroll
      for (int n_ = 0; n_ < 4; ++n_) storeT((n_ < 2) ? AhT : W1T, wq + 2 * (n_ & 1), tj, res[n_], lane); }
    LDS_BARRIER();
    { f32x4 res[2];
#pragma unroll
      for (int n_ = 0; n_ < 2; ++n_) res[n_] = mm64(Tm, W1T, wq + 2 * n_, tj, Z4, lane);
#pragma unroll
      for (int n_ = 0; n_ < 2; ++n_) storeT(UlT, wq + 2 * n_, tj, res[n_], lane); }
    LDS_BARRIER();
    bf16_t* gM = (bf16_t*)(C.ws + WS_RWM) + (size_t)ch * 4096; bf16_t* gNT = (bf16_t*)(C.ws + WS_RWNT) + (size_t)ch * 4096; bf16_t* gQ = (bf16_t*)(C.ws + WS_RWQH) + (size_t)ch * 4096; bf16_t* gY = (bf16_t*)(C.ws + WS_RWYL) + (size_t)ch * 4096;
#pragma unroll
    for (int n_ = 0; n_ < 8; ++n_) { const int o = n_ >> 1, ti = wq + 2 * (n_ & 1); const int rho = 16 * tj + r, kap = 16 * ti + 4 * g;
        if (o == 0) {
            const u32x2 w = *(const LAS u32x2*)(Rt + rho * LD + kap); f32x4 v = (f32x4){bflo(w[0]), bfhi(w[0]), bflo(w[1]), bfhi(w[1])};
            v = mm64(AhT, Arb, ti, tj, v, lane); *(u32x2*)(gQ + rho * 64 + kap) = (u32x2){pk2(v[0], v[1]), pk2(v[2], v[3])}; }
        else if (o == 1) {
            f32x4 v = mm64(UlT, Arb, ti, tj, Z4, lane); v = mm64(VT, Ark, ti, tj, v, lane); *(u32x2*)(gY + rho * 64 + kap) = (u32x2){pk2(v[0], v[1]), pk2(v[2], v[3])}; }
        else if (o == 2) {
            f32x4 v = mm64(AhT, BtT, ti, tj, Z4, lane); const float gl = gamL[rho];
#pragma unroll
            for (int j = 0; j < 4; ++j) v[j] = gl * (v[j] + ((kap + j == rho) ? 1.0f : 0.f));
            *(u32x2*)(gM + rho * 64 + kap) = (u32x2){pk2(v[0], v[1]), pk2(v[2], v[3])}; }
        else {
            f32x4 v = mm64(BtT, UlT, ti, tj, Z4, lane); v = mm64(KtT, VT, ti, tj, v, lane);
#pragma unroll
            for (int j = 0; j < 4; ++j) v[j] *= gamL[kap + j];
            *(u32x2*)(gNT + rho * 64 + kap) = (u32x2){pk2(v[0], v[1]), pk2(v[2], v[3])}; } }
    LDS_BARRIER();
#undef RB
}

__device__ __forceinline__ void mlb_unit(const Params& P, const Ctx& C, int l, int u) {
    const int tid = C.tid, wave = C.wave, lane = C.lane, r = lane & 15, g = lane >> 4;
    const int hh = u & 3, bcx = u >> 2, b = bcx >> 7, c = bcx & 127; const int tok0 = b * SEQ + c * 64; const int ch = (b * 4 + hh) * 128 + c;
    LAS unsigned char* L = C.lds;
    LAS bf16_t* Qs = (LAS bf16_t*)L; LAS bf16_t* Ks = (LAS bf16_t*)(L + BUFB); LAS bf16_t* KhT = (LAS bf16_t*)(L + 2 * BUFB); LAS bf16_t* Sm = (LAS bf16_t*)(L + 3 * BUFB); LAS bf16_t* VTe = (LAS bf16_t*)(L + 4 * BUFB);
    LAS float* vbc = (LAS float*)(L + 4 * BUFB + 80 * LD * 2); LAS float* vig = vbc + 64; LAS float* vmd = vig + 64; LAS float* vws = vmd + 64;
    const bf16_t* p = (const bf16_t*)(C.ws + WS_P);
    unsigned xr[19], vr[8];
    { const int cq = tid & 127, tg = tid >> 7, isk = cq >> 6, d = cq & 63; const int col = 2048 + isk * 256 + hh * 64 + d; const int t0 = 16 * tg; const bool okp = (c * 64 + t0 > 0);
#pragma unroll
      for (int k = 0; k < 19; ++k) xr[k] = p[(size_t)(tok0 + ((k < 3 && !okp) ? 0 : t0 + k - 3)) * NPROJ + col];
      const int v = tid & 63, sg = tid >> 6;
#pragma unroll
      for (int k = 0; k < 8; ++k) vr[k] = p[(size_t)(tok0 + 8 * sg + k) * NPROJ + 2560 + hh * 64 + v]; }
    if (wave == 0) { const float* pg = (const float*)(C.ws + WS_PG) + (size_t)(tok0 + lane) * 8; const float ig = pg[hh], f = pg[4 + hh];
        const float lf = fminf(f, 0.f) - __logf(1.0f + __expf(-fabsf(f)));
        float bcv = lf;
#pragma unroll
        for (int o = 1; o < 64; o <<= 1) { const float t = __shfl_up(bcv, o); bcv += (lane >= o) ? t : 0.f; }
        float pm = ig - bcv;
#pragma unroll
        for (int o = 1; o < 64; o <<= 1) { const float t = __shfl_up(pm, o); pm = (lane >= o) ? fmaxf(pm, t) : pm; }
        const float md = bcv + pm; const float bcL = __shfl(bcv, 63); const float as = bcL - bcv + ig; const float mloc = wave_max(as); const float ws = __expf(as - mloc);
        vbc[lane] = bcv; vig[lane] = ig; vmd[lane] = md; vws[lane] = ws;
        float* vec = (float*)(C.ws + WS_MLVEC) + ((size_t)ch * 64 + lane) * 2; vec[0] = bcv; vec[1] = md;
        if (lane == 0) { float* sc = (float*)(C.ws + WS_MLSC) + (size_t)ch * 2; sc[0] = bcL; sc[1] = mloc; } }
    LDS_BARRIER();
    { const int cq = tid & 127, tg = tid >> 7, isk = cq >> 6, d = cq & 63; const int col = 2048 + isk * 256 + hh * 64 + d; const int cw = isk * 256 + hh * 64 + d;
      const float* cwp = P.in[I_CONVW] + (size_t)l * 4 * 512; const float w0 = cwp[cw], w1 = cwp[512 + cw], w2 = cwp[1024 + cw], w3 = cwp[1536 + cw], cb = P.in[I_CONVB][l * 512 + cw];
      float xm3 = 0.f, xm2 = 0.f, xm1 = 0.f; const int t0 = 16 * tg;
      if (c * 64 + t0 > 0) { xm3 = bf2f((unsigned short)xr[0]); xm2 = bf2f((unsigned short)xr[1]); xm1 = bf2f((unsigned short)xr[2]); }
      float o16[16];
#pragma unroll
      for (int k = 0; k < 16; ++k) { const float x0 = bf2f((unsigned short)xr[k + 3]); const float y = w0 * xm3 + w1 * xm2 + w2 * xm1 + w3 * x0 + cb; const float s = y * sigmoidf_(y);
          o16[k] = isk ? s * 0.125f : s; xm3 = xm2; xm2 = xm1; xm1 = x0; }
      if (!isk) { bf16_t* gq = (bf16_t*)(C.ws + WS_MLQ) + (size_t)ch * 4096;
#pragma unroll
          for (int k = 0; k < 16; ++k) { const bf16_t v = (bf16_t)f2bf(o16[k]); Qs[(t0 + k) * LD + d] = v; gq[(t0 + k) * 64 + d] = v; } }
      else {
#pragma unroll
          for (int k = 0; k < 16; ++k) { Ks[(t0 + k) * LD + d] = (bf16_t)f2bf(o16[k]); o16[k] *= vws[t0 + k]; }
          *(LAS u32x4*)(KhT + d * LD + t0) = (u32x4){pk2(o16[0], o16[1]), pk2(o16[2], o16[3]), pk2(o16[4], o16[5]), pk2(o16[6], o16[7])};
          *(LAS u32x4*)(KhT + d * LD + t0 + 8) = (u32x4){pk2(o16[8], o16[9]), pk2(o16[10], o16[11]), pk2(o16[12], o16[13]), pk2(o16[14], o16[15])}; }
      { const int v = tid & 63, sg = tid >> 6; float vv[8];
#pragma unroll
        for (int k = 0; k < 8; ++k) vv[k] = bf2f((unsigned short)vr[k]);
        *(LAS u32x4*)(VTe + v * LD + 8 * sg) = (u32x4){pk2(vv[0], vv[1]), pk2(vv[2], vv[3]), pk2(vv[4], vv[5]), pk2(vv[6], vv[7])}; }
      if (tid < 128) { const int row = 64 + (tid >> 3), pc = tid & 7; const unsigned one2 = 0x3f803f80u; const unsigned val = (row == 64) ? one2 : 0u; *(LAS u32x4*)(VTe + row * LD + 8 * pc) = (u32x4){val, val, val, val}; }
    }
    LDS_BARRIER();
    const f32x4 Z4 = (f32x4){0.f, 0.f, 0.f, 0.f};
    bf16_t* gKL = (bf16_t*)(C.ws + WS_MLKL) + (size_t)ch * 5120; bf16_t* gNL = (bf16_t*)(C.ws + WS_MLNL) + (size_t)ch * 5120;
    for (int task = wave; task < 36; task += 8) {
        if (task < 16) { const int ti = task >> 2, tj = task & 3; f32x4 v = mm64(Ks, Qs, ti, tj, Z4, lane);
            const int rho = 16 * tj + r, kap = 16 * ti + 4 * g; const float bl = vbc[rho] - vmd[rho];
#pragma unroll
            for (int j = 0; j < 4; ++j) { const int s = kap + j; v[j] = (s <= rho) ? v[j] * __expf(bl - vbc[s] + vig[s]) : 0.f; }
            storeT(Sm, ti, tj, v, lane); }
        else { const int t2 = task - 16, ti = t2 / 5, tj = t2 % 5;
            const f32x4 v = mm64(KhT, VTe, ti, tj, Z4, lane); *(u32x2*)(gKL + (16 * tj + r) * 64 + 16 * ti + 4 * g) = (u32x2){pk2(v[0], v[1]), pk2(v[2], v[3])}; } }
    LDS_BARRIER();
    for (int task = wave; task < 20; task += 8) { const int ti = task >> 2, tj = task & 3; const f32x4 v = mm64(VTe, Sm, ti, tj, Z4, lane); *(u32x2*)(gNL + (16 * tj + r) * 80 + 16 * ti + 4 * g) = (u32x2){pk2(v[0], v[1]), pk2(v[2], v[3])}; }
    LDS_BARRIER();
}

__device__ __forceinline__ void rwkv_chain(const Ctx& C, int bh, int vh) {
    const int tid = C.tid, wave = C.wave, lane = C.lane, r = lane & 15, g = lane >> 4; const size_t ch0 = (size_t)bh * 128;
    LAS unsigned char* L = C.lds; LAS unsigned char* Mb = L; LAS unsigned char* Nb = L + 8 * BUFB; LAS unsigned char* Sb = Nb + 8 * (32 * LD * 2);
    static_assert(8 * BUFB + 8 * 32 * LD * 2 + 8 * 32 * 128 <= MISC_OFF, "chain LDS");
    const bf16_t* gM = (const bf16_t*)(C.ws + WS_RWM) + ch0 * 4096; const bf16_t* gN = (const bf16_t*)(C.ws + WS_RWNT) + ch0 * 4096 + (size_t)vh * 32 * 64; bf16_t* gS = (bf16_t*)(C.ws + WS_RWS) + ch0 * 4096;
    u32x4 pmA[8], pnA4[4];
#define CH_LOAD(pm, pn, nbx) do { const bf16_t* m_ = gM + (size_t)(nbx) * 8 * 4096; \
        _Pragma("unroll") for (int i = 0; i < 8; ++i) pm[i] = ((const u32x4*)m_)[tid + 512 * i]; \
        _Pragma("unroll") for (int i = 0; i < 4; ++i) { const int q = tid + 512 * i, chunk = q >> 8, within = q & 255; pn[i] = ((const u32x4*)(gN + ((size_t)(nbx) * 8 + chunk) * 4096))[within]; } } while (0)
#define CH_PUT(pm, pn) do { \
        _Pragma("unroll") for (int i = 0; i < 8; ++i) { const int q = tid + 512 * i, chunk = q >> 9, within = q & 511, row = within >> 3, pc = within & 7; *(LAS u32x4*)(Mb + chunk * BUFB + row * (LD * 2) + pc * 16) = pm[i]; } \
        _Pragma("unroll") for (int i = 0; i < 4; ++i) { const int q = tid + 512 * i, chunk = q >> 8, within = q & 255, row = within >> 3, pc = within & 7; *(LAS u32x4*)(Nb + chunk * (32 * LD * 2) + row * (LD * 2) + pc * 16) = pn[i]; } } while (0)
    CH_LOAD(pmA, pnA4, 0);
    f32x4 acc[4];
#pragma unroll
    for (int t = 0; t < 4; ++t) acc[t] = (f32x4){0.f, 0.f, 0.f, 0.f};
#define CH_FRAGS(cc_, mf_, nf_) do { const LAS unsigned char* mc = Mb + (cc_) * BUFB; const LAS unsigned char* nc = Nb + (cc_) * (32 * LD * 2); \
        _Pragma("unroll") for (int t = 0; t < 4; ++t) { nf_[t] = *(const LAS u32x2*)(nc + (16 * wave + r) * (LD * 2) + (16 * t + 4 * g) * 2); \
            const LAS unsigned char* mp = mc + (16 * t + r) * (LD * 2) + (4 * g) * 2; const u32x2 lo = *(const LAS u32x2*)mp, hi = *(const LAS u32x2*)(mp + 32); mf_[t] = (u32x4){lo[0], lo[1], hi[0], hi[1]}; } } while (0)
#define CH_ONE(cc_, mf_, nf_) do { \
            u32x4 m2[4]; { const LAS unsigned char* mc = Mb + (cc_) * BUFB; \
            _Pragma("unroll") for (int t = 0; t < 4; ++t) { const LAS unsigned char* mp = mc + (16 * t + r) * (LD * 2) + (32 + 4 * g) * 2; const u32x2 lo = *(const LAS u32x2*)mp, hi = *(const LAS u32x2*)(mp + 32); m2[t] = (u32x4){lo[0], lo[1], hi[0], hi[1]}; } } \
            u32x2 pk[4]; \
            _Pragma("unroll") for (int t = 0; t < 4; ++t) pk[t] = (u32x2){pk2(acc[t][0], acc[t][1]), pk2(acc[t][2], acc[t][3])}; \
            LAS unsigned char* sg = Sb + (cc_) * 4096 + (16 * wave + r) * 128 + (4 * g) * 2; \
            _Pragma("unroll") for (int t = 0; t < 4; ++t) *(LAS u32x2*)(sg + 32 * t) = pk[t]; \
            bf16x8 zb[2]; \
            _Pragma("unroll") for (int s = 0; s < 2; ++s) { const u32x4 z = (u32x4){pk[2 * s][0], pk[2 * s][1], pk[2 * s + 1][0], pk[2 * s + 1][1]}; zb[s] = __builtin_bit_cast(bf16x8, z); } \
            _Pragma("unroll") for (int t = 0; t < 4; ++t) { const u32x2 nw = nf_[t]; const f32x4 a0 = (f32x4){bflo(nw[0]), bfhi(nw[0]), bflo(nw[1]), bfhi(nw[1])}; \
                acc[t] = mfma16(__builtin_bit_cast(bf16x8, mf_[t]), zb[0], a0); } \
            _Pragma("unroll") for (int t = 0; t < 4; ++t) acc[t] = mfma16(__builtin_bit_cast(bf16x8, m2[t]), zb[1], acc[t]); } while (0)
#define CH_STEP(nbx) do { if (wave < 2) { u32x4 mf0[4], mf1[4]; u32x2 nf0[4], nf1[4]; CH_FRAGS(0, mf0, nf0); \
        _Pragma("unroll 1") for (int cc = 0; cc < 8; cc += 2) { \
            CH_FRAGS(cc + 1, mf1, nf1); CH_ONE(cc, mf0, nf0); \
            if (cc + 2 < 8) CH_FRAGS(cc + 2, mf0, nf0); CH_ONE(cc + 1, mf1, nf1); } } } while (0)
#define CH_SOUT(nbx) do { _Pragma("unroll") for (int i = 0; i < 4; ++i) { const int q = tid + 512 * i, chunk = q >> 8, within = q & 255, row = within >> 3, pc = within & 7; \
        const u32x4 v = *(const LAS u32x4*)(Sb + chunk * 4096 + row * 128 + pc * 16); *(u32x4*)(gS + ((size_t)(nbx) * 8 + chunk) * 4096 + (32 * vh + row) * 64 + pc * 8) = v; } } while (0)
    for (int nb = 0; nb < 16; ++nb) {
        LDS_BARRIER(); if (nb > 0) CH_SOUT(nb - 1); CH_PUT(pmA, pnA4); LDS_BARRIER();
        if (nb + 1 < 16) CH_LOAD(pmA, pnA4, nb + 1);
        CH_STEP(nb);
    }
    LDS_BARRIER(); CH_SOUT(15);
#undef CH_SOUT
#undef CH_LOAD
#undef CH_PUT
#undef CH_STEP
#undef CH_FRAGS
#undef CH_ONE
}
__device__ __forceinline__ void mlstm_cscan(const Ctx& C, int bh, int part) {
    const int tid = C.tid; const size_t ch0 = (size_t)bh * 128; const int e0 = 10 * (part * 128 + (tid & 127));
    const bf16_t* KL = (const bf16_t*)(C.ws + WS_MLKL) + ch0 * 5120 + e0; bf16_t* CT = (bf16_t*)(C.ws + WS_MLCT) + ch0 * 5120 + e0; float* MM = (float*)(C.ws + WS_MLM) + ch0; const float* SC = (const float*)(C.ws + WS_MLSC) + ch0 * 2;
    float st[10]; unsigned ring[8][5]; float m = 0.f;
    LAS float* scl = (LAS float*)C.lds; if (tid < 256) scl[tid] = SC[tid];
    __syncthreads();
    if (tid >= 128) return;
#pragma unroll
    for (int i = 0; i < 10; ++i) st[i] = 0.f;
#pragma unroll
    for (int k = 0; k < 8; ++k)
#pragma unroll
        for (int i = 0; i < 5; ++i) ring[k][i] = *(const unsigned*)(KL + (size_t)k * 5120 + 2 * i);
    for (int c0 = 0; c0 < 128; c0 += 8) {
#pragma unroll
        for (int k = 0; k < 8; ++k) { const int c = c0 + k; unsigned cur[5];
#pragma unroll
            for (int i = 0; i < 5; ++i) cur[i] = ring[k][i];
            if (c + 8 < 128) {
#pragma unroll
                for (int i = 0; i < 5; ++i) ring[k][i] = *(const unsigned*)(KL + (size_t)(c + 8) * 5120 + 2 * i); }
            const float bcL = scl[2 * c], mloc = scl[2 * c + 1];
            unsigned* ct = (unsigned*)(CT + (size_t)c * 5120);
#pragma unroll
            for (int i = 0; i < 5; ++i) ct[i] = pk2(st[2 * i], st[2 * i + 1]);
            if (tid == 0 && part == 0) MM[c] = m;
            const float mn = fmaxf(bcL + m, mloc); const float dec = __expf(bcL + m - mn), sc = __expf(mloc - mn); m = mn;
#pragma unroll
            for (int i = 0; i < 5; ++i) { st[2 * i] = dec * st[2 * i] + sc * bflo(cur[i]); st[2 * i + 1] = dec * st[2 * i + 1] + sc * bfhi(cur[i]); } }
    }
}

__device__ __forceinline__ void passd_unit(const Params& P, const Ctx& C, int l, int u) {
    const int wave = C.wave, lane = C.lane, r = lane & 15, g = lane >> 4; const int b = u >> 7, c = u & 127; const int tok0 = b * SEQ + c * 64;
    bf16_t* ymix = (bf16_t*)(C.ws + WS_YMIX);
    {
        bf16x8 qf[3][2], sf[3][4][2]; u32x2 yl[3][4], bo[3][4], gg[3][4];
#pragma unroll
        for (int n_ = 0; n_ < 3; ++n_) { const int task = wave + 8 * n_, h = task >> 2, tb = task & 3; const size_t ch = (size_t)(b * 6 + h) * 128 + c; const int t = 16 * tb + r; const int tok = tok0 + t;
            const bf16_t* gS = (const bf16_t*)(C.ws + WS_RWS) + ch * 4096; const bf16_t* gQ = (const bf16_t*)(C.ws + WS_RWQH) + ch * 4096 + t * 64 + 8 * g; const bf16_t* gY = (const bf16_t*)(C.ws + WS_RWYL) + ch * 4096 + t * 64 + 4 * g;
            const bf16_t* aux = (const bf16_t*)(C.ws + WS_RWAUX) + (size_t)tok * 768 + 64 * h + 4 * g;
            qf[n_][0] = *(const bf16x8*)gQ; qf[n_][1] = *(const bf16x8*)(gQ + 32);
#pragma unroll
            for (int ti = 0; ti < 4; ++ti) { const bf16_t* sp = gS + (16 * ti + r) * 64 + 8 * g; sf[n_][ti][0] = *(const bf16x8*)sp; sf[n_][ti][1] = *(const bf16x8*)(sp + 32);
                yl[n_][ti] = *(const u32x2*)(gY + 16 * ti); bo[n_][ti] = *(const u32x2*)(aux + 16 * ti); gg[n_][ti] = *(const u32x2*)(aux + RWD + 16 * ti); } }
#pragma unroll
        for (int n_ = 0; n_ < 3; ++n_) { const int task = wave + 8 * n_, h = task >> 2, tb = task & 3; const int t = 16 * tb + r; const int tok = tok0 + t;
            f32x4 y[4]; float s = 0.f;
#pragma unroll
            for (int ti = 0; ti < 4; ++ti) { const u32x2 yw = yl[n_][ti]; f32x4 a = (f32x4){bflo(yw[0]), bfhi(yw[0]), bflo(yw[1]), bfhi(yw[1])};
                a = mfma16(sf[n_][ti][0], qf[n_][0], a); a = mfma16(sf[n_][ti][1], qf[n_][1], a); y[ti] = a; s += (a[0] + a[1]) + (a[2] + a[3]); }
            s += __shfl_xor(s, 16); s += __shfl_xor(s, 32); const float mean = s * (1.f / 64.f); float s2 = 0.f;
#pragma unroll
            for (int ti = 0; ti < 4; ++ti) { y[ti] = y[ti] - mean; s2 += (y[ti][0] * y[ti][0] + y[ti][1] * y[ti][1]) + (y[ti][2] * y[ti][2] + y[ti][3] * y[ti][3]); }
            s2 += __shfl_xor(s2, 16); s2 += __shfl_xor(s2, 32); const float rstd = rsqrtf(s2 * (1.f / 64.f) + 64e-5f);
            bf16_t* yo = ymix + (size_t)tok * DM + 64 * h + 4 * g;
            const float* lw = P.in[I_LNW] + l * RWD + 64 * h + 4 * g; const float* lb = P.in[I_LNB] + l * RWD + 64 * h + 4 * g;
#pragma unroll
            for (int ti = 0; ti < 4; ++ti) { const u32x2 bo_ = bo[n_][ti], gg_ = gg[n_][ti]; const f32x4 w4 = *(const f32x4*)(lw + 16 * ti), b4 = *(const f32x4*)(lb + 16 * ti);
                const float o0 = (y[ti][0] * rstd * w4[0] + b4[0] + bflo(bo_[0])) * bflo(gg_[0]), o1 = (y[ti][1] * rstd * w4[1] + b4[1] + bfhi(bo_[0])) * bfhi(gg_[0]);
                const float o2 = (y[ti][2] * rstd * w4[2] + b4[2] + bflo(bo_[1])) * bflo(gg_[1]), o3 = (y[ti][3] * rstd * w4[3] + b4[3] + bfhi(bo_[1])) * bfhi(gg_[1]);
                *(u32x2*)(yo + 16 * ti) = (u32x2){pk2(o0, o1), pk2(o2, o3)}; } }
    }
    {
        bf16x8 qf[2][2], cf[2][5][2]; u32x2 nl[2][5], og[2][4]; float bcl[2], mdl[2], mcv[2];
#pragma unroll
        for (int n_ = 0; n_ < 2; ++n_) { const int task = wave + 8 * (n_ + 3), hh = (task - 24) >> 2, tb = task & 3; const size_t ch = (size_t)(b * 4 + hh) * 128 + c; const int t = 16 * tb + r; const int tok = tok0 + t;
            const bf16_t* gC = (const bf16_t*)(C.ws + WS_MLCT) + ch * 5120; const bf16_t* gQ = (const bf16_t*)(C.ws + WS_MLQ) + ch * 4096 + t * 64 + 8 * g; const bf16_t* gNL = (const bf16_t*)(C.ws + WS_MLNL) + ch * 5120 + t * 80 + 4 * g;
            const bf16_t* ogp = (const bf16_t*)(C.ws + WS_P) + (size_t)tok * NPROJ + 2816 + 64 * hh + 4 * g;
            qf[n_][0] = *(const bf16x8*)gQ; qf[n_][1] = *(const bf16x8*)(gQ + 32);
            const float* vec = (const float*)(C.ws + WS_MLVEC) + (ch * 64 + t) * 2; bcl[n_] = vec[0]; mdl[n_] = vec[1]; mcv[n_] = ((const float*)(C.ws + WS_MLM))[ch];
#pragma unroll
            for (int ti = 0; ti < 5; ++ti) { const bf16_t* cp = gC + (16 * ti + r) * 64 + 8 * g; cf[n_][ti][0] = *(const bf16x8*)cp; cf[n_][ti][1] = *(const bf16x8*)(cp + 32); nl[n_][ti] = *(const u32x2*)(gNL + 16 * ti); }
#pragma unroll
            for (int ti = 0; ti < 4; ++ti) og[n_][ti] = *(const u32x2*)(ogp + 16 * ti); }
#pragma unroll
        for (int n_ = 0; n_ < 2; ++n_) { const int task = wave + 8 * (n_ + 3), hh = (task - 24) >> 2, tb = task & 3; const int t = 16 * tb + r; const int tok = tok0 + t;
            const float mint = bcl[n_] + mcv[n_], mt = fmaxf(mint, mdl[n_]); const float inter = __expf(mint - mt), fl = __expf(mdl[n_] - mt);
            f32x4 y[5];
#pragma unroll
            for (int ti = 0; ti < 5; ++ti) { f32x4 a = (f32x4){0.f, 0.f, 0.f, 0.f};
                a = mfma16(cf[n_][ti][0], qf[n_][0], a); a = mfma16(cf[n_][ti][1], qf[n_][1], a); const u32x2 nw = nl[n_][ti]; const f32x4 nlv = (f32x4){bflo(nw[0]), bfhi(nw[0]), bflo(nw[1]), bfhi(nw[1])}; y[ti] = fl * nlv + inter * a; }
            const float nq = __shfl(y[4][0], r);
            const float inv = 1.0f / fmaxf(fabsf(nq), __expf(-mt));
            float s = 0.f;
#pragma unroll
            for (int ti = 0; ti < 4; ++ti) { y[ti] = y[ti] * inv; s += (y[ti][0] + y[ti][1]) + (y[ti][2] + y[ti][3]); }
            s += __shfl_xor(s, 16); s += __shfl_xor(s, 32); const float mean = s * (1.f / 64.f); float s2 = 0.f;
#pragma unroll
            for (int ti = 0; ti < 4; ++ti) { y[ti] = y[ti] - mean; s2 += (y[ti][0] * y[ti][0] + y[ti][1] * y[ti][1]) + (y[ti][2] * y[ti][2] + y[ti][3] * y[ti][3]); }
            s2 += __shfl_xor(s2, 16); s2 += __shfl_xor(s2, 32); const float rstd = rsqrtf(s2 * (1.f / 64.f) + 1e-6f);
            bf16_t* yo = ymix + (size_t)tok * DM + 768 + 64 * hh + 4 * g; const float* nw = P.in[I_MLNW] + l * 256 + 64 * hh + 4 * g;
#pragma unroll
            for (int ti = 0; ti < 4; ++ti) { const u32x2 oo = og[n_][ti]; const f32x4 w4 = *(const f32x4*)(nw + 16 * ti);
                const float o0 = y[ti][0] * rstd * w4[0] * sigmoidf_(bflo(oo[0])), o1 = y[ti][1] * rstd * w4[1] * sigmoidf_(bfhi(oo[0])), o2 = y[ti][2] * rstd * w4[2] * sigmoidf_(bflo(oo[1])), o3 = y[ti][3] * rstd * w4[3] * sigmoidf_(bfhi(oo[1]));
                *(u32x2*)(yo + 16 * ti) = (u32x2){pk2(o0, o1), pk2(o2, o3)}; } }
    }
}

__device__ __forceinline__ void ln1_router_phase(const Params& P, const Ctx& C, int l, int cnt_off) {
    const int tid = C.tid, wave = C.wave, lane = C.lane, r = lane & 15, g = lane >> 4;
    constexpr int HS = 1032;
    LAS bf16_t* hhi = (LAS bf16_t*)C.lds;
    LAS bf16_t* hlo = hhi + 16 * HS;
    LAS float* part = (LAS float*)(hlo + 16 * HS);
    LAS int* lcnt = (LAS int*)(part + 8 * 8 * 32);
    bf16x8 bh[4][2], bl[4][2];
#pragma unroll
    for (int ks = 0; ks < 4; ++ks)
#pragma unroll
        for (int nt = 0; nt < 2; ++nt) { const size_t off = ((size_t)l * NEXP + 16 * nt + r) * DM + 32 * (4 * wave + ks) + 8 * g;
            bh[ks][nt] = *(const bf16x8*)((const bf16_t*)(C.ws + WS_WRH) + off); bl[ks][nt] = *(const bf16x8*)((const bf16_t*)(C.ws + WS_WRL) + off); }
    for (int i = tid; i < 16 * HS; i += 512) { hhi[i] = 0; hlo[i] = 0; }
    if (tid < 32) lcnt[tid] = 0;
    { int* pdest = (int*)(C.ws + WS_PDEST); int* ptok = (int*)(C.ws + WS_PTOK); for (int i = C.blk * 512 + tid; i < POS_MAX; i += C.G * 512) { pdest[i] = -1; ptok[i] = 0; } }
    __syncthreads();
    const int tpb = (MTOK + C.G - 1) / C.G, tok_lo = C.blk * tpb, tok_hi = (tok_lo + tpb < MTOK) ? tok_lo + tpb : MTOK;
    const bf16_t* t1 = (const bf16_t*)(C.ws + WS_T1); bf16_t* hb = (bf16_t*)(C.ws + WS_HB);
    int* toke = (int*)(C.ws + WS_TOKE); float* tokg = (float*)(C.ws + WS_TOKG); int* toklr = (int*)(C.ws + WS_TOKLR);
    const f32x4* lw4 = (const f32x4*)(P.in[I_LN1W] + (size_t)l * DM) + lane; const f32x4* lb4 = (const f32x4*)(P.in[I_LN1B] + (size_t)l * DM) + lane;
    u32x2 vn[4], rn[4];
    { const int tok = tok_lo + wave; const size_t ro = (size_t)((tok < tok_hi) ? tok : tok_lo) * DM; const u32x2* xr = (const u32x2*)(t1 + ro) + lane; const u32x2* rr = (const u32x2*)(hb + ro) + lane;
#pragma unroll
      for (int j = 0; j < 4; ++j) { vn[j] = xr[64 * j]; rn[j] = rr[64 * j]; } }
    const float rbias = P.in[I_RB][l * NEXP + (lane & 31)];
    for (int base = tok_lo; base < tok_hi; base += 8) {
        const int tok = base + wave;
        f32x4 v[4];
#pragma unroll
        for (int j = 0; j < 4; ++j) v[j] = (f32x4){bflo(vn[j][0]), bfhi(vn[j][0]), bflo(vn[j][1]), bfhi(vn[j][1])} + DN_ALPHA * (f32x4){bflo(rn[j][0]), bfhi(rn[j][0]), bflo(rn[j][1]), bfhi(rn[j][1])};
        { const int tn = base + 8 + wave; const size_t ro = (size_t)((tn < tok_hi) ? tn : tok_lo) * DM; const u32x2* xr = (const u32x2*)(t1 + ro) + lane; const u32x2* rr = (const u32x2*)(hb + ro) + lane;
#pragma unroll
          for (int j = 0; j < 4; ++j) { vn[j] = xr[64 * j]; rn[j] = rr[64 * j]; } }
        if (tok < tok_hi) {
            float s = 0.f;
#pragma unroll
            for (int j = 0; j < 4; ++j) s += (v[j][0] + v[j][1]) + (v[j][2] + v[j][3]);
            const float mean = wave_sum(s) * (1.f / DM); float s2 = 0.f;
#pragma unroll
            for (int j = 0; j < 4; ++j) { v[j] = v[j] - mean; s2 += (v[j][0] * v[j][0] + v[j][1] * v[j][1]) + (v[j][2] * v[j][2] + v[j][3] * v[j][3]); }
            const float rstd = rsqrtf(wave_sum(s2) * (1.f / DM) + LN_EPS);
            u32x2* ob = (u32x2*)(hb + (size_t)tok * DM) + lane;
#pragma unroll
            for (int j = 0; j < 4; ++j) { const f32x4 y = v[j] * rstd * lw4[64 * j] + lb4[64 * j]; const u32x2 hi = (u32x2){pk2(y[0], y[1]), pk2(y[2], y[3])}; ob[64 * j] = hi;
                const u32x2 lo = (u32x2){pk2(y[0] - bflo(hi[0]), y[1] - bfhi(hi[0])), pk2(y[2] - bflo(hi[1]), y[3] - bfhi(hi[1]))};
                *(LAS u32x2*)(hhi + wave * HS + 4 * (lane + 64 * j)) = hi; *(LAS u32x2*)(hlo + wave * HS + 4 * (lane + 64 * j)) = lo; }
        }
        __syncthreads();
        { f32x4 acc[2]; acc[0] = (f32x4){0.f, 0.f, 0.f, 0.f}; acc[1] = acc[0];
#pragma unroll
          for (int ks = 0; ks < 4; ++ks) { const int ko = r * HS + 32 * (4 * wave + ks) + 8 * g; const bf16x8 ah = *(const LAS bf16x8*)(hhi + ko), al = *(const LAS bf16x8*)(hlo + ko);
#pragma unroll
              for (int nt = 0; nt < 2; ++nt) { acc[nt] = mfma16(ah, bh[ks][nt], acc[nt]); acc[nt] = mfma16(ah, bl[ks][nt], acc[nt]); acc[nt] = mfma16(al, bh[ks][nt], acc[nt]); } }
          if (g < 2) {
#pragma unroll
              for (int nt = 0; nt < 2; ++nt)
#pragma unroll
                  for (int j = 0; j < 4; ++j) part[(wave * 8 + 4 * g + j) * 32 + 16 * nt + r] = acc[nt][j]; } }
        __syncthreads();
        if (tok < tok_hi) { const int ee = lane & 31; float lg = rbias;
#pragma unroll
            for (int w8 = 0; w8 < 8; ++w8) lg += part[(w8 * 8 + wave) * 32 + ee];
            float bv[4]; int bi[4];
#pragma unroll
            for (int rd = 0; rd < 4; ++rd) { float mv = lg; int mi = ee;
#pragma unroll
                for (int o = 1; o < 32; o <<= 1) { const float ov = __shfl_xor(mv, o); const int oi = __shfl_xor(mi, o); const bool take = (ov > mv) || (ov == mv && oi < mi); mv = take ? ov : mv; mi = take ? oi : mi; }
                bv[rd] = mv; bi[rd] = mi; lg = (ee == mi) ? -__builtin_inff() : lg; }
            if (lane == 0) { const float e1 = __expf(bv[1] - bv[0]), e2 = __expf(bv[2] - bv[0]), e3 = __expf(bv[3] - bv[0]); const float inv = 1.0f / (1.0f + e1 + e2 + e3);
                const int l0 = __hip_atomic_fetch_add(&lcnt[bi[0]], 1, __ATOMIC_RELAXED, __HIP_MEMORY_SCOPE_WORKGROUP), l1 = __hip_atomic_fetch_add(&lcnt[bi[1]], 1, __ATOMIC_RELAXED, __HIP_MEMORY_SCOPE_WORKGROUP), l2 = __hip_atomic_fetch_add(&lcnt[bi[2]], 1, __ATOMIC_RELAXED, __HIP_MEMORY_SCOPE_WORKGROUP), l3 = __hip_atomic_fetch_add(&lcnt[bi[3]], 1, __ATOMIC_RELAXED, __HIP_MEMORY_SCOPE_WORKGROUP);
                *(int4*)(toke + tok * 4) = make_int4(bi[0], bi[1], bi[2], bi[3]); *(f32x4*)(tokg + tok * 4) = (f32x4){inv, e1 * inv, e2 * inv, e3 * inv}; *(int4*)(toklr + tok * 4) = make_int4(l0, l1, l2, l3); } }
        __syncthreads();
    }
    if (tid < 32) { unsigned* gc = (unsigned*)(C.ws + WS_CTL) + CW_CNT + cnt_off + l * 32 + tid;
        const unsigned bb = __hip_atomic_fetch_add(gc, (unsigned)lcnt[tid], __ATOMIC_RELAXED, __HIP_MEMORY_SCOPE_AGENT);
        ((int*)(C.ws + WS_BBASE))[C.blk * 32 + tid] = (int)bb; }
    __syncthreads();
}
__device__ __forceinline__ void permute_phase(const Params& P, const Ctx& C, int l) {
    const int tid = C.tid, wave = C.wave, lane = C.lane;
    LAS int* pst = (LAS int*)C.lds;
    if (tid == 0) { const unsigned* gc = (const unsigned*)(C.ws + WS_CTL) + CW_CNT + l * 32; int ps = 0;
        for (int e = 0; e < 32; ++e) { pst[e] = ps; ps += ((int)__hip_atomic_load(gc + e, __ATOMIC_RELAXED, __HIP_MEMORY_SCOPE_AGENT) + 255) & ~255; } }
    __syncthreads();
    const int tpb = (MTOK + C.G - 1) / C.G, tok_lo = C.blk * tpb, tok_hi = (tok_lo + tpb < MTOK) ? tok_lo + tpb : MTOK;
    const int* toke = (const int*)(C.ws + WS_TOKE); const float* tokg = (const float*)(C.ws + WS_TOKG); const int* toklr = (const int*)(C.ws + WS_TOKLR); const int* bbase = (const int*)(C.ws + WS_BBASE) + C.blk * 32;
    const bf16_t* hb = (const bf16_t*)(C.ws + WS_HB); bf16_t* xp = (bf16_t*)(C.ws + WS_XPERM); int* pdest = (int*)(C.ws + WS_PDEST); float* pgate = (float*)(C.ws + WS_PGATE);
    int* ptok = (int*)(C.ws + WS_PTOK);
    for (int a = tid; a < 4 * (tok_hi - tok_lo); a += 512) { const int tok = tok_lo + (a >> 2), as = tok * 4 + (a & 3);
        const int e = toke[as]; const int pos = pst[e] + bbase[e] + toklr[as];
        pdest[pos] = as; pgate[pos] = tokg[as]; ptok[pos] = tok; }
    __syncthreads();
}
__device__ __forceinline__ void build_tile_e(const Ctx& C, int l) {
    LAS int* te = (LAS int*)(C.lds + TILEE_OFF);
    if (C.tid == 0) { const unsigned* gc = (const unsigned*)(C.ws + WS_CTL) + CW_CNT + l * 32; int t = 0;
        for (int e = 0; e < 32; ++e) { const int nt = ((int)__hip_atomic_load(gc + e, __ATOMIC_RELAXED, __HIP_MEMORY_SCOPE_AGENT) + 255) >> 8; for (int k = 0; k < nt && t < NT_MAX; ++k) te[t++] = e; }
        for (; t < NT_MAX; ++t) te[t] = 0; }
    __syncthreads();
}
__device__ __forceinline__ void combine_ln2_phase(const Params& P, const Ctx& C, int l) {
    const int lane = C.lane; const int gw = C.blk * 8 + C.wave, NGW = C.G * 8;
    const bool last = (l == NLAYER - 1);
    LAS float* wg = (LAS float*)C.lds;
    if (!last) load_wg(wg, P.in[I_WIN] + (size_t)(l + 1) * DM * CIN, C.tid);
    const bf16_t* yb = (const bf16_t*)(C.ws + WS_YB);
    float* hf = P.out; bf16_t* hb = (bf16_t*)(C.ws + WS_HB); float* pg = (float*)(C.ws + WS_PG);
    const f32x4* lw4 = (const f32x4*)(P.in[I_LN2W] + (size_t)l * DM) + lane; const f32x4* lb4 = (const f32x4*)(P.in[I_LN2B] + (size_t)l * DM) + lane;
    u32x2 nh[4], ny[4][4];
    { const int tok = (gw < MTOK) ? gw : 0; const u32x2* xr = (const u32x2*)(hb + (size_t)tok * DM) + lane;
#pragma unroll
      for (int j = 0; j < 4; ++j) nh[j] = xr[64 * j];
#pragma unroll
      for (int sl = 0; sl < 4; ++sl) { const u32x2* yr = (const u32x2*)(yb + (size_t)(tok * 4 + sl) * DM) + lane;
#pragma unroll
          for (int j = 0; j < 4; ++j) ny[sl][j] = yr[64 * j]; } }
    for (int tok = gw; tok < MTOK; tok += NGW) {
        f32x4 v[4]; float s = 0.f;
#pragma unroll
        for (int j = 0; j < 4; ++j) { v[j] = (f32x4){bflo(nh[j][0]), bfhi(nh[j][0]), bflo(nh[j][1]), bfhi(nh[j][1])} * DN_ALPHA;
#pragma unroll
            for (int sl = 0; sl < 4; ++sl) { const u32x2 w = ny[sl][j]; v[j][0] += bflo(w[0]); v[j][1] += bfhi(w[0]); v[j][2] += bflo(w[1]); v[j][3] += bfhi(w[1]); } }
        { const int tn = (tok + NGW < MTOK) ? tok + NGW : tok; const u32x2* xr = (const u32x2*)(hb + (size_t)tn * DM) + lane;
#pragma unroll
          for (int j = 0; j < 4; ++j) nh[j] = xr[64 * j];
#pragma unroll
          for (int sl = 0; sl < 4; ++sl) { const u32x2* yr = (const u32x2*)(yb + (size_t)(tn * 4 + sl) * DM) + lane;
#pragma unroll
              for (int j = 0; j < 4; ++j) ny[sl][j] = yr[64 * j]; } }
#pragma unroll
        for (int j = 0; j < 4; ++j) s += (v[j][0] + v[j][1]) + (v[j][2] + v[j][3]);
        const float mean = wave_sum(s) * (1.f / DM); float s2 = 0.f;
#pragma unroll
        for (int j = 0; j < 4; ++j) { v[j] = v[j] - mean; s2 += (v[j][0] * v[j][0] + v[j][1] * v[j][1]) + (v[j][2] * v[j][2] + v[j][3] * v[j][3]); }
        const float rstd = rsqrtf(wave_sum(s2) * (1.f / DM) + LN_EPS);
#pragma unroll
        for (int j = 0; j < 4; ++j) v[j] = v[j] * rstd * lw4[64 * j] + lb4[64 * j];
        if (last) { f32x4* of = (f32x4*)(hf + (size_t)tok * DM) + lane;
#pragma unroll
            for (int j = 0; j < 4; ++j) of[64 * j] = v[j]; }
        if (!last) { u32x2* ob = (u32x2*)(hb + (size_t)tok * DM) + lane;
#pragma unroll
            for (int j = 0; j < 4; ++j) ob[64 * j] = (u32x2){pk2(v[j][0], v[j][1]), pk2(v[j][2], v[j][3])};
            gate_cols(v, wg, P.in[I_BIN] + (size_t)(l + 1) * CIN + NPROJ, pg + (size_t)tok * 8, lane); }
    }
}

typedef const __attribute__((address_space(4))) Params* CParamsPtr;
__device__ __forceinline__ const Params* kparams() {
    const unsigned long long a = (unsigned long long)__builtin_amdgcn_kernarg_segment_ptr(); unsigned lo = (unsigned)a, hi = (unsigned)(a >> 32);
    asm volatile("" : "+v"(lo), "+v"(hi));
    lo = __builtin_amdgcn_readfirstlane(lo); hi = __builtin_amdgcn_readfirstlane(hi);
    return (const Params*)(CParamsPtr)(((unsigned long long)hi << 32) | lo);
}
__device__ __forceinline__ Ctx make_ctx(const Params& P, LAS unsigned char* lds, int wv0) {
    Ctx C; C.lds = lds; unsigned ones_ = ~0u; asm volatile("" : "+s"(ones_)); int t_ = wv0 * 64 + (int)__builtin_amdgcn_mbcnt_hi(ones_, __builtin_amdgcn_mbcnt_lo(ones_, 0u)), b_ = blockIdx.x, g_ = gridDim.x; asm volatile("" : "+v"(t_), "+v"(b_), "+v"(g_)); b_ = __builtin_amdgcn_readfirstlane(b_); g_ = __builtin_amdgcn_readfirstlane(g_);
    C.tid = t_; C.lane = C.tid & 63; C.wave = __builtin_amdgcn_readfirstlane(C.tid >> 6); C.blk = b_; C.G = g_; C.ws = P.ws; return C; }
__global__ void __launch_bounds__(512, 2) hybrid_fwd(Params Punused) {
    extern __shared__ __attribute__((aligned(16))) unsigned char lds_raw[];
    LAS unsigned char* const lds = (LAS unsigned char*)lds_raw;
    const int wv0 = __builtin_amdgcn_readfirstlane((int)threadIdx.x >> 6);
    volatile LAS unsigned* MISC = (volatile LAS unsigned*)(lds + MISC_OFF);
    for (int u = threadIdx.x; u < (LDS_BYTES - MISC_OFF) / 4; u += 512) MISC[u] = 0u;
    __syncthreads();
    const int lo = __builtin_amdgcn_readfirstlane(kparams()->ph_lo), hi = __builtin_amdgcn_readfirstlane(kparams()->ph_hi);
    #define IS_T0 (wv0 == 0 && __builtin_amdgcn_mbcnt_hi(~0u, __builtin_amdgcn_mbcnt_lo(~0u, 0u)) == 0u)
    if (hi - lo > 1) (void)xcd_barrier_post((unsigned*)(kparams()->ws + WS_CTL) + CW_BAR, MISC + 8, IS_T0);
#ifndef PHMASK
#define PHMASK 0x7ff
#endif
#define PH_EN(k) (((PHMASK) >> (k)) & 1)
#define RUN(gid) ((gid) >= lo && (gid) < hi)
#define SEAM(gid) do { if ((gid) + 1 < hi) { XcdBarrier bar_; bar_.bar = (unsigned*)(kparams()->ws + WS_CTL) + CW_BAR; bar_.x = xb_xcc_id(); bar_.st = (volatile LAS unsigned*)(lds + MISC_OFF) + 8; xcd_barrier(bar_, IS_T0); if (DUPBAR) xcd_barrier(bar_, IS_T0); } } while (0)
#ifndef DUPMASK
#define DUPMASK 0
#endif
#ifndef DUPBAR
#define DUPBAR 0
#endif
#define DUP(k) for (int rep_ = 0; rep_ < 1 + (((DUPMASK) >> (k)) & 1); ++rep_)
#define PHASE_BEGIN const Params& P = *kparams(); const Ctx C = make_ctx(P, lds, wv0);
    if (PH_EN(0) && RUN(0)) { DUP(0) { PHASE_BEGIN p0_prologue(P, C); } SEAM(0); }
#pragma unroll 1
    for (int l = 0; l < NLAYER; ++l) {
        const int g0 = 1 + l * NPH;
        if (g0 + NPH <= lo || g0 >= hi) continue;
        if (PH_EN(1) && RUN(g0 + 0)) {
            DUP(1) { PHASE_BEGIN
            pg8::Gemm g{(const bf16_t*)(C.ws + WS_HB), (const bf16_t*)(C.ws + WS_WIN) + (size_t)l * NPROJ * DM, MTOK, NPROJ, DM}; pg8::StaticOrder S; S.init(MTOK, NPROJ, C.G, C.blk);
            pg8::EpiBf16b E{(bf16_t*)(C.ws + WS_P), NPROJ, P.in[I_BIN] + (size_t)l * CIN};
            pg8::gemm_phase<pg8::EpiBf16b, pg8::StaticOrder>(C.lds, g, S, E, nullptr, C.tid); }
            SEAM(g0 + 0); }
        if (PH_EN(2) && RUN(g0 + 1)) {
            DUP(2) { PHASE_BEGIN
            constexpr int NU_SWA = 512, NU_RW = NB * 128 * 6, NU_ML = NB * 128 * 4;
#ifndef DUP2
#define DUP2 0
#endif
            for (int rp = 0; rp < 1 + ((DUP2 >> 1) & 1); ++rp) for (int cb = C.blk; cb < NB * 128; cb += C.G)
                for (int hh_ = 0; hh_ < 6; ++hh_) { rwb_unit(P, C, l, cb * 6 + hh_, hh_ != 0); if (hh_ == 0) { asm volatile("s_waitcnt vmcnt(0)" ::: "memory"); __syncthreads(); } }
            for (int rp = 0; rp < 1 + ((DUP2 >> 2) & 1); ++rp) for (int u = C.blk; u < NU_ML; u += C.G) mlb_unit(P, C, l, u); }
            SEAM(g0 + 1); }
        if (PH_EN(3) && RUN(g0 + 2)) {
            DUP(3) { PHASE_BEGIN
            {
#ifndef P3DUP
#define P3DUP 0
#endif
                if (C.blk < 48) { for (int rp = 0; rp < 1 + (P3DUP & 1); ++rp) { rwkv_chain(C, C.blk >> 1, C.blk & 1); __syncthreads(); } } else if (C.blk < 112) { for (int rp = 0; rp < 1 + ((P3DUP >> 1) & 1); ++rp) { mlstm_cscan(C, (C.blk - 48) >> 2, (C.blk - 48) & 3); __syncthreads(); } }
                LAS int* qslot = (LAS int*)(C.lds + MISC_OFF + 64); unsigned* qctr = (unsigned*)(C.ws + WS_CTL) + CW_SWAQ + l * 64;
                for (;;) { __syncthreads();
                    if (C.tid == 0) *qslot = (int)__hip_atomic_fetch_add(qctr, 1u, __ATOMIC_RELAXED, __HIP_MEMORY_SCOPE_AGENT);
                    __syncthreads();
                    const int u = *qslot; if (u >= 512) break;
                    swa_unit(P, C, l, u); } } }
            SEAM(g0 + 2); }
        if (PH_EN(4) && RUN(g0 + 3)) {
            DUP(4) { PHASE_BEGIN
            for (int u = C.blk; u < NB * 128; u += C.G) passd_unit(P, C, l, u); }
            SEAM(g0 + 3); }
        if (PH_EN(5) && RUN(g0 + 4)) {
            DUP(5) { PHASE_BEGIN
            pg8::Gemm g{(const bf16_t*)(C.ws + WS_YMIX), (const bf16_t*)(C.ws + WS_WOUT) + (size_t)l * DM * DM, MTOK, DM, DM}; pg8::StaticOrder S; S.init(MTOK, DM, C.G, C.blk);
            pg8::EpiPlainBf16 E{(bf16_t*)(C.ws + WS_T1), DM};
            pg8::gemm_phase<pg8::EpiPlainBf16, pg8::StaticOrder>(C.lds, g, S, E, nullptr, C.tid); }
            SEAM(g0 + 4); }
        if (PH_EN(6) && RUN(g0 + 5)) { DUP(6) { PHASE_BEGIN ln1_router_phase(P, C, l, (rep_ + 1 < 1 + (((DUPMASK) >> 6) & 1)) ? 512 : 0); } SEAM(g0 + 5); }
        if (PH_EN(7) && RUN(g0 + 6)) { DUP(7) { PHASE_BEGIN permute_phase(P, C, l); } SEAM(g0 + 6); }
        if (PH_EN(8) && RUN(g0 + 7)) {
            DUP(8) { PHASE_BEGIN
            build_tile_e(C, l);
            pg8::Gemm g{(const bf16_t*)(C.ws + WS_HB), (const bf16_t*)(C.ws + WS_WUP) + (size_t)l * NEXP * NUP * DM, POS_MAX, NUP, DM};
            pg8::MoeOrder<8> S{(const LAS int*)(C.lds + TILEE_OFF), C.G, C.blk, (const int*)(C.ws + WS_PTOK)};
            pg8::EpiSwiglu E{(bf16_t*)(C.ws + WS_ACT), P.in[I_EBUP] + (size_t)l * NEXP * NUP};
            pg8::gemm_phase<pg8::EpiSwiglu, pg8::MoeOrder<8>, false, true>(C.lds, g, S, E, nullptr, C.tid); }
            SEAM(g0 + 7); }
        if (PH_EN(9) && RUN(g0 + 8)) {
            DUP(9) { PHASE_BEGIN
            build_tile_e(C, l);
            pg8::Gemm g{(const bf16_t*)(C.ws + WS_ACT), (const bf16_t*)(C.ws + WS_WDN) + (size_t)l * NEXP * DM * DEXP, POS_MAX, DM, DEXP};
            pg8::MoeOrder<4> S{(const LAS int*)(C.lds + TILEE_OFF), C.G, C.blk, nullptr};
            pg8::EpiDown E{(bf16_t*)(C.ws + WS_YB), P.in[I_EBDN] + (size_t)l * NEXP * DM, (const int*)(C.ws + WS_PDEST), (const float*)(C.ws + WS_PGATE)};
            pg8::gemm_phase<pg8::EpiDown, pg8::MoeOrder<4>>(C.lds, g, S, E, nullptr, C.tid); }
            SEAM(g0 + 8); }
        if (PH_EN(10) && RUN(g0 + 9)) { DUP(10) { PHASE_BEGIN combine_ln2_phase(P, C, l); } SEAM(g0 + 9); }
    }
#undef RUN
#undef SEAM
}

#ifndef MK_PER_PHASE
#define MK_PER_PHASE 0
#endif
extern "C" void kernel_launch(void* const* d_in, const int* in_sizes, int n_in, void* d_out, int out_size, void* d_ws, size_t ws_size, hipStream_t stream) {
    static int grid = 0;
    if (grid == 0) {
        if (n_in != 29 || out_size != MTOK * DM || ws_size < WS_END) { fprintf(stderr, "kernel_launch: unexpected shapes (n_in %d out %d ws %zu)\n", n_in, out_size, ws_size); grid = -1; return; }
        int dev = 0, cus = 0;
        if (hipGetDevice(&dev) != hipSuccess || hipDeviceGetAttribute(&cus, hipDeviceAttributeMultiprocessorCount, dev) != hipSuccess) { grid = -1; return; }
        if (hipFuncSetAttribute((const void*)hybrid_fwd, hipFuncAttributeMaxDynamicSharedMemorySize, LDS_BYTES) != hipSuccess) { fprintf(stderr, "kernel_launch: hipFuncSetAttribute failed\n"); grid = -1; return; }
        int per_cu = 0;
        if (hipOccupancyMaxActiveBlocksPerMultiprocessor(&per_cu, (const void*)hybrid_fwd, 512, LDS_BYTES) != hipSuccess || per_cu < 1) { fprintf(stderr, "kernel_launch: occupancy query says %d\n", per_cu); }
        (void)hipGetLastError();
        grid = cus;
    }
    if (grid < 0) return;
    (void)hipMemsetAsync((char*)d_ws + WS_CTL, 0, CTL_ZERO_BYTES, stream);
    Params p; memset(&p, 0, sizeof(p));
    for (int i = 0; i < 29; ++i) p.in[i] = (const float*)d_in[i];
    p.out = (float*)d_out; p.ws = (unsigned char*)d_ws;
#if MK_PER_PHASE
    for (int ph = 0; ph < NPHASE_TOTAL; ++ph) { p.ph_lo = ph; p.ph_hi = ph + 1; hipLaunchKernelGGL(hybrid_fwd, dim3(grid), dim3(512), LDS_BYTES, stream, p); }
#else
    p.ph_lo = 0; p.ph_hi = NPHASE_TOTAL;
    hipLaunchKernelGGL(hybrid_fwd, dim3(grid), dim3(512), LDS_BYTES, stream, p);
#endif
}
```

```cpp
#include <hip/hip_runtime.h>
#include <cstdio>
#include <cstdint>
#include <cstring>

#define GAS __attribute__((address_space(1)))
#define LAS __attribute__((address_space(3)))
typedef float f32x2 __attribute__((ext_vector_type(2)));
typedef unsigned u32x2 __attribute__((ext_vector_type(2)));

namespace pg8 {
constexpr int EPI_BTAB = 140288, EPI_DTAB = 138240, EPI_GTAB = 139264;
#define PG8_LAS __attribute__((address_space(3)))
typedef unsigned short bf16_t;
typedef short bf16x8 __attribute__((ext_vector_type(8)));
typedef float f32x4 __attribute__((ext_vector_type(4)));
typedef unsigned u32x4 __attribute__((ext_vector_type(4)));
constexpr int BM = 256, BK = 64, HALF = 128, HTB = HALF * BK * 2  , STAGE_BYTES = 8 * HTB, NXCD = 8, WGM = 8;

__host__ __device__ __forceinline__ int lds_byte(int r, int c) { const int st = (r >> 4) * 2 + (c >> 5), rr = r & 15, cc = c & 31, ob = rr * 64 + cc * 2; return st * 1024 + (ob ^ (((ob >> 9) & 1) << 5)); }
__host__ __device__ __forceinline__ void stage_rc(int b, int& R, int& C) { const int st = b / 1024, sb = b % 1024, swz = sb ^ (((sb >> 9) & 1) << 5); R = (st >> 1) * 16 + swz / 64; C = (st & 1) * 32 + (swz % 64) / 2; }
__host__ __device__ __forceinline__ int perm32(int rho) { const int n = rho >> 4, i = rho & 15; return 8 * (i >> 2) + 4 * n + (i & 3); }

struct Unit { int pm, pn; };
struct Gemm { const bf16_t* A; const bf16_t* Bt; int M, N, K; };

struct StaticOrder {
    int nM, nN, nwg, G, c;
    __host__ __device__ void init(int M, int N, int G_, int c_) { nM = M / BM; nN = N / BM; nwg = nM * nN; G = G_; c = c_; }
    __host__ __device__ bool next(int i, Unit& u) const {
        const long L = (long)i * G + c; if (L >= nwg) return false;
        int wgid = (int)L; { const int q = nwg / NXCD, r = nwg % NXCD, xcd = wgid % NXCD, off = wgid / NXCD; wgid = (xcd < r ? xcd * (q + 1) : r * (q + 1) + (xcd - r) * q) + off; }
        const int nig = WGM * nN, gid = wgid / nig, fm = gid * WGM, gsz = (nM - fm) < WGM ? (nM - fm) : WGM;
        u.pm = fm + ((wgid % nig) % gsz); u.pn = (wgid % nig) / gsz; return true;
    }
    __device__ __forceinline__ void a_ready(const Unit&) const {}
    __device__ __forceinline__ void done(const Unit&) const {}
};
template <int NN> struct MoeOrder {
    const PG8_LAS int* tile_e; int G, c; const int* rowtok;
    __device__ __forceinline__ bool next(int i, Unit& u) const {
        const int s = i * G + c; if (s >= 544 * NN) return false;
        constexpr int per = 8 * NN; const int a = s / per, r = s % per, b = r >> 3, x = r & 7;
        const int pm = 68 * x + a; u.pm = pm; u.pn = tile_e[pm] * NN + b; return true;
    }
    __device__ __forceinline__ void a_ready(const Unit&) const {}
    __device__ __forceinline__ void done(const Unit&) const {}
};

__device__ __forceinline__ unsigned cvt_pk_bf16(float lo, float hi) { unsigned r; asm volatile("v_cvt_pk_bf16_f32 %0, %1, %2" : "=v"(r) : "v"(lo), "v"(hi)); return r; }

struct EpiBf16b {
    static constexpr bool PERM = true, AFTER_DRAIN = false;
    bf16_t* O; int ldc; const float* bias;
    __device__ __forceinline__ void prefetch(PG8_LAS unsigned char* lds, const Unit& u, int wid, int lane) const {
        if (wid < 4) __builtin_amdgcn_global_load_lds((const unsigned*)(bias + u.pn * BM + 64 * wid + lane), (PG8_LAS unsigned*)(lds + EPI_BTAB + wid * 256), 4, 0, 0); }
    __device__ __forceinline__ void operator()(const f32x4 (&acc)[2][2][4][2], const Unit& u, int wr, int wc, int fr, int fq, PG8_LAS unsigned char* lds) const {
        const int row0 = u.pm * BM + wr * 64 + fr; const int col0 = u.pn * BM + wc * 32 + 8 * fq;
        const PG8_LAS float* bt = (const PG8_LAS float*)(lds + EPI_BTAB) + wc * 32 + 8 * fq;
        f32x4 bv[2][2];
#pragma unroll
        for (int bj = 0; bj < 2; ++bj)
#pragma unroll
            for (int n = 0; n < 2; ++n) bv[bj][n] = *(const PG8_LAS f32x4*)(bt + bj * HALF + 4 * n);
#pragma unroll
        for (int ai = 0; ai < 2; ++ai)
#pragma unroll
            for (int m = 0; m < 4; ++m) { bf16_t* rowp = O + (size_t)(row0 + ai * HALF + m * 16) * ldc + col0;
#pragma unroll
                for (int bj = 0; bj < 2; ++bj) { const f32x4 v0 = acc[ai][bj][m][0] + bv[bj][0], v1 = acc[ai][bj][m][1] + bv[bj][1];
                    u32x4 w; w.x = cvt_pk_bf16(v0[0], v0[1]); w.y = cvt_pk_bf16(v0[2], v0[3]); w.z = cvt_pk_bf16(v1[0], v1[1]); w.w = cvt_pk_bf16(v1[2], v1[3]);
                    *(u32x4*)(rowp + bj * HALF) = w; } }
    }
};
struct EpiPlainBf16 {
    static constexpr bool PERM = true, AFTER_DRAIN = false;
    bf16_t* O; int ldc;
    __device__ __forceinline__ void prefetch(PG8_LAS unsigned char*, const Unit&, int, int) const {}
    __device__ __forceinline__ void operator()(const f32x4 (&acc)[2][2][4][2], const Unit& u, int wr, int wc, int fr, int fq, PG8_LAS unsigned char*) const {
        const int row0 = u.pm * BM + wr * 64 + fr, col0 = u.pn * BM + wc * 32 + 8 * fq;
#pragma unroll
        for (int ai = 0; ai < 2; ++ai)
#pragma unroll
            for (int m = 0; m < 4; ++m) { bf16_t* rowp = O + (size_t)(row0 + ai * HALF + m * 16) * ldc + col0;
#pragma unroll
                for (int bj = 0; bj < 2; ++bj) { const f32x4 v0 = acc[ai][bj][m][0], v1 = acc[ai][bj][m][1];
                    u32x4 w; w.x = cvt_pk_bf16(v0[0], v0[1]); w.y = cvt_pk_bf16(v0[2], v0[3]); w.z = cvt_pk_bf16(v1[0], v1[1]); w.w = cvt_pk_bf16(v1[2], v1[3]);
                    *(u32x4*)(rowp + bj * HALF) = w; } }
    }
};
struct EpiSwiglu {
    static constexpr bool PERM = true, AFTER_DRAIN = false;
    bf16_t* O; const float* bias;
    __device__ __forceinline__ void prefetch(PG8_LAS unsigned char* lds, const Unit& u, int wid, int lane) const {
        if (wid < 4) __builtin_amdgcn_global_load_lds((const unsigned*)(bias + u.pn * BM + 64 * wid + lane), (PG8_LAS unsigned*)(lds + EPI_BTAB + wid * 256), 4, 0, 0); }
    __device__ __forceinline__ void operator()(const f32x4 (&acc)[2][2][4][2], const Unit& u, int wr, int wc, int fr, int fq, PG8_LAS unsigned char* lds) const {
        const int row0 = u.pm * BM + wr * 64 + fr;
        const int ocol0 = ((u.pn & 7) * BM + wc * 32 + 8 * fq) >> 1;
        const PG8_LAS float* bt = (const PG8_LAS float*)(lds + EPI_BTAB) + wc * 32 + 8 * fq;
        f32x4 bv[2][2];
#pragma unroll
        for (int bj = 0; bj < 2; ++bj)
#pragma unroll
            for (int n = 0; n < 2; ++n) bv[bj][n] = *(const PG8_LAS f32x4*)(bt + bj * HALF + 4 * n);
        const bool oddrow = (fq & 1) != 0;
#pragma unroll
        for (int ai = 0; ai < 2; ++ai)
#pragma unroll
            for (int m = 0; m < 4; ++m) { bf16_t* rowp = O + (size_t)(row0 + ai * HALF + m * 16) * 1024 + ocol0;
                u32x2 w[2];
#pragma unroll
                for (int bj = 0; bj < 2; ++bj) { const f32x4 v0 = acc[ai][bj][m][0] + bv[bj][0], v1 = acc[ai][bj][m][1] + bv[bj][1];
                    float o[4];
#pragma unroll
                    for (int q = 0; q < 4; ++q) { const float gl = (q < 2) ? v0[2 * q] : v1[2 * q - 4], li = (q < 2) ? v0[2 * q + 1] : v1[2 * q - 3];
                        const float hg = fminf(gl, 7.0f), hl = fminf(fmaxf(li, -7.0f), 7.0f);
                        o[q] = hg * (hl + 1.0f) * __builtin_amdgcn_rcpf(1.0f + __expf(-1.702f * hg)); }
                    w[bj].x = cvt_pk_bf16(o[0], o[1]); w[bj].y = cvt_pk_bf16(o[2], o[3]); }
                { auto sx = __builtin_amdgcn_permlane16_swap(w[0].x, w[1].x, false, false); w[0].x = sx[0]; w[1].x = sx[1];
                  auto sy = __builtin_amdgcn_permlane16_swap(w[0].y, w[1].y, false, false); w[0].y = sy[0]; w[1].y = sy[1]; }
                u32x4 wv; wv.x = w[0].x; wv.y = w[0].y; wv.z = w[1].x; wv.w = w[1].y;
                *(u32x4*)(rowp + (oddrow ? (HALF / 2) - 4 : 0)) = wv; }
    }
};
struct EpiDown {
    static constexpr bool PERM = true, AFTER_DRAIN = false;
    bf16_t* O; const float* bias; const int* dest; const float* gate;
    __device__ __forceinline__ void prefetch(PG8_LAS unsigned char* lds, const Unit& u, int wid, int lane) const {
        if (wid < 4) { __builtin_amdgcn_global_load_lds((const unsigned*)(bias + u.pn * BM + 64 * wid + lane), (PG8_LAS unsigned*)(lds + EPI_BTAB + wid * 256), 4, 0, 0);
                       __builtin_amdgcn_global_load_lds((const unsigned*)(dest + u.pm * BM + 64 * wid + lane), (PG8_LAS unsigned*)(lds + EPI_DTAB + wid * 256), 4, 0, 0); }
        else __builtin_amdgcn_global_load_lds((const unsigned*)(gate + u.pm * BM + 64 * (wid - 4) + lane), (PG8_LAS unsigned*)(lds + EPI_GTAB + (wid - 4) * 256), 4, 0, 0); }
    __device__ __forceinline__ void operator()(const f32x4 (&acc)[2][2][4][2], const Unit& u, int wr, int wc, int fr, int fq, PG8_LAS unsigned char* lds) const {
        const int rloc = wr * 64 + fr;
        const int ocol0 = (u.pn & 3) * BM + wc * 32 + 8 * fq;
        const PG8_LAS float* bt = (const PG8_LAS float*)(lds + EPI_BTAB) + wc * 32 + 8 * fq; const PG8_LAS int* dt = (const PG8_LAS int*)(lds + EPI_DTAB); const PG8_LAS float* gtb = (const PG8_LAS float*)(lds + EPI_GTAB);
#pragma unroll
        for (int ai = 0; ai < 2; ++ai)
#pragma unroll
            for (int m = 0; m < 4; ++m) { const int pl = rloc + ai * HALF + m * 16; const int d = dt[pl]; const float gt = gtb[pl];
                if (d >= 0) { bf16_t* rowp = O + (size_t)d * 1024 + ocol0;
#pragma unroll
                    for (int bj = 0; bj < 2; ++bj) { const f32x4 b0 = *(const PG8_LAS f32x4*)(bt + bj * HALF), b1 = *(const PG8_LAS f32x4*)(bt + bj * HALF + 4); const f32x4 v0 = (acc[ai][bj][m][0] + b0) * gt, v1 = (acc[ai][bj][m][1] + b1) * gt;
                        u32x4 w; w.x = cvt_pk_bf16(v0[0], v0[1]); w.y = cvt_pk_bf16(v0[2], v0[3]); w.z = cvt_pk_bf16(v1[0], v1[1]); w.w = cvt_pk_bf16(v1[2], v1[3]);
                        *(u32x4*)(rowp + bj * HALF) = w; } } }
    }
};

template <class Epi, class Sched, bool STAMP = false, bool GATHER = false>
__device__ __forceinline__ void gemm_phase(PG8_LAS unsigned char* lds, const Gemm g, const Sched& S, const Epi& E, unsigned long long* stamps, const int tid_in) {
    const int tid = tid_in, wid = __builtin_amdgcn_readfirstlane(tid >> 6), lane = tid & 63, wr = wid >> 2, wc = wid & 3, fr = lane & 15, fq = lane >> 4;
    const int K = g.K, nt = K / BK;
    int ts_lo = 0, ts_hi = 0, nts = 0; const unsigned long long rt_entry = STAMP ? (unsigned long long)wall_clock64() : 0ull;
#define PG8_STAMP() do { if (STAMP && wid == 0 && nts < 64) { const unsigned long long _c = (unsigned long long)clock64(); \
        ts_lo = (lane == nts) ? (int)(unsigned)_c : ts_lo; ts_hi = (lane == nts) ? (int)(unsigned)(_c >> 32) : ts_hi; ++nts; } } while (0)
    PG8_STAMP();
    unsigned voffA[2], voffB[2];
#pragma unroll
    for (int i = 0; i < 2; ++i) { int R, C; stage_rc(tid * 16 + i * 8192, R, C); const int Rb = Epi::PERM ? ((R & ~31) + perm32(R & 31)) : R;
        voffA[i] = (unsigned)(R * K + C) * 2u; voffB[i] = (unsigned)(Rb * K + C) * 2u; }
    unsigned gc[2][2], gn[2][2];
    PG8_LAS int* rowtab = (PG8_LAS int*)(lds + 137216);
    const size_t kstep = (size_t)(BK * 2);
    const size_t hstep = (size_t)HALF * K * 2;
    const size_t tstep = 2 * hstep;
    const unsigned ldsw = (unsigned)wid * 1024u;
    const int aoff = lds_byte(wr * 64 + fr, fq * 8), boff = lds_byte(wc * 32 + fr, fq * 8);
#define PG8_SA(b, h) (((b) * 2 + (h)) * HTB)
#define PG8_SB(b, h) ((4 + (b) * 2 + (h)) * HTB)
#define PG8_STAGE(bufoff, gbase, voff) do { _Pragma("unroll") for (int _i = 0; _i < 2; ++_i) \
        __builtin_amdgcn_global_load_lds((const unsigned*)((const char*)(gbase) + (voff)[_i]), (PG8_LAS unsigned*)(lds + (bufoff) + ldsw + _i * 8192), 16, 0, 0); } while (0)
#define PG8_LDA(dst, b, h) do { _Pragma("unroll") for (int m = 0; m < 4; ++m) _Pragma("unroll") for (int k = 0; k < 2; ++k) dst[m][k] = *(const PG8_LAS bf16x8*)(lds + PG8_SA(b, h) + aoff + m * 2048 + k * 1024); } while (0)
#define PG8_LDB(dst, b, h) do { _Pragma("unroll") for (int n = 0; n < 2; ++n) _Pragma("unroll") for (int k = 0; k < 2; ++k) dst[n][k] = *(const PG8_LAS bf16x8*)(lds + PG8_SB(b, h) + boff + n * 2048 + k * 1024); } while (0)
#define PG8_MMA(ai, bj, At, Bt) do { __builtin_amdgcn_s_setprio(1); _Pragma("unroll") for (int m = 0; m < 4; ++m) _Pragma("unroll") for (int n = 0; n < 2; ++n) _Pragma("unroll") for (int k = 0; k < 2; ++k) \
        acc[ai][bj][m][n] = __builtin_amdgcn_mfma_f32_16x16x32_bf16(Bt[n][k], At[m][k], acc[ai][bj][m][n], 0, 0, 0); __builtin_amdgcn_s_setprio(0); } while (0)
#define PG8_WAIT_V(n) asm volatile("s_waitcnt vmcnt(" #n ")" ::: "memory")
#define PG8_WAIT_L(n) asm volatile("s_waitcnt lgkmcnt(" #n ")" ::: "memory")
#define PG8_BAR __builtin_amdgcn_s_barrier()
#define PG8_SCHED __builtin_amdgcn_sched_barrier(0)
    Unit cur, nxt; int ui = 0;
    if (!S.next(0, cur)) return;
    f32x4 acc[2][2][4][2];
#pragma unroll
    for (int a = 0; a < 2; ++a)
#pragma unroll
        for (int b = 0; b < 2; ++b)
#pragma unroll
            for (int m = 0; m < 4; ++m)
#pragma unroll
                for (int n = 0; n < 2; ++n) acc[a][b][m][n] = (f32x4){0.f, 0.f, 0.f, 0.f};
    bf16x8 At[4][2], B0[2][2], B1[2][2];
    const char* cA = GATHER ? (const char*)g.A : (const char*)g.A + (size_t)cur.pm * tstep; const char* cB = (const char*)g.Bt + (size_t)cur.pn * tstep;
    if constexpr (GATHER) {
#pragma unroll
        for (int h = 0; h < 2; ++h)
#pragma unroll
            for (int i = 0; i < 2; ++i) { int R, C; stage_rc(tid * 16 + i * 8192, R, C); gc[h][i] = (unsigned)S.rowtok[256 * cur.pm + 128 * h + R] * (unsigned)(K * 2) + (unsigned)(C * 2); gn[h][i] = gc[h][i]; } }
    S.a_ready(cur);
    PG8_STAGE(PG8_SB(0, 0), cB, voffB); if constexpr (GATHER) PG8_STAGE(PG8_SA(0, 0), cA, gc[0]); else PG8_STAGE(PG8_SA(0, 0), cA, voffA); PG8_STAGE(PG8_SB(0, 1), cB + hstep, voffB); if constexpr (GATHER) PG8_STAGE(PG8_SA(0, 1), cA, gc[1]); else PG8_STAGE(PG8_SA(0, 1), cA + hstep, voffA);
    if (wr == 1) PG8_BAR;
    PG8_WAIT_V(4); PG8_BAR;
    PG8_STAGE(PG8_SB(1, 0), cB + kstep, voffB); if constexpr (GATHER) PG8_STAGE(PG8_SA(1, 0), cA + kstep, gc[0]); else PG8_STAGE(PG8_SA(1, 0), cA + kstep, voffA); PG8_STAGE(PG8_SB(1, 1), cB + hstep + kstep, voffB);
    PG8_WAIT_V(6); PG8_BAR;
    PG8_STAMP();
    for (;;) {
        const bool has_next = S.next(ui + 1, nxt);
        const char* nA = GATHER ? cA : (has_next ? (const char*)g.A + (size_t)nxt.pm * tstep : cA); const char* nB = has_next ? (const char*)g.Bt + (size_t)nxt.pn * tstep : cB;
        for (int t = 0; t < nt; t += 2) {
            const bool last = (t == nt - 2);
            const char* a1 = cA + (size_t)(t + 1) * kstep;
            const char* a2 = last ? nA : cA + (size_t)(t + 2) * kstep; const char* b2 = last ? nB : cB + (size_t)(t + 2) * kstep;
            const char* a3 = a2 + kstep; const char* b3 = b2 + kstep;
            if (last && has_next) S.a_ready(nxt);
            if (t == nt - 4) { int ln_ = lane; asm volatile("" : "+v"(ln_)); E.prefetch(lds, cur, wid, ln_); }
            if constexpr (GATHER) {
                if (t == nt - 4 && has_next && wid < 4)
                    __builtin_amdgcn_global_load_lds((const unsigned*)(S.rowtok + 256 * nxt.pm + 64 * wid + lane), (PG8_LAS unsigned*)((PG8_LAS unsigned char*)rowtab + wid * 256), 4, 0, 0);
                if (last && has_next) { int tz = tid; asm volatile("" : "+v"(tz));
#pragma unroll
                    for (int h = 0; h < 2; ++h)
#pragma unroll
                        for (int i = 0; i < 2; ++i) { int R, C; stage_rc(tz * 16 + i * 8192, R, C); gn[h][i] = (unsigned)rowtab[128 * h + R] * (unsigned)(K * 2) + (unsigned)(C * 2); } } }
            unsigned g0x[2], g1x[2];
#pragma unroll
            for (int i = 0; i < 2; ++i) { g0x[i] = last ? gn[0][i] : gc[0][i]; g1x[i] = last ? gn[1][i] : gc[1][i]; }
            PG8_LDB(B0, 0, 0); PG8_SCHED; PG8_LDA(At, 0, 0); if constexpr (GATHER) PG8_STAGE(PG8_SA(1, 1), a1, gc[1]); else PG8_STAGE(PG8_SA(1, 1), a1 + hstep, voffA);
            PG8_WAIT_L(8); PG8_BAR; PG8_WAIT_L(0); PG8_MMA(0, 0, At, B0); PG8_BAR; PG8_SCHED;
            PG8_LDB(B1, 0, 1); PG8_STAGE(PG8_SB(0, 0), b2, voffB);
            PG8_BAR; PG8_WAIT_L(0); PG8_MMA(0, 1, At, B1); PG8_BAR;
            PG8_LDA(At, 0, 1); if constexpr (GATHER) PG8_STAGE(PG8_SA(0, 0), a2, g0x); else PG8_STAGE(PG8_SA(0, 0), a2, voffA);
            PG8_BAR; PG8_WAIT_L(0); PG8_MMA(1, 0, At, B0); PG8_BAR; PG8_SCHED;
            PG8_STAGE(PG8_SB(0, 1), b2 + hstep, voffB);
            PG8_WAIT_V(6); PG8_BAR; PG8_MMA(1, 1, At, B1); PG8_BAR;
            PG8_LDB(B0, 1, 0); PG8_SCHED; PG8_LDA(At, 1, 0); if constexpr (GATHER) PG8_STAGE(PG8_SA(0, 1), a2, g1x); else PG8_STAGE(PG8_SA(0, 1), a2 + hstep, voffA);
            PG8_WAIT_L(8); PG8_BAR; PG8_WAIT_L(0); PG8_MMA(0, 0, At, B0); PG8_BAR; PG8_SCHED;
            PG8_LDB(B1, 1, 1); PG8_STAGE(PG8_SB(1, 0), b3, voffB);
            PG8_BAR; PG8_WAIT_L(0); PG8_MMA(0, 1, At, B1); PG8_BAR;
            PG8_LDA(At, 1, 1); if constexpr (GATHER) PG8_STAGE(PG8_SA(1, 0), a3, g0x); else PG8_STAGE(PG8_SA(1, 0), a3, voffA);
            PG8_BAR; PG8_WAIT_L(0); PG8_MMA(1, 0, At, B0); PG8_BAR; PG8_SCHED;
            PG8_STAGE(PG8_SB(1, 1), b3 + hstep, voffB);
            PG8_WAIT_V(6); PG8_BAR; PG8_MMA(1, 1, At, B1); PG8_BAR;
        }
        PG8_STAMP();
        if constexpr (!Epi::AFTER_DRAIN) { E(acc, cur, wr, wc, fr, fq, lds); S.done(cur); }
        PG8_STAMP();
        if (!has_next) break;
#pragma unroll
        for (int a = 0; a < 2; ++a)
#pragma unroll
            for (int b = 0; b < 2; ++b)
#pragma unroll
                for (int m = 0; m < 4; ++m)
#pragma unroll
                    for (int n = 0; n < 2; ++n) acc[a][b][m][n] = (f32x4){0.f, 0.f, 0.f, 0.f};
        cur = nxt; cA = nA; cB = nB; ++ui;
        if constexpr (GATHER) {
#pragma unroll
            for (int h = 0; h < 2; ++h)
#pragma unroll
                for (int i = 0; i < 2; ++i) gc[h][i] = gn[h][i]; }
    }
    PG8_WAIT_V(0);
    if (wr == 0) PG8_BAR;
    PG8_BAR;
    if constexpr (Epi::AFTER_DRAIN) { E.fused(acc, cur, wr, wc, fr, fq, lds, wid, lane); S.done(cur); }
    PG8_STAMP();
    if (STAMP && wid == 0) { stamps[lane] = lane < nts ? (((unsigned long long)(unsigned)ts_hi << 32) | (unsigned)ts_lo) : 0ull;
        if (lane == 62) stamps[62] = rt_entry; if (lane == 63) stamps[63] = (unsigned long long)wall_clock64(); }
#undef PG8_STAMP
#undef PG8_SA
#undef PG8_SB
#undef PG8_STAGE
#undef PG8_LDA
#undef PG8_LDB
#undef PG8_MMA
#undef PG8_WAIT_V
#undef PG8_WAIT_L
#undef PG8_BAR
#undef PG8_SCHED
}
}
using pg8::bf16_t; using pg8::bf16x8; using pg8::f32x4; using pg8::u32x4;

constexpr int NB = 4, SEQ = 8192, MTOK = NB * SEQ, DM = 1024, NLAYER = 4, CIN = 3080, NPROJ = 3072, NEXP = 32, DEXP = 1024, NUP = 2048;
constexpr int RWD = 384, RW_COLS = 1408;
constexpr int NT_MAX = 544, POS_MAX = NT_MAX * 256;
constexpr float DN_ALPHA = 1.6817928305074290861f;
constexpr float LN_EPS = 1e-5f;
constexpr int NPH = 10;
constexpr int NPHASE_TOTAL = 1 + NLAYER * NPH;

constexpr size_t MiB = 1u << 20;
constexpr size_t WS_CTL = 0, CTL_ZERO_BYTES = 65536;
constexpr size_t WS_WIN = 1 * MiB;
constexpr size_t WS_WOUT = 25 * MiB;
constexpr size_t WS_WUP = 33 * MiB;
constexpr size_t WS_WDN = 545 * MiB;
constexpr size_t WS_ROPE = 801 * MiB;
constexpr size_t WS_HB = 803 * MiB;
constexpr size_t WS_HF = 867 * MiB;
constexpr size_t WS_H1F = 995 * MiB;
constexpr size_t WS_T1 = 1123 * MiB;
constexpr size_t WS_P = 1251 * MiB;
constexpr size_t WS_PG = 1443 * MiB;
constexpr size_t WS_YMIX = 1444 * MiB;
constexpr size_t WS_RWM = 1508 * MiB;
constexpr size_t WS_RWNT = 1532 * MiB;
constexpr size_t WS_RWQH = 1580 * MiB;
constexpr size_t WS_RWYL = 1604 * MiB;
constexpr size_t WS_RWS = 1652 * MiB;
constexpr size_t WS_RWAUX = 1676 * MiB;
constexpr size_t WS_MLQ = 1724 * MiB;
constexpr size_t WS_MLNL = 1740 * MiB;
constexpr size_t WS_MLVEC = 1780 * MiB;
constexpr size_t WS_MLSC = 1781 * MiB;
constexpr size_t WS_MLKL = 1782 * MiB;
constexpr size_t WS_MLCT = 1822 * MiB;
constexpr size_t WS_MLM = 1842 * MiB;
constexpr size_t WS_WUPT = 1843 * MiB;
constexpr size_t WS_AUPT = 1843 * MiB + 256 * 1024;
constexpr size_t WS_GUPT = 1843 * MiB + 512 * 1024;
constexpr size_t WS_LISCR = 1845 * MiB;
constexpr size_t WS_WRH = 1844 * MiB;
constexpr size_t WS_WRL = 1844 * MiB + 256 * 1024;
constexpr size_t WS_XPERM = 2021 * MiB;
constexpr size_t WS_ACT = 2293 * MiB;
constexpr size_t WS_YB = 2565 * MiB;
constexpr size_t WS_TOKE = 2821 * MiB;
constexpr size_t WS_TOKG = 2822 * MiB;
constexpr size_t WS_TOKLR = 2823 * MiB;
constexpr size_t WS_PDEST = 2824 * MiB;
constexpr size_t WS_PGATE = 2825 * MiB;
constexpr size_t WS_BBASE = 2826 * MiB;
constexpr size_t WS_PTOK = 2827 * MiB;
constexpr size_t WS_END = 2828 * MiB;
constexpr int CW_CNT = 1024;
constexpr int CW_SWAQ = 2048;
constexpr int CW_BAR = 4096;
constexpr int LDS_BYTES = 147456;
constexpr int MISC_OFF = 143360;
constexpr int TILEE_OFF = 133120;

#define LDS_WAIT() asm volatile("s_waitcnt lgkmcnt(0)" ::: "memory")
#define LDS_BARRIER() do { asm volatile("s_waitcnt lgkmcnt(0)" ::: "memory"); __builtin_amdgcn_s_barrier(); asm volatile("" ::: "memory"); } while (0)
#define VM_WAIT() asm volatile("s_waitcnt vmcnt(0)" ::: "memory")
__device__ __forceinline__ unsigned f2bf(float f) { unsigned u = __builtin_bit_cast(unsigned, f); return (u + 0x7fffu + ((u >> 16) & 1u)) >> 16; }
typedef __bf16 bf16v2_t __attribute__((ext_vector_type(2)));
__device__ __forceinline__ unsigned pk2(float lo, float hi) { const f32x2 v = (f32x2){lo, hi}; return __builtin_bit_cast(unsigned, __builtin_convertvector(v, bf16v2_t)); }
__device__ __forceinline__ float bf2f(unsigned short b) { return __builtin_bit_cast(float, ((unsigned)b) << 16); }
__device__ __forceinline__ float bflo(unsigned w) { return __builtin_bit_cast(float, w << 16); }
__device__ __forceinline__ float bfhi(unsigned w) { return __builtin_bit_cast(float, w & 0xffff0000u); }
template <int CTRL, int RMASK> __device__ __forceinline__ float dpp_add(float v) { return v + __builtin_bit_cast(float, __builtin_amdgcn_update_dpp(0, __builtin_bit_cast(int, v), CTRL, RMASK, 0xF, false)); }
__device__ __forceinline__ float wave_sum(float v) {
    v = dpp_add<0xB1, 0xF>(v); v = dpp_add<0x4E, 0xF>(v); v = dpp_add<0x141, 0xF>(v); v = dpp_add<0x140, 0xF>(v);
    v = dpp_add<0x142, 0xA>(v); v = dpp_add<0x143, 0xC>(v);
    return __builtin_bit_cast(float, __builtin_amdgcn_readlane(__builtin_bit_cast(int, v), 63));
}
template <int CTRL> __device__ __forceinline__ float dpp_mov(float x) { return __builtin_bit_cast(float, __builtin_amdgcn_update_dpp(0, __builtin_bit_cast(int, x), CTRL, 0xF, 0xF, true)); }
__device__ __forceinline__ float sum8(float x) { x += dpp_mov<0xB1>(x); x += dpp_mov<0x4E>(x); x += dpp_mov<0x141>(x); return x; }
__device__ __forceinline__ float sigmoidf_(float x) { return __builtin_amdgcn_rcpf(1.0f + __expf(-x)); }

#define XB_TMO      128
#define XB_XCNT(j)  (256  + 64 * (j))
#define XB_XSUB(j)  (1280 + 64 * (j))
#define XB_XGEN(j)  (2304 + 64 * (j))
#define XB_TOP      3328
#define XB_TOPGEN   3392
#define XCD_BAR_WORDS 3456
#define XB_SPIN_CAP (1u << 22)
__device__ __forceinline__ unsigned xb_ld(unsigned* p)              { return __hip_atomic_load(p, __ATOMIC_RELAXED, __HIP_MEMORY_SCOPE_AGENT); }
__device__ __forceinline__ unsigned xb_add(unsigned* p, unsigned v) { return __hip_atomic_fetch_add(p, v, __ATOMIC_RELAXED, __HIP_MEMORY_SCOPE_AGENT); }
__device__ __forceinline__ unsigned xb_xcc_id() { return (unsigned)__builtin_amdgcn_s_getreg((3 << 11) | 20) & 0xFu; }
#define XB_SPIN(cond, bar) do { unsigned _sp = 0; while (cond) { __builtin_amdgcn_s_sleep(1); \
    if ((++_sp & 255u) == 0u) { if (xb_ld(&(bar)[XB_TMO])) break; if (_sp > XB_SPIN_CAP) { atomicAdd(&(bar)[XB_TMO], 1u); break; } } } } while (0)

struct XcdBarrier {
    unsigned* bar; unsigned x;
    volatile LAS unsigned* st;
};

__device__ __forceinline__ XcdBarrier xcd_barrier_post(unsigned* bar, volatile LAS unsigned* st, bool t0  ) {
    XcdBarrier b; b.bar = bar; b.x = xb_xcc_id(); b.st = st;
    if (t0) (void)xb_add(&bar[XB_XCNT(b.x)], 1u);
    return b;
}
__device__ __forceinline__ void xcd_barrier_complete(unsigned* bar, unsigned x, unsigned& nloc, unsigned& nx) {
    const unsigned G = gridDim.x * gridDim.y * gridDim.z;
    unsigned sum, cnt, mine, sp = 0u;
    for (;;) {
        sum = 0u; cnt = 0u; mine = 0u;
#pragma unroll
        for (unsigned j = 0; j < 16; ++j) { const unsigned c = xb_ld(&bar[XB_XCNT(j)]); sum += c; cnt += (c > 0u) ? 1u : 0u; mine = (j == x) ? c : mine; }
        if (sum == G) break;
        __builtin_amdgcn_s_sleep(1);
        if ((++sp & 255u) == 0u) { if (xb_ld(&bar[XB_TMO])) break; if (sp > XB_SPIN_CAP) { atomicAdd(&bar[XB_TMO], 1u); break; } }
    }
    nloc = mine > 0u ? mine : 1u; nx = cnt > 0u ? cnt : 1u;
}

__device__ __forceinline__ void xcd_barrier(const XcdBarrier& b, bool t0  ) {
    asm volatile("s_waitcnt vmcnt(0)" ::: "memory");
    __syncthreads();
    if (t0) {
        unsigned* bar = b.bar;
        __builtin_amdgcn_s_waitcnt(0);
        unsigned nloc = b.st[0], nx = b.st[1];
        if (nloc == 0u) { xcd_barrier_complete(bar, b.x, nloc, nx); b.st[0] = nloc; b.st[1] = nx; }
        const unsigned old = xb_add(&bar[XB_XSUB(b.x)], 1u);
        const unsigned gen = old / nloc;
        if (old + 1u == (gen + 1u) * nloc) {
            __builtin_amdgcn_fence(__ATOMIC_RELEASE, "agent");
            asm volatile("s_waitcnt vmcnt(0)" ::: "memory");
            const unsigned og = xb_add(&bar[XB_TOP], 1u);
            const unsigned tg = og / nx;
            if (og + 1u == (tg + 1u) * nx) xb_add(&bar[XB_TOPGEN], 1u);
            else XB_SPIN(xb_ld(&bar[XB_TOPGEN]) == tg, bar);
            __builtin_amdgcn_fence(__ATOMIC_ACQUIRE, "agent");
            xb_add(&bar[XB_XGEN(b.x)], 1u);
            asm volatile("s_waitcnt vmcnt(0)" ::: "memory");
        } else {
            XB_SPIN(xb_ld(&bar[XB_XGEN(b.x)]) == gen, bar);
            __builtin_amdgcn_fence(__ATOMIC_ACQUIRE, "agent");
            asm volatile("s_waitcnt vmcnt(0)" ::: "memory");
        }
    }
    __syncthreads();
}
struct Params {
    const float* in[29];
    float* out; unsigned char* ws;
    int ph_lo, ph_hi;
    int pad0, pad1;
};
enum { I_X = 0, I_WIN, I_BIN, I_MU, I_WUP, I_W0, I_AUP, I_A0, I_GUP, I_KK, I_KA, I_RK, I_LNW, I_LNB, I_SINK, I_CONVW, I_CONVB, I_MLNW, I_WOUT,
       I_LN1W, I_LN1B, I_RW, I_RB, I_EWUP, I_EBUP, I_EWDN, I_EBDN, I_LN2W, I_LN2B };

struct Ctx {
    LAS unsigned char* lds; int tid, lane, wave, blk, G;
    unsigned char* ws;
};

__device__ __forceinline__ void tr_item(const float* W, int ldw, int K, bf16_t* WT, LAS float* scr, int kb, int nb, int lane) {
    const int k0 = 64 * kb, n0 = 32 * nb;
#pragma unroll 8
    for (int i = 0; i < 32; ++i) { const int kk = 2 * i + (lane >> 5); scr[kk * 33 + (lane & 31)] = W[(size_t)(k0 + kk) * ldw + n0 + (lane & 31)]; }
    LDS_WAIT();
    const int c = lane & 7;
#pragma unroll
    for (int j = 0; j < 4; ++j) { const int n = (lane >> 3) + 8 * j; const LAS float* s = scr + (8 * c) * 33 + n;
        u32x4 o; o.x = pk2(s[0 * 33], s[1 * 33]); o.y = pk2(s[2 * 33], s[3 * 33]); o.z = pk2(s[4 * 33], s[5 * 33]); o.w = pk2(s[6 * 33], s[7 * 33]);
        *(u32x4*)(WT + (size_t)(n0 + n) * K + k0 + 8 * c) = o; }
    LDS_WAIT();
}
__device__ __forceinline__ void gate_cols(const f32x4 (&v)[4], const LAS float* tab, const float* bg, float* pgrow, int lane) {
    float acc[8];
#pragma unroll
    for (int c = 0; c < 8; ++c) acc[c] = 0.f;
#pragma unroll
    for (int j = 0; j < 4; ++j)
#pragma unroll
        for (int q = 0; q < 4; ++q) { const LAS f32x4* tp = (const LAS f32x4*)(tab + ((j * 4 + q) * 64 + lane) * 8); const f32x4 a = tp[0], b = tp[1]; const float x = v[j][q];
            acc[0] += x * a[0]; acc[1] += x * a[1]; acc[2] += x * a[2]; acc[3] += x * a[3]; acc[4] += x * b[0]; acc[5] += x * b[1]; acc[6] += x * b[2]; acc[7] += x * b[3]; }
#pragma unroll
    for (int c = 0; c < 8; ++c) acc[c] = wave_sum(acc[c]);
    if (lane < 8) { float r = acc[0];
#pragma unroll
        for (int c = 1; c < 8; ++c) r = (lane == c) ? acc[c] : r;
        pgrow[lane] = r + bg[lane]; }
}
__device__ __forceinline__ void load_wg(LAS float* tab, const float* win_l, int tid) {
    for (int d = tid; d < DM; d += 512) { const int j = d >> 8, ln = (d >> 2) & 63, q = d & 3; const f32x4 a = *(const f32x4*)(win_l + (size_t)d * CIN + NPROJ), b = *(const f32x4*)(win_l + (size_t)d * CIN + NPROJ + 4);
        LAS f32x4* tp = (LAS f32x4*)(tab + ((j * 4 + q) * 64 + ln) * 8); tp[0] = a; tp[1] = b; }
    __syncthreads();
}
__device__ __forceinline__ void p0_prologue(const Params& P, const Ctx& C) {
    LAS float* scr = (LAS float*)(C.lds + C.wave * 16384);
    const int gw = C.blk * 8 + C.wave, NGW = C.G * 8;
    bf16_t* win_t = (bf16_t*)(C.ws + WS_WIN); bf16_t* wout_t = (bf16_t*)(C.ws + WS_WOUT); bf16_t* wup_t = (bf16_t*)(C.ws + WS_WUP); bf16_t* wdn_t = (bf16_t*)(C.ws + WS_WDN);
    constexpr int I_IN = 16 * 96, I_OUT = 16 * 32, I_UP = 16 * 64, I_DN = 16 * 32;
    constexpr int N1 = NLAYER * I_IN, N2 = NLAYER * I_OUT, N3 = NLAYER * NEXP * I_UP, N4 = NLAYER * NEXP * I_DN;
    for (int it = gw; it < N1 + N2 + N3 + N4; it += NGW) {
        int r = it;
        if (r < N1) { const int l = r / I_IN; r %= I_IN; tr_item(P.in[I_WIN] + (size_t)l * DM * CIN, CIN, DM, win_t + (size_t)l * NPROJ * DM, scr, r / 96, r % 96, C.lane); continue; } r -= N1;
        if (r < N2) { const int l = r / I_OUT; r %= I_OUT; tr_item(P.in[I_WOUT] + (size_t)l * DM * DM, DM, DM, wout_t + (size_t)l * DM * DM, scr, r / 32, r % 32, C.lane); continue; } r -= N2;
        if (r < N3) { const int le = r / I_UP; r %= I_UP; tr_item(P.in[I_EWUP] + (size_t)le * DM * NUP, NUP, DM, wup_t + (size_t)le * NUP * DM, scr, r / 64, r % 64, C.lane); continue; } r -= N3;
        { const int le = r / I_DN; r %= I_DN; tr_item(P.in[I_EWDN] + (size_t)le * DEXP * DM, DM, DEXP, wdn_t + (size_t)le * DM * DEXP, scr, r / 32, r % 32, C.lane); }
    }
    f32x2* rope = (f32x2*)(C.ws + WS_ROPE);
    for (int idx = C.blk * 512 + C.tid; idx < SEQ * 32; idx += C.G * 512) { const int t = idx >> 5, i = idx & 31;
        const float inv = powf(10000.0f, -(float)i / 32.0f); const float ang = (float)t * inv;
        const double rev = (double)ang * 0.15915494309189533577; const float fr = (float)(rev - __builtin_rint(rev));
        rope[idx] = (f32x2){__builtin_amdgcn_cosf(fr), __builtin_amdgcn_sinf(fr)}; }
    { bf16_t* wt = (bf16_t*)(C.ws + WS_WUPT); bf16_t* at = (bf16_t*)(C.ws + WS_AUPT); bf16_t* gt = (bf16_t*)(C.ws + WS_GUPT);
      for (int idx = C.blk * 512 + C.tid; idx < NLAYER * RWD * 64; idx += C.G * 512) { const int ll = idx / (RWD * 64), rem = idx % (RWD * 64), j = rem >> 6, i = rem & 63;
          wt[idx] = (bf16_t)f2bf(P.in[I_WUP][((size_t)ll * 64 + i) * RWD + j]); at[idx] = (bf16_t)f2bf(P.in[I_AUP][((size_t)ll * 64 + i) * RWD + j]); }
      for (int idx = C.blk * 512 + C.tid; idx < NLAYER * RWD * 128; idx += C.G * 512) { const int ll = idx / (RWD * 128), rem = idx % (RWD * 128), j = rem >> 7, i = rem & 127;
          gt[idx] = (bf16_t)f2bf(P.in[I_GUP][((size_t)ll * 128 + i) * RWD + j]); } }
    { bf16_t* wh = (bf16_t*)(C.ws + WS_WRH); bf16_t* wl = (bf16_t*)(C.ws + WS_WRL);
      for (int idx = C.blk * 512 + C.tid; idx < NLAYER * NEXP * DM; idx += C.G * 512) { const int ll = idx / (NEXP * DM), rem = idx % (NEXP * DM), e = rem >> 10, d = rem & 1023;
          const float w = P.in[I_RW][((size_t)ll * DM + d) * NEXP + e]; const unsigned hi = f2bf(w); const float lo = w - bflo(hi); wh[idx] = (bf16_t)hi; wl[idx] = (bf16_t)f2bf(lo); } }
    __syncthreads(); LAS float* wg = (LAS float*)C.lds; load_wg(wg, P.in[I_WIN], C.tid);
    bf16_t* hb = (bf16_t*)(C.ws + WS_HB); float* pg = (float*)(C.ws + WS_PG);
    for (int m = gw; m < MTOK; m += NGW) {
        const f32x4* xr = (const f32x4*)(P.in[I_X] + (size_t)m * DM) + C.lane; f32x4 v[4];
#pragma unroll
        for (int j = 0; j < 4; ++j) v[j] = xr[64 * j];
        u32x2* o8 = (u32x2*)(hb + (size_t)m * DM) + C.lane;
#pragma unroll
        for (int j = 0; j < 4; ++j) o8[64 * j] = (u32x2){pk2(v[j][0], v[j][1]), pk2(v[j][2], v[j][3])};
        gate_cols(v, wg, P.in[I_BIN] + NPROJ, pg + (size_t)m * 8, C.lane);
    }
}

constexpr int LD = 72;
constexpr int BUFB = 64 * LD * 2;
__device__ __forceinline__ f32x4 mfma16(bf16x8 a, bf16x8 b, f32x4 c) { return __builtin_amdgcn_mfma_f32_16x16x32_bf16(a, b, c, 0, 0, 0); }
constexpr int SWA_VLD = 264;
__device__ __forceinline__ void swa_unit(const Params& P, const Ctx& C, int l, int u) {
    const int tid = C.tid, wave = C.wave, lane = C.lane, r = lane & 15, g = lane >> 4; const int b = u >> 7, n = (u >> 1) & 63, hk = u & 1;
    LAS bf16_t* Ks = (LAS bf16_t*)C.lds; LAS bf16_t* VT = Ks + 256 * LD;
    const bf16_t* p = (const bf16_t*)(C.ws + WS_P); const f32x2* rope = (const f32x2*)(C.ws + WS_ROPE);
    const int t_base = n * 128 - 128;
#pragma unroll
    for (int it = 0; it < 2; ++it) { const int q = tid + 512 * it, row = q >> 2, c8 = q & 3; const int t = t_base + row;
        u32x4 o1 = (u32x4){0u, 0u, 0u, 0u}, o2 = o1;
        if (t >= 0) { const bf16_t* pr = p + (size_t)(b * SEQ + t) * NPROJ + 1792 + hk * 64 + 8 * c8; const u32x4 a1 = *(const u32x4*)pr, a2 = *(const u32x4*)(pr + 32);
            const f32x4* rp = (const f32x4*)(rope + t * 32 + 8 * c8); float y1[8], y2[8];
#pragma unroll
            for (int e = 0; e < 4; ++e) { const f32x4 cs = rp[e];
                const float x1a = bflo(a1[e]), x1b = bfhi(a1[e]), x2a = bflo(a2[e]), x2b = bfhi(a2[e]);
                y1[2 * e] = x1a * cs[0] - x2a * cs[1]; y2[2 * e] = x2a * cs[0] + x1a * cs[1]; y1[2 * e + 1] = x1b * cs[2] - x2b * cs[3]; y2[2 * e + 1] = x2b * cs[2] + x1b * cs[3]; }
            o1 = (u32x4){pk2(y1[0], y1[1]), pk2(y1[2], y1[3]), pk2(y1[4], y1[5]), pk2(y1[6], y1[7])}; o2 = (u32x4){pk2(y2[0], y2[1]), pk2(y2[2], y2[3]), pk2(y2[4], y2[5]), pk2(y2[6], y2[7])}; }
        *(LAS u32x4*)(Ks + row * LD + 8 * c8) = o1; *(LAS u32x4*)(Ks + row * LD + 32 + 8 * c8) = o2; }
    if (tid < 256) { const int kg = tid >> 3, c8 = tid & 7; u32x4 in[8];
#pragma unroll
        for (int k = 0; k < 8; ++k) { const int t = t_base + 8 * kg + k; in[k] = (t >= 0) ? *(const u32x4*)(p + (size_t)(b * SEQ + t) * NPROJ + 1920 + hk * 64 + 8 * c8) : (u32x4){0u, 0u, 0u, 0u}; }
#pragma unroll
        for (int d = 0; d < 8; ++d) { unsigned hv[8];
#pragma unroll
            for (int k = 0; k < 8; ++k) { const unsigned w = in[k][d >> 1]; hv[k] = (d & 1) ? (w >> 16) : (w & 0xffffu); }
            *(LAS u32x4*)(VT + (8 * c8 + d) * SWA_VLD + 8 * kg) = (u32x4){hv[0] | (hv[1] << 16), hv[2] | (hv[3] << 16), hv[4] | (hv[5] << 16), hv[6] | (hv[7] << 16)}; } }
    LDS_BARRIER();
    const int qi = 16 * wave + r, t = n * 128 + qi;
    const f32x4* rq = (const f32x4*)(rope + t * 32 + 8 * g);
#pragma unroll 1
    for (int gq = 0; gq < 3; ++gq) { const int hq = hk * 3 + gq; int wave = C.wave; asm volatile("" : "+s"(wave));
        bf16x8 qf0, qf1;
        { const bf16_t* pr = p + (size_t)(b * SEQ + t) * NPROJ + RW_COLS + hq * 64 + 8 * g; const u32x4 a1 = *(const u32x4*)pr, a2 = *(const u32x4*)(pr + 32); float y1[8], y2[8];
#pragma unroll
          for (int e = 0; e < 4; ++e) { const f32x4 cs = rq[e]; const float x1a = bflo(a1[e]), x1b = bfhi(a1[e]), x2a = bflo(a2[e]), x2b = bfhi(a2[e]);
              y1[2 * e] = (x1a * cs[0] - x2a * cs[1]) * 0.125f; y2[2 * e] = (x2a * cs[0] + x1a * cs[1]) * 0.125f; y1[2 * e + 1] = (x1b * cs[2] - x2b * cs[3]) * 0.125f; y2[2 * e + 1] = (x2b * cs[2] + x1b * cs[3]) * 0.125f; }
          const u32x4 w1 = (u32x4){pk2(y1[0], y1[1]), pk2(y1[2], y1[3]), pk2(y1[4], y1[5]), pk2(y1[6], y1[7])}, w2 = (u32x4){pk2(y2[0], y2[1]), pk2(y2[2], y2[3]), pk2(y2[4], y2[5]), pk2(y2[6], y2[7])};
          qf0 = __builtin_bit_cast(bf16x8, w1); qf1 = __builtin_bit_cast(bf16x8, w2); }
        f32x4 sc[10]; const float sink = P.in[I_SINK][l * 6 + hq]; float mx = sink;
        int qiv = qi; asm volatile("" : "+v"(qiv));
#pragma unroll
        for (int kt = 0; kt < 10; ++kt) { const int kb = 16 * (wave + kt); f32x4 a = (f32x4){0.f, 0.f, 0.f, 0.f};
            if (kb < 256) { const LAS bf16_t* kp = Ks + (kb + r) * LD + 8 * g; a = mfma16(*(const LAS bf16x8*)kp, qf0, a); a = mfma16(*(const LAS bf16x8*)(kp + 32), qf1, a); }
#pragma unroll
            for (int j = 0; j < 4; ++j) { const int kj = kb + 4 * g + j; const bool valid = (kj > qiv) && (kj <= qiv + 128) && (kj < 256) && ((n != 0) || (kj >= 128)); a[j] = valid ? a[j] : -__builtin_inff(); mx = fmaxf(mx, a[j]); }
            sc[kt] = a; }
        mx = fmaxf(mx, __shfl_xor(mx, 16)); mx = fmaxf(mx, __shfl_xor(mx, 32));
        float sum = 0.f;
#pragma unroll
        for (int kt = 0; kt < 10; ++kt) {
#pragma unroll
            for (int j = 0; j < 4; ++j) { const float e = __expf(sc[kt][j] - mx); sc[kt][j] = e; sum += e; } }
        sum += __shfl_xor(sum, 16); sum += __shfl_xor(sum, 32); sum += __expf(sink - mx);
        const float inv = 1.0f / sum;
        f32x4 o[4];
#pragma unroll
        for (int dt = 0; dt < 4; ++dt) o[dt] = (f32x4){0.f, 0.f, 0.f, 0.f};
#pragma unroll
        for (int s = 0; s < 5; ++s) { const int kb = 16 * (wave + 2 * s);
            if (kb < 256) { const u32x4 pw = (u32x4){pk2(sc[2 * s][0], sc[2 * s][1]), pk2(sc[2 * s][2], sc[2 * s][3]), pk2(sc[2 * s + 1][0], sc[2 * s + 1][1]), pk2(sc[2 * s + 1][2], sc[2 * s + 1][3])};
                const bf16x8 pf = __builtin_bit_cast(bf16x8, pw); const bool two = (kb + 16 < 256);
#pragma unroll
                for (int dt = 0; dt < 4; ++dt) { const LAS bf16_t* vp = VT + (16 * dt + r) * SWA_VLD + kb + 4 * g; const u32x2 lo = *(const LAS u32x2*)vp; u32x2 hi = (u32x2){0u, 0u}; if (two) hi = *(const LAS u32x2*)(vp + 16);
                    const u32x4 af = (u32x4){lo[0], lo[1], hi[0], hi[1]}; o[dt] = mfma16(__builtin_bit_cast(bf16x8, af), pf, o[dt]); } } }
        bf16_t* yr = (bf16_t*)(C.ws + WS_YMIX) + (size_t)(b * SEQ + t) * DM + RWD + hq * 64 + 4 * g;
#pragma unroll
        for (int dt = 0; dt < 4; ++dt) *(u32x2*)(yr + 16 * dt) = (u32x2){pk2(o[dt][0] * inv, o[dt][1] * inv), pk2(o[dt][2] * inv, o[dt][3] * inv)};
    }
    LDS_BARRIER();
}
__device__ __forceinline__ f32x4 mm64(const LAS bf16_t* X, const LAS bf16_t* Y, int ti, int tj, f32x4 acc, int lane) {
    const int r = lane & 15, g = lane >> 4;
    const LAS bf16_t* xp = X + (16 * ti + r) * LD + 8 * g; const LAS bf16_t* yp = Y + (16 * tj + r) * LD + 8 * g;
    acc = mfma16(*(const LAS bf16x8*)xp, *(const LAS bf16x8*)yp, acc);
    acc = mfma16(*(const LAS bf16x8*)(xp + 32), *(const LAS bf16x8*)(yp + 32), acc);
    return acc;
}
__device__ __forceinline__ void storeT(LAS bf16_t* D, int ti, int tj, f32x4 v, int lane) {
    const int r = lane & 15, g = lane >> 4;
    *(LAS u32x2*)(D + (16 * tj + r) * LD + 16 * ti + 4 * g) = (u32x2){pk2(v[0], v[1]), pk2(v[2], v[3])};
}
template <int MODE> __device__ __forceinline__ f32x4 maskT(f32x4 v, int ti, int tj, int lane) {
    const int rho = 16 * tj + (lane & 15), kap = 16 * ti + 4 * (lane >> 4);
#pragma unroll
    for (int j = 0; j < 4; ++j) { const bool keep = (MODE == 0) ? (kap + j < rho) : (MODE == 1) ? (kap + j <= rho) : (kap + j > rho); v[j] = keep ? v[j] : 0.f; }
    return v;
}
__device__ __forceinline__ float wave_max(float v) {
#pragma unroll
    for (int o = 1; o < 64; o <<= 1) v = fmaxf(v, __shfl_xor(v, o));
    return v;
}

__device__ __forceinline__ void rwb_unit(const Params& P, const Ctx& C, int l, int u, bool reuse) {
    const int tid = C.tid, wave = C.wave, lane = C.lane, r = lane & 15, g = lane >> 4;
    const int h = u % 6, bcx = u / 6, b = bcx >> 7, c = bcx & 127; const int tok0 = b * SEQ + c * 64; const int ch = (b * 6 + h) * 128 + c;
    LAS unsigned char* L = C.lds;
#define RB(i) ((LAS bf16_t*)(L + (i) * BUFB))
    LAS bf16_t* X1 = RB(0); LAS bf16_t* X1T = RB(1); LAS bf16_t* Aak = RB(2); LAS bf16_t* Arb = RB(3); LAS bf16_t* Ark = RB(4); LAS bf16_t* Pb = RB(5);
    LAS bf16_t* At = RB(6); LAS bf16_t* AtT = RB(7); LAS bf16_t* Bt = RB(8); LAS bf16_t* BtT = RB(9); LAS bf16_t* Kt = RB(10); LAS bf16_t* KtT = RB(11); LAS bf16_t* Rt = RB(12); LAS bf16_t* VT = RB(13);
    LAS float* XW = (LAS float*)L; LAS float* XA = XW + 64 * 65; LAS float* XG = XA + 64 * 65;
    LAS bf16_t* LI = (LAS bf16_t*)(L + 6 * BUFB);
    LAS float* segtot = (LAS float*)(L + 14 * BUFB); LAS float* gamL = segtot + 512;
    const bf16_t* p = (const bf16_t*)(C.ws + WS_P); const float* mu = P.in[I_MU] + l * RW_COLS;
    float cr9[9], ck9[9], cv9[9];
    { const int jc0 = 64 * h + lane;
#pragma unroll
      for (int i = 0; i < 9; ++i) { const int row = 8 * wave - 1 + i; const bool ok = (c * 64 + row >= 0); const bf16_t* q = p + (size_t)(tok0 + (ok ? row : 0)) * NPROJ;
          const float a_ = bf2f(q[jc0]), b_ = bf2f(q[RWD + jc0]), c_ = bf2f(q[2 * RWD + jc0]); cr9[i] = ok ? a_ : 0.f; ck9[i] = ok ? b_ : 0.f; cv9[i] = ok ? c_ : 0.f; } }
    bf16_t* liscr = (bf16_t*)(C.ws + WS_LISCR) + (size_t)C.blk * (64 * 264);
    if (!reuse) { u32x4 cu[4], pv[4]; f32x4 m0[4], m1[4];
#pragma unroll
      for (int i = 0; i < 4; ++i) { const int q = tid + 512 * i, t = q >> 5, c8 = q & 31; const bf16_t* src = p + (size_t)(tok0 + t) * NPROJ + 1152 + 8 * c8; const bool ok = (c * 64 + t > 0);
          cu[i] = *(const u32x4*)src; pv[i] = *(const u32x4*)(ok ? src - NPROJ : src); if (!ok) pv[i] = (u32x4){0u, 0u, 0u, 0u};
          m0[i] = *(const f32x4*)(mu + 1152 + 8 * c8); m1[i] = *(const f32x4*)(mu + 1152 + 8 * c8 + 4); }
#pragma unroll
      for (int i = 0; i < 4; ++i) { const int q = tid + 512 * i, t = q >> 5, c8 = q & 31; float x[8];
#pragma unroll
          for (int e = 0; e < 4; ++e) { const float c0 = bflo(cu[i][e]), c1 = bfhi(cu[i][e]), p0 = bflo(pv[i][e]), p1 = bfhi(pv[i][e]);
              const float mm0 = (e < 2) ? m0[i][2 * e] : m1[i][2 * e - 4], mm1 = (e < 2) ? m0[i][2 * e + 1] : m1[i][2 * e - 3];
              x[2 * e] = c0 + (p0 - c0) * mm0; x[2 * e + 1] = c1 + (p1 - c1) * mm1; }
          if (c8 < 8) {
#pragma unroll
              for (int e = 0; e < 8; ++e) x[e] = 1.0f - 2.0f * __builtin_amdgcn_rcpf(__expf(2.0f * x[e]) + 1.0f); }
          else if (c8 >= 16) {
#pragma unroll
              for (int e = 0; e < 8; ++e) x[e] = sigmoidf_(x[e]); }
          const u32x4 w = (u32x4){pk2(x[0], x[1]), pk2(x[2], x[3]), pk2(x[4], x[5]), pk2(x[6], x[7])};
          *(LAS u32x4*)(LI + t * 264 + 8 * c8) = w; *(u32x4*)(liscr + t * 264 + 8 * c8) = w; } }
    else {
#pragma unroll
      for (int i = 0; i < 4; ++i) { const int q = tid + 512 * i, t = q >> 5, c8 = q & 31; *(LAS u32x4*)(LI + t * 264 + 8 * c8) = *(const u32x4*)(liscr + t * 264 + 8 * c8); } }
    LDS_BARRIER();
    { bf16x8 bw[1][2], ba[1][2], bg[1][4];
      const int tj = wave & 3;
      const bf16_t* Ww = (const bf16_t*)(C.ws + WS_WUPT) + ((size_t)l * RWD + 64 * h + 16 * tj + r) * 64 + 8 * g;
      const bf16_t* Wa = (const bf16_t*)(C.ws + WS_AUPT) + ((size_t)l * RWD + 64 * h + 16 * tj + r) * 64 + 8 * g;
      const bf16_t* Wg = (const bf16_t*)(C.ws + WS_GUPT) + ((size_t)l * RWD + 64 * h + 16 * tj + r) * 128 + 8 * g;
#pragma unroll
      for (int ks = 0; ks < 2; ++ks) { bw[0][ks] = *(const bf16x8*)(Ww + 32 * ks); ba[0][ks] = *(const bf16x8*)(Wa + 32 * ks); }
#pragma unroll
      for (int ks = 0; ks < 4; ++ks) bg[0][ks] = *(const bf16x8*)(Wg + 32 * ks);
#pragma unroll
      for (int n = 0; n < 6; ++n) { const int o = n >> 1, ti = ((wave >> 2) + 2 * n) & 3; const int xoff = (o == 0) ? 0 : (o == 1) ? 64 : 128;
          const LAS bf16_t* xp = LI + (16 * ti + r) * 264 + xoff + 8 * g; f32x4 acc = (f32x4){0.f, 0.f, 0.f, 0.f};
          if (o == 0) { acc = mfma16(*(const LAS bf16x8*)xp, bw[0][0], acc); acc = mfma16(*(const LAS bf16x8*)(xp + 32), bw[0][1], acc); }
          else if (o == 1) { acc = mfma16(*(const LAS bf16x8*)xp, ba[0][0], acc); acc = mfma16(*(const LAS bf16x8*)(xp + 32), ba[0][1], acc); }
          else {
#pragma unroll
              for (int ks = 0; ks < 4; ++ks) acc = mfma16(*(const LAS bf16x8*)(xp + 32 * ks), bg[0][ks], acc); }
          LAS float* XO = (o == 0) ? XW : (o == 1) ? XA : XG;
#pragma unroll
          for (int j = 0; j < 4; ++j) XO[(16 * ti + 4 * g + j) * 65 + 16 * tj + r] = acc[j]; } }
    LDS_BARRIER();
    {
        const int jc = 64 * h + lane, tg = wave;
        const float w0 = P.in[I_W0][l * RWD + jc], a0 = P.in[I_A0][l * RWD + jc], kkc = P.in[I_KK][l * RWD + jc], kac = P.in[I_KA][l * RWD + jc], rkc = P.in[I_RK][l * RWD + jc];
        const float mur = mu[jc], muk = mu[RWD + jc], muv = mu[2 * RWD + jc];
        float pr = cr9[0], pk = ck9[0], pv = cv9[0];
        float ld[8], av[8], kn[8], km[8], rs[8], vs[8];
        bf16_t* aux = (bf16_t*)(C.ws + WS_RWAUX) + (size_t)(tok0 + 8 * tg) * 768;
#pragma unroll
        for (int i = 0; i < 8; ++i) { const int t = 8 * tg + i; const float cr = cr9[i + 1], ck = ck9[i + 1], cv = cv9[i + 1];
            rs[i] = cr + (pr - cr) * mur; const float ks = ck + (pk - ck) * muk; vs[i] = cv + (pv - cv) * muv; pr = cr; pk = ck; pv = cv;
            const float z = -(w0 + XW[t * 65 + lane]); const float sp = (z > 20.f) ? z : __logf(1.0f + __expf(z)); ld[i] = -__expf(-sp - 0.5f);
            const float a = sigmoidf_(a0 + XA[t * 65 + lane]); av[i] = a;
            const float kkv = ks * kkc; kn[i] = kkv * rsqrtf(fmaxf(wave_sum(kkv * kkv), 1e-24f));
            km[i] = ks * (1.0f + (a - 1.0f) * kac);
            const float dot = wave_sum(rs[i] * km[i] * rkc);
            aux[(size_t)i * 768 + jc] = (bf16_t)f2bf(dot * vs[i]); aux[(size_t)i * 768 + RWD + jc] = (bf16_t)f2bf(XG[t * 65 + lane]); }
        float cs[8]; cs[0] = ld[0];
#pragma unroll
        for (int i = 1; i < 8; ++i) cs[i] = cs[i - 1] + ld[i];
        segtot[tg * 64 + lane] = cs[7];
        LDS_BARRIER();
        float off = 0.f, tot = 0.f;
#pragma unroll
        for (int k = 0; k < 8; ++k) { const float sv = segtot[k * 64 + lane]; tot += sv; off += (k < tg) ? sv : 0.f; }
        if (wave == 0) gamL[lane] = __expf(tot);
        float oa[8], ob[8], ok[8], orr[8];
#pragma unroll
        for (int i = 0; i < 8; ++i) { const int t = 8 * tg + i; const float cum = off + cs[i]; const float gam = __expf(cum), gin = __expf(-cum), gpr = __expf(cum - ld[i]);
            oa[i] = -gpr * kn[i]; ob[i] = kn[i] * av[i] * gin; ok[i] = km[i] * gin; orr[i] = gam * rs[i];
            At[t * LD + lane] = (bf16_t)f2bf(oa[i]); Bt[t * LD + lane] = (bf16_t)f2bf(ob[i]); Kt[t * LD + lane] = (bf16_t)f2bf(ok[i]); Rt[t * LD + lane] = (bf16_t)f2bf(orr[i]); }
        *(LAS u32x4*)(AtT + lane * LD + 8 * tg) = (u32x4){pk2(oa[0], oa[1]), pk2(oa[2], oa[3]), pk2(oa[4], oa[5]), pk2(oa[6], oa[7])};
        *(LAS u32x4*)(BtT + lane * LD + 8 * tg) = (u32x4){pk2(ob[0], ob[1]), pk2(ob[2], ob[3]), pk2(ob[4], ob[5]), pk2(ob[6], ob[7])};
        *(LAS u32x4*)(KtT + lane * LD + 8 * tg) = (u32x4){pk2(ok[0], ok[1]), pk2(ok[2], ok[3]), pk2(ok[4], ok[5]), pk2(ok[6], ok[7])};
        *(LAS u32x4*)(VT + lane * LD + 8 * tg) = (u32x4){pk2(vs[0], vs[1]), pk2(vs[2], vs[3]), pk2(vs[4], vs[5]), pk2(vs[6], vs[7])};
    }
    LDS_BARRIER();
    const f32x4 Z4 = (f32x4){0.f, 0.f, 0.f, 0.f};
    const int wq = wave >> 2, tj = wave & 3;
    { f32x4 res[10];
#pragma unroll
      for (int n_ = 0; n_ < 10; ++n_) { const int o = n_ >> 1, ti = wq + 2 * (n_ & 1);
          if (o == 0) res[n_] = maskT<2>(mm64(At, Bt, ti, tj, Z4, lane), ti, tj, lane);
          else if (o == 1) res[n_] = maskT<0>(mm64(Bt, At, ti, tj, Z4, lane), ti, tj, lane);
          else if (o == 2) res[n_] = maskT<0>(mm64(Kt, At, ti, tj, Z4, lane), ti, tj, lane);
          else if (o == 3) res[n_] = maskT<1>(mm64(Bt, Rt, ti, tj, Z4, lane), ti, tj, lane);
          else res[n_] = maskT<1>(mm64(Kt, Rt, ti, tj, Z4, lane), ti, tj, lane); }
#pragma unroll
      for (int n_ = 0; n_ < 10; ++n_) { const int o = n_ >> 1, ti = wq + 2 * (n_ & 1);
          if (o == 0) storeT(X1T, ti, tj, res[n_], lane);
          else if (o == 1) { storeT(X1, ti, tj, res[n_], lane); f32x4 v = res[n_]; const int rho = 16 * tj + r, kap = 16 * ti + 4 * g;
#pragma unroll
              for (int j = 0; j < 4; ++j) v[j] += (kap + j == rho) ? 1.0f : 0.f;
              storeT(Pb, ti, tj, v, lane); }
          else if (o == 2) storeT(Aak, ti, tj, res[n_], lane);
          else if (o == 3) storeT(Arb, ti, tj, res[n_], lane);
          else storeT(Ark, ti, tj, res[n_], lane); } }
    LDS_BARRIER();
    f32x4 pacc[2];
#pragma unroll
    for (int q = 0; q < 2; ++q) { const int ti = wq + 2 * q; const u32x2 w = *(const LAS u32x2*)(Pb + (16 * tj + r) * LD + 16 * ti + 4 * g);
        pacc[q] = (f32x4){bflo(w[0]), bfhi(w[0]), bflo(w[1]), bfhi(w[1])}; }
#pragma unroll 1
    for (int rnd = 0; rnd < 6; ++rnd) {
        LAS bf16_t* Xn = (rnd & 1) ? RB(6) : RB(0); LAS bf16_t* XnT = (rnd & 1) ? RB(8) : RB(1);
        LAS bf16_t* Yn = (rnd & 1) ? RB(0) : RB(6); LAS bf16_t* YnT = (rnd & 1) ? RB(1) : RB(8);
        LAS bf16_t* Pold = (rnd & 1) ? RB(5) : RB(10); LAS bf16_t* Pnew = (rnd & 1) ? RB(10) : RB(5);
        f32x4 sq[4];
        if (rnd < 5) {
#pragma unroll
            for (int n_ = 0; n_ < 4; ++n_) { const int ti = wq + 2 * (n_ & 1); sq[n_] = (n_ < 2) ? mm64(Xn, XnT, ti, tj, Z4, lane) : mm64(XnT, Xn, ti, tj, Z4, lane); } }
        if (rnd > 0) {
#pragma unroll
            for (int q = 0; q < 2; ++q) pacc[q] = mm64(XnT, Pold, wq + 2 * q, tj, pacc[q], lane); }
        if (rnd < 5) {
#pragma unroll
            for (int n_ = 0; n_ < 4; ++n_) storeT((n_ < 2) ? YnT : Yn, wq + 2 * (n_ & 1), tj, sq[n_], lane); }
        if (rnd > 0) {
#pragma unroll
            for (int q = 0; q < 2; ++q) storeT(Pnew, wq + 2 * q, tj, pacc[q], lane); }
        LDS_BARRIER();
    }
    LAS bf16_t* Tm = RB(10);
    LAS bf16_t* AhT = RB(0); LAS bf16_t* W1T = RB(1); LAS bf16_t* UlT = RB(6);
    { f32x4 res[4];
#pragma unroll
      for (int n_ = 0; n_ < 4; ++n_) { const int ti = wq + 2 * (n_ & 1); res[n_] = (n_ < 2) ? mm64(Tm, AtT, ti, tj, Z4, lane) : mm64(Aak, VT, ti, tj, Z4, lane); }
#pragma unroll
      for (int n_ = 0; n_ < 4; ++n_) storeT((n_ < 2) ? AhT : W1T, wq + 2 * (n_ & 1), tj, res[n_], lane); }
    LDS_BARRIER();
    { f32x4 res[2];
#pragma unroll
      for (int n_ = 0; n_ < 2; ++n_) res[n_] = mm64(Tm, W1T, wq + 2 * n_, tj, Z4, lane);
#pragma unroll
      for (int n_ = 0; n_ < 2; ++n_) storeT(UlT, wq + 2 * n_, tj, res[n_], lane); }
    LDS_BARRIER();
    bf16_t* gM = (bf16_t*)(C.ws + WS_RWM) + (size_t)ch * 4096; bf16_t* gNT = (bf16_t*)(C.ws + WS_RWNT) + (size_t)ch * 4096; bf16_t* gQ = (bf16_t*)(C.ws + WS_RWQH) + (size_t)ch * 4096; bf16_t* gY = (bf16_t*)(C.ws + WS_RWYL) + (size_t)ch * 4096;
#pragma unroll
    for (int n_ = 0; n_ < 8; ++n_) { const int o = n_ >> 1, ti = wq + 2 * (n_ & 1); const int rho = 16 * tj + r, kap = 16 * ti + 4 * g;
        if (o == 0) {
            const u32x2 w = *(const LAS u32x2*)(Rt + rho * LD + kap); f32x4 v = (f32x4){bflo(w[0]), bfhi(w[0]), bflo(w[1]), bfhi(w[1])};
            v = mm64(AhT, Arb, ti, tj, v, lane); *(u32x2*)(gQ + rho * 64 + kap) = (u32x2){pk2(v[0], v[1]), pk2(v[2], v[3])}; }
        else if (o == 1) {
            f32x4 v = mm64(UlT, Arb, ti, tj, Z4, lane); v = mm64(VT, Ark, ti, tj, v, lane); *(u32x2*)(gY + rho * 64 + kap) = (u32x2){pk2(v[0], v[1]), pk2(v[2], v[3])}; }
        else if (o == 2) {
            f32x4 v = mm64(AhT, BtT, ti, tj, Z4, lane); const float gl = gamL[rho];
#pragma unroll
            for (int j = 0; j < 4; ++j) v[j] = gl * (v[j] + ((kap + j == rho) ? 1.0f : 0.f));
            *(u32x2*)(gM + rho * 64 + kap) = (u32x2){pk2(v[0], v[1]), pk2(v[2], v[3])}; }
        else {
            f32x4 v = mm64(BtT, UlT, ti, tj, Z4, lane); v = mm64(KtT, VT, ti, tj, v, lane);
#pragma unroll
            for (int j = 0; j < 4; ++j) v[j] *= gamL[kap + j];
            *(u32x2*)(gNT + rho * 64 + kap) = (u32x2){pk2(v[0], v[1]), pk2(v[2], v[3])}; } }
    LDS_BARRIER();
#undef RB
}

__device__ __forceinline__ void mlb_unit(const Params& P, const Ctx& C, int l, int u) {
    const int tid = C.tid, wave = C.wave, lane = C.lane, r = lane & 15, g = lane >> 4;
    const int hh = u & 3, bcx = u >> 2, b = bcx >> 7, c = bcx & 127; const int tok0 = b * SEQ + c * 64; const int ch = (b * 4 + hh) * 128 + c;
    LAS unsigned char* L = C.lds;
    LAS bf16_t* Qs = (LAS bf16_t*)L; LAS bf16_t* Ks = (LAS bf16_t*)(L + BUFB); LAS bf16_t* KhT = (LAS bf16_t*)(L + 2 * BUFB); LAS bf16_t* Sm = (LAS bf16_t*)(L + 3 * BUFB); LAS bf16_t* VTe = (LAS bf16_t*)(L + 4 * BUFB);
    LAS float* vbc = (LAS float*)(L + 4 * BUFB + 80 * LD * 2); LAS float* vig = vbc + 64; LAS float* vmd = vig + 64; LAS float* vws = vmd + 64;
    const bf16_t* p = (const bf16_t*)(C.ws + WS_P);
    unsigned xr[19], vr[8];
    { const int cq = tid & 127, tg = tid >> 7, isk = cq >> 6, d = cq & 63; const int col = 2048 + isk * 256 + hh * 64 + d; const int t0 = 16 * tg; const bool okp = (c * 64 + t0 > 0);
#pragma unroll
      for (int k = 0; k < 19; ++k) xr[k] = p[(size_t)(tok0 + ((k < 3 && !okp) ? 0 : t0 + k - 3)) * NPROJ + col];
      const int v = tid & 63, sg = tid >> 6;
#pragma unroll
      for (int k = 0; k < 8; ++k) vr[k] = p[(size_t)(tok0 + 8 * sg + k) * NPROJ + 2560 + hh * 64 + v]; }
    if (wave == 0) { const float* pg = (const float*)(C.ws + WS_PG) + (size_t)(tok0 + lane) * 8; const float ig = pg[hh], f = pg[4 + hh];
        const float lf = fminf(f, 0.f) - __logf(1.0f + __expf(-fabsf(f)));
        float bcv = lf;
#pragma unroll
        for (int o = 1; o < 64; o <<= 1) { const float t = __shfl_up(bcv, o); bcv += (lane >= o) ? t : 0.f; }
        float pm = ig - bcv;
#pragma unroll
        for (int o = 1; o < 64; o <<= 1) { const float t = __shfl_up(pm, o); pm = (lane >= o) ? fmaxf(pm, t) : pm; }
        const float md = bcv + pm; const float bcL = __shfl(bcv, 63); const float as = bcL - bcv + ig; const float mloc = wave_max(as); const float ws = __expf(as - mloc);
        vbc[lane] = bcv; vig[lane] = ig; vmd[lane] = md; vws[lane] = ws;
        float* vec = (float*)(C.ws + WS_MLVEC) + ((size_t)ch * 64 + lane) * 2; vec[0] = bcv; vec[1] = md;
        if (lane == 0) { float* sc = (float*)(C.ws + WS_MLSC) + (size_t)ch * 2; sc[0] = bcL; sc[1] = mloc; } }
    LDS_BARRIER();
    { const int cq = tid & 127, tg = tid >> 7, isk = cq >> 6, d = cq & 63; const int col = 2048 + isk * 256 + hh * 64 + d; const int cw = isk * 256 + hh * 64 + d;
      const float* cwp = P.in[I_CONVW] + (size_t)l * 4 * 512; const float w0 = cwp[cw], w1 = cwp[512 + cw], w2 = cwp[1024 + cw], w3 = cwp[1536 + cw], cb = P.in[I_CONVB][l * 512 + cw];
      float xm3 = 0.f, xm2 = 0.f, xm1 = 0.f; const int t0 = 16 * tg;
      if (c * 64 + t0 > 0) { xm3 = bf2f((unsigned short)xr[0]); xm2 = bf2f((unsigned short)xr[1]); xm1 = bf2f((unsigned short)xr[2]); }
      float o16[16];
#pragma unroll
      for (int k = 0; k < 16; ++k) { const float x0 = bf2f((unsigned short)xr[k + 3]); const float y = w0 * xm3 + w1 * xm2 + w2 * xm1 + w3 * x0 + cb; const float s = y * sigmoidf_(y);
          o16[k] = isk ? s * 0.125f : s; xm3 = xm2; xm2 = xm1; xm1 = x0; }
      if (!isk) { bf16_t* gq = (bf16_t*)(C.ws + WS_MLQ) + (size_t)ch * 4096;
#pragma unroll
          for (int k = 0; k < 16; ++k) { const bf16_t v = (bf16_t)f2bf(o16[k]); Qs[(t0 + k) * LD + d] = v; gq[(t0 + k) * 64 + d] = v; } }
      else {
#pragma unroll
          for (int k = 0; k < 16; ++k) { Ks[(t0 + k) * LD + d] = (bf16_t)f2bf(o16[k]); o16[k] *= vws[t0 + k]; }
          *(LAS u32x4*)(KhT + d * LD + t0) = (u32x4){pk2(o16[0], o16[1]), pk2(o16[2], o16[3]), pk2(o16[4], o16[5]), pk2(o16[6], o16[7])};
          *(LAS u32x4*)(KhT + d * LD + t0 + 8) = (u32x4){pk2(o16[8], o16[9]), pk2(o16[10], o16[11]), pk2(o16[12], o16[13]), pk2(o16[14], o16[15])}; }
      { const int v = tid & 63, sg = tid >> 6; float vv[8];
#pragma unroll
        for (int k = 0; k < 8; ++k) vv[k] = bf2f((unsigned short)vr[k]);
        *(LAS u32x4*)(VTe + v * LD + 8 * sg) = (u32x4){pk2(vv[0], vv[1]), pk2(vv[2], vv[3]), pk2(vv[4], vv[5]), pk2(vv[6], vv[7])}; }
      if (tid < 128) { const int row = 64 + (tid >> 3), pc = tid & 7; const unsigned one2 = 0x3f803f80u; const unsigned val = (row == 64) ? one2 : 0u; *(LAS u32x4*)(VTe + row * LD + 8 * pc) = (u32x4){val, val, val, val}; }
    }
    LDS_BARRIER();
    const f32x4 Z4 = (f32x4){0.f, 0.f, 0.f, 0.f};
    bf16_t* gKL = (bf16_t*)(C.ws + WS_MLKL) + (size_t)ch * 5120; bf16_t* gNL = (bf16_t*)(C.ws + WS_MLNL) + (size_t)ch * 5120;
    for (int task = wave; task < 36; task += 8) {
        if (task < 16) { const int ti = task >> 2, tj = task & 3; f32x4 v = mm64(Ks, Qs, ti, tj, Z4, lane);
            const int rho = 16 * tj + r, kap = 16 * ti + 4 * g; const float bl = vbc[rho] - vmd[rho];
#pragma unroll
            for (int j = 0; j < 4; ++j) { const int s = kap + j; v[j] = (s <= rho) ? v[j] * __expf(bl - vbc[s] + vig[s]) : 0.f; }
            storeT(Sm, ti, tj, v, lane); }
        else { const int t2 = task - 16, ti = t2 / 5, tj = t2 % 5;
            const f32x4 v = mm64(KhT, VTe, ti, tj, Z4, lane); *(u32x2*)(gKL + (16 * tj + r) * 64 + 16 * ti + 4 * g) = (u32x2){pk2(v[0], v[1]), pk2(v[2], v[3])}; } }
    LDS_BARRIER();
    for (int task = wave; task < 20; task += 8) { const int ti = task >> 2, tj = task & 3; const f32x4 v = mm64(VTe, Sm, ti, tj, Z4, lane); *(u32x2*)(gNL + (16 * tj + r) * 80 + 16 * ti + 4 * g) = (u32x2){pk2(v[0], v[1]), pk2(v[2], v[3])}; }
    LDS_BARRIER();
}

__device__ __forceinline__ void rwkv_chain(const Ctx& C, int bh, int vh) {
    const int tid = C.tid, wave = C.wave, lane = C.lane, r = lane & 15, g = lane >> 4; const size_t ch0 = (size_t)bh * 128;
    LAS unsigned char* L = C.lds; LAS unsigned char* Mb = L; LAS unsigned char* Nb = L + 8 * BUFB; LAS unsigned char* Sb = Nb + 8 * (32 * LD * 2);
    static_assert(8 * BUFB + 8 * 32 * LD * 2 + 8 * 32 * 128 <= MISC_OFF, "chain LDS");
    const bf16_t* gM = (const bf16_t*)(C.ws + WS_RWM) + ch0 * 4096; const bf16_t* gN = (const bf16_t*)(C.ws + WS_RWNT) + ch0 * 4096 + (size_t)vh * 32 * 64; bf16_t* gS = (bf16_t*)(C.ws + WS_RWS) + ch0 * 4096;
    u32x4 pmA[8], pnA4[4];
#define CH_LOAD(pm, pn, nbx) do { const bf16_t* m_ = gM + (size_t)(nbx) * 8 * 4096; \
        _Pragma("unroll") for (int i = 0; i < 8; ++i) pm[i] = ((const u32x4*)m_)[tid + 512 * i]; \
        _Pragma("unroll") for (int i = 0; i < 4; ++i) { const int q = tid + 512 * i, chunk = q >> 8, within = q & 255; pn[i] = ((const u32x4*)(gN + ((size_t)(nbx) * 8 + chunk) * 4096))[within]; } } while (0)
#define CH_PUT(pm, pn) do { \
        _Pragma("unroll") for (int i = 0; i < 8; ++i) { const int q = tid + 512 * i, chunk = q >> 9, within = q & 511, row = within >> 3, pc = within & 7; *(LAS u32x4*)(Mb + chunk * BUFB + row * (LD * 2) + pc * 16) = pm[i]; } \
        _Pragma("unroll") for (int i = 0; i < 4; ++i) { const int q = tid + 512 * i, chunk = q >> 8, within = q & 255, row = within >> 3, pc = within & 7; *(LAS u32x4*)(Nb + chunk * (32 * LD * 2) + row * (LD * 2) + pc * 16) = pn[i]; } } while (0)
    CH_LOAD(pmA, pnA4, 0);
    f32x4 acc[4];
#pragma unroll
    for (int t = 0; t < 4; ++t) acc[t] = (f32x4){0.f, 0.f, 0.f, 0.f};
#define CH_FRAGS(cc_, mf_, nf_) do { const LAS unsigned char* mc = Mb + (cc_) * BUFB; const LAS unsigned char* nc = Nb + (cc_) * (32 * LD * 2); \
        _Pragma("unroll") for (int t = 0; t < 4; ++t) { nf_[t] = *(const LAS u32x2*)(nc + (16 * wave + r) * (LD * 2) + (16 * t + 4 * g) * 2); \
            const LAS unsigned char* mp = mc + (16 * t + r) * (LD * 2) + (4 * g) * 2; const u32x2 lo = *(const LAS u32x2*)mp, hi = *(const LAS u32x2*)(mp + 32); mf_[t] = (u32x4){lo[0], lo[1], hi[0], hi[1]}; } } while (0)
#define CH_ONE(cc_, mf_, nf_) do { \
            u32x4 m2[4]; { const LAS unsigned char* mc = Mb + (cc_) * BUFB; \
            _Pragma("unroll") for (int t = 0; t < 4; ++t) { const LAS unsigned char* mp = mc + (16 * t + r) * (LD * 2) + (32 + 4 * g) * 2; const u32x2 lo = *(const LAS u32x2*)mp, hi = *(const LAS u32x2*)(mp + 32); m2[t] = (u32x4){lo[0], lo[1], hi[0], hi[1]}; } } \
            u32x2 pk[4]; \
            _Pragma("unroll") for (int t = 0; t < 4; ++t) pk[t] = (u32x2){pk2(acc[t][0], acc[t][1]), pk2(acc[t][2], acc[t][3])}; \
            LAS unsigned char* sg = Sb + (cc_) * 4096 + (16 * wave + r) * 128 + (4 * g) * 2; \
            _Pragma("unroll") for (int t = 0; t < 4; ++t) *(LAS u32x2*)(sg + 32 * t) = pk[t]; \
            bf16x8 zb[2]; \
            _Pragma("unroll") for (int s = 0; s < 2; ++s) { const u32x4 z = (u32x4){pk[2 * s][0], pk[2 * s][1], pk[2 * s + 1][0], pk[2 * s + 1][1]}; zb[s] = __builtin_bit_cast(bf16x8, z); } \
            _Pragma("unroll") for (int t = 0; t < 4; ++t) { const u32x2 nw = nf_[t]; const f32x4 a0 = (f32x4){bflo(nw[0]), bfhi(nw[0]), bflo(nw[1]), bfhi(nw[1])}; \
                acc[t] = mfma16(__builtin_bit_cast(bf16x8, mf_[t]), zb[0], a0); } \
            _Pragma("unroll") for (int t = 0; t < 4; ++t) acc[t] = mfma16(__builtin_bit_cast(bf16x8, m2[t]), zb[1], acc[t]); } while (0)
#define CH_STEP(nbx) do { if (wave < 2) { u32x4 mf0[4], mf1[4]; u32x2 nf0[4], nf1[4]; CH_FRAGS(0, mf0, nf0); \
        _Pragma("unroll 1") for (int cc = 0; cc < 8; cc += 2) { \
            CH_FRAGS(cc + 1, mf1, nf1); CH_ONE(cc, mf0, nf0); \
            if (cc + 2 < 8) CH_FRAGS(cc + 2, mf0, nf0); CH_ONE(cc + 1, mf1, nf1); } } } while (0)
#define CH_SOUT(nbx) do { _Pragma("unroll") for (int i = 0; i < 4; ++i) { const int q = tid + 512 * i, chunk = q >> 8, within = q & 255, row = within >> 3, pc = within & 7; \
        const u32x4 v = *(const LAS u32x4*)(Sb + chunk * 4096 + row * 128 + pc * 16); *(u32x4*)(gS + ((size_t)(nbx) * 8 + chunk) * 4096 + (32 * vh + row) * 64 + pc * 8) = v; } } while (0)
    for (int nb = 0; nb < 16; ++nb) {
        LDS_BARRIER(); if (nb > 0) CH_SOUT(nb - 1); CH_PUT(pmA, pnA4); LDS_BARRIER();
        if (nb + 1 < 16) CH_LOAD(pmA, pnA4, nb + 1);
        CH_STEP(nb);
    }
    LDS_BARRIER(); CH_SOUT(15);
#undef CH_SOUT
#undef CH_LOAD
#undef CH_PUT
#undef CH_STEP
#undef CH_FRAGS
#undef CH_ONE
}
__device__ __forceinline__ void mlstm_cscan(const Ctx& C, int bh, int part) {
    const int tid = C.tid; const size_t ch0 = (size_t)bh * 128; const int e0 = 10 * (part * 128 + (tid & 127));
    const bf16_t* KL = (const bf16_t*)(C.ws + WS_MLKL) + ch0 * 5120 + e0; bf16_t* CT = (bf16_t*)(C.ws + WS_MLCT) + ch0 * 5120 + e0; float* MM = (float*)(C.ws + WS_MLM) + ch0; const float* SC = (const float*)(C.ws + WS_MLSC) + ch0 * 2;
    float st[10]; unsigned ring[8][5]; float m = 0.f;
    LAS float* scl = (LAS float*)C.lds; if (tid < 256) scl[tid] = SC[tid];
    __syncthreads();
    if (tid >= 128) return;
#pragma unroll
    for (int i = 0; i < 10; ++i) st[i] = 0.f;
#pragma unroll
    for (int k = 0; k < 8; ++k)
#pragma unroll
        for (int i = 0; i < 5; ++i) ring[k][i] = *(const unsigned*)(KL + (size_t)k * 5120 + 2 * i);
    for (int c0 = 0; c0 < 128; c0 += 8) {
#pragma unroll
        for (int k = 0; k < 8; ++k) { const int c = c0 + k; unsigned cur[5];
#pragma unroll
            for (int i = 0; i < 5; ++i) cur[i] = ring[k][i];
            if (c + 8 < 128) {
#pragma unroll
                for (int i = 0; i < 5; ++i) ring[k][i] = *(const unsigned*)(KL + (size_t)(c + 8) * 5120 + 2 * i); }
            const float bcL = scl[2 * c], mloc = scl[2 * c + 1];
            unsigned* ct = (unsigned*)(CT + (size_t)c * 5120);
#pragma unroll
            for (int i = 0; i < 5; ++i) ct[i] = pk2(st[2 * i], st[2 * i + 1]);
            if (tid == 0 && part == 0) MM[c] = m;
            const float mn = fmaxf(bcL + m, mloc); const float dec = __expf(bcL + m - mn), sc = __expf(mloc - mn); m = mn;
#pragma unroll
            for (int i = 0; i < 5; ++i) { st[2 * i] = dec * st[2 * i] + sc * bflo(cur[i]); st[2 * i + 1] = dec * st[2 * i + 1] + sc * bfhi(cur[i]); } }
    }
}

__device__ __forceinline__ void passd_unit(const Params& P, const Ctx& C, int l, int u) {
    const int wave = C.wave, lane = C.lane, r = lane & 15, g = lane >> 4; const int b = u >> 7, c = u & 127; const int tok0 = b * SEQ + c * 64;
    bf16_t* ymix = (bf16_t*)(C.ws + WS_YMIX);
    {
        bf16x8 qf[3][2], sf[3][4][2]; u32x2 yl[3][4], bo[3][4], gg[3][4];
#pragma unroll
        for (int n_ = 0; n_ < 3; ++n_) { const int task = wave + 8 * n_, h = task >> 2, tb = task & 3; const size_t ch = (size_t)(b * 6 + h) * 128 + c; const int t = 16 * tb + r; const int tok = tok0 + t;
            const bf16_t* gS = (const bf16_t*)(C.ws + WS_RWS) + ch * 4096; const bf16_t* gQ = (const bf16_t*)(C.ws + WS_RWQH) + ch * 4096 + t * 64 + 8 * g; const bf16_t* gY = (const bf16_t*)(C.ws + WS_RWYL) + ch * 4096 + t * 64 + 4 * g;
            const bf16_t* aux = (const bf16_t*)(C.ws + WS_RWAUX) + (size_t)tok * 768 + 64 * h + 4 * g;
            qf[n_][0] = *(const bf16x8*)gQ; qf[n_][1] = *(const bf16x8*)(gQ + 32);
#pragma unroll
            for (int ti = 0; ti < 4; ++ti) { const bf16_t* sp = gS + (16 * ti + r) * 64 + 8 * g; sf[n_][ti][0] = *(const bf16x8*)sp; sf[n_][ti][1] = *(const bf16x8*)(sp + 32);
                yl[n_][ti] = *(const u32x2*)(gY + 16 * ti); bo[n_][ti] = *(const u32x2*)(aux + 16 * ti); gg[n_][ti] = *(const u32x2*)(aux + RWD + 16 * ti); } }
#pragma unroll
        for (int n_ = 0; n_ < 3; ++n_) { const int task = wave + 8 * n_, h = task >> 2, tb = task & 3; const int t = 16 * tb + r; const int tok = tok0 + t;
            f32x4 y[4]; float s = 0.f;
#pragma unroll
            for (int ti = 0; ti < 4; ++ti) { const u32x2 yw = yl[n_][ti]; f32x4 a = (f32x4){bflo(yw[0]), bfhi(yw[0]), bflo(yw[1]), bfhi(yw[1])};
                a = mfma16(sf[n_][ti][0], qf[n_][0], a); a = mfma16(sf[n_][ti][1], qf[n_][1], a); y[ti] = a; s += (a[0] + a[1]) + (a[2] + a[3]); }
            s += __shfl_xor(s, 16); s += __shfl_xor(s, 32); const float mean = s * (1.f / 64.f); float s2 = 0.f;
#pragma unroll
            for (int ti = 0; ti < 4; ++ti) { y[ti] = y[ti] - mean; s2 += (y[ti][0] * y[ti][0] + y[ti][1] * y[ti][1]) + (y[ti][2] * y[ti][2] + y[ti][3] * y[ti][3]); }
            s2 += __shfl_xor(s2, 16); s2 += __shfl_xor(s2, 32); const float rstd = rsqrtf(s2 * (1.f / 64.f) + 64e-5f);
            bf16_t* yo = ymix + (size_t)tok * DM + 64 * h + 4 * g;
            const float* lw = P.in[I_LNW] + l * RWD + 64 * h + 4 * g; const float* lb = P.in[I_LNB] + l * RWD + 64 * h + 4 * g;
#pragma unroll
            for (int ti = 0; ti < 4; ++ti) { const u32x2 bo_ = bo[n_][ti], gg_ = gg[n_][ti]; const f32x4 w4 = *(const f32x4*)(lw + 16 * ti), b4 = *(const f32x4*)(lb + 16 * ti);
                const float o0 = (y[ti][0] * rstd * w4[0] + b4[0] + bflo(bo_[0])) * bflo(gg_[0]), o1 = (y[ti][1] * rstd * w4[1] + b4[1] + bfhi(bo_[0])) * bfhi(gg_[0]);
                const float o2 = (y[ti][2] * rstd * w4[2] + b4[2] + bflo(bo_[1])) * bflo(gg_[1]), o3 = (y[ti][3] * rstd * w4[3] + b4[3] + bfhi(bo_[1])) * bfhi(gg_[1]);
                *(u32x2*)(yo + 16 * ti) = (u32x2){pk2(o0, o1), pk2(o2, o3)}; } }
    }
    {
        bf16x8 qf[2][2], cf[2][5][2]; u32x2 nl[2][5], og[2][4]; float bcl[2], mdl[2], mcv[2];
#pragma unroll
        for (int n_ = 0; n_ < 2; ++n_) { const int task = wave + 8 * (n_ + 3), hh = (task - 24) >> 2, tb = task & 3; const size_t ch = (size_t)(b * 4 + hh) * 128 + c; const int t = 16 * tb + r; const int tok = tok0 + t;
            const bf16_t* gC = (const bf16_t*)(C.ws + WS_MLCT) + ch * 5120; const bf16_t* gQ = (const bf16_t*)(C.ws + WS_MLQ) + ch * 4096 + t * 64 + 8 * g; const bf16_t* gNL = (const bf16_t*)(C.ws + WS_MLNL) + ch * 5120 + t * 80 + 4 * g;
            const bf16_t* ogp = (const bf16_t*)(C.ws + WS_P) + (size_t)tok * NPROJ + 2816 + 64 * hh + 4 * g;
            qf[n_][0] = *(const bf16x8*)gQ; qf[n_][1] = *(const bf16x8*)(gQ + 32);
            const float* vec = (const float*)(C.ws + WS_MLVEC) + (ch * 64 + t) * 2; bcl[n_] = vec[0]; mdl[n_] = vec[1]; mcv[n_] = ((const float*)(C.ws + WS_MLM))[ch];
#pragma unroll
            for (int ti = 0; ti < 5; ++ti) { const bf16_t* cp = gC + (16 * ti + r) * 64 + 8 * g; cf[n_][ti][0] = *(const bf16x8*)cp; cf[n_][ti][1] = *(const bf16x8*)(cp + 32); nl[n_][ti] = *(const u32x2*)(gNL + 16 * ti); }
#pragma unroll
            for (int ti = 0; ti < 4; ++ti) og[n_][ti] = *(const u32x2*)(ogp + 16 * ti); }
#pragma unroll
        for (int n_ = 0; n_ < 2; ++n_) { const int task = wave + 8 * (n_ + 3), hh = (task - 24) >> 2, tb = task & 3; const int t = 16 * tb + r; const int tok = tok0 + t;
            const float mint = bcl[n_] + mcv[n_], mt = fmaxf(mint, mdl[n_]); const float inter = __expf(mint - mt), fl = __expf(mdl[n_] - mt);
            f32x4 y[5];
#pragma unroll
            for (int ti = 0; ti < 5; ++ti) { f32x4 a = (f32x4){0.f, 0.f, 0.f, 0.f};
                a = mfma16(cf[n_][ti][0], qf[n_][0], a); a = mfma16(cf[n_][ti][1], qf[n_][1], a); const u32x2 nw = nl[n_][ti]; const f32x4 nlv = (f32x4){bflo(nw[0]), bfhi(nw[0]), bflo(nw[1]), bfhi(nw[1])}; y[ti] = fl * nlv + inter * a; }
            const float nq = __shfl(y[4][0], r);
            const float inv = 1.0f / fmaxf(fabsf(nq), __expf(-mt));
            float s = 0.f;
#pragma unroll
            for (int ti = 0; ti < 4; ++ti) { y[ti] = y[ti] * inv; s += (y[ti][0] + y[ti][1]) + (y[ti][2] + y[ti][3]); }
            s += __shfl_xor(s, 16); s += __shfl_xor(s, 32); const float mean = s * (1.f / 64.f); float s2 = 0.f;
#pragma unroll
            for (int ti = 0; ti < 4; ++ti) { y[ti] = y[ti] - mean; s2 += (y[ti][0] * y[ti][0] + y[ti][1] * y[ti][1]) + (y[ti][2] * y[ti][2] + y[ti][3] * y[ti][3]); }
            s2 += __shfl_xor(s2, 16); s2 += __shfl_xor(s2, 32); const float rstd = rsqrtf(s2 * (1.f / 64.f) + 1e-6f);
            bf16_t* yo = ymix + (size_t)tok * DM + 768 + 64 * hh + 4 * g; const float* nw = P.in[I_MLNW] + l * 256 + 64 * hh + 4 * g;
#pragma unroll
            for (int ti = 0; ti < 4; ++ti) { const u32x2 oo = og[n_][ti]; const f32x4 w4 = *(const f32x4*)(nw + 16 * ti);
                const float o0 = y[ti][0] * rstd * w4[0] * sigmoidf_(bflo(oo[0])), o1 = y[ti][1] * rstd * w4[1] * sigmoidf_(bfhi(oo[0])), o2 = y[ti][2] * rstd * w4[2] * sigmoidf_(bflo(oo[1])), o3 = y[ti][3] * rstd * w4[3] * sigmoidf_(bfhi(oo[1]));
                *(u32x2*)(yo + 16 * ti) = (u32x2){pk2(o0, o1), pk2(o2, o3)}; } }
    }
}

__device__ __forceinline__ void ln1_router_phase(const Params& P, const Ctx& C, int l, int cnt_off) {
    const int tid = C.tid, wave = C.wave, lane = C.lane, r = lane & 15, g = lane >> 4;
    constexpr int HS = 1032;
    LAS bf16_t* hhi = (LAS bf16_t*)C.lds;
    LAS bf16_t* hlo = hhi + 16 * HS;
    LAS float* part = (LAS float*)(hlo + 16 * HS);
    LAS int* lcnt = (LAS int*)(part + 8 * 8 * 32);
    bf16x8 bh[4][2], bl[4][2];
#pragma unroll
    for (int ks = 0; ks < 4; ++ks)
#pragma unroll
        for (int nt = 0; nt < 2; ++nt) { const size_t off = ((size_t)l * NEXP + 16 * nt + r) * DM + 32 * (4 * wave + ks) + 8 * g;
            bh[ks][nt] = *(const bf16x8*)((const bf16_t*)(C.ws + WS_WRH) + off); bl[ks][nt] = *(const bf16x8*)((const bf16_t*)(C.ws + WS_WRL) + off); }
    for (int i = tid; i < 16 * HS; i += 512) { hhi[i] = 0; hlo[i] = 0; }
    if (tid < 32) lcnt[tid] = 0;
    { int* pdest = (int*)(C.ws + WS_PDEST); int* ptok = (int*)(C.ws + WS_PTOK); for (int i = C.blk * 512 + tid; i < POS_MAX; i += C.G * 512) { pdest[i] = -1; ptok[i] = 0; } }
    __syncthreads();
    const int tpb = (MTOK + C.G - 1) / C.G, tok_lo = C.blk * tpb, tok_hi = (tok_lo + tpb < MTOK) ? tok_lo + tpb : MTOK;
    const bf16_t* t1 = (const bf16_t*)(C.ws + WS_T1); bf16_t* hb = (bf16_t*)(C.ws + WS_HB);
    int* toke = (int*)(C.ws + WS_TOKE); float* tokg = (float*)(C.ws + WS_TOKG); int* toklr = (int*)(C.ws + WS_TOKLR);
    const f32x4* lw4 = (const f32x4*)(P.in[I_LN1W] + (size_t)l * DM) + lane; const f32x4* lb4 = (const f32x4*)(P.in[I_LN1B] + (size_t)l * DM) + lane;
    u32x2 vn[4], rn[4];
    { const int tok = tok_lo + wave; const size_t ro = (size_t)((tok < tok_hi) ? tok : tok_lo) * DM; const u32x2* xr = (const u32x2*)(t1 + ro) + lane; const u32x2* rr = (const u32x2*)(hb + ro) + lane;
#pragma unroll
      for (int j = 0; j < 4; ++j) { vn[j] = xr[64 * j]; rn[j] = rr[64 * j]; } }
    const float rbias = P.in[I_RB][l * NEXP + (lane & 31)];
    for (int base = tok_lo; base < tok_hi; base += 8) {
        const int tok = base + wave;
        f32x4 v[4];
#pragma unroll
        for (int j = 0; j < 4; ++j) v[j] = (f32x4){bflo(vn[j][0]), bfhi(vn[j][0]), bflo(vn[j][1]), bfhi(vn[j][1])} + DN_ALPHA * (f32x4){bflo(rn[j][0]), bfhi(rn[j][0]), bflo(rn[j][1]), bfhi(rn[j][1])};
        { const int tn = base + 8 + wave; const size_t ro = (size_t)((tn < tok_hi) ? tn : tok_lo) * DM; const u32x2* xr = (const u32x2*)(t1 + ro) + lane; const u32x2* rr = (const u32x2*)(hb + ro) + lane;
#pragma unroll
          for (int j = 0; j < 4; ++j) { vn[j] = xr[64 * j]; rn[j] = rr[64 * j]; } }
        if (tok < tok_hi) {
            float s = 0.f;
#pragma unroll
            for (int j = 0; j < 4; ++j) s += (v[j][0] + v[j][1]) + (v[j][2] + v[j][3]);
            const float mean = wave_sum(s) * (1.f / DM); float s2 = 0.f;
#pragma unroll
            for (int j = 0; j < 4; ++j) { v[j] = v[j] - mean; s2 += (v[j][0] * v[j][0] + v[j][1] * v[j][1]) + (v[j][2] * v[j][2] + v[j][3] * v[j][3]); }
            const float rstd = rsqrtf(wave_sum(s2) * (1.f / DM) + LN_EPS);
            u32x2* ob = (u32x2*)(hb + (size_t)tok * DM) + lane;
#pragma unroll
            for (int j = 0; j < 4; ++j) { const f32x4 y = v[j] * rstd * lw4[64 * j] + lb4[64 * j]; const u32x2 hi = (u32x2){pk2(y[0], y[1]), pk2(y[2], y[3])}; ob[64 * j] = hi;
                const u32x2 lo = (u32x2){pk2(y[0] - bflo(hi[0]), y[1] - bfhi(hi[0])), pk2(y[2] - bflo(hi[1]), y[3] - bfhi(hi[1]))};
                *(LAS u32x2*)(hhi + wave * HS + 4 * (lane + 64 * j)) = hi; *(LAS u32x2*)(hlo + wave * HS + 4 * (lane + 64 * j)) = lo; }
        }
        __syncthreads();
        { f32x4 acc[2]; acc[0] = (f32x4){0.f, 0.f, 0.f, 0.f}; acc[1] = acc[0];
#pragma unroll
          for (int ks = 0; ks < 4; ++ks) { const int ko = r * HS + 32 * (4 * wave + ks) + 8 * g; const bf16x8 ah = *(const LAS bf16x8*)(hhi + ko), al = *(const LAS bf16x8*)(hlo + ko);
#pragma unroll
              for (int nt = 0; nt < 2; ++nt) { acc[nt] = mfma16(ah, bh[ks][nt], acc[nt]); acc[nt] = mfma16(ah, bl[ks][nt], acc[nt]); acc[nt] = mfma16(al, bh[ks][nt], acc[nt]); } }
          if (g < 2) {
#pragma unroll
              for (int nt = 0; nt < 2; ++nt)
#pragma unroll
                  for (int j = 0; j < 4; ++j) part[(wave * 8 + 4 * g + j) * 32 + 16 * nt + r] = acc[nt][j]; } }
        __syncthreads();
        if (tok < tok_hi) { const int ee = lane & 31; float lg = rbias;
#pragma unroll
            for (int w8 = 0; w8 < 8; ++w8) lg += part[(w8 * 8 + wave) * 32 + ee];
            float bv[4]; int bi[4];
#pragma unroll
            for (int rd = 0; rd < 4; ++rd) { float mv = lg; int mi = ee;
#pragma unroll
                for (int o = 1; o < 32; o <<= 1) { const float ov = __shfl_xor(mv, o); const int oi = __shfl_xor(mi, o); const bool take = (ov > mv) || (ov == mv && oi < mi); mv = take ? ov : mv; mi = take ? oi : mi; }
                bv[rd] = mv; bi[rd] = mi; lg = (ee == mi) ? -__builtin_inff() : lg; }
            if (lane == 0) { const float e1 = __expf(bv[1] - bv[0]), e2 = __expf(bv[2] - bv[0]), e3 = __expf(bv[3] - bv[0]); const float inv = 1.0f / (1.0f + e1 + e2 + e3);
                const int l0 = __hip_atomic_fetch_add(&lcnt[bi[0]], 1, __ATOMIC_RELAXED, __HIP_MEMORY_SCOPE_WORKGROUP), l1 = __hip_atomic_fetch_add(&lcnt[bi[1]], 1, __ATOMIC_RELAXED, __HIP_MEMORY_SCOPE_WORKGROUP), l2 = __hip_atomic_fetch_add(&lcnt[bi[2]], 1, __ATOMIC_RELAXED, __HIP_MEMORY_SCOPE_WORKGROUP), l3 = __hip_atomic_fetch_add(&lcnt[bi[3]], 1, __ATOMIC_RELAXED, __HIP_MEMORY_SCOPE_WORKGROUP);
                *(int4*)(toke + tok * 4) = make_int4(bi[0], bi[1], bi[2], bi[3]); *(f32x4*)(tokg + tok * 4) = (f32x4){inv, e1 * inv, e2 * inv, e3 * inv}; *(int4*)(toklr + tok * 4) = make_int4(l0, l1, l2, l3); } }
        __syncthreads();
    }
    if (tid < 32) { unsigned* gc = (unsigned*)(C.ws + WS_CTL) + CW_CNT + cnt_off + l * 32 + tid;
        const unsigned bb = __hip_atomic_fetch_add(gc, (unsigned)lcnt[tid], __ATOMIC_RELAXED, __HIP_MEMORY_SCOPE_AGENT);
        ((int*)(C.ws + WS_BBASE))[C.blk * 32 + tid] = (int)bb; }
    __syncthreads();
}
__device__ __forceinline__ void permute_phase(const Params& P, const Ctx& C, int l) {
    const int tid = C.tid, wave = C.wave, lane = C.lane;
    LAS int* pst = (LAS int*)C.lds;
    if (tid == 0) { const unsigned* gc = (const unsigned*)(C.ws + WS_CTL) + CW_CNT + l * 32; int ps = 0;
        for (int e = 0; e < 32; ++e) { pst[e] = ps; ps += ((int)__hip_atomic_load(gc + e, __ATOMIC_RELAXED, __HIP_MEMORY_SCOPE_AGENT) + 255) & ~255; } }
    __syncthreads();
    const int tpb = (MTOK + C.G - 1) / C.G, tok_lo = C.blk * tpb, tok_hi = (tok_lo + tpb < MTOK) ? tok_lo + tpb : MTOK;
    const int* toke = (const int*)(C.ws + WS_TOKE); const float* tokg = (const float*)(C.ws + WS_TOKG); const int* toklr = (const int*)(C.ws + WS_TOKLR); const int* bbase = (const int*)(C.ws + WS_BBASE) + C.blk * 32;
    const bf16_t* hb = (const bf16_t*)(C.ws + WS_HB); bf16_t* xp = (bf16_t*)(C.ws + WS_XPERM); int* pdest = (int*)(C.ws + WS_PDEST); float* pgate = (float*)(C.ws + WS_PGATE);
    int* ptok = (int*)(C.ws + WS_PTOK);
    for (int a = tid; a < 4 * (tok_hi - tok_lo); a += 512) { const int tok = tok_lo + (a >> 2), as = tok * 4 + (a & 3);
        const int e = toke[as]; const int pos = pst[e] + bbase[e] + toklr[as];
        pdest[pos] = as; pgate[pos] = tokg[as]; ptok[pos] = tok; }
    __syncthreads();
}
__device__ __forceinline__ void build_tile_e(const Ctx& C, int l) {
    LAS int* te = (LAS int*)(C.lds + TILEE_OFF);
    if (C.tid == 0) { const unsigned* gc = (const unsigned*)(C.ws + WS_CTL) + CW_CNT + l * 32; int t = 0;
        for (int e = 0; e < 32; ++e) { const int nt = ((int)__hip_atomic_load(gc + e, __ATOMIC_RELAXED, __HIP_MEMORY_SCOPE_AGENT) + 255) >> 8; for (int k = 0; k < nt && t < NT_MAX; ++k) te[t++] = e; }
        for (; t < NT_MAX; ++t) te[t] = 0; }
    __syncthreads();
}
__device__ __forceinline__ void combine_ln2_phase(const Params& P, const Ctx& C, int l) {
    const int lane = C.lane; const int gw = C.blk * 8 + C.wave, NGW = C.G * 8;
    const bool last = (l == NLAYER - 1);
    LAS float* wg = (LAS float*)C.lds;
    if (!last) load_wg(wg, P.in[I_WIN] + (size_t)(l + 1) * DM * CIN, C.tid);
    const bf16_t* yb = (const bf16_t*)(C.ws + WS_YB);
    float* hf = P.out; bf16_t* hb = (bf16_t*)(C.ws + WS_HB); float* pg = (float*)(C.ws + WS_PG);
    const f32x4* lw4 = (const f32x4*)(P.in[I_LN2W] + (size_t)l * DM) + lane; const f32x4* lb4 = (const f32x4*)(P.in[I_LN2B] + (size_t)l * DM) + lane;
    u32x2 nh[4], ny[4][4];
    { const int tok = (gw < MTOK) ? gw : 0; const u32x2* xr = (const u32x2*)(hb + (size_t)tok * DM) + lane;
#pragma unroll
      for (int j = 0; j < 4; ++j) nh[j] = xr[64 * j];
#pragma unroll
      for (int sl = 0; sl < 4; ++sl) { const u32x2* yr = (const u32x2*)(yb + (size_t)(tok * 4 + sl) * DM) + lane;
#pragma unroll
          for (int j = 0; j < 4; ++j) ny[sl][j] = yr[64 * j]; } }
    for (int tok = gw; tok < MTOK; tok += NGW) {
        f32x4 v[4]; float s = 0.f;
#pragma unroll
        for (int j = 0; j < 4; ++j) { v[j] = (f32x4){bflo(nh[j][0]), bfhi(nh[j][0]), bflo(nh[j][1]), bfhi(nh[j][1])} * DN_ALPHA;
#pragma unroll
            for (int sl = 0; sl < 4; ++sl) { const u32x2 w = ny[sl][j]; v[j][0] += bflo(w[0]); v[j][1] += bfhi(w[0]); v[j][2] += bflo(w[1]); v[j][3] += bfhi(w[1]); } }
        { const int tn = (tok + NGW < MTOK) ? tok + NGW : tok; const u32x2* xr = (const u32x2*)(hb + (size_t)tn * DM) + lane;
#pragma unroll
          for (int j = 0; j < 4; ++j) nh[j] = xr[64 * j];
#pragma unroll
          for (int sl = 0; sl < 4; ++sl) { const u32x2* yr = (const u32x2*)(yb + (size_t)(tn * 4 + sl) * DM) + lane;
#pragma unroll
              for (int j = 0; j < 4; ++j) ny[sl][j] = yr[64 * j]; } }
#pragma unroll
        for (int j = 0; j < 4; ++j) s += (v[j][0] + v[j][1]) + (v[j][2] + v[j][3]);
        const float mean = wave_sum(s) * (1.f / DM); float s2 = 0.f;
#pragma unroll
        for (int j = 0; j < 4; ++j) { v[j] = v[j] - mean; s2 += (v[j][0] * v[j][0] + v[j][1] * v[j][1]) + (v[j][2] * v[j][2] + v[j][3] * v[j][3]); }
        const float rstd = rsqrtf(wave_sum(s2) * (1.f / DM) + LN_EPS);
#pragma unroll
        for (int j = 0; j < 4; ++j) v[j] = v[j] * rstd * lw4[64 * j] + lb4[64 * j];
        if (last) { f32x4* of = (f32x4*)(hf + (size_t)tok * DM) + lane;
#pragma unroll
            for (int j = 0; j < 4; ++j) of[64 * j] = v[j]; }
        if (!last) { u32x2* ob = (u32x2*)(hb + (size_t)tok * DM) + lane;
#pragma unroll
            for (int j = 0; j < 4; ++j) ob[64 * j] = (u32x2){pk2(v[j][0], v[j][1]), pk2(v[j][2], v[j][3])};
            gate_cols(v, wg, P.in[I_BIN] + (size_t)(l + 1) * CIN + NPROJ, pg + (size_t)tok * 8, lane); }
    }
}

typedef const __attribute__((address_space(4))) Params* CParamsPtr;
__device__ __forceinline__ const Params* kparams() {
    const unsigned long long a = (unsigned long long)__builtin_amdgcn_kernarg_segment_ptr(); unsigned lo = (unsigned)a, hi = (unsigned)(a >> 32);
    asm volatile("" : "+v"(lo), "+v"(hi));
    lo = __builtin_amdgcn_readfirstlane(lo); hi = __builtin_amdgcn_readfirstlane(hi);
    return (const Params*)(CParamsPtr)(((unsigned long long)hi << 32) | lo);
}
__device__ __forceinline__ Ctx make_ctx(const Params& P, LAS unsigned char* lds, int wv0) {
    Ctx C; C.lds = lds; unsigned ones_ = ~0u; asm volatile("" : "+s"(ones_)); int t_ = wv0 * 64 + (int)__builtin_amdgcn_mbcnt_hi(ones_, __builtin_amdgcn_mbcnt_lo(ones_, 0u)), b_ = blockIdx.x, g_ = gridDim.x; asm volatile("" : "+v"(t_), "+v"(b_), "+v"(g_)); b_ = __builtin_amdgcn_readfirstlane(b_); g_ = __builtin_amdgcn_readfirstlane(g_);
    C.tid = t_; C.lane = C.tid & 63; C.wave = __builtin_amdgcn_readfirstlane(C.tid >> 6); C.blk = b_; C.G = g_; C.ws = P.ws; return C; }
__global__ void __launch_bounds__(512, 2) hybrid_fwd(Params Punused) {
    extern __shared__ __attribute__((aligned(16))) unsigned char lds_raw[];
    LAS unsigned char* const lds = (LAS unsigned char*)lds_raw;
    const int wv0 = __builtin_amdgcn_readfirstlane((int)threadIdx.x >> 6);
    volatile LAS unsigned* MISC = (volatile LAS unsigned*)(lds + MISC_OFF);
    for (int u = threadIdx.x; u < (LDS_BYTES - MISC_OFF) / 4; u += 512) MISC[u] = 0u;
    __syncthreads();
    const int lo = __builtin_amdgcn_readfirstlane(kparams()->ph_lo), hi = __builtin_amdgcn_readfirstlane(kparams()->ph_hi);
    #define IS_T0 (wv0 == 0 && __builtin_amdgcn_mbcnt_hi(~0u, __builtin_amdgcn_mbcnt_lo(~0u, 0u)) == 0u)
    if (hi - lo > 1) (void)xcd_barrier_post((unsigned*)(kparams()->ws + WS_CTL) + CW_BAR, MISC + 8, IS_T0);
#ifndef PHMASK
#define PHMASK 0x7ff
#endif
#define PH_EN(k) (((PHMASK) >> (k)) & 1)
#define RUN(gid) ((gid) >= lo && (gid) < hi)
#define SEAM(gid) do { if ((gid) + 1 < hi) { XcdBarrier bar_; bar_.bar = (unsigned*)(kparams()->ws + WS_CTL) + CW_BAR; bar_.x = xb_xcc_id(); bar_.st = (volatile LAS unsigned*)(lds + MISC_OFF) + 8; xcd_barrier(bar_, IS_T0); if (DUPBAR) xcd_barrier(bar_, IS_T0); } } while (0)
#ifndef DUPMASK
#define DUPMASK 0
#endif
#ifndef DUPBAR
#define DUPBAR 0
#endif
#define DUP(k) for (int rep_ = 0; rep_ < 1 + (((DUPMASK) >> (k)) & 1); ++rep_)
#define PHASE_BEGIN const Params& P = *kparams(); const Ctx C = make_ctx(P, lds, wv0);
    if (PH_EN(0) && RUN(0)) { DUP(0) { PHASE_BEGIN p0_prologue(P, C); } SEAM(0); }
#pragma unroll 1
    for (int l = 0; l < NLAYER; ++l) {
        const int g0 = 1 + l * NPH;
        if (g0 + NPH <= lo || g0 >= hi) continue;
        if (PH_EN(1) && RUN(g0 + 0)) {
            DUP(1) { PHASE_BEGIN
            pg8::Gemm g{(const bf16_t*)(C.ws + WS_HB), (const bf16_t*)(C.ws + WS_WIN) + (size_t)l * NPROJ * DM, MTOK, NPROJ, DM}; pg8::StaticOrder S; S.init(MTOK, NPROJ, C.G, C.blk);
            pg8::EpiBf16b E{(bf16_t*)(C.ws + WS_P), NPROJ, P.in[I_BIN] + (size_t)l * CIN};
            pg8::gemm_phase<pg8::EpiBf16b, pg8::StaticOrder>(C.lds, g, S, E, nullptr, C.tid); }
            SEAM(g0 + 0); }
        if (PH_EN(2) && RUN(g0 + 1)) {
            DUP(2) { PHASE_BEGIN
            constexpr int NU_SWA = 512, NU_RW = NB * 128 * 6, NU_ML = NB * 128 * 4;
#ifndef DUP2
#define DUP2 0
#endif
            for (int rp = 0; rp < 1 + ((DUP2 >> 1) & 1); ++rp) for (int cb = C.blk; cb < NB * 128; cb += C.G)
                for (int hh_ = 0; hh_ < 6; ++hh_) { rwb_unit(P, C, l, cb * 6 + hh_, hh_ != 0); if (hh_ == 0) { asm volatile("s_waitcnt vmcnt(0)" ::: "memory"); __syncthreads(); } }
            for (int rp = 0; rp < 1 + ((DUP2 >> 2) & 1); ++rp) for (int u = C.blk; u < NU_ML; u += C.G) mlb_unit(P, C, l, u); }
            SEAM(g0 + 1); }
        if (PH_EN(3) && RUN(g0 + 2)) {
            DUP(3) { PHASE_BEGIN
            {
#ifndef P3DUP
#define P3DUP 0
#endif
                if (C.blk < 48) { for (int rp = 0; rp < 1 + (P3DUP & 1); ++rp) { rwkv_chain(C, C.blk >> 1, C.blk & 1); __syncthreads(); } } else if (C.blk < 112) { for (int rp = 0; rp < 1 + ((P3DUP >> 1) & 1); ++rp) { mlstm_cscan(C, (C.blk - 48) >> 2, (C.blk - 48) & 3); __syncthreads(); } }
                LAS int* qslot = (LAS int*)(C.lds + MISC_OFF + 64); unsigned* qctr = (unsigned*)(C.ws + WS_CTL) + CW_SWAQ + l * 64;
                for (;;) { __syncthreads();
                    if (C.tid == 0) *qslot = (int)__hip_atomic_fetch_add(qctr, 1u, __ATOMIC_RELAXED, __HIP_MEMORY_SCOPE_AGENT);
                    __syncthreads();
                    const int u = *qslot; if (u >= 512) break;
                    swa_unit(P, C, l, u); } } }
            SEAM(g0 + 2); }
        if (PH_EN(4) && RUN(g0 + 3)) {
            DUP(4) { PHASE_BEGIN
            for (int u = C.blk; u < NB * 128; u += C.G) passd_unit(P, C, l, u); }
            SEAM(g0 + 3); }
        if (PH_EN(5) && RUN(g0 + 4)) {
            DUP(5) { PHASE_BEGIN
            pg8::Gemm g{(const bf16_t*)(C.ws + WS_YMIX), (const bf16_t*)(C.ws + WS_WOUT) + (size_t)l * DM * DM, MTOK, DM, DM}; pg8::StaticOrder S; S.init(MTOK, DM, C.G, C.blk);
            pg8::EpiPlainBf16 E{(bf16_t*)(C.ws + WS_T1), DM};
            pg8::gemm_phase<pg8::EpiPlainBf16, pg8::StaticOrder>(C.lds, g, S, E, nullptr, C.tid); }
            SEAM(g0 + 4); }
        if (PH_EN(6) && RUN(g0 + 5)) { DUP(6) { PHASE_BEGIN ln1_router_phase(P, C, l, (rep_ + 1 < 1 + (((DUPMASK) >> 6) & 1)) ? 512 : 0); } SEAM(g0 + 5); }
        if (PH_EN(7) && RUN(g0 + 6)) { DUP(7) { PHASE_BEGIN permute_phase(P, C, l); } SEAM(g0 + 6); }
        if (PH_EN(8) && RUN(g0 + 7)) {
            DUP(8) { PHASE_BEGIN
            build_tile_e(C, l);
            pg8::Gemm g{(const bf16_t*)(C.ws + WS_HB), (const bf16_t*)(C.ws + WS_WUP) + (size_t)l * NEXP * NUP * DM, POS_MAX, NUP, DM};
            pg8::MoeOrder<8> S{(const LAS int*)(C.lds + TILEE_OFF), C.G, C.blk, (const int*)(C.ws + WS_PTOK)};
            pg8::EpiSwiglu E{(bf16_t*)(C.ws + WS_ACT), P.in[I_EBUP] + (size_t)l * NEXP * NUP};
            pg8::gemm_phase<pg8::EpiSwiglu, pg8::MoeOrder<8>, false, true>(C.lds, g, S, E, nullptr, C.tid); }
            SEAM(g0 + 7); }
        if (PH_EN(9) && RUN(g0 + 8)) {
            DUP(9) { PHASE_BEGIN
            build_tile_e(C, l);
            pg8::Gemm g{(const bf16_t*)(C.ws + WS_ACT), (const bf16_t*)(C.ws + WS_WDN) + (size_t)l * NEXP * DM * DEXP, POS_MAX, DM, DEXP};
            pg8::MoeOrder<4> S{(const LAS int*)(C.lds + TILEE_OFF), C.G, C.blk, nullptr};
            pg8::EpiDown E{(bf16_t*)(C.ws + WS_YB), P.in[I_EBDN] + (size_t)l * NEXP * DM, (const int*)(C.ws + WS_PDEST), (const float*)(C.ws + WS_PGATE)};
            pg8::gemm_phase<pg8::EpiDown, pg8::MoeOrder<4>>(C.lds, g, S, E, nullptr, C.tid); }
            SEAM(g0 + 8); }
        if (PH_EN(10) && RUN(g0 + 9)) { DUP(10) { PHASE_BEGIN combine_ln2_phase(P, C, l); } SEAM(g0 + 9); }
    }
#undef RUN
#undef SEAM
}

#ifndef MK_PER_PHASE
#define MK_PER_PHASE 0
#endif
extern "C" void kernel_launch(void* const* d_in, const int* in_sizes, int n_in, void* d_out, int out_size, void* d_ws, size_t ws_size, hipStream_t stream) {
    static int grid = 0;
    if (grid == 0) {
        if (n_in != 29 || out_size != MTOK * DM || ws_size < WS_END) { fprintf(stderr, "kernel_launch: unexpected shapes (n_in %d out %d ws %zu)\n", n_in, out_size, ws_size); grid = -1; return; }
        int dev = 0, cus = 0;
        if (hipGetDevice(&dev) != hipSuccess || hipDeviceGetAttribute(&cus, hipDeviceAttributeMultiprocessorCount, dev) != hipSuccess) { grid = -1; return; }
        if (hipFuncSetAttribute((const void*)hybrid_fwd, hipFuncAttributeMaxDynamicSharedMemorySize, LDS_BYTES) != hipSuccess) { fprintf(stderr, "kernel_launch: hipFuncSetAttribute failed\n"); grid = -1; return; }
        int per_cu = 0;
        if (hipOccupancyMaxActiveBlocksPerMultiprocessor(&per_cu, (const void*)hybrid_fwd, 512, LDS_BYTES) != hipSuccess || per_cu < 1) { fprintf(stderr, "kernel_launch: occupancy query says %d\n", per_cu); }
        (void)hipGetLastError();
        grid = cus;
    }
    if (grid < 0) return;
    (void)hipMemsetAsync((char*)d_ws + WS_CTL, 0, CTL_ZERO_BYTES, stream);
    Params p; memset(&p, 0, sizeof(p));
    for (int i = 0; i < 29; ++i) p.in[i] = (const float*)d_in[i];
    p.out = (float*)d_out; p.ws = (unsigned char*)d_ws;
#if MK_PER_PHASE
    for (int ph = 0; ph < NPHASE_TOTAL; ++ph) { p.ph_lo = ph; p.ph_hi = ph + 1; hipLaunchKernelGGL(hybrid_fwd, dim3(grid), dim3(512), LDS_BYTES, stream, p); }
#else
    p.ph_lo = 0; p.ph_hi = NPHASE_TOTAL;
    hipLaunchKernelGGL(hybrid_fwd, dim3(grid), dim3(512), LDS_BYTES, stream, p);
#endif
}
```

```cpp
#include <hip/hip_runtime.h>
#include <cstdio>
#include <cstdint>
#include <cstring>

#define GAS __attribute__((address_space(1)))
#define LAS __attribute__((address_space(3)))
typedef float f32x2 __attribute__((ext_vector_type(2)));
typedef unsigned u32x2 __attribute__((ext_vector_type(2)));

namespace pg8 {
constexpr int EPI_BTAB = 140288, EPI_DTAB = 138240, EPI_GTAB = 139264;
#define PG8_LAS __attribute__((address_space(3)))
typedef unsigned short bf16_t;
typedef short bf16x8 __attribute__((ext_vector_type(8)));
typedef float f32x4 __attribute__((ext_vector_type(4)));
typedef unsigned u32x4 __attribute__((ext_vector_type(4)));
constexpr int BM = 256, BK = 64, HALF = 128, HTB = HALF * BK * 2  , STAGE_BYTES = 8 * HTB, NXCD = 8, WGM = 8;

__host__ __device__ __forceinline__ int lds_byte(int r, int c) { const int st = (r >> 4) * 2 + (c >> 5), rr = r & 15, cc = c & 31, ob = rr * 64 + cc * 2; return st * 1024 + (ob ^ (((ob >> 9) & 1) << 5)); }
__host__ __device__ __forceinline__ void stage_rc(int b, int& R, int& C) { const int st = b / 1024, sb = b % 1024, swz = sb ^ (((sb >> 9) & 1) << 5); R = (st >> 1) * 16 + swz / 64; C = (st & 1) * 32 + (swz % 64) / 2; }
__host__ __device__ __forceinline__ int perm32(int rho) { const int n = rho >> 4, i = rho & 15; return 8 * (i >> 2) + 4 * n + (i & 3); }

struct Unit { int pm, pn; };
struct Gemm { const bf16_t* A; const bf16_t* Bt; int M, N, K; };

struct StaticOrder {
    int nM, nN, nwg, G, c;
    __host__ __device__ void init(int M, int N, int G_, int c_) { nM = M / BM; nN = N / BM; nwg = nM * nN; G = G_; c = c_; }
    __host__ __device__ bool next(int i, Unit& u) const {
        const long L = (long)i * G + c; if (L >= nwg) return false;
        int wgid = (int)L; { const int q = nwg / NXCD, r = nwg % NXCD, xcd = wgid % NXCD, off = wgid / NXCD; wgid = (xcd < r ? xcd * (q + 1) : r * (q + 1) + (xcd - r) * q) + off; }
        const int nig = WGM * nN, gid = wgid / nig, fm = gid * WGM, gsz = (nM - fm) < WGM ? (nM - fm) : WGM;
        u.pm = fm + ((wgid % nig) % gsz); u.pn = (wgid % nig) / gsz; return true;
    }
    __device__ __forceinline__ void a_ready(const Unit&) const {}
    __device__ __forceinline__ void done(const Unit&) const {}
};
template <int NN> struct MoeOrder {
    const PG8_LAS int* tile_e; int G, c; const int* rowtok;
    __device__ __forceinline__ bool next(int i, Unit& u) const {
        const int s = i * G + c; if (s >= 544 * NN) return false;
        constexpr int per = 8 * NN; const int a = s / per, r = s % per, b = r >> 3, x = r & 7;
        const int pm = 68 * x + a; u.pm = pm; u.pn = tile_e[pm] * NN + b; return true;
    }
    __device__ __forceinline__ void a_ready(const Unit&) const {}
    __device__ __forceinline__ void done(const Unit&) const {}
};

__device__ __forceinline__ unsigned cvt_pk_bf16(float lo, float hi) { unsigned r; asm volatile("v_cvt_pk_bf16_f32 %0, %1, %2" : "=v"(r) : "v"(lo), "v"(hi)); return r; }

struct EpiBf16b {
    static constexpr bool PERM = true, AFTER_DRAIN = false;
    bf16_t* O; int ldc; const float* bias;
    __device__ __forceinline__ void prefetch(PG8_LAS unsigned char* lds, const Unit& u, int wid, int lane) const {
        if (wid < 4) __builtin_amdgcn_global_load_lds((const unsigned*)(bias + u.pn * BM + 64 * wid + lane), (PG8_LAS unsigned*)(lds + EPI_BTAB + wid * 256), 4, 0, 0); }
    __device__ __forceinline__ void operator()(const f32x4 (&acc)[2][2][4][2], const Unit& u, int wr, int wc, int fr, int fq, PG8_LAS unsigned char* lds) const {
        const int row0 = u.pm * BM + wr * 64 + fr; const int col0 = u.pn * BM + wc * 32 + 8 * fq;
        const PG8_LAS float* bt = (const PG8_LAS float*)(lds + EPI_BTAB) + wc * 32 + 8 * fq;
        f32x4 bv[2][2];
#pragma unroll
        for (int bj = 0; bj < 2; ++bj)
#pragma unroll
            for (int n = 0; n < 2; ++n) bv[bj][n] = *(const PG8_LAS f32x4*)(bt + bj * HALF + 4 * n);
#pragma unroll
        for (int ai = 0; ai < 2; ++ai)
#pragma unroll
            for (int m = 0; m < 4; ++m) { bf16_t* rowp = O + (size_t)(row0 + ai * HALF + m * 16) * ldc + col0;
#pragma unroll
                for (int bj = 0; bj < 2; ++bj) { const f32x4 v0 = acc[ai][bj][m][0] + bv[bj][0], v1 = acc[ai][bj][m][1] + bv[bj][1];
                    u32x4 w; w.x = cvt_pk_bf16(v0[0], v0[1]); w.y = cvt_pk_bf16(v0[2], v0[3]); w.z = cvt_pk_bf16(v1[0], v1[1]); w.w = cvt_pk_bf16(v1[2], v1[3]);
                    *(u32x4*)(rowp + bj * HALF) = w; } }
    }
};
struct EpiPlainBf16 {
    static constexpr bool PERM = true, AFTER_DRAIN = false;
    bf16_t* O; int ldc;
    __device__ __forceinline__ void prefetch(PG8_LAS unsigned char*, const Unit&, int, int) const {}
    __device__ __forceinline__ void operator()(const f32x4 (&acc)[2][2][4][2], const Unit& u, int wr, int wc, int fr, int fq, PG8_LAS unsigned char*) const {
        const int row0 = u.pm * BM + wr * 64 + fr, col0 = u.pn * BM + wc * 32 + 8 * fq;
#pragma unroll
        for (int ai = 0; ai < 2; ++ai)
#pragma unroll
            for (int m = 0; m < 4; ++m) { bf16_t* rowp = O + (size_t)(row0 + ai * HALF + m * 16) * ldc + col0;
#pragma unroll
                for (int bj = 0; bj < 2; ++bj) { const f32x4 v0 = acc[ai][bj][m][0], v1 = acc[ai][bj][m][1];
                    u32x4 w; w.x = cvt_pk_bf16(v0[0], v0[1]); w.y = cvt_pk_bf16(v0[2], v0[3]); w.z = cvt_pk_bf16(v1[0], v1[1]); w.w = cvt_pk_bf16(v1[2], v1[3]);
                    *(u32x4*)(rowp + bj * HALF) = w; } }
    }
};
struct EpiSwiglu {
    static constexpr bool PERM = true, AFTER_DRAIN = false;
    bf16_t* O; const float* bias;
    __device__ __forceinline__ void prefetch(PG8_LAS unsigned char* lds, const Unit& u, int wid, int lane) const {
        if (wid < 4) __builtin_amdgcn_global_load_lds((const unsigned*)(bias + u.pn * BM + 64 * wid + lane), (PG8_LAS unsigned*)(lds + EPI_BTAB + wid * 256), 4, 0, 0); }
    __device__ __forceinline__ void operator()(const f32x4 (&acc)[2][2][4][2], const Unit& u, int wr, int wc, int fr, int fq, PG8_LAS unsigned char* lds) const {
        const int row0 = u.pm * BM + wr * 64 + fr;
        const int ocol0 = ((u.pn & 7) * BM + wc * 32 + 8 * fq) >> 1;
        const PG8_LAS float* bt = (const PG8_LAS float*)(lds + EPI_BTAB) + wc * 32 + 8 * fq;
        f32x4 bv[2][2];
#pragma unroll
        for (int bj = 0; bj < 2; ++bj)
#pragma unroll
            for (int n = 0; n < 2; ++n) bv[bj][n] = *(const PG8_LAS f32x4*)(bt + bj * HALF + 4 * n);
        const bool oddrow = (fq & 1) != 0;
#pragma unroll
        for (int ai = 0; ai < 2; ++ai)
#pragma unroll
            for (int m = 0; m < 4; ++m) { bf16_t* rowp = O + (size_t)(row0 + ai * HALF + m * 16) * 1024 + ocol0;
                u32x2 w[2];
#pragma unroll
                for (int bj = 0; bj < 2; ++bj) { const f32x4 v0 = acc[ai][bj][m][0] + bv[bj][0], v1 = acc[ai][bj][m][1] + bv[bj][1];
                    float o[4];
#pragma unroll
                    for (int q = 0; q < 4; ++q) { const float gl = (q < 2) ? v0[2 * q] : v1[2 * q - 4], li = (q < 2) ? v0[2 * q + 1] : v1[2 * q - 3];
                        const float hg = fminf(gl, 7.0f), hl = fminf(fmaxf(li, -7.0f), 7.0f);
                        o[q] = hg * (hl + 1.0f) * __builtin_amdgcn_rcpf(1.0f + __expf(-1.702f * hg)); }
                    w[bj].x = cvt_pk_bf16(o[0], o[1]); w[bj].y = cvt_pk_bf16(o[2], o[3]); }
                { auto sx = __builtin_amdgcn_permlane16_swap(w[0].x, w[1].x, false, false); w[0].x = sx[0]; w[1].x = sx[1];
                  auto sy = __builtin_amdgcn_permlane16_swap(w[0].y, w[1].y, false, false); w[0].y = sy[0]; w[1].y = sy[1]; }
                u32x4 wv; wv.x = w[0].x; wv.y = w[0].y; wv.z = w[1].x; wv.w = w[1].y;
                *(u32x4*)(rowp + (oddrow ? (HALF / 2) - 4 : 0)) = wv; }
    }
};
struct EpiDown {
    static constexpr bool PERM = true, AFTER_DRAIN = false;
    bf16_t* O; const float* bias; const int* dest; const float* gate;
    __device__ __forceinline__ void prefetch(PG8_LAS unsigned char* lds, const Unit& u, int wid, int lane) const {
        if (wid < 4) { __builtin_amdgcn_global_load_lds((const unsigned*)(bias + u.pn * BM + 64 * wid + lane), (PG8_LAS unsigned*)(lds + EPI_BTAB + wid * 256), 4, 0, 0);
                       __builtin_amdgcn_global_load_lds((const unsigned*)(dest + u.pm * BM + 64 * wid + lane), (PG8_LAS unsigned*)(lds + EPI_DTAB + wid * 256), 4, 0, 0); }
        else __builtin_amdgcn_global_load_lds((const unsigned*)(gate + u.pm * BM + 64 * (wid - 4) + lane), (PG8_LAS unsigned*)(lds + EPI_GTAB + (wid - 4) * 256), 4, 0, 0); }
    __device__ __forceinline__ void operator()(const f32x4 (&acc)[2][2][4][2], const Unit& u, int wr, int wc, int fr, int fq, PG8_LAS unsigned char* lds) const {
        const int rloc = wr * 64 + fr;
        const int ocol0 = (u.pn & 3) * BM + wc * 32 + 8 * fq;
        const PG8_LAS float* bt = (const PG8_LAS float*)(lds + EPI_BTAB) + wc * 32 + 8 * fq; const PG8_LAS int* dt = (const PG8_LAS int*)(lds + EPI_DTAB); const PG8_LAS float* gtb = (const PG8_LAS float*)(lds + EPI_GTAB);
#pragma unroll
        for (int ai = 0; ai < 2; ++ai)
#pragma unroll
            for (int m = 0; m < 4; ++m) { const int pl = rloc + ai * HALF + m * 16; const int d = dt[pl]; const float gt = gtb[pl];
                if (d >= 0) { bf16_t* rowp = O + (size_t)d * 1024 + ocol0;
#pragma unroll
                    for (int bj = 0; bj < 2; ++bj) { const f32x4 b0 = *(const PG8_LAS f32x4*)(bt + bj * HALF), b1 = *(const PG8_LAS f32x4*)(bt + bj * HALF + 4); const f32x4 v0 = (acc[ai][bj][m][0] + b0) * gt, v1 = (acc[ai][bj][m][1] + b1) * gt;
                        u32x4 w; w.x = cvt_pk_bf16(v0[0], v0[1]); w.y = cvt_pk_bf16(v0[2], v0[3]); w.z = cvt_pk_bf16(v1[0], v1[1]); w.w = cvt_pk_bf16(v1[2], v1[3]);
                        *(u32x4*)(rowp + bj * HALF) = w; } } }
    }
};

template <class Epi, class Sched, bool STAMP = false, bool GATHER = false>
__device__ __forceinline__ void gemm_phase(PG8_LAS unsigned char* lds, const Gemm g, const Sched& S, const Epi& E, unsigned long long* stamps, const int tid_in) {
    const int tid = tid_in, wid = __builtin_amdgcn_readfirstlane(tid >> 6), lane = tid & 63, wr = wid >> 2, wc = wid & 3, fr = lane & 15, fq = lane >> 4;
    const int K = g.K, nt = K / BK;
    int ts_lo = 0, ts_hi = 0, nts = 0; const unsigned long long rt_entry = STAMP ? (unsigned long long)wall_clock64() : 0ull;
#define PG8_STAMP() do { if (STAMP && wid == 0 && nts < 64) { const unsigned long long _c = (unsigned long long)clock64(); \
        ts_lo = (lane == nts) ? (int)(unsigned)_c : ts_lo; ts_hi = (lane == nts) ? (int)(unsigned)(_c >> 32) : ts_hi; ++nts; } } while (0)
    PG8_STAMP();
    unsigned voffA[2], voffB[2];
#pragma unroll
    for (int i = 0; i < 2; ++i) { int R, C; stage_rc(tid * 16 + i * 8192, R, C); const int Rb = Epi::PERM ? ((R & ~31) + perm32(R & 31)) : R;
        voffA[i] = (unsigned)(R * K + C) * 2u; voffB[i] = (unsigned)(Rb * K + C) * 2u; }
    unsigned gc[2][2], gn[2][2];
    PG8_LAS int* rowtab = (PG8_LAS int*)(lds + 137216);
    const size_t kstep = (size_t)(BK * 2);
    const size_t hstep = (size_t)HALF * K * 2;
    const size_t tstep = 2 * hstep;
    const unsigned ldsw = (unsigned)wid * 1024u;
    const int aoff = lds_byte(wr * 64 + fr, fq * 8), boff = lds_byte(wc * 32 + fr, fq * 8);
#define PG8_SA(b, h) (((b) * 2 + (h)) * HTB)
#define PG8_SB(b, h) ((4 + (b) * 2 + (h)) * HTB)
#define PG8_STAGE(bufoff, gbase, voff) do { _Pragma("unroll") for (int _i = 0; _i < 2; ++_i) \
        __builtin_amdgcn_global_load_lds((const unsigned*)((const char*)(gbase) + (voff)[_i]), (PG8_LAS unsigned*)(lds + (bufoff) + ldsw + _i * 8192), 16, 0, 0); } while (0)
#define PG8_LDA(dst, b, h) do { _Pragma("unroll") for (int m = 0; m < 4; ++m) _Pragma("unroll") for (int k = 0; k < 2; ++k) dst[m][k] = *(const PG8_LAS bf16x8*)(lds + PG8_SA(b, h) + aoff + m * 2048 + k * 1024); } while (0)
#define PG8_LDB(dst, b, h) do { _Pragma("unroll") for (int n = 0; n < 2; ++n) _Pragma("unroll") for (int k = 0; k < 2; ++k) dst[n][k] = *(const PG8_LAS bf16x8*)(lds + PG8_SB(b, h) + boff + n * 2048 + k * 1024); } while (0)
#define PG8_MMA(ai, bj, At, Bt) do { __builtin_amdgcn_s_setprio(1); _Pragma("unroll") for (int m = 0; m < 4; ++m) _Pragma("unroll") for (int n = 0; n < 2; ++n) _Pragma("unroll") for (int k = 0; k < 2; ++k) \
        acc[ai][bj][m][n] = __builtin_amdgcn_mfma_f32_16x16x32_bf16(Bt[n][k], At[m][k], acc[ai][bj][m][n], 0, 0, 0); __builtin_amdgcn_s_setprio(0); } while (0)
#define PG8_WAIT_V(n) asm volatile("s_waitcnt vmcnt(" #n ")" ::: "memory")
#define PG8_WAIT_L(n) asm volatile("s_waitcnt lgkmcnt(" #n ")" ::: "memory")
#define PG8_BAR __builtin_amdgcn_s_barrier()
#define PG8_SCHED __builtin_amdgcn_sched_barrier(0)
    Unit cur, nxt; int ui = 0;
    if (!S.next(0, cur)) return;
    f32x4 acc[2][2][4][2];
#pragma unroll
    for (int a = 0; a < 2; ++a)
#pragma unroll
        for (int b = 0; b < 2; ++b)
#pragma unroll
            for (int m = 0; m < 4; ++m)
#pragma unroll
                for (int n = 0; n < 2; ++n) acc[a][b][m][n] = (f32x4){0.f, 0.f, 0.f, 0.f};
    bf16x8 At[4][2], B0[2][2], B1[2][2];
    const char* cA = GATHER ? (const char*)g.A : (const char*)g.A + (size_t)cur.pm * tstep; const char* cB = (const char*)g.Bt + (size_t)cur.pn * tstep;
    if constexpr (GATHER) {
#pragma unroll
        for (int h = 0; h < 2; ++h)
#pragma unroll
            for (int i = 0; i < 2; ++i) { int R, C; stage_rc(tid * 16 + i * 8192, R, C); gc[h][i] = (unsigned)S.rowtok[256 * cur.pm + 128 * h + R] * (unsigned)(K * 2) + (unsigned)(C * 2); gn[h][i] = gc[h][i]; } }
    S.a_ready(cur);
    PG8_STAGE(PG8_SB(0, 0), cB, voffB); if constexpr (GATHER) PG8_STAGE(PG8_SA(0, 0), cA, gc[0]); else PG8_STAGE(PG8_SA(0, 0), cA, voffA); PG8_STAGE(PG8_SB(0, 1), cB + hstep, voffB); if constexpr (GATHER) PG8_STAGE(PG8_SA(0, 1), cA, gc[1]); else PG8_STAGE(PG8_SA(0, 1), cA + hstep, voffA);
    if (wr == 1) PG8_BAR;
    PG8_WAIT_V(4); PG8_BAR;
    PG8_STAGE(PG8_SB(1, 0), cB + kstep, voffB); if constexpr (GATHER) PG8_STAGE(PG8_SA(1, 0), cA + kstep, gc[0]); else PG8_STAGE(PG8_SA(1, 0), cA + kstep, voffA); PG8_STAGE(PG8_SB(1, 1), cB + hstep + kstep, voffB);
    PG8_WAIT_V(6); PG8_BAR;
    PG8_STAMP();
    for (;;) {
        const bool has_next = S.next(ui + 1, nxt);
        const char* nA = GATHER ? cA : (has_next ? (const char*)g.A + (size_t)nxt.pm * tstep : cA); const char* nB = has_next ? (const char*)g.Bt + (size_t)nxt.pn * tstep : cB;
        for (int t = 0; t < nt; t += 2) {
            const bool last = (t == nt - 2);
            const char* a1 = cA + (size_t)(t + 1) * kstep;
            const char* a2 = last ? nA : cA + (size_t)(t + 2) * kstep; const char* b2 = last ? nB : cB + (size_t)(t + 2) * kstep;
            const char* a3 = a2 + kstep; const char* b3 = b2 + kstep;
            if (last && has_next) S.a_ready(nxt);
            if (t == nt - 4) { int ln_ = lane; asm volatile("" : "+v"(ln_)); E.prefetch(lds, cur, wid, ln_); }
            if constexpr (GATHER) {
                if (t == nt - 4 && has_next && wid < 4)
                    __builtin_amdgcn_global_load_lds((const unsigned*)(S.rowtok + 256 * nxt.pm + 64 * wid + lane), (PG8_LAS unsigned*)((PG8_LAS unsigned char*)rowtab + wid * 256), 4, 0, 0);
                if (last && has_next) { int tz = tid; asm volatile("" : "+v"(tz));
#pragma unroll
                    for (int h = 0; h < 2; ++h)
#pragma unroll
                        for (int i = 0; i < 2; ++i) { int R, C; stage_rc(tz * 16 + i * 8192, R, C); gn[h][i] = (unsigned)rowtab[128 * h + R] * (unsigned)(K * 2) + (unsigned)(C * 2); } } }
            unsigned g0x[2], g1x[2];
#pragma unroll
            for (int i = 0; i < 2; ++i) { g0x[i] = last ? gn[0][i] : gc[0][i]; g1x[i] = last ? gn[1][i] : gc[1][i]; }
            PG8_LDB(B0, 0, 0); PG8_SCHED; PG8_LDA(At, 0, 0); if constexpr (GATHER) PG8_STAGE(PG8_SA(1, 1), a1, gc[1]); else PG8_STAGE(PG8_SA(1, 1), a1 + hstep, voffA);
            PG8_WAIT_L(8); PG8_BAR; PG8_WAIT_L(0); PG8_MMA(0, 0, At, B0); PG8_BAR; PG8_SCHED;
            PG8_LDB(B1, 0, 1); PG8_STAGE(PG8_SB(0, 0), b2, voffB);
            PG8_BAR; PG8_WAIT_L(0); PG8_MMA(0, 1, At, B1); PG8_BAR;
            PG8_LDA(At, 0, 1); if constexpr (GATHER) PG8_STAGE(PG8_SA(0, 0), a2, g0x); else PG8_STAGE(PG8_SA(0, 0), a2, voffA);
            PG8_BAR; PG8_WAIT_L(0); PG8_MMA(1, 0, At, B0); PG8_BAR; PG8_SCHED;
            PG8_STAGE(PG8_SB(0, 1), b2 + hstep, voffB);
            PG8_WAIT_V(6); PG8_BAR; PG8_MMA(1, 1, At, B1); PG8_BAR;
            PG8_LDB(B0, 1, 0); PG8_SCHED; PG8_LDA(At, 1, 0); if constexpr (GATHER) PG8_STAGE(PG8_SA(0, 1), a2, g1x); else PG8_STAGE(PG8_SA(0, 1), a2 + hstep, voffA);
            PG8_WAIT_L(8); PG8_BAR; PG8_WAIT_L(0); PG8_MMA(0, 0, At, B0); PG8_BAR; PG8_SCHED;
            PG8_LDB(B1, 1, 1); PG8_STAGE(PG8_SB(1, 0), b3, voffB);
            PG8_BAR; PG8_WAIT_L(0); PG8_MMA(0, 1, At, B1); PG8_BAR;
            PG8_LDA(At, 1, 1); if constexpr (GATHER) PG8_STAGE(PG8_SA(1, 0), a3, g0x); else PG8_STAGE(PG8_SA(1, 0), a3, voffA);
            PG8_BAR; PG8_WAIT_L(0); PG8_MMA(1, 0, At, B0); PG8_BAR; PG8_SCHED;
            PG8_STAGE(PG8_SB(1, 1), b3 + hstep, voffB);
            PG8_WAIT_V(6); PG8_BAR; PG8_MMA(1, 1, At, B1); PG8_BAR;
        }
        PG8_STAMP();
        if constexpr (!Epi::AFTER_DRAIN) { E(acc, cur, wr, wc, fr, fq, lds); S.done(cur); }
        PG8_STAMP();
        if (!has_next) break;
#pragma unroll
        for (int a = 0; a < 2; ++a)
#pragma unroll
            for (int b = 0; b < 2; ++b)
#pragma unroll
                for (int m = 0; m < 4; ++m)
#pragma unroll
                    for (int n = 0; n < 2; ++n) acc[a][b][m][n] = (f32x4){0.f, 0.f, 0.f, 0.f};
        cur = nxt; cA = nA; cB = nB; ++ui;
        if constexpr (GATHER) {
#pragma unroll
            for (int h = 0; h < 2; ++h)
#pragma unroll
                for (int i = 0; i < 2; ++i) gc[h][i] = gn[h][i]; }
    }
    PG8_WAIT_V(0);
    if (wr == 0) PG8_BAR;
    PG8_BAR;
    if constexpr (Epi::AFTER_DRAIN) { E.fused(acc, cur, wr, wc, fr, fq, lds, wid, lane); S.done(cur); }
    PG8_STAMP();
    if (STAMP && wid == 0) { stamps[lane] = lane < nts ? (((unsigned long long)(unsigned)ts_hi << 32) | (unsigned)ts_lo) : 0ull;
        if (lane == 62) stamps[62] = rt_entry; if (lane == 63) stamps[63] = (unsigned long long)wall_clock64(); }
#undef PG8_STAMP
#undef PG8_SA
#undef PG8_SB
#undef PG8_STAGE
#undef PG8_LDA
#undef PG8_LDB
#undef PG8_MMA
#undef PG8_WAIT_V
#undef PG8_WAIT_L
#undef PG8_BAR
#undef PG8_SCHED
}
}
using pg8::bf16_t; using pg8::bf16x8; using pg8::f32x4; using pg8::u32x4;

constexpr int NB = 4, SEQ = 8192, MTOK = NB * SEQ, DM = 1024, NLAYER = 4, CIN = 3080, NPROJ = 3072, NEXP = 32, DEXP = 1024, NUP = 2048;
constexpr int RWD = 384, RW_COLS = 1408;
constexpr int NT_MAX = 544, POS_MAX = NT_MAX * 256;
constexpr float DN_ALPHA = 1.6817928305074290861f;
constexpr float LN_EPS = 1e-5f;
constexpr int NPH = 10;
constexpr int NPHASE_TOTAL = 1 + NLAYER * NPH;

constexpr size_t MiB = 1u << 20;
constexpr size_t WS_CTL = 0, CTL_ZERO_BYTES = 65536;
constexpr size_t WS_WIN = 1 * MiB;
constexpr size_t WS_WOUT = 25 * MiB;
constexpr size_t WS_WUP = 33 * MiB;
constexpr size_t WS_WDN = 545 * MiB;
constexpr size_t WS_ROPE = 801 * MiB;
constexpr size_t WS_HB = 803 * MiB;
constexpr size_t WS_HF = 867 * MiB;
constexpr size_t WS_H1F = 995 * MiB;
constexpr size_t WS_T1 = 1123 * MiB;
constexpr size_t WS_P = 1251 * MiB;
constexpr size_t WS_PG = 1443 * MiB;
constexpr size_t WS_YMIX = 1444 * MiB;
constexpr size_t WS_RWM = 1508 * MiB;
constexpr size_t WS_RWNT = 1532 * MiB;
constexpr size_t WS_RWQH = 1580 * MiB;
constexpr size_t WS_RWYL = 1604 * MiB;
constexpr size_t WS_RWS = 1652 * MiB;
constexpr size_t WS_RWAUX = 1676 * MiB;
constexpr size_t WS_MLQ = 1724 * MiB;
constexpr size_t WS_MLNL = 1740 * MiB;
constexpr size_t WS_MLVEC = 1780 * MiB;
constexpr size_t WS_MLSC = 1781 * MiB;
constexpr size_t WS_MLKL = 1782 * MiB;
constexpr size_t WS_MLCT = 1822 * MiB;
constexpr size_t WS_MLM = 1842 * MiB;
constexpr size_t WS_WUPT = 1843 * MiB;
constexpr size_t WS_AUPT = 1843 * MiB + 256 * 1024;
constexpr size_t WS_GUPT = 1843 * MiB + 512 * 1024;
constexpr size_t WS_LISCR = 1845 * MiB;
constexpr size_t WS_WRH = 1844 * MiB;
constexpr size_t WS_WRL = 1844 * MiB + 256 * 1024;
constexpr size_t WS_XPERM = 2021 * MiB;
constexpr size_t WS_ACT = 2293 * MiB;
constexpr size_t WS_YB = 2565 * MiB;
constexpr size_t WS_TOKE = 2821 * MiB;
constexpr size_t WS_TOKG = 2822 * MiB;
constexpr size_t WS_TOKLR = 2823 * MiB;
constexpr size_t WS_PDEST = 2824 * MiB;
constexpr size_t WS_PGATE = 2825 * MiB;
constexpr size_t WS_BBASE = 2826 * MiB;
constexpr size_t WS_PTOK = 2827 * MiB;
constexpr size_t WS_END = 2828 * MiB;
constexpr int CW_CNT = 1024;
constexpr int CW_SWAQ = 2048;
constexpr int CW_BAR = 4096;
constexpr int LDS_BYTES = 147456;
constexpr int MISC_OFF = 143360;
constexpr int TILEE_OFF = 133120;

#define LDS_WAIT() asm volatile("s_waitcnt lgkmcnt(0)" ::: "memory")
#define LDS_BARRIER() do { asm volatile("s_waitcnt lgkmcnt(0)" ::: "memory"); __builtin_amdgcn_s_barrier(); asm volatile("" ::: "memory"); } while (0)
#define VM_WAIT() asm volatile("s_waitcnt vmcnt(0)" ::: "memory")
__device__ __forceinline__ unsigned f2bf(float f) { unsigned u = __builtin_bit_cast(unsigned, f); return (u + 0x7fffu + ((u >> 16) & 1u)) >> 16; }
typedef __bf16 bf16v2_t __attribute__((ext_vector_type(2)));
__device__ __forceinline__ unsigned pk2(float lo, float hi) { const f32x2 v = (f32x2){lo, hi}; return __builtin_bit_cast(unsigned, __builtin_convertvector(v, bf16v2_t)); }
__device__ __forceinline__ float bf2f(unsigned short b) { return __builtin_bit_cast(float, ((unsigned)b) << 16); }
__device__ __forceinline__ float bflo(unsigned w) { return __builtin_bit_cast(float, w << 16); }
__device__ __forceinline__ float bfhi(unsigned w) { return __builtin_bit_cast(float, w & 0xffff0000u); }
template <int CTRL, int RMASK> __device__ __forceinline__ float dpp_add(float v) { return v + __builtin_bit_cast(float, __builtin_amdgcn_update_dpp(0, __builtin_bit_cast(int, v), CTRL, RMASK, 0xF, false)); }
__device__ __forceinline__ float wave_sum(float v) {
    v = dpp_add<0xB1, 0xF>(v); v = dpp_add<0x4E, 0xF>(v); v = dpp_add<0x141, 0xF>(v); v = dpp_add<0x140, 0xF>(v);
    v = dpp_add<0x142, 0xA>(v); v = dpp_add<0x143, 0xC>(v);
    return __builtin_bit_cast(float, __builtin_amdgcn_readlane(__builtin_bit_cast(int, v), 63));
}
template <int CTRL> __device__ __forceinline__ float dpp_mov(float x) { return __builtin_bit_cast(float, __builtin_amdgcn_update_dpp(0, __builtin_bit_cast(int, x), CTRL, 0xF, 0xF, true)); }
__device__ __forceinline__ float sum8(float x) { x += dpp_mov<0xB1>(x); x += dpp_mov<0x4E>(x); x += dpp_mov<0x141>(x); return x; }
__device__ __forceinline__ float sigmoidf_(float x) { return __builtin_amdgcn_rcpf(1.0f + __expf(-x)); }

#define XB_TMO      128
#define XB_XCNT(j)  (256  + 64 * (j))
#define XB_XSUB(j)  (1280 + 64 * (j))
#define XB_XGEN(j)  (2304 + 64 * (j))
#define XB_TOP      3328
#define XB_TOPGEN   3392
#define XCD_BAR_WORDS 3456
#define XB_SPIN_CAP (1u << 22)
__device__ __forceinline__ unsigned xb_ld(unsigned* p)              { return __hip_atomic_load(p, __ATOMIC_RELAXED, __HIP_MEMORY_SCOPE_AGENT); }
__device__ __forceinline__ unsigned xb_add(unsigned* p, unsigned v) { return __hip_atomic_fetch_add(p, v, __ATOMIC_RELAXED, __HIP_MEMORY_SCOPE_AGENT); }
__device__ __forceinline__ unsigned xb_xcc_id() { return (unsigned)__builtin_amdgcn_s_getreg((3 << 11) | 20) & 0xFu; }
#define XB_SPIN(cond, bar) do { unsigned _sp = 0; while (cond) { __builtin_amdgcn_s_sleep(1); \
    if ((++_sp & 255u) == 0u) { if (xb_ld(&(bar)[XB_TMO])) break; if (_sp > XB_SPIN_CAP) { atomicAdd(&(bar)[XB_TMO], 1u); break; } } } } while (0)

struct XcdBarrier {
    unsigned* bar; unsigned x;
    volatile LAS unsigned* st;
};

__device__ __forceinline__ XcdBarrier xcd_barrier_post(unsigned* bar, volatile LAS unsigned* st, bool t0  ) {
    XcdBarrier b; b.bar = bar; b.x = xb_xcc_id(); b.st = st;
    if (t0) (void)xb_add(&bar[XB_XCNT(b.x)], 1u);
    return b;
}
__device__ __forceinline__ void xcd_barrier_complete(unsigned* bar, unsigned x, unsigned& nloc, unsigned& nx) {
    const unsigned G = gridDim.x * gridDim.y * gridDim.z;
    unsigned sum, cnt, mine, sp = 0u;
    for (;;) {
        sum = 0u; cnt = 0u; mine = 0u;
#pragma unroll
        for (unsigned j = 0; j < 16; ++j) { const unsigned c = xb_ld(&bar[XB_XCNT(j)]); sum += c; cnt += (c > 0u) ? 1u : 0u; mine = (j == x) ? c : mine; }
        if (sum == G) break;
        __builtin_amdgcn_s_sleep(1);
        if ((++sp & 255u) == 0u) { if (xb_ld(&bar[XB_TMO])) break; if (sp > XB_SPIN_CAP) { atomicAdd(&bar[XB_TMO], 1u); break; } }
    }
    nloc = mine > 0u ? mine : 1u; nx = cnt > 0u ? cnt : 1u;
}

__device__ __forceinline__ void xcd_barrier(const XcdBarrier& b, bool t0  ) {
    asm volatile("s_waitcnt vmcnt(0)" ::: "memory");
    __syncthreads();
    if (t0) {
        unsigned* bar = b.bar;
        __builtin_amdgcn_s_waitcnt(0);
        unsigned nloc = b.st[0], nx = b.st[1];
        if (nloc == 0u) { xcd_barrier_complete(bar, b.x, nloc, nx); b.st[0] = nloc; b.st[1] = nx; }
        const unsigned old = xb_add(&bar[XB_XSUB(b.x)], 1u);
        const unsigned gen = old / nloc;
        if (old + 1u == (gen + 1u) * nloc) {
            __builtin_amdgcn_fence(__ATOMIC_RELEASE, "agent");
            asm volatile("s_waitcnt vmcnt(0)" ::: "memory");
            const unsigned og = xb_add(&bar[XB_TOP], 1u);
            const unsigned tg = og / nx;
            if (og + 1u == (tg + 1u) * nx) xb_add(&bar[XB_TOPGEN], 1u);
            else XB_SPIN(xb_ld(&bar[XB_TOPGEN]) == tg, bar);
            __builtin_amdgcn_fence(__ATOMIC_ACQUIRE, "agent");
            xb_add(&bar[XB_XGEN(b.x)], 1u);
            asm volatile("s_waitcnt vmcnt(0)" ::: "memory");
        } else {
            XB_SPIN(xb_ld(&bar[XB_XGEN(b.x)]) == gen, bar);
            __builtin_amdgcn_fence(__ATOMIC_ACQUIRE, "agent");
            asm volatile("s_waitcnt vmcnt(0)" ::: "memory");
        }
    }
    __syncthreads();
}
struct Params {
    const float* in[29];
    float* out; unsigned char* ws;
    int ph_lo, ph_hi;
    int pad0, pad1;
};
enum { I_X = 0, I_WIN, I_BIN, I_MU, I_WUP, I_W0, I_AUP, I_A0, I_GUP, I_KK, I_KA, I_RK, I_LNW, I_LNB, I_SINK, I_CONVW, I_CONVB, I_MLNW, I_WOUT,
       I_LN1W, I_LN1B, I_RW, I_RB, I_EWUP, I_EBUP, I_EWDN, I_EBDN, I_LN2W, I_LN2B };

struct Ctx {
    LAS unsigned char* lds; int tid, lane, wave, blk, G;
    unsigned char* ws;
};

__device__ __forceinline__ void tr_item(const float* W, int ldw, int K, bf16_t* WT, LAS float* scr, int kb, int nb, int lane) {
    const int k0 = 64 * kb, n0 = 32 * nb;
#pragma unroll 8
    for (int i = 0; i < 32; ++i) { const int kk = 2 * i + (lane >> 5); scr[kk * 33 + (lane & 31)] = __builtin_nontemporal_load(W + (size_t)(k0 + kk) * ldw + n0 + (lane & 31)); }
    LDS_WAIT();
    const int c = lane & 7;
#pragma unroll
    for (int j = 0; j < 4; ++j) { const int n = (lane >> 3) + 8 * j; const LAS float* s = scr + (8 * c) * 33 + n;
        u32x4 o; o.x = pk2(s[0 * 33], s[1 * 33]); o.y = pk2(s[2 * 33], s[3 * 33]); o.z = pk2(s[4 * 33], s[5 * 33]); o.w = pk2(s[6 * 33], s[7 * 33]);
        *(u32x4*)(WT + (size_t)(n0 + n) * K + k0 + 8 * c) = o; }
    LDS_WAIT();
}
__device__ __forceinline__ void gate_cols(const f32x4 (&v)[4], const LAS float* tab, const float* bg, float* pgrow, int lane) {
    float acc[8];
#pragma unroll
    for (int c = 0; c < 8; ++c) acc[c] = 0.f;
#pragma unroll
    for (int j = 0; j < 4; ++j)
#pragma unroll
        for (int q = 0; q < 4; ++q) { const LAS f32x4* tp = (const LAS f32x4*)(tab + ((j * 4 + q) * 64 + lane) * 8); const f32x4 a = tp[0], b = tp[1]; const float x = v[j][q];
            acc[0] += x * a[0]; acc[1] += x * a[1]; acc[2] += x * a[2]; acc[3] += x * a[3]; acc[4] += x * b[0]; acc[5] += x * b[1]; acc[6] += x * b[2]; acc[7] += x * b[3]; }
#pragma unroll
    for (int c = 0; c < 8; ++c) acc[c] = wave_sum(acc[c]);
    if (lane < 8) { float r = acc[0];
#pragma unroll
        for (int c = 1; c < 8; ++c) r = (lane == c) ? acc[c] : r;
        pgrow[lane] = r + bg[lane]; }
}
__device__ __forceinline__ void load_wg(LAS float* tab, const float* win_l, int tid) {
    for (int d = tid; d < DM; d += 512) { const int j = d >> 8, ln = (d >> 2) & 63, q = d & 3; const f32x4 a = *(const f32x4*)(win_l + (size_t)d * CIN + NPROJ), b = *(const f32x4*)(win_l + (size_t)d * CIN + NPROJ + 4);
        LAS f32x4* tp = (LAS f32x4*)(tab + ((j * 4 + q) * 64 + ln) * 8); tp[0] = a; tp[1] = b; }
    __syncthreads();
}
__device__ __forceinline__ void p0_prologue(const Params& P, const Ctx& C) {
    LAS float* scr = (LAS float*)(C.lds + C.wave * 16384);
    const int gw = C.blk * 8 + C.wave, NGW = C.G * 8;
    bf16_t* win_t = (bf16_t*)(C.ws + WS_WIN); bf16_t* wout_t = (bf16_t*)(C.ws + WS_WOUT); bf16_t* wup_t = (bf16_t*)(C.ws + WS_WUP); bf16_t* wdn_t = (bf16_t*)(C.ws + WS_WDN);
    constexpr int I_IN = 16 * 96, I_OUT = 16 * 32, I_UP = 16 * 64, I_DN = 16 * 32;
    constexpr int N1 = NLAYER * I_IN, N2 = NLAYER * I_OUT, N3 = NLAYER * NEXP * I_UP, N4 = NLAYER * NEXP * I_DN;
    for (int it = gw; it < N1 + N2 + N3 + N4; it += NGW) {
        int r = it;
        if (r < N1) { const int l = r / I_IN; r %= I_IN; tr_item(P.in[I_WIN] + (size_t)l * DM * CIN, CIN, DM, win_t + (size_t)l * NPROJ * DM, scr, r / 96, r % 96, C.lane); continue; } r -= N1;
        if (r < N2) { const int l = r / I_OUT; r %= I_OUT; tr_item(P.in[I_WOUT] + (size_t)l * DM * DM, DM, DM, wout_t + (size_t)l * DM * DM, scr, r / 32, r % 32, C.lane); continue; } r -= N2;
        if (r < N3) { const int le = r / I_UP; r %= I_UP; tr_item(P.in[I_EWUP] + (size_t)le * DM * NUP, NUP, DM, wup_t + (size_t)le * NUP * DM, scr, r / 64, r % 64, C.lane); continue; } r -= N3;
        { const int le = r / I_DN; r %= I_DN; tr_item(P.in[I_EWDN] + (size_t)le * DEXP * DM, DM, DEXP, wdn_t + (size_t)le * DM * DEXP, scr, r / 32, r % 32, C.lane); }
    }
    f32x2* rope = (f32x2*)(C.ws + WS_ROPE);
    for (int idx = C.blk * 512 + C.tid; idx < SEQ * 32; idx += C.G * 512) { const int t = idx >> 5, i = idx & 31;
        const float inv = powf(10000.0f, -(float)i / 32.0f); const float ang = (float)t * inv;
        const double rev = (double)ang * 0.15915494309189533577; const float fr = (float)(rev - __builtin_rint(rev));
        rope[idx] = (f32x2){__builtin_amdgcn_cosf(fr), __builtin_amdgcn_sinf(fr)}; }
    { bf16_t* wt = (bf16_t*)(C.ws + WS_WUPT); bf16_t* at = (bf16_t*)(C.ws + WS_AUPT); bf16_t* gt = (bf16_t*)(C.ws + WS_GUPT);
      for (int idx = C.blk * 512 + C.tid; idx < NLAYER * RWD * 64; idx += C.G * 512) { const int ll = idx / (RWD * 64), rem = idx % (RWD * 64), j = rem >> 6, i = rem & 63;
          wt[idx] = (bf16_t)f2bf(P.in[I_WUP][((size_t)ll * 64 + i) * RWD + j]); at[idx] = (bf16_t)f2bf(P.in[I_AUP][((size_t)ll * 64 + i) * RWD + j]); }
      for (int idx = C.blk * 512 + C.tid; idx < NLAYER * RWD * 128; idx += C.G * 512) { const int ll = idx / (RWD * 128), rem = idx % (RWD * 128), j = rem >> 7, i = rem & 127;
          gt[idx] = (bf16_t)f2bf(P.in[I_GUP][((size_t)ll * 128 + i) * RWD + j]); } }
    { bf16_t* wh = (bf16_t*)(C.ws + WS_WRH); bf16_t* wl = (bf16_t*)(C.ws + WS_WRL);
      for (int idx = C.blk * 512 + C.tid; idx < NLAYER * NEXP * DM; idx += C.G * 512) { const int ll = idx / (NEXP * DM), rem = idx % (NEXP * DM), e = rem >> 10, d = rem & 1023;
          const float w = P.in[I_RW][((size_t)ll * DM + d) * NEXP + e]; const unsigned hi = f2bf(w); const float lo = w - bflo(hi); wh[idx] = (bf16_t)hi; wl[idx] = (bf16_t)f2bf(lo); } }
    __syncthreads(); LAS float* wg = (LAS float*)C.lds; load_wg(wg, P.in[I_WIN], C.tid);
    bf16_t* hb = (bf16_t*)(C.ws + WS_HB); float* pg = (float*)(C.ws + WS_PG);
    for (int m = gw; m < MTOK; m += NGW) {
        const f32x4* xr = (const f32x4*)(P.in[I_X] + (size_t)m * DM) + C.lane; f32x4 v[4];
#pragma unroll
        for (int j = 0; j < 4; ++j) v[j] = xr[64 * j];
        u32x2* o8 = (u32x2*)(hb + (size_t)m * DM) + C.lane;
#pragma unroll
        for (int j = 0; j < 4; ++j) o8[64 * j] = (u32x2){pk2(v[j][0], v[j][1]), pk2(v[j][2], v[j][3])};
        gate_cols(v, wg, P.in[I_BIN] + NPROJ, pg + (size_t)m * 8, C.lane);
    }
}

constexpr int LD = 72;
constexpr int BUFB = 64 * LD * 2;
__device__ __forceinline__ f32x4 mfma16(bf16x8 a, bf16x8 b, f32x4 c) { return __builtin_amdgcn_mfma_f32_16x16x32_bf16(a, b, c, 0, 0, 0); }
constexpr int SWA_VLD = 264;
__device__ __forceinline__ void swa_unit(const Params& P, const Ctx& C, int l, int u) {
    const int tid = C.tid, wave = C.wave, lane = C.lane, r = lane & 15, g = lane >> 4; const int b = u >> 7, n = (u >> 1) & 63, hk = u & 1;
    LAS bf16_t* Ks = (LAS bf16_t*)C.lds; LAS bf16_t* VT = Ks + 256 * LD;
    const bf16_t* p = (const bf16_t*)(C.ws + WS_P); const f32x2* rope = (const f32x2*)(C.ws + WS_ROPE);
    const int t_base = n * 128 - 128;
#pragma unroll
    for (int it = 0; it < 2; ++it) { const int q = tid + 512 * it, row = q >> 2, c8 = q & 3; const int t = t_base + row;
        u32x4 o1 = (u32x4){0u, 0u, 0u, 0u}, o2 = o1;
        if (t >= 0) { const bf16_t* pr = p + (size_t)(b * SEQ + t) * NPROJ + 1792 + hk * 64 + 8 * c8; const u32x4 a1 = *(const u32x4*)pr, a2 = *(const u32x4*)(pr + 32);
            const f32x4* rp = (const f32x4*)(rope + t * 32 + 8 * c8); float y1[8], y2[8];
#pragma unroll
            for (int e = 0; e < 4; ++e) { const f32x4 cs = rp[e];
                const float x1a = bflo(a1[e]), x1b = bfhi(a1[e]), x2a = bflo(a2[e]), x2b = bfhi(a2[e]);
                y1[2 * e] = x1a * cs[0] - x2a * cs[1]; y2[2 * e] = x2a * cs[0] + x1a * cs[1]; y1[2 * e + 1] = x1b * cs[2] - x2b * cs[3]; y2[2 * e + 1] = x2b * cs[2] + x1b * cs[3]; }
            o1 = (u32x4){pk2(y1[0], y1[1]), pk2(y1[2], y1[3]), pk2(y1[4], y1[5]), pk2(y1[6], y1[7])}; o2 = (u32x4){pk2(y2[0], y2[1]), pk2(y2[2], y2[3]), pk2(y2[4], y2[5]), pk2(y2[6], y2[7])}; }
        *(LAS u32x4*)(Ks + row * LD + 8 * c8) = o1; *(LAS u32x4*)(Ks + row * LD + 32 + 8 * c8) = o2; }
    if (tid < 256) { const int kg = tid >> 3, c8 = tid & 7; u32x4 in[8];
#pragma unroll
        for (int k = 0; k < 8; ++k) { const int t = t_base + 8 * kg + k; in[k] = (t >= 0) ? *(const u32x4*)(p + (size_t)(b * SEQ + t) * NPROJ + 1920 + hk * 64 + 8 * c8) : (u32x4){0u, 0u, 0u, 0u}; }
#pragma unroll
        for (int d = 0; d < 8; ++d) { unsigned hv[8];
#pragma unroll
            for (int k = 0; k < 8; ++k) { const unsigned w = in[k][d >> 1]; hv[k] = (d & 1) ? (w >> 16) : (w & 0xffffu); }
            *(LAS u32x4*)(VT + (8 * c8 + d) * SWA_VLD + 8 * kg) = (u32x4){hv[0] | (hv[1] << 16), hv[2] | (hv[3] << 16), hv[4] | (hv[5] << 16), hv[6] | (hv[7] << 16)}; } }
    LDS_BARRIER();
    const int qi = 16 * wave + r, t = n * 128 + qi;
    const f32x4* rq = (const f32x4*)(rope + t * 32 + 8 * g);
#pragma unroll 1
    for (int gq = 0; gq < 3; ++gq) { const int hq = hk * 3 + gq; int wave = C.wave; asm volatile("" : "+s"(wave));
        bf16x8 qf0, qf1;
        { const bf16_t* pr = p + (size_t)(b * SEQ + t) * NPROJ + RW_COLS + hq * 64 + 8 * g; const u32x4 a1 = *(const u32x4*)pr, a2 = *(const u32x4*)(pr + 32); float y1[8], y2[8];
#pragma unroll
          for (int e = 0; e < 4; ++e) { const f32x4 cs = rq[e]; const float x1a = bflo(a1[e]), x1b = bfhi(a1[e]), x2a = bflo(a2[e]), x2b = bfhi(a2[e]);
              y1[2 * e] = (x1a * cs[0] - x2a * cs[1]) * 0.125f; y2[2 * e] = (x2a * cs[0] + x1a * cs[1]) * 0.125f; y1[2 * e + 1] = (x1b * cs[2] - x2b * cs[3]) * 0.125f; y2[2 * e + 1] = (x2b * cs[2] + x1b * cs[3]) * 0.125f; }
          const u32x4 w1 = (u32x4){pk2(y1[0], y1[1]), pk2(y1[2], y1[3]), pk2(y1[4], y1[5]), pk2(y1[6], y1[7])}, w2 = (u32x4){pk2(y2[0], y2[1]), pk2(y2[2], y2[3]), pk2(y2[4], y2[5]), pk2(y2[6], y2[7])};
          qf0 = __builtin_bit_cast(bf16x8, w1); qf1 = __builtin_bit_cast(bf16x8, w2); }
        f32x4 sc[10]; const float sink = P.in[I_SINK][l * 6 + hq]; float mx = sink;
        int qiv = qi; asm volatile("" : "+v"(qiv));
#pragma unroll
        for (int kt = 0; kt < 10; ++kt) { const int kb = 16 * (wave + kt); f32x4 a = (f32x4){0.f, 0.f, 0.f, 0.f};
            if (kb < 256) { const LAS bf16_t* kp = Ks + (kb + r) * LD + 8 * g; a = mfma16(*(const LAS bf16x8*)kp, qf0, a); a = mfma16(*(const LAS bf16x8*)(kp + 32), qf1, a); }
#pragma unroll
            for (int j = 0; j < 4; ++j) { const int kj = kb + 4 * g + j; const bool valid = (kj > qiv) && (kj <= qiv + 128) && (kj < 256) && ((n != 0) || (kj >= 128)); a[j] = valid ? a[j] : -__builtin_inff(); mx = fmaxf(mx, a[j]); }
            sc[kt] = a; }
        mx = fmaxf(mx, __shfl_xor(mx, 16)); mx = fmaxf(mx, __shfl_xor(mx, 32));
        float sum = 0.f;
#pragma unroll
        for (int kt = 0; kt < 10; ++kt) {
#pragma unroll
            for (int j = 0; j < 4; ++j) { const float e = __expf(sc[kt][j] - mx); sc[kt][j] = e; sum += e; } }
        sum += __shfl_xor(sum, 16); sum += __shfl_xor(sum, 32); sum += __expf(sink - mx);
        const float inv = 1.0f / sum;
        f32x4 o[4];
#pragma unroll
        for (int dt = 0; dt < 4; ++dt) o[dt] = (f32x4){0.f, 0.f, 0.f, 0.f};
#pragma unroll
        for (int s = 0; s < 5; ++s) { const int kb = 16 * (wave + 2 * s);
            if (kb < 256) { const u32x4 pw = (u32x4){pk2(sc[2 * s][0], sc[2 * s][1]), pk2(sc[2 * s][2], sc[2 * s][3]), pk2(sc[2 * s + 1][0], sc[2 * s + 1][1]), pk2(sc[2 * s + 1][2], sc[2 * s + 1][3])};
                const bf16x8 pf = __builtin_bit_cast(bf16x8, pw); const bool two = (kb + 16 < 256);
#pragma unroll
                for (int dt = 0; dt < 4; ++dt) { const LAS bf16_t* vp = VT + (16 * dt + r) * SWA_VLD + kb + 4 * g; const u32x2 lo = *(const LAS u32x2*)vp; u32x2 hi = (u32x2){0u, 0u}; if (two) hi = *(const LAS u32x2*)(vp + 16);
                    const u32x4 af = (u32x4){lo[0], lo[1], hi[0], hi[1]}; o[dt] = mfma16(__builtin_bit_cast(bf16x8, af), pf, o[dt]); } } }
        bf16_t* yr = (bf16_t*)(C.ws + WS_YMIX) + (size_t)(b * SEQ + t) * DM + RWD + hq * 64 + 4 * g;
#pragma unroll
        for (int dt = 0; dt < 4; ++dt) *(u32x2*)(yr + 16 * dt) = (u32x2){pk2(o[dt][0] * inv, o[dt][1] * inv), pk2(o[dt][2] * inv, o[dt][3] * inv)};
    }
    LDS_BARRIER();
}
__device__ __forceinline__ f32x4 mm64(const LAS bf16_t* X, const LAS bf16_t* Y, int ti, int tj, f32x4 acc, int lane) {
    const int r = lane & 15, g = lane >> 4;
    const LAS bf16_t* xp = X + (16 * ti + r) * LD + 8 * g; const LAS bf16_t* yp = Y + (16 * tj + r) * LD + 8 * g;
    acc = mfma16(*(const LAS bf16x8*)xp, *(const LAS bf16x8*)yp, acc);
    acc = mfma16(*(const LAS bf16x8*)(xp + 32), *(const LAS bf16x8*)(yp + 32), acc);
    return acc;
}
__device__ __forceinline__ void storeT(LAS bf16_t* D, int ti, int tj, f32x4 v, int lane) {
    const int r = lane & 15, g = lane >> 4;
    *(LAS u32x2*)(D + (16 * tj + r) * LD + 16 * ti + 4 * g) = (u32x2){pk2(v[0], v[1]), pk2(v[2], v[3])};
}
template <int MODE> __device__ __forceinline__ f32x4 maskT(f32x4 v, int ti, int tj, int lane) {
    const int rho = 16 * tj + (lane & 15), kap = 16 * ti + 4 * (lane >> 4);
#pragma unroll
    for (int j = 0; j < 4; ++j) { const bool keep = (MODE == 0) ? (kap + j < rho) : (MODE == 1) ? (kap + j <= rho) : (kap + j > rho); v[j] = keep ? v[j] : 0.f; }
    return v;
}
__device__ __forceinline__ float wave_max(float v) {
#pragma unroll
    for (int o = 1; o < 64; o <<= 1) v = fmaxf(v, __shfl_xor(v, o));
    return v;
}

__device__ __forceinline__ void rwb_unit(const Params& P, const Ctx& C, int l, int u, bool reuse) {
    const int tid = C.tid, wave = C.wave, lane = C.lane, r = lane & 15, g = lane >> 4;
    const int h = u % 6, bcx = u / 6, b = bcx >> 7, c = bcx & 127; const int tok0 = b * SEQ + c * 64; const int ch = (b * 6 + h) * 128 + c;
    LAS unsigned char* L = C.lds;
#define RB(i) ((LAS bf16_t*)(L + (i) * BUFB))
    LAS bf16_t* X1 = RB(0); LAS bf16_t* X1T = RB(1); LAS bf16_t* Aak = RB(2); LAS bf16_t* Arb = RB(3); LAS bf16_t* Ark = RB(4); LAS bf16_t* Pb = RB(5);
    LAS bf16_t* At = RB(6); LAS bf16_t* AtT = RB(7); LAS bf16_t* Bt = RB(8); LAS bf16_t* BtT = RB(9); LAS bf16_t* Kt = RB(10); LAS bf16_t* KtT = RB(11); LAS bf16_t* Rt = RB(12); LAS bf16_t* VT = RB(13);
    LAS float* XW = (LAS float*)L; LAS float* XA = XW + 64 * 65; LAS float* XG = XA + 64 * 65;
    LAS bf16_t* LI = (LAS bf16_t*)(L + 6 * BUFB);
    LAS float* segtot = (LAS float*)(L + 14 * BUFB); LAS float* gamL = segtot + 512;
    const bf16_t* p = (const bf16_t*)(C.ws + WS_P); const float* mu = P.in[I_MU] + l * RW_COLS;
    float cr9[9], ck9[9], cv9[9];
    { const int jc0 = 64 * h + lane;
#pragma unroll
      for (int i = 0; i < 9; ++i) { const int row = 8 * wave - 1 + i; const bool ok = (c * 64 + row >= 0); const bf16_t* q = p + (size_t)(tok0 + (ok ? row : 0)) * NPROJ;
          const float a_ = bf2f(q[jc0]), b_ = bf2f(q[RWD + jc0]), c_ = bf2f(q[2 * RWD + jc0]); cr9[i] = ok ? a_ : 0.f; ck9[i] = ok ? b_ : 0.f; cv9[i] = ok ? c_ : 0.f; } }
    bf16_t* liscr = (bf16_t*)(C.ws + WS_LISCR) + (size_t)C.blk * (64 * 264);
    if (!reuse) { u32x4 cu[4], pv[4]; f32x4 m0[4], m1[4];
#pragma unroll
      for (int i = 0; i < 4; ++i) { const int q = tid + 512 * i, t = q >> 5, c8 = q & 31; const bf16_t* src = p + (size_t)(tok0 + t) * NPROJ + 1152 + 8 * c8; const bool ok = (c * 64 + t > 0);
          cu[i] = *(const u32x4*)src; pv[i] = *(const u32x4*)(ok ? src - NPROJ : src); if (!ok) pv[i] = (u32x4){0u, 0u, 0u, 0u};
          m0[i] = *(const f32x4*)(mu + 1152 + 8 * c8); m1[i] = *(const f32x4*)(mu + 1152 + 8 * c8 + 4); }
#pragma unroll
      for (int i = 0; i < 4; ++i) { const int q = tid + 512 * i, t = q >> 5, c8 = q & 31; float x[8];
#pragma unroll
          for (int e = 0; e < 4; ++e) { const float c0 = bflo(cu[i][e]), c1 = bfhi(cu[i][e]), p0 = bflo(pv[i][e]), p1 = bfhi(pv[i][e]);
              const float mm0 = (e < 2) ? m0[i][2 * e] : m1[i][2 * e - 4], mm1 = (e < 2) ? m0[i][2 * e + 1] : m1[i][2 * e - 3];
              x[2 * e] = c0 + (p0 - c0) * mm0; x[2 * e + 1] = c1 + (p1 - c1) * mm1; }
          if (c8 < 8) {
#pragma unroll
              for (int e = 0; e < 8; ++e) x[e] = 1.0f - 2.0f * __builtin_amdgcn_rcpf(__expf(2.0f * x[e]) + 1.0f); }
          else if (c8 >= 16) {
#pragma unroll
              for (int e = 0; e < 8; ++e) x[e] = sigmoidf_(x[e]); }
          const u32x4 w = (u32x4){pk2(x[0], x[1]), pk2(x[2], x[3]), pk2(x[4], x[5]), pk2(x[6], x[7])};
          *(LAS u32x4*)(LI + t * 264 + 8 * c8) = w; *(u32x4*)(liscr + t * 264 + 8 * c8) = w; } }
    else {
#pragma unroll
      for (int i = 0; i < 4; ++i) { const int q = tid + 512 * i, t = q >> 5, c8 = q & 31; *(LAS u32x4*)(LI + t * 264 + 8 * c8) = *(const u32x4*)(liscr + t * 264 + 8 * c8); } }
    LDS_BARRIER();
    { bf16x8 bw[1][2], ba[1][2], bg[1][4];
      const int tj = wave & 3;
      const bf16_t* Ww = (const bf16_t*)(C.ws + WS_WUPT) + ((size_t)l * RWD + 64 * h + 16 * tj + r) * 64 + 8 * g;
      const bf16_t* Wa = (const bf16_t*)(C.ws + WS_AUPT) + ((size_t)l * RWD + 64 * h + 16 * tj + r) * 64 + 8 * g;
      const bf16_t* Wg = (const bf16_t*)(C.ws + WS_GUPT) + ((size_t)l * RWD + 64 * h + 16 * tj + r) * 128 + 8 * g;
#pragma unroll
      for (int ks = 0; ks < 2; ++ks) { bw[0][ks] = *(const bf16x8*)(Ww + 32 * ks); ba[0][ks] = *(const bf16x8*)(Wa + 32 * ks); }
#pragma unroll
      for (int ks = 0; ks < 4; ++ks) bg[0][ks] = *(const bf16x8*)(Wg + 32 * ks);
#pragma unroll
      for (int n = 0; n < 6; ++n) { const int o = n >> 1, ti = ((wave >> 2) + 2 * n) & 3; const int xoff = (o == 0) ? 0 : (o == 1) ? 64 : 128;
          const LAS bf16_t* xp = LI + (16 * ti + r) * 264 + xoff + 8 * g; f32x4 acc = (f32x4){0.f, 0.f, 0.f, 0.f};
          if (o == 0) { acc = mfma16(*(const LAS bf16x8*)xp, bw[0][0], acc); acc = mfma16(*(const LAS bf16x8*)(xp + 32), bw[0][1], acc); }
          else if (o == 1) { acc = mfma16(*(const LAS bf16x8*)xp, ba[0][0], acc); acc = mfma16(*(const LAS bf16x8*)(xp + 32), ba[0][1], acc); }
          else {
#pragma unroll
              for (int ks = 0; ks < 4; ++ks) acc = mfma16(*(const LAS bf16x8*)(xp + 32 * ks), bg[0][ks], acc); }
          LAS float* XO = (o == 0) ? XW : (o == 1) ? XA : XG;
#pragma unroll
          for (int j = 0; j < 4; ++j) XO[(16 * ti + 4 * g + j) * 65 + 16 * tj + r] = acc[j]; } }
    LDS_BARRIER();
    {
        const int jc = 64 * h + lane, tg = wave;
        const float w0 = P.in[I_W0][l * RWD + jc], a0 = P.in[I_A0][l * RWD + jc], kkc = P.in[I_KK][l * RWD + jc], kac = P.in[I_KA][l * RWD + jc], rkc = P.in[I_RK][l * RWD + jc];
        const float mur = mu[jc], muk = mu[RWD + jc], muv = mu[2 * RWD + jc];
        float pr = cr9[0], pk = ck9[0], pv = cv9[0];
        float ld[8], av[8], kn[8], km[8], rs[8], vs[8];
        bf16_t* aux = (bf16_t*)(C.ws + WS_RWAUX) + (size_t)(tok0 + 8 * tg) * 768;
#pragma unroll
        for (int i = 0; i < 8; ++i) { const int t = 8 * tg + i; const float cr = cr9[i + 1], ck = ck9[i + 1], cv = cv9[i + 1];
            rs[i] = cr + (pr - cr) * mur; const float ks = ck + (pk - ck) * muk; vs[i] = cv + (pv - cv) * muv; pr = cr; pk = ck; pv = cv;
            const float z = -(w0 + XW[t * 65 + lane]); const float sp = (z > 20.f) ? z : __logf(1.0f + __expf(z)); ld[i] = -__expf(-sp - 0.5f);
            const float a = sigmoidf_(a0 + XA[t * 65 + lane]); av[i] = a;
            const float kkv = ks * kkc; kn[i] = kkv * rsqrtf(fmaxf(wave_sum(kkv * kkv), 1e-24f));
            km[i] = ks * (1.0f + (a - 1.0f) * kac);
            const float dot = wave_sum(rs[i] * km[i] * rkc);
            aux[(size_t)i * 768 + jc] = (bf16_t)f2bf(dot * vs[i]); aux[(size_t)i * 768 + RWD + jc] = (bf16_t)f2bf(XG[t * 65 + lane]); }
        float cs[8]; cs[0] = ld[0];
#pragma unroll
        for (int i = 1; i < 8; ++i) cs[i] = cs[i - 1] + ld[i];
        segtot[tg * 64 + lane] = cs[7];
        LDS_BARRIER();
        float off = 0.f, tot = 0.f;
#pragma unroll
        for (int k = 0; k < 8; ++k) { const float sv = segtot[k * 64 + lane]; tot += sv; off += (k < tg) ? sv : 0.f; }
        if (wave == 0) gamL[lane] = __expf(tot);
        float oa[8], ob[8], ok[8], orr[8];
#pragma unroll
        for (int i = 0; i < 8; ++i) { const int t = 8 * tg + i; const float cum = off + cs[i]; const float gam = __expf(cum), gin = __expf(-cum), gpr = __expf(cum - ld[i]);
            oa[i] = -gpr * kn[i]; ob[i] = kn[i] * av[i] * gin; ok[i] = km[i] * gin; orr[i] = gam * rs[i];
            At[t * LD + lane] = (bf16_t)f2bf(oa[i]); Bt[t * LD + lane] = (bf16_t)f2bf(ob[i]); Kt[t * LD + lane] = (bf16_t)f2bf(ok[i]); Rt[t * LD + lane] = (bf16_t)f2bf(orr[i]); }
        *(LAS u32x4*)(AtT + lane * LD + 8 * tg) = (u32x4){pk2(oa[0], oa[1]), pk2(oa[2], oa[3]), pk2(oa[4], oa[5]), pk2(oa[6], oa[7])};
        *(LAS u32x4*)(BtT + lane * LD + 8 * tg) = (u32x4){pk2(ob[0], ob[1]), pk2(ob[2], ob[3]), pk2(ob[4], ob[5]), pk2(ob[6], ob[7])};
        *(LAS u32x4*)(KtT + lane * LD + 8 * tg) = (u32x4){pk2(ok[0], ok[1]), pk2(ok[2], ok[3]), pk2(ok[4], ok[5]), pk2(ok[6], ok[7])};
        *(LAS u32x4*)(VT + lane * LD + 8 * tg) = (u32x4){pk2(vs[0], vs[1]), pk2(vs[2], vs[3]), pk2(vs[4], vs[5]), pk2(vs[6], vs[7])};
    }
    LDS_BARRIER();
    const f32x4 Z4 = (f32x4){0.f, 0.f, 0.f, 0.f};
    const int wq = wave >> 2, tj = wave & 3;
    { f32x4 res[10];
#pragma unroll
      for (int n_ = 0; n_ < 10; ++n_) { const int o = n_ >> 1, ti = wq + 2 * (n_ & 1);
          if (o == 0) res[n_] = maskT<2>(mm64(At, Bt, ti, tj, Z4, lane), ti, tj, lane);
          else if (o == 1) res[n_] = maskT<0>(mm64(Bt, At, ti, tj, Z4, lane), ti, tj, lane);
          else if (o == 2) res[n_] = maskT<0>(mm64(Kt, At, ti, tj, Z4, lane), ti, tj, lane);
          else if (o == 3) res[n_] = maskT<1>(mm64(Bt, Rt, ti, tj, Z4, lane), ti, tj, lane);
          else res[n_] = maskT<1>(mm64(Kt, Rt, ti, tj, Z4, lane), ti, tj, lane); }
#pragma unroll
      for (int n_ = 0; n_ < 10; ++n_) { const int o = n_ >> 1, ti = wq + 2 * (n_ & 1);
          if (o == 0) storeT(X1T, ti, tj, res[n_], lane);
          else if (o == 1) { storeT(X1, ti, tj, res[n_], lane); f32x4 v = res[n_]; const int rho = 16 * tj + r, kap = 16 * ti + 4 * g;
#pragma unroll
              for (int j = 0; j < 4; ++j) v[j] += (kap + j == rho) ? 1.0f : 0.f;
              storeT(Pb, ti, tj, v, lane); }
          else if (o == 2) storeT(Aak, ti, tj, res[n_], lane);
          else if (o == 3) storeT(Arb, ti, tj, res[n_], lane);
          else storeT(Ark, ti, tj, res[n_], lane); } }
    LDS_BARRIER();
    f32x4 pacc[2];
#pragma unroll
    for (int q = 0; q < 2; ++q) { const int ti = wq + 2 * q; const u32x2 w = *(const LAS u32x2*)(Pb + (16 * tj + r) * LD + 16 * ti + 4 * g);
        pacc[q] = (f32x4){bflo(w[0]), bfhi(w[0]), bflo(w[1]), bfhi(w[1])}; }
#pragma unroll 1
    for (int rnd = 0; rnd < 6; ++rnd) {
        LAS bf16_t* Xn = (rnd & 1) ? RB(6) : RB(0); LAS bf16_t* XnT = (rnd & 1) ? RB(8) : RB(1);
        LAS bf16_t* Yn = (rnd & 1) ? RB(0) : RB(6); LAS bf16_t* YnT = (rnd & 1) ? RB(1) : RB(8);
        LAS bf16_t* Pold = (rnd & 1) ? RB(5) : RB(10); LAS bf16_t* Pnew = (rnd & 1) ? RB(10) : RB(5);
        f32x4 sq[4];
        if (rnd < 5) {
#pragma unroll
            for (int n_ = 0; n_ < 4; ++n_) { const int ti = wq + 2 * (n_ & 1); sq[n_] = (n_ < 2) ? mm64(Xn, XnT, ti, tj, Z4, lane) : mm64(XnT, Xn, ti, tj, Z4, lane); } }
        if (rnd > 0) {
#pragma unroll
            for (int q = 0; q < 2; ++q) pacc[q] = mm64(XnT, Pold, wq + 2 * q, tj, pacc[q], lane); }
        if (rnd < 5) {
#pragma unroll
            for (int n_ = 0; n_ < 4; ++n_) storeT((n_ < 2) ? YnT : Yn, wq + 2 * (n_ & 1), tj, sq[n_], lane); }
        if (rnd > 0) {
#pragma unroll
            for (int q = 0; q < 2; ++q) storeT(Pnew, wq + 2 * q, tj, pacc[q], lane); }
        LDS_BARRIER();
    }
    LAS bf16_t* Tm = RB(10);
    LAS bf16_t* AhT = RB(0); LAS bf16_t* W1T = RB(1); LAS bf16_t* UlT = RB(6);
    { f32x4 res[4];
#pragma unroll
      for (int n_ = 0; n_ < 4; ++n_) { const int ti = wq + 2 * (n_ & 1); res[n_] = (n_ < 2) ? mm64(Tm, AtT, ti, tj, Z4, lane) : mm64(Aak, VT, ti, tj, Z4, lane); }
#pragma unroll
      for (int n_ = 0; n_ < 4; ++n_) storeT((n_ < 2) ? AhT : W1T, wq + 2 * (n_ & 1), tj, res[n_], lane); }
    LDS_BARRIER();
    { f32x4 res[2];
#pragma unroll
      for (int n_ = 0; n_ < 2; ++n_) res[n_] = mm64(Tm, W1T, wq + 2 * n_, tj, Z4, lane);
#pragma unroll
      for (int n_ = 0; n_ < 2; ++n_) storeT(UlT, wq + 2 * n_, tj, res[n_], lane); }
    LDS_BARRIER();
    bf16_t* gM = (bf16_t*)(C.ws + WS_RWM) + (size_t)ch * 4096; bf16_t* gNT = (bf16_t*)(C.ws + WS_RWNT) + (size_t)ch * 4096; bf16_t* gQ = (bf16_t*)(C.ws + WS_RWQH) + (size_t)ch * 4096; bf16_t* gY = (bf16_t*)(C.ws + WS_RWYL) + (size_t)ch * 4096;
#pragma unroll
    for (int n_ = 0; n_ < 8; ++n_) { const int o = n_ >> 1, ti = wq + 2 * (n_ & 1); const int rho = 16 * tj + r, kap = 16 * ti + 4 * g;
        if (o == 0) {
            const u32x2 w = *(const LAS u32x2*)(Rt + rho * LD + kap); f32x4 v = (f32x4){bflo(w[0]), bfhi(w[0]), bflo(w[1]), bfhi(w[1])};
            v = mm64(AhT, Arb, ti, tj, v, lane); *(u32x2*)(gQ + rho * 64 + kap) = (u32x2){pk2(v[0], v[1]), pk2(v[2], v[3])}; }
        else if (o == 1) {
            f32x4 v = mm64(UlT, Arb, ti, tj, Z4, lane); v = mm64(VT, Ark, ti, tj, v, lane); *(u32x2*)(gY + rho * 64 + kap) = (u32x2){pk2(v[0], v[1]), pk2(v[2], v[3])}; }
        else if (o == 2) {
            f32x4 v = mm64(AhT, BtT, ti, tj, Z4, lane); const float gl = gamL[rho];
#pragma unroll
            for (int j = 0; j < 4; ++j) v[j] = gl * (v[j] + ((kap + j == rho) ? 1.0f : 0.f));
            *(u32x2*)(gM + rho * 64 + kap) = (u32x2){pk2(v[0], v[1]), pk2(v[2], v[3])}; }
        else {
            f32x4 v = mm64(BtT, UlT, ti, tj, Z4, lane); v = mm64(KtT, VT, ti, tj, v, lane);
#pragma unroll
            for (int j = 0; j < 4; ++j) v[j] *= gamL[kap + j];
            *(u32x2*)(gNT + rho * 64 + kap) = (u32x2){pk2(v[0], v[1]), pk2(v[2], v[3])}; } }
    LDS_BARRIER();
#undef RB
}

__device__ __forceinline__ void mlb_unit(const Params& P, const Ctx& C, int l, int u) {
    const int tid = C.tid, wave = C.wave, lane = C.lane, r = lane & 15, g = lane >> 4;
    const int hh = u & 3, bcx = u >> 2, b = bcx >> 7, c = bcx & 127; const int tok0 = b * SEQ + c * 64; const int ch = (b * 4 + hh) * 128 + c;
    LAS unsigned char* L = C.lds;
    LAS bf16_t* Qs = (LAS bf16_t*)L; LAS bf16_t* Ks = (LAS bf16_t*)(L + BUFB); LAS bf16_t* KhT = (LAS bf16_t*)(L + 2 * BUFB); LAS bf16_t* Sm = (LAS bf16_t*)(L + 3 * BUFB); LAS bf16_t* VTe = (LAS bf16_t*)(L + 4 * BUFB);
    LAS float* vbc = (LAS float*)(L + 4 * BUFB + 80 * LD * 2); LAS float* vig = vbc + 64; LAS float* vmd = vig + 64; LAS float* vws = vmd + 64;
    const bf16_t* p = (const bf16_t*)(C.ws + WS_P);
    unsigned xr[19], vr[8];
    { const int cq = tid & 127, tg = tid >> 7, isk = cq >> 6, d = cq & 63; const int col = 2048 + isk * 256 + hh * 64 + d; const int t0 = 16 * tg; const bool okp = (c * 64 + t0 > 0);
#pragma unroll
      for (int k = 0; k < 19; ++k) xr[k] = p[(size_t)(tok0 + ((k < 3 && !okp) ? 0 : t0 + k - 3)) * NPROJ + col];
      const int v = tid & 63, sg = tid >> 6;
#pragma unroll
      for (int k = 0; k < 8; ++k) vr[k] = p[(size_t)(tok0 + 8 * sg + k) * NPROJ + 2560 + hh * 64 + v]; }
    if (wave == 0) { const float* pg = (const float*)(C.ws + WS_PG) + (size_t)(tok0 + lane) * 8; const float ig = pg[hh], f = pg[4 + hh];
        const float lf = fminf(f, 0.f) - __logf(1.0f + __expf(-fabsf(f)));
        float bcv = lf;
#pragma unroll
        for (int o = 1; o < 64; o <<= 1) { const float t = __shfl_up(bcv, o); bcv += (lane >= o) ? t : 0.f; }
        float pm = ig - bcv;
#pragma unroll
        for (int o = 1; o < 64; o <<= 1) { const float t = __shfl_up(pm, o); pm = (lane >= o) ? fmaxf(pm, t) : pm; }
        const float md = bcv + pm; const float bcL = __shfl(bcv, 63); const float as = bcL - bcv + ig; const float mloc = wave_max(as); const float ws = __expf(as - mloc);
        vbc[lane] = bcv; vig[lane] = ig; vmd[lane] = md; vws[lane] = ws;
        float* vec = (float*)(C.ws + WS_MLVEC) + ((size_t)ch * 64 + lane) * 2; vec[0] = bcv; vec[1] = md;
        if (lane == 0) { float* sc = (float*)(C.ws + WS_MLSC) + (size_t)ch * 2; sc[0] = bcL; sc[1] = mloc; } }
    LDS_BARRIER();
    { const int cq = tid & 127, tg = tid >> 7, isk = cq >> 6, d = cq & 63; const int col = 2048 + isk * 256 + hh * 64 + d; const int cw = isk * 256 + hh * 64 + d;
      const float* cwp = P.in[I_CONVW] + (size_t)l * 4 * 512; const float w0 = cwp[cw], w1 = cwp[512 + cw], w2 = cwp[1024 + cw], w3 = cwp[1536 + cw], cb = P.in[I_CONVB][l * 512 + cw];
      float xm3 = 0.f, xm2 = 0.f, xm1 = 0.f; const int t0 = 16 * tg;
      if (c * 64 + t0 > 0) { xm3 = bf2f((unsigned short)xr[0]); xm2 = bf2f((unsigned short)xr[1]); xm1 = bf2f((unsigned short)xr[2]); }
      float o16[16];
#pragma unroll
      for (int k = 0; k < 16; ++k) { const float x0 = bf2f((unsigned short)xr[k + 3]); const float y = w0 * xm3 + w1 * xm2 + w2 * xm1 + w3 * x0 + cb; const float s = y * sigmoidf_(y);
          o16[k] = isk ? s * 0.125f : s; xm3 = xm2; xm2 = xm1; xm1 = x0; }
      if (!isk) { bf16_t* gq = (bf16_t*)(C.ws + WS_MLQ) + (size_t)ch * 4096;
#pragma unroll
          for (int k = 0; k < 16; ++k) { const bf16_t v = (bf16_t)f2bf(o16[k]); Qs[(t0 + k) * LD + d] = v; gq[(t0 + k) * 64 + d] = v; } }
      else {
#pragma unroll
          for (int k = 0; k < 16; ++k) { Ks[(t0 + k) * LD + d] = (bf16_t)f2bf(o16[k]); o16[k] *= vws[t0 + k]; }
          *(LAS u32x4*)(KhT + d * LD + t0) = (u32x4){pk2(o16[0], o16[1]), pk2(o16[2], o16[3]), pk2(o16[4], o16[5]), pk2(o16[6], o16[7])};
          *(LAS u32x4*)(KhT + d * LD + t0 + 8) = (u32x4){pk2(o16[8], o16[9]), pk2(o16[10], o16[11]), pk2(o16[12], o16[13]), pk2(o16[14], o16[15])}; }
      { const int v = tid & 63, sg = tid >> 6; float vv[8];
#pragma unroll
        for (int k = 0; k < 8; ++k) vv[k] = bf2f((unsigned short)vr[k]);
        *(LAS u32x4*)(VTe + v * LD + 8 * sg) = (u32x4){pk2(vv[0], vv[1]), pk2(vv[2], vv[3]), pk2(vv[4], vv[5]), pk2(vv[6], vv[7])}; }
      if (tid < 128) { const int row = 64 + (tid >> 3), pc = tid & 7; const unsigned one2 = 0x3f803f80u; const unsigned val = (row == 64) ? one2 : 0u; *(LAS u32x4*)(VTe + row * LD + 8 * pc) = (u32x4){val, val, val, val}; }
    }
    LDS_BARRIER();
    const f32x4 Z4 = (f32x4){0.f, 0.f, 0.f, 0.f};
    bf16_t* gKL = (bf16_t*)(C.ws + WS_MLKL) + (size_t)ch * 5120; bf16_t* gNL = (bf16_t*)(C.ws + WS_MLNL) + (size_t)ch * 5120;
    for (int task = wave; task < 36; task += 8) {
        if (task < 16) { const int ti = task >> 2, tj = task & 3; f32x4 v = mm64(Ks, Qs, ti, tj, Z4, lane);
            const int rho = 16 * tj + r, kap = 16 * ti + 4 * g; const float bl = vbc[rho] - vmd[rho];
#pragma unroll
            for (int j = 0; j < 4; ++j) { const int s = kap + j; v[j] = (s <= rho) ? v[j] * __expf(bl - vbc[s] + vig[s]) : 0.f; }
            storeT(Sm, ti, tj, v, lane); }
        else { const int t2 = task - 16, ti = t2 / 5, tj = t2 % 5;
            const f32x4 v = mm64(KhT, VTe, ti, tj, Z4, lane); *(u32x2*)(gKL + (16 * tj + r) * 64 + 16 * ti + 4 * g) = (u32x2){pk2(v[0], v[1]), pk2(v[2], v[3])}; } }
    LDS_BARRIER();
    for (int task = wave; task < 20; task += 8) { const int ti = task >> 2, tj = task & 3; const f32x4 v = mm64(VTe, Sm, ti, tj, Z4, lane); *(u32x2*)(gNL + (16 * tj + r) * 80 + 16 * ti + 4 * g) = (u32x2){pk2(v[0], v[1]), pk2(v[2], v[3])}; }
    LDS_BARRIER();
}

__device__ __forceinline__ void rwkv_chain(const Ctx& C, int bh, int vh) {
    const int tid = C.tid, wave = C.wave, lane = C.lane, r = lane & 15, g = lane >> 4; const size_t ch0 = (size_t)bh * 128;
    LAS unsigned char* L = C.lds; LAS unsigned char* Mb = L; LAS unsigned char* Nb = L + 8 * BUFB; LAS unsigned char* Sb = Nb + 8 * (32 * LD * 2);
    static_assert(8 * BUFB + 8 * 32 * LD * 2 + 8 * 32 * 128 <= MISC_OFF, "chain LDS");
    const bf16_t* gM = (const bf16_t*)(C.ws + WS_RWM) + ch0 * 4096; const bf16_t* gN = (const bf16_t*)(C.ws + WS_RWNT) + ch0 * 4096 + (size_t)vh * 32 * 64; bf16_t* gS = (bf16_t*)(C.ws + WS_RWS) + ch0 * 4096;
    u32x4 pmA[8], pnA4[4];
#define CH_LOAD(pm, pn, nbx) do { const bf16_t* m_ = gM + (size_t)(nbx) * 8 * 4096; \
        _Pragma("unroll") for (int i = 0; i < 8; ++i) pm[i] = ((const u32x4*)m_)[tid + 512 * i]; \
        _Pragma("unroll") for (int i = 0; i < 4; ++i) { const int q = tid + 512 * i, chunk = q >> 8, within = q & 255; pn[i] = ((const u32x4*)(gN + ((size_t)(nbx) * 8 + chunk) * 4096))[within]; } } while (0)
#define CH_PUT(pm, pn) do { \
        _Pragma("unroll") for (int i = 0; i < 8; ++i) { const int q = tid + 512 * i, chunk = q >> 9, within = q & 511, row = within >> 3, pc = within & 7; *(LAS u32x4*)(Mb + chunk * BUFB + row * (LD * 2) + pc * 16) = pm[i]; } \
        _Pragma("unroll") for (int i = 0; i < 4; ++i) { const int q = tid + 512 * i, chunk = q >> 8, within = q & 255, row = within >> 3, pc = within & 7; *(LAS u32x4*)(Nb + chunk * (32 * LD * 2) + row * (LD * 2) + pc * 16) = pn[i]; } } while (0)
    CH_LOAD(pmA, pnA4, 0);
    f32x4 acc[4];
#pragma unroll
    for (int t = 0; t < 4; ++t) acc[t] = (f32x4){0.f, 0.f, 0.f, 0.f};
#define CH_FRAGS(cc_, mf_, nf_) do { const LAS unsigned char* mc = Mb + (cc_) * BUFB; const LAS unsigned char* nc = Nb + (cc_) * (32 * LD * 2); \
        _Pragma("unroll") for (int t = 0; t < 4; ++t) { nf_[t] = *(const LAS u32x2*)(nc + (16 * wave + r) * (LD * 2) + (16 * t + 4 * g) * 2); \
            const LAS unsigned char* mp = mc + (16 * t + r) * (LD * 2) + (4 * g) * 2; const u32x2 lo = *(const LAS u32x2*)mp, hi = *(const LAS u32x2*)(mp + 32); mf_[t] = (u32x4){lo[0], lo[1], hi[0], hi[1]}; } } while (0)
#define CH_ONE(cc_, mf_, nf_) do { \
            u32x4 m2[4]; { const LAS unsigned char* mc = Mb + (cc_) * BUFB; \
            _Pragma("unroll") for (int t = 0; t < 4; ++t) { const LAS unsigned char* mp = mc + (16 * t + r) * (LD * 2) + (32 + 4 * g) * 2; const u32x2 lo = *(const LAS u32x2*)mp, hi = *(const LAS u32x2*)(mp + 32); m2[t] = (u32x4){lo[0], lo[1], hi[0], hi[1]}; } } \
            u32x2 pk[4]; \
            _Pragma("unroll") for (int t = 0; t < 4; ++t) pk[t] = (u32x2){pk2(acc[t][0], acc[t][1]), pk2(acc[t][2], acc[t][3])}; \
            LAS unsigned char* sg = Sb + (cc_) * 4096 + (16 * wave + r) * 128 + (4 * g) * 2; \
            _Pragma("unroll") for (int t = 0; t < 4; ++t) *(LAS u32x2*)(sg + 32 * t) = pk[t]; \
            bf16x8 zb[2]; \
            _Pragma("unroll") for (int s = 0; s < 2; ++s) { const u32x4 z = (u32x4){pk[2 * s][0], pk[2 * s][1], pk[2 * s + 1][0], pk[2 * s + 1][1]}; zb[s] = __builtin_bit_cast(bf16x8, z); } \
            _Pragma("unroll") for (int t = 0; t < 4; ++t) { const u32x2 nw = nf_[t]; const f32x4 a0 = (f32x4){bflo(nw[0]), bfhi(nw[0]), bflo(nw[1]), bfhi(nw[1])}; \
                acc[t] = mfma16(__builtin_bit_cast(bf16x8, mf_[t]), zb[0], a0); } \
            _Pragma("unroll") for (int t = 0; t < 4; ++t) acc[t] = mfma16(__builtin_bit_cast(bf16x8, m2[t]), zb[1], acc[t]); } while (0)
#define CH_STEP(nbx) do { if (wave < 2) { u32x4 mf0[4], mf1[4]; u32x2 nf0[4], nf1[4]; CH_FRAGS(0, mf0, nf0); \
        _Pragma("unroll 1") for (int cc = 0; cc < 8; cc += 2) { \
            CH_FRAGS(cc + 1, mf1, nf1); CH_ONE(cc, mf0, nf0); \
            if (cc + 2 < 8) CH_FRAGS(cc + 2, mf0, nf0); CH_ONE(cc + 1, mf1, nf1); } } } while (0)
#define CH_SOUT(nbx) do { _Pragma("unroll") for (int i = 0; i < 4; ++i) { const int q = tid + 512 * i, chunk = q >> 8, within = q & 255, row = within >> 3, pc = within & 7; \
        const u32x4 v = *(const LAS u32x4*)(Sb + chunk * 4096 + row * 128 + pc * 16); *(u32x4*)(gS + ((size_t)(nbx) * 8 + chunk) * 4096 + (32 * vh + row) * 64 + pc * 8) = v; } } while (0)
    for (int nb = 0; nb < 16; ++nb) {
        LDS_BARRIER(); if (nb > 0) CH_SOUT(nb - 1); CH_PUT(pmA, pnA4); LDS_BARRIER();
        if (nb + 1 < 16) CH_LOAD(pmA, pnA4, nb + 1);
        CH_STEP(nb);
    }
    LDS_BARRIER(); CH_SOUT(15);
#undef CH_SOUT
#undef CH_LOAD
#undef CH_PUT
#undef CH_STEP
#undef CH_FRAGS
#undef CH_ONE
}
__device__ __forceinline__ void mlstm_cscan(const Ctx& C, int bh, int part) {
    const int tid = C.tid; const size_t ch0 = (size_t)bh * 128; const int e0 = 10 * (part * 128 + (tid & 127));
    const bf16_t* KL = (const bf16_t*)(C.ws + WS_MLKL) + ch0 * 5120 + e0; bf16_t* CT = (bf16_t*)(C.ws + WS_MLCT) + ch0 * 5120 + e0; float* MM = (float*)(C.ws + WS_MLM) + ch0; const float* SC = (const float*)(C.ws + WS_MLSC) + ch0 * 2;
    float st[10]; unsigned ring[8][5]; float m = 0.f;
    LAS float* scl = (LAS float*)C.lds; if (tid < 256) scl[tid] = SC[tid];
    __syncthreads();
    if (tid >= 128) return;
#pragma unroll
    for (int i = 0; i < 10; ++i) st[i] = 0.f;
#pragma unroll
    for (int k = 0; k < 8; ++k)
#pragma unroll
        for (int i = 0; i < 5; ++i) ring[k][i] = *(const unsigned*)(KL + (size_t)k * 5120 + 2 * i);
    for (int c0 = 0; c0 < 128; c0 += 8) {
#pragma unroll
        for (int k = 0; k < 8; ++k) { const int c = c0 + k; unsigned cur[5];
#pragma unroll
            for (int i = 0; i < 5; ++i) cur[i] = ring[k][i];
            if (c + 8 < 128) {
#pragma unroll
                for (int i = 0; i < 5; ++i) ring[k][i] = *(const unsigned*)(KL + (size_t)(c + 8) * 5120 + 2 * i); }
            const float bcL = scl[2 * c], mloc = scl[2 * c + 1];
            unsigned* ct = (unsigned*)(CT + (size_t)c * 5120);
#pragma unroll
            for (int i = 0; i < 5; ++i) ct[i] = pk2(st[2 * i], st[2 * i + 1]);
            if (tid == 0 && part == 0) MM[c] = m;
            const float mn = fmaxf(bcL + m, mloc); const float dec = __expf(bcL + m - mn), sc = __expf(mloc - mn); m = mn;
#pragma unroll
            for (int i = 0; i < 5; ++i) { st[2 * i] = dec * st[2 * i] + sc * bflo(cur[i]); st[2 * i + 1] = dec * st[2 * i + 1] + sc * bfhi(cur[i]); } }
    }
}

__device__ __forceinline__ void passd_unit(const Params& P, const Ctx& C, int l, int u) {
    const int wave = C.wave, lane = C.lane, r = lane & 15, g = lane >> 4; const int b = u >> 7, c = u & 127; const int tok0 = b * SEQ + c * 64;
    bf16_t* ymix = (bf16_t*)(C.ws + WS_YMIX);
    {
        bf16x8 qf[3][2], sf[3][4][2]; u32x2 yl[3][4], bo[3][4], gg[3][4];
#pragma unroll
        for (int n_ = 0; n_ < 3; ++n_) { const int task = wave + 8 * n_, h = task >> 2, tb = task & 3; const size_t ch = (size_t)(b * 6 + h) * 128 + c; const int t = 16 * tb + r; const int tok = tok0 + t;
            const bf16_t* gS = (const bf16_t*)(C.ws + WS_RWS) + ch * 4096; const bf16_t* gQ = (const bf16_t*)(C.ws + WS_RWQH) + ch * 4096 + t * 64 + 8 * g; const bf16_t* gY = (const bf16_t*)(C.ws + WS_RWYL) + ch * 4096 + t * 64 + 4 * g;
            const bf16_t* aux = (const bf16_t*)(C.ws + WS_RWAUX) + (size_t)tok * 768 + 64 * h + 4 * g;
            qf[n_][0] = *(const bf16x8*)gQ; qf[n_][1] = *(const bf16x8*)(gQ + 32);
#pragma unroll
            for (int ti = 0; ti < 4; ++ti) { const bf16_t* sp = gS + (16 * ti + r) * 64 + 8 * g; sf[n_][ti][0] = *(const bf16x8*)sp; sf[n_][ti][1] = *(const bf16x8*)(sp + 32);
                yl[n_][ti] = *(const u32x2*)(gY + 16 * ti); bo[n_][ti] = *(const u32x2*)(aux + 16 * ti); gg[n_][ti] = *(const u32x2*)(aux + RWD + 16 * ti); } }
#pragma unroll
        for (int n_ = 0; n_ < 3; ++n_) { const int task = wave + 8 * n_, h = task >> 2, tb = task & 3; const int t = 16 * tb + r; const int tok = tok0 + t;
            f32x4 y[4]; float s = 0.f;
#pragma unroll
            for (int ti = 0; ti < 4; ++ti) { const u32x2 yw = yl[n_][ti]; f32x4 a = (f32x4){bflo(yw[0]), bfhi(yw[0]), bflo(yw[1]), bfhi(yw[1])};
                a = mfma16(sf[n_][ti][0], qf[n_][0], a); a = mfma16(sf[n_][ti][1], qf[n_][1], a); y[ti] = a; s += (a[0] + a[1]) + (a[2] + a[3]); }
            s += __shfl_xor(s, 16); s += __shfl_xor(s, 32); const float mean = s * (1.f / 64.f); float s2 = 0.f;
#pragma unroll
            for (int ti = 0; ti < 4; ++ti) { y[ti] = y[ti] - mean; s2 += (y[ti][0] * y[ti][0] + y[ti][1] * y[ti][1]) + (y[ti][2] * y[ti][2] + y[ti][3] * y[ti][3]); }
            s2 += __shfl_xor(s2, 16); s2 += __shfl_xor(s2, 32); const float rstd = rsqrtf(s2 * (1.f / 64.f) + 64e-5f);
            bf16_t* yo = ymix + (size_t)tok * DM + 64 * h + 4 * g;
            const float* lw = P.in[I_LNW] + l * RWD + 64 * h + 4 * g; const float* lb = P.in[I_LNB] + l * RWD + 64 * h + 4 * g;
#pragma unroll
            for (int ti = 0; ti < 4; ++ti) { const u32x2 bo_ = bo[n_][ti], gg_ = gg[n_][ti]; const f32x4 w4 = *(const f32x4*)(lw + 16 * ti), b4 = *(const f32x4*)(lb + 16 * ti);
                const float o0 = (y[ti][0] * rstd * w4[0] + b4[0] + bflo(bo_[0])) * bflo(gg_[0]), o1 = (y[ti][1] * rstd * w4[1] + b4[1] + bfhi(bo_[0])) * bfhi(gg_[0]);
                const float o2 = (y[ti][2] * rstd * w4[2] + b4[2] + bflo(bo_[1])) * bflo(gg_[1]), o3 = (y[ti][3] * rstd * w4[3] + b4[3] + bfhi(bo_[1])) * bfhi(gg_[1]);
                *(u32x2*)(yo + 16 * ti) = (u32x2){pk2(o0, o1), pk2(o2, o3)}; } }
    }
    {
        bf16x8 qf[2][2], cf[2][5][2]; u32x2 nl[2][5], og[2][4]; float bcl[2], mdl[2], mcv[2];
#pragma unroll
        for (int n_ = 0; n_ < 2; ++n_) { const int task = wave + 8 * (n_ + 3), hh = (task - 24) >> 2, tb = task & 3; const size_t ch = (size_t)(b * 4 + hh) * 128 + c; const int t = 16 * tb + r; const int tok = tok0 + t;
            const bf16_t* gC = (const bf16_t*)(C.ws + WS_MLCT) + ch * 5120; const bf16_t* gQ = (const bf16_t*)(C.ws + WS_MLQ) + ch * 4096 + t * 64 + 8 * g; const bf16_t* gNL = (const bf16_t*)(C.ws + WS_MLNL) + ch * 5120 + t * 80 + 4 * g;
            const bf16_t* ogp = (const bf16_t*)(C.ws + WS_P) + (size_t)tok * NPROJ + 2816 + 64 * hh + 4 * g;
            qf[n_][0] = *(const bf16x8*)gQ; qf[n_][1] = *(const bf16x8*)(gQ + 32);
            const float* vec = (const float*)(C.ws + WS_MLVEC) + (ch * 64 + t) * 2; bcl[n_] = vec[0]; mdl[n_] = vec[1]; mcv[n_] = ((const float*)(C.ws + WS_MLM))[ch];
#pragma unroll
            for (int ti = 0; ti < 5; ++ti) { const bf16_t* cp = gC + (16 * ti + r) * 64 + 8 * g; cf[n_][ti][0] = *(const bf16x8*)cp; cf[n_][ti][1] = *(const bf16x8*)(cp + 32); nl[n_][ti] = *(const u32x2*)(gNL + 16 * ti); }
#pragma unroll
            for (int ti = 0; ti < 4; ++ti) og[n_][ti] = *(const u32x2*)(ogp + 16 * ti); }
#pragma unroll
        for (int n_ = 0; n_ < 2; ++n_) { const int task = wave + 8 * (n_ + 3), hh = (task - 24) >> 2, tb = task & 3; const int t = 16 * tb + r; const int tok = tok0 + t;
            const float mint = bcl[n_] + mcv[n_], mt = fmaxf(mint, mdl[n_]); const float inter = __expf(mint - mt), fl = __expf(mdl[n_] - mt);
            f32x4 y[5];
#pragma unroll
            for (int ti = 0; ti < 5; ++ti) { f32x4 a = (f32x4){0.f, 0.f, 0.f, 0.f};
                a = mfma16(cf[n_][ti][0], qf[n_][0], a); a = mfma16(cf[n_][ti][1], qf[n_][1], a); const u32x2 nw = nl[n_][ti]; const f32x4 nlv = (f32x4){bflo(nw[0]), bfhi(nw[0]), bflo(nw[1]), bfhi(nw[1])}; y[ti] = fl * nlv + inter * a; }
            const float nq = __shfl(y[4][0], r);
            const float inv = 1.0f / fmaxf(fabsf(nq), __expf(-mt));
            float s = 0.f;
#pragma unroll
            for (int ti = 0; ti < 4; ++ti) { y[ti] = y[ti] * inv; s += (y[ti][0] + y[ti][1]) + (y[ti][2] + y[ti][3]); }
            s += __shfl_xor(s, 16); s += __shfl_xor(s, 32); const float mean = s * (1.f / 64.f); float s2 = 0.f;
#pragma unroll
            for (int ti = 0; ti < 4; ++ti) { y[ti] = y[ti] - mean; s2 += (y[ti][0] * y[ti][0] + y[ti][1] * y[ti][1]) + (y[ti][2] * y[ti][2] + y[ti][3] * y[ti][3]); }
            s2 += __shfl_xor(s2, 16); s2 += __shfl_xor(s2, 32); const float rstd = rsqrtf(s2 * (1.f / 64.f) + 1e-6f);
            bf16_t* yo = ymix + (size_t)tok * DM + 768 + 64 * hh + 4 * g; const float* nw = P.in[I_MLNW] + l * 256 + 64 * hh + 4 * g;
#pragma unroll
            for (int ti = 0; ti < 4; ++ti) { const u32x2 oo = og[n_][ti]; const f32x4 w4 = *(const f32x4*)(nw + 16 * ti);
                const float o0 = y[ti][0] * rstd * w4[0] * sigmoidf_(bflo(oo[0])), o1 = y[ti][1] * rstd * w4[1] * sigmoidf_(bfhi(oo[0])), o2 = y[ti][2] * rstd * w4[2] * sigmoidf_(bflo(oo[1])), o3 = y[ti][3] * rstd * w4[3] * sigmoidf_(bfhi(oo[1]));
                *(u32x2*)(yo + 16 * ti) = (u32x2){pk2(o0, o1), pk2(o2, o3)}; } }
    }
}

__device__ __forceinline__ void ln1_router_phase(const Params& P, const Ctx& C, int l, int cnt_off) {
    const int tid = C.tid, wave = C.wave, lane = C.lane, r = lane & 15, g = lane >> 4;
    constexpr int HS = 1032;
    LAS bf16_t* hhi = (LAS bf16_t*)C.lds;
    LAS bf16_t* hlo = hhi + 16 * HS;
    LAS float* part = (LAS float*)(hlo + 16 * HS);
    LAS int* lcnt = (LAS int*)(part + 8 * 8 * 32);
    bf16x8 bh[4][2], bl[4][2];
#pragma unroll
    for (int ks = 0; ks < 4; ++ks)
#pragma unroll
        for (int nt = 0; nt < 2; ++nt) { const size_t off = ((size_t)l * NEXP + 16 * nt + r) * DM + 32 * (4 * wave + ks) + 8 * g;
            bh[ks][nt] = *(const bf16x8*)((const bf16_t*)(C.ws + WS_WRH) + off); bl[ks][nt] = *(const bf16x8*)((const bf16_t*)(C.ws + WS_WRL) + off); }
    for (int i = tid; i < 16 * HS; i += 512) { hhi[i] = 0; hlo[i] = 0; }
    if (tid < 32) lcnt[tid] = 0;
    { int* pdest = (int*)(C.ws + WS_PDEST); int* ptok = (int*)(C.ws + WS_PTOK); for (int i = C.blk * 512 + tid; i < POS_MAX; i += C.G * 512) { pdest[i] = -1; ptok[i] = 0; } }
    __syncthreads();
    const int tpb = (MTOK + C.G - 1) / C.G, tok_lo = C.blk * tpb, tok_hi = (tok_lo + tpb < MTOK) ? tok_lo + tpb : MTOK;
    const bf16_t* t1 = (const bf16_t*)(C.ws + WS_T1); bf16_t* hb = (bf16_t*)(C.ws + WS_HB);
    int* toke = (int*)(C.ws + WS_TOKE); float* tokg = (float*)(C.ws + WS_TOKG); int* toklr = (int*)(C.ws + WS_TOKLR);
    const f32x4* lw4 = (const f32x4*)(P.in[I_LN1W] + (size_t)l * DM) + lane; const f32x4* lb4 = (const f32x4*)(P.in[I_LN1B] + (size_t)l * DM) + lane;
    u32x2 vn[4], rn[4];
    { const int tok = tok_lo + wave; const size_t ro = (size_t)((tok < tok_hi) ? tok : tok_lo) * DM; const u32x2* xr = (const u32x2*)(t1 + ro) + lane; const u32x2* rr = (const u32x2*)(hb + ro) + lane;
#pragma unroll
      for (int j = 0; j < 4; ++j) { vn[j] = xr[64 * j]; rn[j] = rr[64 * j]; } }
    const float rbias = P.in[I_RB][l * NEXP + (lane & 31)];
    for (int base = tok_lo; base < tok_hi; base += 8) {
        const int tok = base + wave;
        f32x4 v[4];
#pragma unroll
        for (int j = 0; j < 4; ++j) v[j] = (f32x4){bflo(vn[j][0]), bfhi(vn[j][0]), bflo(vn[j][1]), bfhi(vn[j][1])} + DN_ALPHA * (f32x4){bflo(rn[j][0]), bfhi(rn[j][0]), bflo(rn[j][1]), bfhi(rn[j][1])};
        { const int tn = base + 8 + wave; const size_t ro = (size_t)((tn < tok_hi) ? tn : tok_lo) * DM; const u32x2* xr = (const u32x2*)(t1 + ro) + lane; const u32x2* rr = (const u32x2*)(hb + ro) + lane;
#pragma unroll
          for (int j = 0; j < 4; ++j) { vn[j] = xr[64 * j]; rn[j] = rr[64 * j]; } }
        if (tok < tok_hi) {
            float s = 0.f;
#pragma unroll
            for (int j = 0; j < 4; ++j) s += (v[j][0] + v[j][1]) + (v[j][2] + v[j][3]);
            const float mean = wave_sum(s) * (1.f / DM); float s2 = 0.f;
#pragma unroll
            for (int j = 0; j < 4; ++j) { v[j] = v[j] - mean; s2 += (v[j][0] * v[j][0] + v[j][1] * v[j][1]) + (v[j][2] * v[j][2] + v[j][3] * v[j][3]); }
            const float rstd = rsqrtf(wave_sum(s2) * (1.f / DM) + LN_EPS);
            u32x2* ob = (u32x2*)(hb + (size_t)tok * DM) + lane;
#pragma unroll
            for (int j = 0; j < 4; ++j) { const f32x4 y = v[j] * rstd * lw4[64 * j] + lb4[64 * j]; const u32x2 hi = (u32x2){pk2(y[0], y[1]), pk2(y[2], y[3])}; ob[64 * j] = hi;
                const u32x2 lo = (u32x2){pk2(y[0] - bflo(hi[0]), y[1] - bfhi(hi[0])), pk2(y[2] - bflo(hi[1]), y[3] - bfhi(hi[1]))};
                *(LAS u32x2*)(hhi + wave * HS + 4 * (lane + 64 * j)) = hi; *(LAS u32x2*)(hlo + wave * HS + 4 * (lane + 64 * j)) = lo; }
        }
        __syncthreads();
        { f32x4 acc[2]; acc[0] = (f32x4){0.f, 0.f, 0.f, 0.f}; acc[1] = acc[0];
#pragma unroll
          for (int ks = 0; ks < 4; ++ks) { const int ko = r * HS + 32 * (4 * wave + ks) + 8 * g; const bf16x8 ah = *(const LAS bf16x8*)(hhi + ko), al = *(const LAS bf16x8*)(hlo + ko);
#pragma unroll
              for (int nt = 0; nt < 2; ++nt) { acc[nt] = mfma16(ah, bh[ks][nt], acc[nt]); acc[nt] = mfma16(ah, bl[ks][nt], acc[nt]); acc[nt] = mfma16(al, bh[ks][nt], acc[nt]); } }
          if (g < 2) {
#pragma unroll
              for (int nt = 0; nt < 2; ++nt)
#pragma unroll
                  for (int j = 0; j < 4; ++j) part[(wave * 8 + 4 * g + j) * 32 + 16 * nt + r] = acc[nt][j]; } }
        __syncthreads();
        if (tok < tok_hi) { const int ee = lane & 31; float lg = rbias;
#pragma unroll
            for (int w8 = 0; w8 < 8; ++w8) lg += part[(w8 * 8 + wave) * 32 + ee];
            float bv[4]; int bi[4];
#pragma unroll
            for (int rd = 0; rd < 4; ++rd) { float mv = lg; int mi = ee;
#pragma unroll
                for (int o = 1; o < 32; o <<= 1) { const float ov = __shfl_xor(mv, o); const int oi = __shfl_xor(mi, o); const bool take = (ov > mv) || (ov == mv && oi < mi); mv = take ? ov : mv; mi = take ? oi : mi; }
                bv[rd] = mv; bi[rd] = mi; lg = (ee == mi) ? -__builtin_inff() : lg; }
            if (lane == 0) { const float e1 = __expf(bv[1] - bv[0]), e2 = __expf(bv[2] - bv[0]), e3 = __expf(bv[3] - bv[0]); const float inv = 1.0f / (1.0f + e1 + e2 + e3);
                const int l0 = __hip_atomic_fetch_add(&lcnt[bi[0]], 1, __ATOMIC_RELAXED, __HIP_MEMORY_SCOPE_WORKGROUP), l1 = __hip_atomic_fetch_add(&lcnt[bi[1]], 1, __ATOMIC_RELAXED, __HIP_MEMORY_SCOPE_WORKGROUP), l2 = __hip_atomic_fetch_add(&lcnt[bi[2]], 1, __ATOMIC_RELAXED, __HIP_MEMORY_SCOPE_WORKGROUP), l3 = __hip_atomic_fetch_add(&lcnt[bi[3]], 1, __ATOMIC_RELAXED, __HIP_MEMORY_SCOPE_WORKGROUP);
                *(int4*)(toke + tok * 4) = make_int4(bi[0], bi[1], bi[2], bi[3]); *(f32x4*)(tokg + tok * 4) = (f32x4){inv, e1 * inv, e2 * inv, e3 * inv}; *(int4*)(toklr + tok * 4) = make_int4(l0, l1, l2, l3); } }
        __syncthreads();
    }
    if (tid < 32) { unsigned* gc = (unsigned*)(C.ws + WS_CTL) + CW_CNT + cnt_off + l * 32 + tid;
        const unsigned bb = __hip_atomic_fetch_add(gc, (unsigned)lcnt[tid], __ATOMIC_RELAXED, __HIP_MEMORY_SCOPE_AGENT);
        ((int*)(C.ws + WS_BBASE))[C.blk * 32 + tid] = (int)bb; }
    __syncthreads();
}
__device__ __forceinline__ void permute_phase(const Params& P, const Ctx& C, int l) {
    const int tid = C.tid, wave = C.wave, lane = C.lane;
    LAS int* pst = (LAS int*)C.lds;
    if (tid == 0) { const unsigned* gc = (const unsigned*)(C.ws + WS_CTL) + CW_CNT + l * 32; int ps = 0;
        for (int e = 0; e < 32; ++e) { pst[e] = ps; ps += ((int)__hip_atomic_load(gc + e, __ATOMIC_RELAXED, __HIP_MEMORY_SCOPE_AGENT) + 255) & ~255; } }
    __syncthreads();
    const int tpb = (MTOK + C.G - 1) / C.G, tok_lo = C.blk * tpb, tok_hi = (tok_lo + tpb < MTOK) ? tok_lo + tpb : MTOK;
    const int* toke = (const int*)(C.ws + WS_TOKE); const float* tokg = (const float*)(C.ws + WS_TOKG); const int* toklr = (const int*)(C.ws + WS_TOKLR); const int* bbase = (const int*)(C.ws + WS_BBASE) + C.blk * 32;
    const bf16_t* hb = (const bf16_t*)(C.ws + WS_HB); bf16_t* xp = (bf16_t*)(C.ws + WS_XPERM); int* pdest = (int*)(C.ws + WS_PDEST); float* pgate = (float*)(C.ws + WS_PGATE);
    int* ptok = (int*)(C.ws + WS_PTOK);
    for (int a = tid; a < 4 * (tok_hi - tok_lo); a += 512) { const int tok = tok_lo + (a >> 2), as = tok * 4 + (a & 3);
        const int e = toke[as]; const int pos = pst[e] + bbase[e] + toklr[as];
        pdest[pos] = as; pgate[pos] = tokg[as]; ptok[pos] = tok; }
    __syncthreads();
}
__device__ __forceinline__ void build_tile_e(const Ctx& C, int l) {
    LAS int* te = (LAS int*)(C.lds + TILEE_OFF);
    if (C.tid == 0) { const unsigned* gc = (const unsigned*)(C.ws + WS_CTL) + CW_CNT + l * 32; int t = 0;
        for (int e = 0; e < 32; ++e) { const int nt = ((int)__hip_atomic_load(gc + e, __ATOMIC_RELAXED, __HIP_MEMORY_SCOPE_AGENT) + 255) >> 8; for (int k = 0; k < nt && t < NT_MAX; ++k) te[t++] = e; }
        for (; t < NT_MAX; ++t) te[t] = 0; }
    __syncthreads();
}
__device__ __forceinline__ void combine_ln2_phase(const Params& P, const Ctx& C, int l) {
    const int lane = C.lane; const int gw = C.blk * 8 + C.wave, NGW = C.G * 8;
    const bool last = (l == NLAYER - 1);
    LAS float* wg = (LAS float*)C.lds;
    if (!last) load_wg(wg, P.in[I_WIN] + (size_t)(l + 1) * DM * CIN, C.tid);
    const bf16_t* yb = (const bf16_t*)(C.ws + WS_YB);
    float* hf = P.out; bf16_t* hb = (bf16_t*)(C.ws + WS_HB); float* pg = (float*)(C.ws + WS_PG);
    const f32x4* lw4 = (const f32x4*)(P.in[I_LN2W] + (size_t)l * DM) + lane; const f32x4* lb4 = (const f32x4*)(P.in[I_LN2B] + (size_t)l * DM) + lane;
    u32x2 nh[4], ny[4][4];
    { const int tok = (gw < MTOK) ? gw : 0; const u32x2* xr = (const u32x2*)(hb + (size_t)tok * DM) + lane;
#pragma unroll
      for (int j = 0; j < 4; ++j) nh[j] = xr[64 * j];
#pragma unroll
      for (int sl = 0; sl < 4; ++sl) { const u32x2* yr = (const u32x2*)(yb + (size_t)(tok * 4 + sl) * DM) + lane;
#pragma unroll
          for (int j = 0; j < 4; ++j) ny[sl][j] = yr[64 * j]; } }
    for (int tok = gw; tok < MTOK; tok += NGW) {
        f32x4 v[4]; float s = 0.f;
#pragma unroll
        for (int j = 0; j < 4; ++j) { v[j] = (f32x4){bflo(nh[j][0]), bfhi(nh[j][0]), bflo(nh[j][1]), bfhi(nh[j][1])} * DN_ALPHA;
#pragma unroll
            for (int sl = 0; sl < 4; ++sl) { const u32x2 w = ny[sl][j]; v[j][0] += bflo(w[0]); v[j][1] += bfhi(w[0]); v[j][2] += bflo(w[1]); v[j][3] += bfhi(w[1]); } }
        { const int tn = (tok + NGW < MTOK) ? tok + NGW : tok; const u32x2* xr = (const u32x2*)(hb + (size_t)tn * DM) + lane;
#pragma unroll
          for (int j = 0; j < 4; ++j) nh[j] = xr[64 * j];
#pragma unroll
          for (int sl = 0; sl < 4; ++sl) { const u32x2* yr = (const u32x2*)(yb + (size_t)(tn * 4 + sl) * DM) + lane;
#pragma unroll
              for (int j = 0; j < 4; ++j) ny[sl][j] = yr[64 * j]; } }
#pragma unroll
        for (int j = 0; j < 4; ++j) s += (v[j][0] + v[j][1]) + (v[j][2] + v[j][3]);
        const float mean = wave_sum(s) * (1.f / DM); float s2 = 0.f;
#pragma unroll
        for (int j = 0; j < 4; ++j) { v[j] = v[j] - mean; s2 += (v[j][0] * v[j][0] + v[j][1] * v[j][1]) + (v[j][2] * v[j][2] + v[j][3] * v[j][3]); }
        const float rstd = rsqrtf(wave_sum(s2) * (1.f / DM) + LN_EPS);
#pragma unroll
        for (int j = 0; j < 4; ++j) v[j] = v[j] * rstd * lw4[64 * j] + lb4[64 * j];
        if (last) { f32x4* of = (f32x4*)(hf + (size_t)tok * DM) + lane;
#pragma unroll
            for (int j = 0; j < 4; ++j) of[64 * j] = v[j]; }
        if (!last) { u32x2* ob = (u32x2*)(hb + (size_t)tok * DM) + lane;
#pragma unroll
            for (int j = 0; j < 4; ++j) ob[64 * j] = (u32x2){pk2(v[j][0], v[j][1]), pk2(v[j][2], v[j][3])};
            gate_cols(v, wg, P.in[I_BIN] + (size_t)(l + 1) * CIN + NPROJ, pg + (size_t)tok * 8, lane); }
    }
}

typedef const __attribute__((address_space(4))) Params* CParamsPtr;
__device__ __forceinline__ const Params* kparams() {
    const unsigned long long a = (unsigned long long)__builtin_amdgcn_kernarg_segment_ptr(); unsigned lo = (unsigned)a, hi = (unsigned)(a >> 32);
    asm volatile("" : "+v"(lo), "+v"(hi));
    lo = __builtin_amdgcn_readfirstlane(lo); hi = __builtin_amdgcn_readfirstlane(hi);
    return (const Params*)(CParamsPtr)(((unsigned long long)hi << 32) | lo);
}
__device__ __forceinline__ Ctx make_ctx(const Params& P, LAS unsigned char* lds, int wv0) {
    Ctx C; C.lds = lds; unsigned ones_ = ~0u; asm volatile("" : "+s"(ones_)); int t_ = wv0 * 64 + (int)__builtin_amdgcn_mbcnt_hi(ones_, __builtin_amdgcn_mbcnt_lo(ones_, 0u)), b_ = blockIdx.x, g_ = gridDim.x; asm volatile("" : "+v"(t_), "+v"(b_), "+v"(g_)); b_ = __builtin_amdgcn_readfirstlane(b_); g_ = __builtin_amdgcn_readfirstlane(g_);
    C.tid = t_; C.lane = C.tid & 63; C.wave = __builtin_amdgcn_readfirstlane(C.tid >> 6); C.blk = b_; C.G = g_; C.ws = P.ws; return C; }
__global__ void __launch_bounds__(512, 2) hybrid_fwd(Params Punused) {
    extern __shared__ __attribute__((aligned(16))) unsigned char lds_raw[];
    LAS unsigned char* const lds = (LAS unsigned char*)lds_raw;
    const int wv0 = __builtin_amdgcn_readfirstlane((int)threadIdx.x >> 6);
    volatile LAS unsigned* MISC = (volatile LAS unsigned*)(lds + MISC_OFF);
    for (int u = threadIdx.x; u < (LDS_BYTES - MISC_OFF) / 4; u += 512) MISC[u] = 0u;
    __syncthreads();
    const int lo = __builtin_amdgcn_readfirstlane(kparams()->ph_lo), hi = __builtin_amdgcn_readfirstlane(kparams()->ph_hi);
    #define IS_T0 (wv0 == 0 && __builtin_amdgcn_mbcnt_hi(~0u, __builtin_amdgcn_mbcnt_lo(~0u, 0u)) == 0u)
    if (hi - lo > 1) (void)xcd_barrier_post((unsigned*)(kparams()->ws + WS_CTL) + CW_BAR, MISC + 8, IS_T0);
#ifndef PHMASK
#define PHMASK 0x7ff
#endif
#define PH_EN(k) (((PHMASK) >> (k)) & 1)
#define RUN(gid) ((gid) >= lo && (gid) < hi)
#define SEAM(gid) do { if ((gid) + 1 < hi) { XcdBarrier bar_; bar_.bar = (unsigned*)(kparams()->ws + WS_CTL) + CW_BAR; bar_.x = xb_xcc_id(); bar_.st = (volatile LAS unsigned*)(lds + MISC_OFF) + 8; xcd_barrier(bar_, IS_T0); if (DUPBAR) xcd_barrier(bar_, IS_T0); } } while (0)
#ifndef DUPMASK
#define DUPMASK 0
#endif
#ifndef DUPBAR
#define DUPBAR 0
#endif
#define DUP(k) for (int rep_ = 0; rep_ < 1 + (((DUPMASK) >> (k)) & 1); ++rep_)
#define PHASE_BEGIN const Params& P = *kparams(); const Ctx C = make_ctx(P, lds, wv0);
    if (PH_EN(0) && RUN(0)) { DUP(0) { PHASE_BEGIN p0_prologue(P, C); } SEAM(0); }
#pragma unroll 1
    for (int l = 0; l < NLAYER; ++l) {
        const int g0 = 1 + l * NPH;
        if (g0 + NPH <= lo || g0 >= hi) continue;
        if (PH_EN(1) && RUN(g0 + 0)) {
            DUP(1) { PHASE_BEGIN
            pg8::Gemm g{(const bf16_t*)(C.ws + WS_HB), (const bf16_t*)(C.ws + WS_WIN) + (size_t)l * NPROJ * DM, MTOK, NPROJ, DM}; pg8::StaticOrder S; S.init(MTOK, NPROJ, C.G, C.blk);
            pg8::EpiBf16b E{(bf16_t*)(C.ws + WS_P), NPROJ, P.in[I_BIN] + (size_t)l * CIN};
            pg8::gemm_phase<pg8::EpiBf16b, pg8::StaticOrder>(C.lds, g, S, E, nullptr, C.tid); }
            SEAM(g0 + 0); }
        if (PH_EN(2) && RUN(g0 + 1)) {
            DUP(2) { PHASE_BEGIN
            constexpr int NU_SWA = 512, NU_RW = NB * 128 * 6, NU_ML = NB * 128 * 4;
#ifndef DUP2
#define DUP2 0
#endif
            for (int rp = 0; rp < 1 + ((DUP2 >> 1) & 1); ++rp) for (int cb = C.blk; cb < NB * 128; cb += C.G)
                for (int hh_ = 0; hh_ < 6; ++hh_) { rwb_unit(P, C, l, cb * 6 + hh_, hh_ != 0); if (hh_ == 0) { asm volatile("s_waitcnt vmcnt(0)" ::: "memory"); __syncthreads(); } }
            for (int rp = 0; rp < 1 + ((DUP2 >> 2) & 1); ++rp) for (int u = C.blk; u < NU_ML; u += C.G) mlb_unit(P, C, l, u); }
            SEAM(g0 + 1); }
        if (PH_EN(3) && RUN(g0 + 2)) {
            DUP(3) { PHASE_BEGIN
            {
#ifndef P3DUP
#define P3DUP 0
#endif
                if (C.blk < 48) { for (int rp = 0; rp < 1 + (P3DUP & 1); ++rp) { rwkv_chain(C, C.blk >> 1, C.blk & 1); __syncthreads(); } } else if (C.blk < 112) { for (int rp = 0; rp < 1 + ((P3DUP >> 1) & 1); ++rp) { mlstm_cscan(C, (C.blk - 48) >> 2, (C.blk - 48) & 3); __syncthreads(); } }
                LAS int* qslot = (LAS int*)(C.lds + MISC_OFF + 64); unsigned* qctr = (unsigned*)(C.ws + WS_CTL) + CW_SWAQ + l * 64;
                for (;;) { __syncthreads();
                    if (C.tid == 0) *qslot = (int)__hip_atomic_fetch_add(qctr, 1u, __ATOMIC_RELAXED, __HIP_MEMORY_SCOPE_AGENT);
                    __syncthreads();
                    const int u = *qslot; if (u >= 512) break;
                    swa_unit(P, C, l, u); } } }
            SEAM(g0 + 2); }
        if (PH_EN(4) && RUN(g0 + 3)) {
            DUP(4) { PHASE_BEGIN
            for (int u = C.blk; u < NB * 128; u += C.G) passd_unit(P, C, l, u); }
            SEAM(g0 + 3); }
        if (PH_EN(5) && RUN(g0 + 4)) {
            DUP(5) { PHASE_BEGIN
            pg8::Gemm g{(const bf16_t*)(C.ws + WS_YMIX), (const bf16_t*)(C.ws + WS_WOUT) + (size_t)l * DM * DM, MTOK, DM, DM}; pg8::StaticOrder S; S.init(MTOK, DM, C.G, C.blk);
            pg8::EpiPlainBf16 E{(bf16_t*)(C.ws + WS_T1), DM};
            pg8::gemm_phase<pg8::EpiPlainBf16, pg8::StaticOrder>(C.lds, g, S, E, nullptr, C.tid); }
            SEAM(g0 + 4); }
        if (PH_EN(6) && RUN(g0 + 5)) { DUP(6) { PHASE_BEGIN ln1_router_phase(P, C, l, (rep_ + 1 < 1 + (((DUPMASK) >> 6) & 1)) ? 512 : 0); } SEAM(g0 + 5); }
        if (PH_EN(7) && RUN(g0 + 6)) { DUP(7) { PHASE_BEGIN permute_phase(P, C, l); } SEAM(g0 + 6); }
        if (PH_EN(8) && RUN(g0 + 7)) {
            DUP(8) { PHASE_BEGIN
            build_tile_e(C, l);
            pg8::Gemm g{(const bf16_t*)(C.ws + WS_HB), (const bf16_t*)(C.ws + WS_WUP) + (size_t)l * NEXP * NUP * DM, POS_MAX, NUP, DM};
            pg8::MoeOrder<8> S{(const LAS int*)(C.lds + TILEE_OFF), C.G, C.blk, (const int*)(C.ws + WS_PTOK)};
            pg8::EpiSwiglu E{(bf16_t*)(C.ws + WS_ACT), P.in[I_EBUP] + (size_t)l * NEXP * NUP};
            pg8::gemm_phase<pg8::EpiSwiglu, pg8::MoeOrder<8>, false, true>(C.lds, g, S, E, nullptr, C.tid); }
            SEAM(g0 + 7); }
        if (PH_EN(9) && RUN(g0 + 8)) {
            DUP(9) { PHASE_BEGIN
            build_tile_e(C, l);
            pg8::Gemm g{(const bf16_t*)(C.ws + WS_ACT), (const bf16_t*)(C.ws + WS_WDN) + (size_t)l * NEXP * DM * DEXP, POS_MAX, DM, DEXP};
            pg8::MoeOrder<4> S{(const LAS int*)(C.lds + TILEE_OFF), C.G, C.blk, nullptr};
            pg8::EpiDown E{(bf16_t*)(C.ws + WS_YB), P.in[I_EBDN] + (size_t)l * NEXP * DM, (const int*)(C.ws + WS_PDEST), (const float*)(C.ws + WS_PGATE)};
            pg8::gemm_phase<pg8::EpiDown, pg8::MoeOrder<4>>(C.lds, g, S, E, nullptr, C.tid); }
            SEAM(g0 + 8); }
        if (PH_EN(10) && RUN(g0 + 9)) { DUP(10) { PHASE_BEGIN combine_ln2_phase(P, C, l); } SEAM(g0 + 9); }
    }
#undef RUN
#undef SEAM
}

#ifndef MK_PER_PHASE
#define MK_PER_PHASE 0
#endif
extern "C" void kernel_launch(void* const* d_in, const int* in_sizes, int n_in, void* d_out, int out_size, void* d_ws, size_t ws_size, hipStream_t stream) {
    static int grid = 0;
    if (grid == 0) {
        if (n_in != 29 || out_size != MTOK * DM || ws_size < WS_END) { fprintf(stderr, "kernel_launch: unexpected shapes (n_in %d out %d ws %zu)\n", n_in, out_size, ws_size); grid = -1; return; }
        int dev = 0, cus = 0;
        if (hipGetDevice(&dev) != hipSuccess || hipDeviceGetAttribute(&cus, hipDeviceAttributeMultiprocessorCount, dev) != hipSuccess) { grid = -1; return; }
        if (hipFuncSetAttribute((const void*)hybrid_fwd, hipFuncAttributeMaxDynamicSharedMemorySize, LDS_BYTES) != hipSuccess) { fprintf(stderr, "kernel_launch: hipFuncSetAttribute failed\n"); grid = -1; return; }
        int per_cu = 0;
        if (hipOccupancyMaxActiveBlocksPerMultiprocessor(&per_cu, (const void*)hybrid_fwd, 512, LDS_BYTES) != hipSuccess || per_cu < 1) { fprintf(stderr, "kernel_launch: occupancy query says %d\n", per_cu); }
        (void)hipGetLastError();
        grid = cus;
    }
    if (grid < 0) return;
    (void)hipMemsetAsync((char*)d_ws + WS_CTL, 0, CTL_ZERO_BYTES, stream);
    Params p; memset(&p, 0, sizeof(p));
    for (int i = 0; i < 29; ++i) p.in[i] = (const float*)d_in[i];
    p.out = (float*)d_out; p.ws = (unsigned char*)d_ws;
#if MK_PER_PHASE
    for (int ph = 0; ph < NPHASE_TOTAL; ++ph) { p.ph_lo = ph; p.ph_hi = ph + 1; hipLaunchKernelGGL(hybrid_fwd, dim3(grid), dim3(512), LDS_BYTES, stream, p); }
#else
    p.ph_lo = 0; p.ph_hi = NPHASE_TOTAL;
    hipLaunchKernelGGL(hybrid_fwd, dim3(grid), dim3(512), LDS_BYTES, stream, p);
#endif
}
```

```cpp
#include <hip/hip_runtime.h>
#include <cstdio>
#include <cstdint>
#include <cstring>

#define GAS __attribute__((address_space(1)))
#define LAS __attribute__((address_space(3)))
typedef float f32x2 __attribute__((ext_vector_type(2)));
typedef unsigned u32x2 __attribute__((ext_vector_type(2)));

namespace pg8 {
constexpr int EPI_BTAB = 140288, EPI_DTAB = 138240, EPI_GTAB = 139264;
#define PG8_LAS __attribute__((address_space(3)))
typedef unsigned short bf16_t;
typedef short bf16x8 __attribute__((ext_vector_type(8)));
typedef float f32x4 __attribute__((ext_vector_type(4)));
typedef unsigned u32x4 __attribute__((ext_vector_type(4)));
constexpr int BM = 256, BK = 64, HALF = 128, HTB = HALF * BK * 2  , STAGE_BYTES = 8 * HTB, NXCD = 8, WGM = 8;

__host__ __device__ __forceinline__ int lds_byte(int r, int c) { const int st = (r >> 4) * 2 + (c >> 5), rr = r & 15, cc = c & 31, ob = rr * 64 + cc * 2; return st * 1024 + (ob ^ (((ob >> 9) & 1) << 5)); }
__host__ __device__ __forceinline__ void stage_rc(int b, int& R, int& C) { const int st = b / 1024, sb = b % 1024, swz = sb ^ (((sb >> 9) & 1) << 5); R = (st >> 1) * 16 + swz / 64; C = (st & 1) * 32 + (swz % 64) / 2; }
__host__ __device__ __forceinline__ int perm32(int rho) { const int n = rho >> 4, i = rho & 15; return 8 * (i >> 2) + 4 * n + (i & 3); }

struct Unit { int pm, pn; };
struct Gemm { const bf16_t* A; const bf16_t* Bt; int M, N, K; };

struct StaticOrder {
    int nM, nN, nwg, G, c;
    __host__ __device__ void init(int M, int N, int G_, int c_) { nM = M / BM; nN = N / BM; nwg = nM * nN; G = G_; c = c_; }
    __host__ __device__ bool next(int i, Unit& u) const {
        const long L = (long)i * G + c; if (L >= nwg) return false;
        int wgid = (int)L; { const int q = nwg / NXCD, r = nwg % NXCD, xcd = wgid % NXCD, off = wgid / NXCD; wgid = (xcd < r ? xcd * (q + 1) : r * (q + 1) + (xcd - r) * q) + off; }
        const int nig = WGM * nN, gid = wgid / nig, fm = gid * WGM, gsz = (nM - fm) < WGM ? (nM - fm) : WGM;
        u.pm = fm + ((wgid % nig) % gsz); u.pn = (wgid % nig) / gsz; return true;
    }
    __device__ __forceinline__ void a_ready(const Unit&) const {}
    __device__ __forceinline__ void done(const Unit&) const {}
};
template <int NN> struct MoeOrder {
    const PG8_LAS int* tile_e; int G, c; const int* rowtok;
    __device__ __forceinline__ bool next(int i, Unit& u) const {
        const int s = i * G + c; if (s >= 544 * NN) return false;
        constexpr int per = 8 * NN; const int a = s / per, r = s % per, b = r >> 3, x = r & 7;
        const int pm = 68 * x + a; u.pm = pm; u.pn = tile_e[pm] * NN + b; return true;
    }
    __device__ __forceinline__ void a_ready(const Unit&) const {}
    __device__ __forceinline__ void done(const Unit&) const {}
};

__device__ __forceinline__ unsigned cvt_pk_bf16(float lo, float hi) { unsigned r; asm volatile("v_cvt_pk_bf16_f32 %0, %1, %2" : "=v"(r) : "v"(lo), "v"(hi)); return r; }

struct EpiBf16b {
    static constexpr bool PERM = true, AFTER_DRAIN = false;
    bf16_t* O; int ldc; const float* bias;
    __device__ __forceinline__ void prefetch(PG8_LAS unsigned char* lds, const Unit& u, int wid, int lane) const {
        if (wid < 4) __builtin_amdgcn_global_load_lds((const unsigned*)(bias + u.pn * BM + 64 * wid + lane), (PG8_LAS unsigned*)(lds + EPI_BTAB + wid * 256), 4, 0, 0); }
    __device__ __forceinline__ void operator()(const f32x4 (&acc)[2][2][4][2], const Unit& u, int wr, int wc, int fr, int fq, PG8_LAS unsigned char* lds) const {
        const int row0 = u.pm * BM + wr * 64 + fr; const int col0 = u.pn * BM + wc * 32 + 8 * fq;
        const PG8_LAS float* bt = (const PG8_LAS float*)(lds + EPI_BTAB) + wc * 32 + 8 * fq;
        f32x4 bv[2][2];
#pragma unroll
        for (int bj = 0; bj < 2; ++bj)
#pragma unroll
            for (int n = 0; n < 2; ++n) bv[bj][n] = *(const PG8_LAS f32x4*)(bt + bj * HALF + 4 * n);
#pragma unroll
        for (int ai = 0; ai < 2; ++ai)
#pragma unroll
            for (int m = 0; m < 4; ++m) { bf16_t* rowp = O + (size_t)(row0 + ai * HALF + m * 16) * ldc + col0;
#pragma unroll
                for (int bj = 0; bj < 2; ++bj) { const f32x4 v0 = acc[ai][bj][m][0] + bv[bj][0], v1 = acc[ai][bj][m][1] + bv[bj][1];
                    u32x4 w; w.x = cvt_pk_bf16(v0[0], v0[1]); w.y = cvt_pk_bf16(v0[2], v0[3]); w.z = cvt_pk_bf16(v1[0], v1[1]); w.w = cvt_pk_bf16(v1[2], v1[3]);
                    *(u32x4*)(rowp + bj * HALF) = w; } }
    }
};
struct EpiPlainBf16 {
    static constexpr bool PERM = true, AFTER_DRAIN = false;
    bf16_t* O; int ldc;
    __device__ __forceinline__ void prefetch(PG8_LAS unsigned char*, const Unit&, int, int) const {}
    __device__ __forceinline__ void operator()(const f32x4 (&acc)[2][2][4][2], const Unit& u, int wr, int wc, int fr, int fq, PG8_LAS unsigned char*) const {
        const int row0 = u.pm * BM + wr * 64 + fr, col0 = u.pn * BM + wc * 32 + 8 * fq;
#pragma unroll
        for (int ai = 0; ai < 2; ++ai)
#pragma unroll
            for (int m = 0; m < 4; ++m) { bf16_t* rowp = O + (size_t)(row0 + ai * HALF + m * 16) * ldc + col0;
#pragma unroll
                for (int bj = 0; bj < 2; ++bj) { const f32x4 v0 = acc[ai][bj][m][0], v1 = acc[ai][bj][m][1];
                    u32x4 w; w.x = cvt_pk_bf16(v0[0], v0[1]); w.y = cvt_pk_bf16(v0[2], v0[3]); w.z = cvt_pk_bf16(v1[0], v1[1]); w.w = cvt_pk_bf16(v1[2], v1[3]);
                    *(u32x4*)(rowp + bj * HALF) = w; } }
    }
};
struct EpiSwiglu {
    static constexpr bool PERM = true, AFTER_DRAIN = false;
    bf16_t* O; const float* bias;
    __device__ __forceinline__ void prefetch(PG8_LAS unsigned char* lds, const Unit& u, int wid, int lane) const {
        if (wid < 4) __builtin_amdgcn_global_load_lds((const unsigned*)(bias + u.pn * BM + 64 * wid + lane), (PG8_LAS unsigned*)(lds + EPI_BTAB + wid * 256), 4, 0, 0); }
    __device__ __forceinline__ void operator()(const f32x4 (&acc)[2][2][4][2], const Unit& u, int wr, int wc, int fr, int fq, PG8_LAS unsigned char* lds) const {
        const int row0 = u.pm * BM + wr * 64 + fr;
        const int ocol0 = ((u.pn & 7) * BM + wc * 32 + 8 * fq) >> 1;
        const PG8_LAS float* bt = (const PG8_LAS float*)(lds + EPI_BTAB) + wc * 32 + 8 * fq;
        f32x4 bv[2][2];
#pragma unroll
        for (int bj = 0; bj < 2; ++bj)
#pragma unroll
            for (int n = 0; n < 2; ++n) bv[bj][n] = *(const PG8_LAS f32x4*)(bt + bj * HALF + 4 * n);
        const bool oddrow = (fq & 1) != 0;
#pragma unroll
        for (int ai = 0; ai < 2; ++ai)
#pragma unroll
            for (int m = 0; m < 4; ++m) { bf16_t* rowp = O + (size_t)(row0 + ai * HALF + m * 16) * 1024 + ocol0;
                u32x2 w[2];
#pragma unroll
                for (int bj = 0; bj < 2; ++bj) { const f32x4 v0 = acc[ai][bj][m][0] + bv[bj][0], v1 = acc[ai][bj][m][1] + bv[bj][1];
                    float o[4];
#pragma unroll
                    for (int q = 0; q < 4; ++q) { const float gl = (q < 2) ? v0[2 * q] : v1[2 * q - 4], li = (q < 2) ? v0[2 * q + 1] : v1[2 * q - 3];
                        const float hg = fminf(gl, 7.0f), hl = fminf(fmaxf(li, -7.0f), 7.0f);
                        o[q] = hg * (hl + 1.0f) * __builtin_amdgcn_rcpf(1.0f + __expf(-1.702f * hg)); }
                    w[bj].x = cvt_pk_bf16(o[0], o[1]); w[bj].y = cvt_pk_bf16(o[2], o[3]); }
                { auto sx = __builtin_amdgcn_permlane16_swap(w[0].x, w[1].x, false, false); w[0].x = sx[0]; w[1].x = sx[1];
                  auto sy = __builtin_amdgcn_permlane16_swap(w[0].y, w[1].y, false, false); w[0].y = sy[0]; w[1].y = sy[1]; }
                u32x4 wv; wv.x = w[0].x; wv.y = w[0].y; wv.z = w[1].x; wv.w = w[1].y;
                *(u32x4*)(rowp + (oddrow ? (HALF / 2) - 4 : 0)) = wv; }
    }
};
struct EpiDown {
    static constexpr bool PERM = true, AFTER_DRAIN = false;
    bf16_t* O; const float* bias; const int* dest; const float* gate;
    __device__ __forceinline__ void prefetch(PG8_LAS unsigned char* lds, const Unit& u, int wid, int lane) const {
        if (wid < 4) { __builtin_amdgcn_global_load_lds((const unsigned*)(bias + u.pn * BM + 64 * wid + lane), (PG8_LAS unsigned*)(lds + EPI_BTAB + wid * 256), 4, 0, 0);
                       __builtin_amdgcn_global_load_lds((const unsigned*)(dest + u.pm * BM + 64 * wid + lane), (PG8_LAS unsigned*)(lds + EPI_DTAB + wid * 256), 4, 0, 0); }
        else __builtin_amdgcn_global_load_lds((const unsigned*)(gate + u.pm * BM + 64 * (wid - 4) + lane), (PG8_LAS unsigned*)(lds + EPI_GTAB + (wid - 4) * 256), 4, 0, 0); }
    __device__ __forceinline__ void operator()(const f32x4 (&acc)[2][2][4][2], const Unit& u, int wr, int wc, int fr, int fq, PG8_LAS unsigned char* lds) const {
        const int rloc = wr * 64 + fr;
        const int ocol0 = (u.pn & 3) * BM + wc * 32 + 8 * fq;
        const PG8_LAS float* bt = (const PG8_LAS float*)(lds + EPI_BTAB) + wc * 32 + 8 * fq; const PG8_LAS int* dt = (const PG8_LAS int*)(lds + EPI_DTAB); const PG8_LAS float* gtb = (const PG8_LAS float*)(lds + EPI_GTAB);
#pragma unroll
        for (int ai = 0; ai < 2; ++ai)
#pragma unroll
            for (int m = 0; m < 4; ++m) { const int pl = rloc + ai * HALF + m * 16; const int d = dt[pl]; const float gt = gtb[pl];
                if (d >= 0) { bf16_t* rowp = O + (size_t)d * 1024 + ocol0;
#pragma unroll
                    for (int bj = 0; bj < 2; ++bj) { const f32x4 b0 = *(const PG8_LAS f32x4*)(bt + bj * HALF), b1 = *(const PG8_LAS f32x4*)(bt + bj * HALF + 4); const f32x4 v0 = (acc[ai][bj][m][0] + b0) * gt, v1 = (acc[ai][bj][m][1] + b1) * gt;
                        u32x4 w; w.x = cvt_pk_bf16(v0[0], v0[1]); w.y = cvt_pk_bf16(v0[2], v0[3]); w.z = cvt_pk_bf16(v1[0], v1[1]); w.w = cvt_pk_bf16(v1[2], v1[3]);
                        *(u32x4*)(rowp + bj * HALF) = w; } } }
    }
};

template <class Epi, class Sched, bool STAMP = false, bool GATHER = false, bool ALIGN_EPI = true>
__device__ __forceinline__ void gemm_phase(PG8_LAS unsigned char* lds, const Gemm g, const Sched& S, const Epi& E, unsigned long long* stamps, const int tid_in) {
    const int tid = tid_in, wid = __builtin_amdgcn_readfirstlane(tid >> 6), lane = tid & 63, wr = wid >> 2, wc = wid & 3, fr = lane & 15, fq = lane >> 4;
    const int K = g.K, nt = K / BK;
    int ts_lo = 0, ts_hi = 0, nts = 0; const unsigned long long rt_entry = STAMP ? (unsigned long long)wall_clock64() : 0ull;
#define PG8_STAMP() do { if (STAMP && wid == 0 && nts < 64) { const unsigned long long _c = (unsigned long long)clock64(); \
        ts_lo = (lane == nts) ? (int)(unsigned)_c : ts_lo; ts_hi = (lane == nts) ? (int)(unsigned)(_c >> 32) : ts_hi; ++nts; } } while (0)
    PG8_STAMP();
    unsigned voffA[2], voffB[2];
#pragma unroll
    for (int i = 0; i < 2; ++i) { int R, C; stage_rc(tid * 16 + i * 8192, R, C); const int Rb = Epi::PERM ? ((R & ~31) + perm32(R & 31)) : R;
        voffA[i] = (unsigned)(R * K + C) * 2u; voffB[i] = (unsigned)(Rb * K + C) * 2u; }
    unsigned gc[2][2], gn[2][2];
    PG8_LAS int* rowtab = (PG8_LAS int*)(lds + 137216);
    const size_t kstep = (size_t)(BK * 2);
    const size_t hstep = (size_t)HALF * K * 2;
    const size_t tstep = 2 * hstep;
    const unsigned ldsw = (unsigned)wid * 1024u;
    const int aoff = lds_byte(wr * 64 + fr, fq * 8), boff = lds_byte(wc * 32 + fr, fq * 8);
#define PG8_SA(b, h) (((b) * 2 + (h)) * HTB)
#define PG8_SB(b, h) ((4 + (b) * 2 + (h)) * HTB)
#define PG8_STAGE(bufoff, gbase, voff) do { _Pragma("unroll") for (int _i = 0; _i < 2; ++_i) \
        __builtin_amdgcn_global_load_lds((const unsigned*)((const char*)(gbase) + (voff)[_i]), (PG8_LAS unsigned*)(lds + (bufoff) + ldsw + _i * 8192), 16, 0, 0); } while (0)
#define PG8_LDA(dst, b, h) do { _Pragma("unroll") for (int m = 0; m < 4; ++m) _Pragma("unroll") for (int k = 0; k < 2; ++k) dst[m][k] = *(const PG8_LAS bf16x8*)(lds + PG8_SA(b, h) + aoff + m * 2048 + k * 1024); } while (0)
#define PG8_LDB(dst, b, h) do { _Pragma("unroll") for (int n = 0; n < 2; ++n) _Pragma("unroll") for (int k = 0; k < 2; ++k) dst[n][k] = *(const PG8_LAS bf16x8*)(lds + PG8_SB(b, h) + boff + n * 2048 + k * 1024); } while (0)
#define PG8_MMA(ai, bj, At, Bt) do { __builtin_amdgcn_s_setprio(1); _Pragma("unroll") for (int m = 0; m < 4; ++m) _Pragma("unroll") for (int n = 0; n < 2; ++n) _Pragma("unroll") for (int k = 0; k < 2; ++k) \
        acc[ai][bj][m][n] = __builtin_amdgcn_mfma_f32_16x16x32_bf16(Bt[n][k], At[m][k], acc[ai][bj][m][n], 0, 0, 0); __builtin_amdgcn_s_setprio(0); } while (0)
#define PG8_WAIT_V(n) asm volatile("s_waitcnt vmcnt(" #n ")" ::: "memory")
#define PG8_WAIT_L(n) asm volatile("s_waitcnt lgkmcnt(" #n ")" ::: "memory")
#define PG8_BAR __builtin_amdgcn_s_barrier()
#define PG8_SCHED __builtin_amdgcn_sched_barrier(0)
    Unit cur, nxt; int ui = 0;
    if (!S.next(0, cur)) return;
    f32x4 acc[2][2][4][2];
#pragma unroll
    for (int a = 0; a < 2; ++a)
#pragma unroll
        for (int b = 0; b < 2; ++b)
#pragma unroll
            for (int m = 0; m < 4; ++m)
#pragma unroll
                for (int n = 0; n < 2; ++n) acc[a][b][m][n] = (f32x4){0.f, 0.f, 0.f, 0.f};
    bf16x8 At[4][2], B0[2][2], B1[2][2];
    const char* cA = GATHER ? (const char*)g.A : (const char*)g.A + (size_t)cur.pm * tstep; const char* cB = (const char*)g.Bt + (size_t)cur.pn * tstep;
    if constexpr (GATHER) {
#pragma unroll
        for (int h = 0; h < 2; ++h)
#pragma unroll
            for (int i = 0; i < 2; ++i) { int R, C; stage_rc(tid * 16 + i * 8192, R, C); gc[h][i] = (unsigned)S.rowtok[256 * cur.pm + 128 * h + R] * (unsigned)(K * 2) + (unsigned)(C * 2); gn[h][i] = gc[h][i]; } }
    S.a_ready(cur);
    PG8_STAGE(PG8_SB(0, 0), cB, voffB); if constexpr (GATHER) PG8_STAGE(PG8_SA(0, 0), cA, gc[0]); else PG8_STAGE(PG8_SA(0, 0), cA, voffA); PG8_STAGE(PG8_SB(0, 1), cB + hstep, voffB); if constexpr (GATHER) PG8_STAGE(PG8_SA(0, 1), cA, gc[1]); else PG8_STAGE(PG8_SA(0, 1), cA + hstep, voffA);
    if (wr == 1) PG8_BAR;
    PG8_WAIT_V(4); PG8_BAR;
    PG8_STAGE(PG8_SB(1, 0), cB + kstep, voffB); if constexpr (GATHER) PG8_STAGE(PG8_SA(1, 0), cA + kstep, gc[0]); else PG8_STAGE(PG8_SA(1, 0), cA + kstep, voffA); PG8_STAGE(PG8_SB(1, 1), cB + hstep + kstep, voffB);
    PG8_WAIT_V(6); PG8_BAR;
    PG8_STAMP();
    for (;;) {
        const bool has_next = S.next(ui + 1, nxt);
        const char* nA = GATHER ? cA : (has_next ? (const char*)g.A + (size_t)nxt.pm * tstep : cA); const char* nB = has_next ? (const char*)g.Bt + (size_t)nxt.pn * tstep : cB;
        for (int t = 0; t < nt; t += 2) {
            const bool last = (t == nt - 2);
            const char* a1 = cA + (size_t)(t + 1) * kstep;
            const char* a2 = last ? nA : cA + (size_t)(t + 2) * kstep; const char* b2 = last ? nB : cB + (size_t)(t + 2) * kstep;
            const char* a3 = a2 + kstep; const char* b3 = b2 + kstep;
            if (last && has_next) S.a_ready(nxt);
            if (t == nt - 4) { int ln_ = lane; asm volatile("" : "+v"(ln_)); E.prefetch(lds, cur, wid, ln_); }
            if constexpr (GATHER) {
                if (t == nt - 4 && has_next && wid < 4)
                    __builtin_amdgcn_global_load_lds((const unsigned*)(S.rowtok + 256 * nxt.pm + 64 * wid + lane), (PG8_LAS unsigned*)((PG8_LAS unsigned char*)rowtab + wid * 256), 4, 0, 0);
                if (last && has_next) { int tz = tid; asm volatile("" : "+v"(tz));
#pragma unroll
                    for (int h = 0; h < 2; ++h)
#pragma unroll
                        for (int i = 0; i < 2; ++i) { int R, C; stage_rc(tz * 16 + i * 8192, R, C); gn[h][i] = (unsigned)rowtab[128 * h + R] * (unsigned)(K * 2) + (unsigned)(C * 2); } } }
            unsigned g0x[2], g1x[2];
#pragma unroll
            for (int i = 0; i < 2; ++i) { g0x[i] = last ? gn[0][i] : gc[0][i]; g1x[i] = last ? gn[1][i] : gc[1][i]; }
            PG8_LDB(B0, 0, 0); PG8_SCHED; PG8_LDA(At, 0, 0); if constexpr (GATHER) PG8_STAGE(PG8_SA(1, 1), a1, gc[1]); else PG8_STAGE(PG8_SA(1, 1), a1 + hstep, voffA);
            PG8_WAIT_L(8); PG8_BAR; PG8_WAIT_L(0); PG8_MMA(0, 0, At, B0); PG8_BAR; PG8_SCHED;
            PG8_LDB(B1, 0, 1); PG8_STAGE(PG8_SB(0, 0), b2, voffB);
            PG8_BAR; PG8_WAIT_L(0); PG8_MMA(0, 1, At, B1); PG8_BAR;
            PG8_LDA(At, 0, 1); if constexpr (GATHER) PG8_STAGE(PG8_SA(0, 0), a2, g0x); else PG8_STAGE(PG8_SA(0, 0), a2, voffA);
            PG8_BAR; PG8_WAIT_L(0); PG8_MMA(1, 0, At, B0); PG8_BAR; PG8_SCHED;
            PG8_STAGE(PG8_SB(0, 1), b2 + hstep, voffB);
            PG8_WAIT_V(6); PG8_BAR; PG8_MMA(1, 1, At, B1); PG8_BAR;
            PG8_LDB(B0, 1, 0); PG8_SCHED; PG8_LDA(At, 1, 0); if constexpr (GATHER) PG8_STAGE(PG8_SA(0, 1), a2, g1x); else PG8_STAGE(PG8_SA(0, 1), a2 + hstep, voffA);
            PG8_WAIT_L(8); PG8_BAR; PG8_WAIT_L(0); PG8_MMA(0, 0, At, B0); PG8_BAR; PG8_SCHED;
            PG8_LDB(B1, 1, 1); PG8_STAGE(PG8_SB(1, 0), b3, voffB);
            PG8_BAR; PG8_WAIT_L(0); PG8_MMA(0, 1, At, B1); PG8_BAR;
            PG8_LDA(At, 1, 1); if constexpr (GATHER) PG8_STAGE(PG8_SA(1, 0), a3, g0x); else PG8_STAGE(PG8_SA(1, 0), a3, voffA);
            PG8_BAR; PG8_WAIT_L(0); PG8_MMA(1, 0, At, B0); PG8_BAR; PG8_SCHED;
            PG8_STAGE(PG8_SB(1, 1), b3 + hstep, voffB);
            PG8_WAIT_V(6); PG8_BAR; PG8_MMA(1, 1, At, B1); PG8_BAR;
        }
        PG8_STAMP();
        if constexpr (ALIGN_EPI) { if (wr == 0) PG8_BAR; }
        if constexpr (!Epi::AFTER_DRAIN) { E(acc, cur, wr, wc, fr, fq, lds); S.done(cur); }
        PG8_STAMP();
        if (!has_next) break;
#pragma unroll
        for (int a = 0; a < 2; ++a)
#pragma unroll
            for (int b = 0; b < 2; ++b)
#pragma unroll
                for (int m = 0; m < 4; ++m)
#pragma unroll
                    for (int n = 0; n < 2; ++n) acc[a][b][m][n] = (f32x4){0.f, 0.f, 0.f, 0.f};
        cur = nxt; cA = nA; cB = nB; ++ui;
        if constexpr (GATHER) {
#pragma unroll
            for (int h = 0; h < 2; ++h)
#pragma unroll
                for (int i = 0; i < 2; ++i) gc[h][i] = gn[h][i]; }
        if constexpr (ALIGN_EPI) { if (wr == 1) PG8_BAR; }
    }
    PG8_WAIT_V(0);
    if constexpr (!ALIGN_EPI) { if (wr == 0) PG8_BAR; }
    PG8_BAR;
    if constexpr (Epi::AFTER_DRAIN) { E.fused(acc, cur, wr, wc, fr, fq, lds, wid, lane); S.done(cur); }
    PG8_STAMP();
    if (STAMP && wid == 0) { stamps[lane] = lane < nts ? (((unsigned long long)(unsigned)ts_hi << 32) | (unsigned)ts_lo) : 0ull;
        if (lane == 62) stamps[62] = rt_entry; if (lane == 63) stamps[63] = (unsigned long long)wall_clock64(); }
#undef PG8_STAMP
#undef PG8_SA
#undef PG8_SB
#undef PG8_STAGE
#undef PG8_LDA
#undef PG8_LDB
#undef PG8_MMA
#undef PG8_WAIT_V
#undef PG8_WAIT_L
#undef PG8_BAR
#undef PG8_SCHED
}
}
using pg8::bf16_t; using pg8::bf16x8; using pg8::f32x4; using pg8::u32x4;

constexpr int NB = 4, SEQ = 8192, MTOK = NB * SEQ, DM = 1024, NLAYER = 4, CIN = 3080, NPROJ = 3072, NEXP = 32, DEXP = 1024, NUP = 2048;
constexpr int RWD = 384, RW_COLS = 1408;
constexpr int NT_MAX = 544, POS_MAX = NT_MAX * 256;
constexpr float DN_ALPHA = 1.6817928305074290861f;
constexpr float LN_EPS = 1e-5f;
constexpr int NPH = 10;
constexpr int NPHASE_TOTAL = 1 + NLAYER * NPH;

constexpr size_t MiB = 1u << 20;
constexpr size_t WS_CTL = 0, CTL_ZERO_BYTES = 65536;
constexpr size_t WS_WIN = 1 * MiB;
constexpr size_t WS_WOUT = 25 * MiB;
constexpr size_t WS_WUP = 33 * MiB;
constexpr size_t WS_WDN = 545 * MiB;
constexpr size_t WS_ROPE = 801 * MiB;
constexpr size_t WS_HB = 803 * MiB;
constexpr size_t WS_HF = 867 * MiB;
constexpr size_t WS_H1F = 995 * MiB;
constexpr size_t WS_T1 = 1123 * MiB;
constexpr size_t WS_P = 1251 * MiB;
constexpr size_t WS_PG = 1443 * MiB;
constexpr size_t WS_YMIX = 1444 * MiB;
constexpr size_t WS_RWM = 1508 * MiB;
constexpr size_t WS_RWNT = 1532 * MiB;
constexpr size_t WS_RWQH = 1580 * MiB;
constexpr size_t WS_RWYL = 1604 * MiB;
constexpr size_t WS_RWS = 1652 * MiB;
constexpr size_t WS_RWAUX = 1676 * MiB;
constexpr size_t WS_MLQ = 1724 * MiB;
constexpr size_t WS_MLNL = 1740 * MiB;
constexpr size_t WS_MLVEC = 1780 * MiB;
constexpr size_t WS_MLSC = 1781 * MiB;
constexpr size_t WS_MLKL = 1782 * MiB;
constexpr size_t WS_MLCT = 1822 * MiB;
constexpr size_t WS_MLM = 1842 * MiB;
constexpr size_t WS_WUPT = 1843 * MiB;
constexpr size_t WS_AUPT = 1843 * MiB + 256 * 1024;
constexpr size_t WS_GUPT = 1843 * MiB + 512 * 1024;
constexpr size_t WS_LISCR = 1845 * MiB;
constexpr size_t WS_WRH = 1844 * MiB;
constexpr size_t WS_WRL = 1844 * MiB + 256 * 1024;
constexpr size_t WS_XPERM = 2021 * MiB;
constexpr size_t WS_ACT = 2293 * MiB;
constexpr size_t WS_YB = 2565 * MiB;
constexpr size_t WS_TOKE = 2821 * MiB;
constexpr size_t WS_TOKG = 2822 * MiB;
constexpr size_t WS_TOKLR = 2823 * MiB;
constexpr size_t WS_PDEST = 2824 * MiB;
constexpr size_t WS_PGATE = 2825 * MiB;
constexpr size_t WS_BBASE = 2826 * MiB;
constexpr size_t WS_PTOK = 2827 * MiB;
constexpr size_t WS_END = 2828 * MiB;
constexpr int CW_CNT = 1024;
constexpr int CW_SWAQ = 2048;
constexpr int CW_BAR = 4096;
constexpr int LDS_BYTES = 147456;
constexpr int MISC_OFF = 143360;
constexpr int TILEE_OFF = 133120;

#define LDS_WAIT() asm volatile("s_waitcnt lgkmcnt(0)" ::: "memory")
#define LDS_BARRIER() do { asm volatile("s_waitcnt lgkmcnt(0)" ::: "memory"); __builtin_amdgcn_s_barrier(); asm volatile("" ::: "memory"); } while (0)
#define VM_WAIT() asm volatile("s_waitcnt vmcnt(0)" ::: "memory")
__device__ __forceinline__ unsigned f2bf(float f) { unsigned u = __builtin_bit_cast(unsigned, f); return (u + 0x7fffu + ((u >> 16) & 1u)) >> 16; }
typedef __bf16 bf16v2_t __attribute__((ext_vector_type(2)));
__device__ __forceinline__ unsigned pk2(float lo, float hi) { const f32x2 v = (f32x2){lo, hi}; return __builtin_bit_cast(unsigned, __builtin_convertvector(v, bf16v2_t)); }
__device__ __forceinline__ float bf2f(unsigned short b) { return __builtin_bit_cast(float, ((unsigned)b) << 16); }
__device__ __forceinline__ float bflo(unsigned w) { return __builtin_bit_cast(float, w << 16); }
__device__ __forceinline__ float bfhi(unsigned w) { return __builtin_bit_cast(float, w & 0xffff0000u); }
template <int CTRL, int RMASK> __device__ __forceinline__ float dpp_add(float v) { return v + __builtin_bit_cast(float, __builtin_amdgcn_update_dpp(0, __builtin_bit_cast(int, v), CTRL, RMASK, 0xF, false)); }
__device__ __forceinline__ float wave_sum(float v) {
    v = dpp_add<0xB1, 0xF>(v); v = dpp_add<0x4E, 0xF>(v); v = dpp_add<0x141, 0xF>(v); v = dpp_add<0x140, 0xF>(v);
    v = dpp_add<0x142, 0xA>(v); v = dpp_add<0x143, 0xC>(v);
    return __builtin_bit_cast(float, __builtin_amdgcn_readlane(__builtin_bit_cast(int, v), 63));
}
template <int CTRL> __device__ __forceinline__ float dpp_mov(float x) { return __builtin_bit_cast(float, __builtin_amdgcn_update_dpp(0, __builtin_bit_cast(int, x), CTRL, 0xF, 0xF, true)); }
__device__ __forceinline__ float sum8(float x) { x += dpp_mov<0xB1>(x); x += dpp_mov<0x4E>(x); x += dpp_mov<0x141>(x); return x; }
__device__ __forceinline__ float sigmoidf_(float x) { return __builtin_amdgcn_rcpf(1.0f + __expf(-x)); }

#define XB_TMO      128
#define XB_XCNT(j)  (256  + 64 * (j))
#define XB_XSUB(j)  (1280 + 64 * (j))
#define XB_XGEN(j)  (2304 + 64 * (j))
#define XB_TOP      3328
#define XB_TOPGEN   3392
#define XCD_BAR_WORDS 3456
#define XB_SPIN_CAP (1u << 22)
__device__ __forceinline__ unsigned xb_ld(unsigned* p)              { return __hip_atomic_load(p, __ATOMIC_RELAXED, __HIP_MEMORY_SCOPE_AGENT); }
__device__ __forceinline__ unsigned xb_add(unsigned* p, unsigned v) { return __hip_atomic_fetch_add(p, v, __ATOMIC_RELAXED, __HIP_MEMORY_SCOPE_AGENT); }
__device__ __forceinline__ unsigned xb_xcc_id() { return (unsigned)__builtin_amdgcn_s_getreg((3 << 11) | 20) & 0xFu; }
#define XB_SPIN(cond, bar) do { unsigned _sp = 0; while (cond) { __builtin_amdgcn_s_sleep(1); \
    if ((++_sp & 255u) == 0u) { if (xb_ld(&(bar)[XB_TMO])) break; if (_sp > XB_SPIN_CAP) { atomicAdd(&(bar)[XB_TMO], 1u); break; } } } } while (0)

struct XcdBarrier {
    unsigned* bar; unsigned x;
    volatile LAS unsigned* st;
};

__device__ __forceinline__ XcdBarrier xcd_barrier_post(unsigned* bar, volatile LAS unsigned* st, bool t0  ) {
    XcdBarrier b; b.bar = bar; b.x = xb_xcc_id(); b.st = st;
    if (t0) (void)xb_add(&bar[XB_XCNT(b.x)], 1u);
    return b;
}
__device__ __forceinline__ void xcd_barrier_complete(unsigned* bar, unsigned x, unsigned& nloc, unsigned& nx) {
    const unsigned G = gridDim.x * gridDim.y * gridDim.z;
    unsigned sum, cnt, mine, sp = 0u;
    for (;;) {
        sum = 0u; cnt = 0u; mine = 0u;
#pragma unroll
        for (unsigned j = 0; j < 16; ++j) { const unsigned c = xb_ld(&bar[XB_XCNT(j)]); sum += c; cnt += (c > 0u) ? 1u : 0u; mine = (j == x) ? c : mine; }
        if (sum == G) break;
        __builtin_amdgcn_s_sleep(1);
        if ((++sp & 255u) == 0u) { if (xb_ld(&bar[XB_TMO])) break; if (sp > XB_SPIN_CAP) { atomicAdd(&bar[XB_TMO], 1u); break; } }
    }
    nloc = mine > 0u ? mine : 1u; nx = cnt > 0u ? cnt : 1u;
}

__device__ __forceinline__ void xcd_barrier(const XcdBarrier& b, bool t0  ) {
    asm volatile("s_waitcnt vmcnt(0)" ::: "memory");
    __syncthreads();
    if (t0) {
        unsigned* bar = b.bar;
        __builtin_amdgcn_s_waitcnt(0);
        unsigned nloc = b.st[0], nx = b.st[1];
        if (nloc == 0u) { xcd_barrier_complete(bar, b.x, nloc, nx); b.st[0] = nloc; b.st[1] = nx; }
        const unsigned old = xb_add(&bar[XB_XSUB(b.x)], 1u);
        const unsigned gen = old / nloc;
        if (old + 1u == (gen + 1u) * nloc) {
            __builtin_amdgcn_fence(__ATOMIC_RELEASE, "agent");
            asm volatile("s_waitcnt vmcnt(0)" ::: "memory");
            const unsigned og = xb_add(&bar[XB_TOP], 1u);
            const unsigned tg = og / nx;
            if (og + 1u == (tg + 1u) * nx) xb_add(&bar[XB_TOPGEN], 1u);
            else XB_SPIN(xb_ld(&bar[XB_TOPGEN]) == tg, bar);
            __builtin_amdgcn_fence(__ATOMIC_ACQUIRE, "agent");
            xb_add(&bar[XB_XGEN(b.x)], 1u);
            asm volatile("s_waitcnt vmcnt(0)" ::: "memory");
        } else {
            XB_SPIN(xb_ld(&bar[XB_XGEN(b.x)]) == gen, bar);
            __builtin_amdgcn_fence(__ATOMIC_ACQUIRE, "agent");
            asm volatile("s_waitcnt vmcnt(0)" ::: "memory");
        }
    }
    __syncthreads();
}
struct Params {
    const float* in[29];
    float* out; unsigned char* ws;
    int ph_lo, ph_hi;
    int pad0, pad1;
};
enum { I_X = 0, I_WIN, I_BIN, I_MU, I_WUP, I_W0, I_AUP, I_A0, I_GUP, I_KK, I_KA, I_RK, I_LNW, I_LNB, I_SINK, I_CONVW, I_CONVB, I_MLNW, I_WOUT,
       I_LN1W, I_LN1B, I_RW, I_RB, I_EWUP, I_EBUP, I_EWDN, I_EBDN, I_LN2W, I_LN2B };

struct Ctx {
    LAS unsigned char* lds; int tid, lane, wave, blk, G;
    unsigned char* ws;
};

__device__ __forceinline__ void tr_item(const float* W, int ldw, int K, bf16_t* WT, LAS float* scr, int kb, int nb, int lane) {
    const int k0 = 64 * kb, n0 = 32 * nb;
#pragma unroll 8
    for (int i = 0; i < 32; ++i) { const int kk = 2 * i + (lane >> 5); scr[kk * 33 + (lane & 31)] = __builtin_nontemporal_load(W + (size_t)(k0 + kk) * ldw + n0 + (lane & 31)); }
    LDS_WAIT();
    const int c = lane & 7;
#pragma unroll
    for (int j = 0; j < 4; ++j) { const int n = (lane >> 3) + 8 * j; const LAS float* s = scr + (8 * c) * 33 + n;
        u32x4 o; o.x = pk2(s[0 * 33], s[1 * 33]); o.y = pk2(s[2 * 33], s[3 * 33]); o.z = pk2(s[4 * 33], s[5 * 33]); o.w = pk2(s[6 * 33], s[7 * 33]);
        *(u32x4*)(WT + (size_t)(n0 + n) * K + k0 + 8 * c) = o; }
    LDS_WAIT();
}
__device__ __forceinline__ void gate_cols(const f32x4 (&v)[4], const LAS float* tab, const float* bg, float* pgrow, int lane) {
    float acc[8];
#pragma unroll
    for (int c = 0; c < 8; ++c) acc[c] = 0.f;
#pragma unroll
    for (int j = 0; j < 4; ++j)
#pragma unroll
        for (int q = 0; q < 4; ++q) { const LAS f32x4* tp = (const LAS f32x4*)(tab + ((j * 4 + q) * 64 + lane) * 8); const f32x4 a = tp[0], b = tp[1]; const float x = v[j][q];
            acc[0] += x * a[0]; acc[1] += x * a[1]; acc[2] += x * a[2]; acc[3] += x * a[3]; acc[4] += x * b[0]; acc[5] += x * b[1]; acc[6] += x * b[2]; acc[7] += x * b[3]; }
#pragma unroll
    for (int c = 0; c < 8; ++c) acc[c] = wave_sum(acc[c]);
    if (lane < 8) { float r = acc[0];
#pragma unroll
        for (int c = 1; c < 8; ++c) r = (lane == c) ? acc[c] : r;
        pgrow[lane] = r + bg[lane]; }
}
__device__ __forceinline__ void load_wg(LAS float* tab, const float* win_l, int tid) {
    for (int d = tid; d < DM; d += 512) { const int j = d >> 8, ln = (d >> 2) & 63, q = d & 3; const f32x4 a = *(const f32x4*)(win_l + (size_t)d * CIN + NPROJ), b = *(const f32x4*)(win_l + (size_t)d * CIN + NPROJ + 4);
        LAS f32x4* tp = (LAS f32x4*)(tab + ((j * 4 + q) * 64 + ln) * 8); tp[0] = a; tp[1] = b; }
    __syncthreads();
}
__device__ __forceinline__ void p0_prologue(const Params& P, const Ctx& C) {
    LAS float* scr = (LAS float*)(C.lds + C.wave * 16384);
    const int gw = C.blk * 8 + C.wave, NGW = C.G * 8;
    bf16_t* win_t = (bf16_t*)(C.ws + WS_WIN); bf16_t* wout_t = (bf16_t*)(C.ws + WS_WOUT); bf16_t* wup_t = (bf16_t*)(C.ws + WS_WUP); bf16_t* wdn_t = (bf16_t*)(C.ws + WS_WDN);
    constexpr int I_IN = 16 * 96, I_OUT = 16 * 32, I_UP = 16 * 64, I_DN = 16 * 32;
    constexpr int N1 = NLAYER * I_IN, N2 = NLAYER * I_OUT, N3 = NLAYER * NEXP * I_UP, N4 = NLAYER * NEXP * I_DN;
    for (int it = gw; it < N1 + N2 + N3 + N4; it += NGW) {
        int r = it;
        if (r < N1) { const int l = r / I_IN; r %= I_IN; tr_item(P.in[I_WIN] + (size_t)l * DM * CIN, CIN, DM, win_t + (size_t)l * NPROJ * DM, scr, r / 96, r % 96, C.lane); continue; } r -= N1;
        if (r < N2) { const int l = r / I_OUT; r %= I_OUT; tr_item(P.in[I_WOUT] + (size_t)l * DM * DM, DM, DM, wout_t + (size_t)l * DM * DM, scr, r / 32, r % 32, C.lane); continue; } r -= N2;
        if (r < N3) { const int le = r / I_UP; r %= I_UP; tr_item(P.in[I_EWUP] + (size_t)le * DM * NUP, NUP, DM, wup_t + (size_t)le * NUP * DM, scr, r / 64, r % 64, C.lane); continue; } r -= N3;
        { const int le = r / I_DN; r %= I_DN; tr_item(P.in[I_EWDN] + (size_t)le * DEXP * DM, DM, DEXP, wdn_t + (size_t)le * DM * DEXP, scr, r / 32, r % 32, C.lane); }
    }
    f32x2* rope = (f32x2*)(C.ws + WS_ROPE);
    for (int idx = C.blk * 512 + C.tid; idx < SEQ * 32; idx += C.G * 512) { const int t = idx >> 5, i = idx & 31;
        const float inv = powf(10000.0f, -(float)i / 32.0f); const float ang = (float)t * inv;
        const double rev = (double)ang * 0.15915494309189533577; const float fr = (float)(rev - __builtin_rint(rev));
        rope[idx] = (f32x2){__builtin_amdgcn_cosf(fr), __builtin_amdgcn_sinf(fr)}; }
    { bf16_t* wt = (bf16_t*)(C.ws + WS_WUPT); bf16_t* at = (bf16_t*)(C.ws + WS_AUPT); bf16_t* gt = (bf16_t*)(C.ws + WS_GUPT);
      for (int idx = C.blk * 512 + C.tid; idx < NLAYER * RWD * 64; idx += C.G * 512) { const int ll = idx / (RWD * 64), rem = idx % (RWD * 64), j = rem >> 6, i = rem & 63;
          wt[idx] = (bf16_t)f2bf(P.in[I_WUP][((size_t)ll * 64 + i) * RWD + j]); at[idx] = (bf16_t)f2bf(P.in[I_AUP][((size_t)ll * 64 + i) * RWD + j]); }
      for (int idx = C.blk * 512 + C.tid; idx < NLAYER * RWD * 128; idx += C.G * 512) { const int ll = idx / (RWD * 128), rem = idx % (RWD * 128), j = rem >> 7, i = rem & 127;
          gt[idx] = (bf16_t)f2bf(P.in[I_GUP][((size_t)ll * 128 + i) * RWD + j]); } }
    { bf16_t* wh = (bf16_t*)(C.ws + WS_WRH); bf16_t* wl = (bf16_t*)(C.ws + WS_WRL);
      for (int idx = C.blk * 512 + C.tid; idx < NLAYER * NEXP * DM; idx += C.G * 512) { const int ll = idx / (NEXP * DM), rem = idx % (NEXP * DM), e = rem >> 10, d = rem & 1023;
          const float w = P.in[I_RW][((size_t)ll * DM + d) * NEXP + e]; const unsigned hi = f2bf(w); const float lo = w - bflo(hi); wh[idx] = (bf16_t)hi; wl[idx] = (bf16_t)f2bf(lo); } }
    __syncthreads(); LAS float* wg = (LAS float*)C.lds; load_wg(wg, P.in[I_WIN], C.tid);
    bf16_t* hb = (bf16_t*)(C.ws + WS_HB); float* pg = (float*)(C.ws + WS_PG);
    for (int m = gw; m < MTOK; m += NGW) {
        const f32x4* xr = (const f32x4*)(P.in[I_X] + (size_t)m * DM) + C.lane; f32x4 v[4];
#pragma unroll
        for (int j = 0; j < 4; ++j) v[j] = xr[64 * j];
        u32x2* o8 = (u32x2*)(hb + (size_t)m * DM) + C.lane;
#pragma unroll
        for (int j = 0; j < 4; ++j) o8[64 * j] = (u32x2){pk2(v[j][0], v[j][1]), pk2(v[j][2], v[j][3])};
        gate_cols(v, wg, P.in[I_BIN] + NPROJ, pg + (size_t)m * 8, C.lane);
    }
}

constexpr int LD = 72;
constexpr int BUFB = 64 * LD * 2;
__device__ __forceinline__ f32x4 mfma16(bf16x8 a, bf16x8 b, f32x4 c) { return __builtin_amdgcn_mfma_f32_16x16x32_bf16(a, b, c, 0, 0, 0); }
constexpr int SWA_VLD = 264;
__device__ __forceinline__ void swa_unit(const Params& P, const Ctx& C, int l, int u) {
    const int tid = C.tid, wave = C.wave, lane = C.lane, r = lane & 15, g = lane >> 4; const int b = u >> 7, n = (u >> 1) & 63, hk = u & 1;
    LAS bf16_t* Ks = (LAS bf16_t*)C.lds; LAS bf16_t* VT = Ks + 256 * LD;
    const bf16_t* p = (const bf16_t*)(C.ws + WS_P); const f32x2* rope = (const f32x2*)(C.ws + WS_ROPE);
    const int t_base = n * 128 - 128;
#pragma unroll
    for (int it = 0; it < 2; ++it) { const int q = tid + 512 * it, row = q >> 2, c8 = q & 3; const int t = t_base + row;
        u32x4 o1 = (u32x4){0u, 0u, 0u, 0u}, o2 = o1;
        if (t >= 0) { const bf16_t* pr = p + (size_t)(b * SEQ + t) * NPROJ + 1792 + hk * 64 + 8 * c8; const u32x4 a1 = *(const u32x4*)pr, a2 = *(const u32x4*)(pr + 32);
            const f32x4* rp = (const f32x4*)(rope + t * 32 + 8 * c8); float y1[8], y2[8];
#pragma unroll
            for (int e = 0; e < 4; ++e) { const f32x4 cs = rp[e];
                const float x1a = bflo(a1[e]), x1b = bfhi(a1[e]), x2a = bflo(a2[e]), x2b = bfhi(a2[e]);
                y1[2 * e] = x1a * cs[0] - x2a * cs[1]; y2[2 * e] = x2a * cs[0] + x1a * cs[1]; y1[2 * e + 1] = x1b * cs[2] - x2b * cs[3]; y2[2 * e + 1] = x2b * cs[2] + x1b * cs[3]; }
            o1 = (u32x4){pk2(y1[0], y1[1]), pk2(y1[2], y1[3]), pk2(y1[4], y1[5]), pk2(y1[6], y1[7])}; o2 = (u32x4){pk2(y2[0], y2[1]), pk2(y2[2], y2[3]), pk2(y2[4], y2[5]), pk2(y2[6], y2[7])}; }
        *(LAS u32x4*)(Ks + row * LD + 8 * c8) = o1; *(LAS u32x4*)(Ks + row * LD + 32 + 8 * c8) = o2; }
    if (tid < 256) { const int kg = tid >> 3, c8 = tid & 7; u32x4 in[8];
#pragma unroll
        for (int k = 0; k < 8; ++k) { const int t = t_base + 8 * kg + k; in[k] = (t >= 0) ? *(const u32x4*)(p + (size_t)(b * SEQ + t) * NPROJ + 1920 + hk * 64 + 8 * c8) : (u32x4){0u, 0u, 0u, 0u}; }
#pragma unroll
        for (int d = 0; d < 8; ++d) { unsigned hv[8];
#pragma unroll
            for (int k = 0; k < 8; ++k) { const unsigned w = in[k][d >> 1]; hv[k] = (d & 1) ? (w >> 16) : (w & 0xffffu); }
            *(LAS u32x4*)(VT + (8 * c8 + d) * SWA_VLD + 8 * kg) = (u32x4){hv[0] | (hv[1] << 16), hv[2] | (hv[3] << 16), hv[4] | (hv[5] << 16), hv[6] | (hv[7] << 16)}; } }
    LDS_BARRIER();
    const int qi = 16 * wave + r, t = n * 128 + qi;
    const f32x4* rq = (const f32x4*)(rope + t * 32 + 8 * g);
#pragma unroll 1
    for (int gq = 0; gq < 3; ++gq) { const int hq = hk * 3 + gq; int wave = C.wave; asm volatile("" : "+s"(wave));
        bf16x8 qf0, qf1;
        { const bf16_t* pr = p + (size_t)(b * SEQ + t) * NPROJ + RW_COLS + hq * 64 + 8 * g; const u32x4 a1 = *(const u32x4*)pr, a2 = *(const u32x4*)(pr + 32); float y1[8], y2[8];
#pragma unroll
          for (int e = 0; e < 4; ++e) { const f32x4 cs = rq[e]; const float x1a = bflo(a1[e]), x1b = bfhi(a1[e]), x2a = bflo(a2[e]), x2b = bfhi(a2[e]);
              y1[2 * e] = (x1a * cs[0] - x2a * cs[1]) * 0.125f; y2[2 * e] = (x2a * cs[0] + x1a * cs[1]) * 0.125f; y1[2 * e + 1] = (x1b * cs[2] - x2b * cs[3]) * 0.125f; y2[2 * e + 1] = (x2b * cs[2] + x1b * cs[3]) * 0.125f; }
          const u32x4 w1 = (u32x4){pk2(y1[0], y1[1]), pk2(y1[2], y1[3]), pk2(y1[4], y1[5]), pk2(y1[6], y1[7])}, w2 = (u32x4){pk2(y2[0], y2[1]), pk2(y2[2], y2[3]), pk2(y2[4], y2[5]), pk2(y2[6], y2[7])};
          qf0 = __builtin_bit_cast(bf16x8, w1); qf1 = __builtin_bit_cast(bf16x8, w2); }
        f32x4 sc[10]; const float sink = P.in[I_SINK][l * 6 + hq]; float mx = sink;
        int qiv = qi; asm volatile("" : "+v"(qiv));
#pragma unroll
        for (int kt = 0; kt < 10; ++kt) { const int kb = 16 * (wave + kt); f32x4 a = (f32x4){0.f, 0.f, 0.f, 0.f};
            if (kb < 256) { const LAS bf16_t* kp = Ks + (kb + r) * LD + 8 * g; a = mfma16(*(const LAS bf16x8*)kp, qf0, a); a = mfma16(*(const LAS bf16x8*)(kp + 32), qf1, a); }
#pragma unroll
            for (int j = 0; j < 4; ++j) { const int kj = kb + 4 * g + j; const bool valid = (kj > qiv) && (kj <= qiv + 128) && (kj < 256) && ((n != 0) || (kj >= 128)); a[j] = valid ? a[j] : -__builtin_inff(); mx = fmaxf(mx, a[j]); }
            sc[kt] = a; }
        mx = fmaxf(mx, __shfl_xor(mx, 16)); mx = fmaxf(mx, __shfl_xor(mx, 32));
        float sum = 0.f;
#pragma unroll
        for (int kt = 0; kt < 10; ++kt) {
#pragma unroll
            for (int j = 0; j < 4; ++j) { const float e = __expf(sc[kt][j] - mx); sc[kt][j] = e; sum += e; } }
        sum += __shfl_xor(sum, 16); sum += __shfl_xor(sum, 32); sum += __expf(sink - mx);
        const float inv = 1.0f / sum;
        f32x4 o[4];
#pragma unroll
        for (int dt = 0; dt < 4; ++dt) o[dt] = (f32x4){0.f, 0.f, 0.f, 0.f};
#pragma unroll
        for (int s = 0; s < 5; ++s) { const int kb = 16 * (wave + 2 * s);
            if (kb < 256) { const u32x4 pw = (u32x4){pk2(sc[2 * s][0], sc[2 * s][1]), pk2(sc[2 * s][2], sc[2 * s][3]), pk2(sc[2 * s + 1][0], sc[2 * s + 1][1]), pk2(sc[2 * s + 1][2], sc[2 * s + 1][3])};
                const bf16x8 pf = __builtin_bit_cast(bf16x8, pw); const bool two = (kb + 16 < 256);
#pragma unroll
                for (int dt = 0; dt < 4; ++dt) { const LAS bf16_t* vp = VT + (16 * dt + r) * SWA_VLD + kb + 4 * g; const u32x2 lo = *(const LAS u32x2*)vp; u32x2 hi = (u32x2){0u, 0u}; if (two) hi = *(const LAS u32x2*)(vp + 16);
                    const u32x4 af = (u32x4){lo[0], lo[1], hi[0], hi[1]}; o[dt] = mfma16(__builtin_bit_cast(bf16x8, af), pf, o[dt]); } } }
        bf16_t* yr = (bf16_t*)(C.ws + WS_YMIX) + (size_t)(b * SEQ + t) * DM + RWD + hq * 64 + 4 * g;
#pragma unroll
        for (int dt = 0; dt < 4; ++dt) *(u32x2*)(yr + 16 * dt) = (u32x2){pk2(o[dt][0] * inv, o[dt][1] * inv), pk2(o[dt][2] * inv, o[dt][3] * inv)};
    }
    LDS_BARRIER();
}
__device__ __forceinline__ f32x4 mm64(const LAS bf16_t* X, const LAS bf16_t* Y, int ti, int tj, f32x4 acc, int lane) {
    const int r = lane & 15, g = lane >> 4;
    const LAS bf16_t* xp = X + (16 * ti + r) * LD + 8 * g; const LAS bf16_t* yp = Y + (16 * tj + r) * LD + 8 * g;
    acc = mfma16(*(const LAS bf16x8*)xp, *(const LAS bf16x8*)yp, acc);
    acc = mfma16(*(const LAS bf16x8*)(xp + 32), *(const LAS bf16x8*)(yp + 32), acc);
    return acc;
}
__device__ __forceinline__ void storeT(LAS bf16_t* D, int ti, int tj, f32x4 v, int lane) {
    const int r = lane & 15, g = lane >> 4;
    *(LAS u32x2*)(D + (16 * tj + r) * LD + 16 * ti + 4 * g) = (u32x2){pk2(v[0], v[1]), pk2(v[2], v[3])};
}
template <int MODE> __device__ __forceinline__ f32x4 maskT(f32x4 v, int ti, int tj, int lane) {
    const int rho = 16 * tj + (lane & 15), kap = 16 * ti + 4 * (lane >> 4);
#pragma unroll
    for (int j = 0; j < 4; ++j) { const bool keep = (MODE == 0) ? (kap + j < rho) : (MODE == 1) ? (kap + j <= rho) : (kap + j > rho); v[j] = keep ? v[j] : 0.f; }
    return v;
}
__device__ __forceinline__ float wave_max(float v) {
#pragma unroll
    for (int o = 1; o < 64; o <<= 1) v = fmaxf(v, __shfl_xor(v, o));
    return v;
}

__device__ __forceinline__ void rwb_unit(const Params& P, const Ctx& C, int l, int u, bool reuse) {
    const int tid = C.tid, wave = C.wave, lane = C.lane, r = lane & 15, g = lane >> 4;
    const int h = u % 6, bcx = u / 6, b = bcx >> 7, c = bcx & 127; const int tok0 = b * SEQ + c * 64; const int ch = (b * 6 + h) * 128 + c;
    LAS unsigned char* L = C.lds;
#define RB(i) ((LAS bf16_t*)(L + (i) * BUFB))
    LAS bf16_t* X1 = RB(0); LAS bf16_t* X1T = RB(1); LAS bf16_t* Aak = RB(2); LAS bf16_t* Arb = RB(3); LAS bf16_t* Ark = RB(4); LAS bf16_t* Pb = RB(5);
    LAS bf16_t* At = RB(6); LAS bf16_t* AtT = RB(7); LAS bf16_t* Bt = RB(8); LAS bf16_t* BtT = RB(9); LAS bf16_t* Kt = RB(10); LAS bf16_t* KtT = RB(11); LAS bf16_t* Rt = RB(12); LAS bf16_t* VT = RB(13);
    LAS float* XW = (LAS float*)L; LAS float* XA = XW + 64 * 65; LAS float* XG = XA + 64 * 65;
    LAS bf16_t* LI = (LAS bf16_t*)(L + 6 * BUFB);
    LAS float* segtot = (LAS float*)(L + 14 * BUFB); LAS float* gamL = segtot + 512;
    const bf16_t* p = (const bf16_t*)(C.ws + WS_P); const float* mu = P.in[I_MU] + l * RW_COLS;
    float cr9[9], ck9[9], cv9[9];
    { const int jc0 = 64 * h + lane;
#pragma unroll
      for (int i = 0; i < 9; ++i) { const int row = 8 * wave - 1 + i; const bool ok = (c * 64 + row >= 0); const bf16_t* q = p + (size_t)(tok0 + (ok ? row : 0)) * NPROJ;
          const float a_ = bf2f(q[jc0]), b_ = bf2f(q[RWD + jc0]), c_ = bf2f(q[2 * RWD + jc0]); cr9[i] = ok ? a_ : 0.f; ck9[i] = ok ? b_ : 0.f; cv9[i] = ok ? c_ : 0.f; } }
    bf16_t* liscr = (bf16_t*)(C.ws + WS_LISCR) + (size_t)C.blk * (64 * 264);
    if (!reuse) { u32x4 cu[4], pv[4]; f32x4 m0[4], m1[4];
#pragma unroll
      for (int i = 0; i < 4; ++i) { const int q = tid + 512 * i, t = q >> 5, c8 = q & 31; const bf16_t* src = p + (size_t)(tok0 + t) * NPROJ + 1152 + 8 * c8; const bool ok = (c * 64 + t > 0);
          cu[i] = *(const u32x4*)src; pv[i] = *(const u32x4*)(ok ? src - NPROJ : src); if (!ok) pv[i] = (u32x4){0u, 0u, 0u, 0u};
          m0[i] = *(const f32x4*)(mu + 1152 + 8 * c8); m1[i] = *(const f32x4*)(mu + 1152 + 8 * c8 + 4); }
#pragma unroll
      for (int i = 0; i < 4; ++i) { const int q = tid + 512 * i, t = q >> 5, c8 = q & 31; float x[8];
#pragma unroll
          for (int e = 0; e < 4; ++e) { const float c0 = bflo(cu[i][e]), c1 = bfhi(cu[i][e]), p0 = bflo(pv[i][e]), p1 = bfhi(pv[i][e]);
              const float mm0 = (e < 2) ? m0[i][2 * e] : m1[i][2 * e - 4], mm1 = (e < 2) ? m0[i][2 * e + 1] : m1[i][2 * e - 3];
              x[2 * e] = c0 + (p0 - c0) * mm0; x[2 * e + 1] = c1 + (p1 - c1) * mm1; }
          if (c8 < 8) {
#pragma unroll
              for (int e = 0; e < 8; ++e) x[e] = 1.0f - 2.0f * __builtin_amdgcn_rcpf(__expf(2.0f * x[e]) + 1.0f); }
          else if (c8 >= 16) {
#pragma unroll
              for (int e = 0; e < 8; ++e) x[e] = sigmoidf_(x[e]); }
          const u32x4 w = (u32x4){pk2(x[0], x[1]), pk2(x[2], x[3]), pk2(x[4], x[5]), pk2(x[6], x[7])};
          *(LAS u32x4*)(LI + t * 264 + 8 * c8) = w; *(u32x4*)(liscr + t * 264 + 8 * c8) = w; } }
    else {
#pragma unroll
      for (int i = 0; i < 4; ++i) { const int q = tid + 512 * i, t = q >> 5, c8 = q & 31; *(LAS u32x4*)(LI + t * 264 + 8 * c8) = *(const u32x4*)(liscr + t * 264 + 8 * c8); } }
    LDS_BARRIER();
    { bf16x8 bw[1][2], ba[1][2], bg[1][4];
      const int tj = wave & 3;
      const bf16_t* Ww = (const bf16_t*)(C.ws + WS_WUPT) + ((size_t)l * RWD + 64 * h + 16 * tj + r) * 64 + 8 * g;
      const bf16_t* Wa = (const bf16_t*)(C.ws + WS_AUPT) + ((size_t)l * RWD + 64 * h + 16 * tj + r) * 64 + 8 * g;
      const bf16_t* Wg = (const bf16_t*)(C.ws + WS_GUPT) + ((size_t)l * RWD + 64 * h + 16 * tj + r) * 128 + 8 * g;
#pragma unroll
      for (int ks = 0; ks < 2; ++ks) { bw[0][ks] = *(const bf16x8*)(Ww + 32 * ks); ba[0][ks] = *(const bf16x8*)(Wa + 32 * ks); }
#pragma unroll
      for (int ks = 0; ks < 4; ++ks) bg[0][ks] = *(const bf16x8*)(Wg + 32 * ks);
#pragma unroll
      for (int n = 0; n < 6; ++n) { const int o = n >> 1, ti = ((wave >> 2) + 2 * n) & 3; const int xoff = (o == 0) ? 0 : (o == 1) ? 64 : 128;
          const LAS bf16_t* xp = LI + (16 * ti + r) * 264 + xoff + 8 * g; f32x4 acc = (f32x4){0.f, 0.f, 0.f, 0.f};
          if (o == 0) { acc = mfma16(*(const LAS bf16x8*)xp, bw[0][0], acc); acc = mfma16(*(const LAS bf16x8*)(xp + 32), bw[0][1], acc); }
          else if (o == 1) { acc = mfma16(*(const LAS bf16x8*)xp, ba[0][0], acc); acc = mfma16(*(const LAS bf16x8*)(xp + 32), ba[0][1], acc); }
          else {
#pragma unroll
              for (int ks = 0; ks < 4; ++ks) acc = mfma16(*(const LAS bf16x8*)(xp + 32 * ks), bg[0][ks], acc); }
          LAS float* XO = (o == 0) ? XW : (o == 1) ? XA : XG;
#pragma unroll
          for (int j = 0; j < 4; ++j) XO[(16 * ti + 4 * g + j) * 65 + 16 * tj + r] = acc[j]; } }
    LDS_BARRIER();
    {
        const int jc = 64 * h + lane, tg = wave;
        const float w0 = P.in[I_W0][l * RWD + jc], a0 = P.in[I_A0][l * RWD + jc], kkc = P.in[I_KK][l * RWD + jc], kac = P.in[I_KA][l * RWD + jc], rkc = P.in[I_RK][l * RWD + jc];
        const float mur = mu[jc], muk = mu[RWD + jc], muv = mu[2 * RWD + jc];
        float pr = cr9[0], pk = ck9[0], pv = cv9[0];
        float ld[8], av[8], kn[8], km[8], rs[8], vs[8];
        bf16_t* aux = (bf16_t*)(C.ws + WS_RWAUX) + (size_t)(tok0 + 8 * tg) * 768;
#pragma unroll
        for (int i = 0; i < 8; ++i) { const int t = 8 * tg + i; const float cr = cr9[i + 1], ck = ck9[i + 1], cv = cv9[i + 1];
            rs[i] = cr + (pr - cr) * mur; const float ks = ck + (pk - ck) * muk; vs[i] = cv + (pv - cv) * muv; pr = cr; pk = ck; pv = cv;
            const float z = -(w0 + XW[t * 65 + lane]); const float sp = (z > 20.f) ? z : __logf(1.0f + __expf(z)); ld[i] = -__expf(-sp - 0.5f);
            const float a = sigmoidf_(a0 + XA[t * 65 + lane]); av[i] = a;
            const float kkv = ks * kkc; kn[i] = kkv * rsqrtf(fmaxf(wave_sum(kkv * kkv), 1e-24f));
            km[i] = ks * (1.0f + (a - 1.0f) * kac);
            const float dot = wave_sum(rs[i] * km[i] * rkc);
            aux[(size_t)i * 768 + jc] = (bf16_t)f2bf(dot * vs[i]); aux[(size_t)i * 768 + RWD + jc] = (bf16_t)f2bf(XG[t * 65 + lane]); }
        float cs[8]; cs[0] = ld[0];
#pragma unroll
        for (int i = 1; i < 8; ++i) cs[i] = cs[i - 1] + ld[i];
        segtot[tg * 64 + lane] = cs[7];
        LDS_BARRIER();
        float off = 0.f, tot = 0.f;
#pragma unroll
        for (int k = 0; k < 8; ++k) { const float sv = segtot[k * 64 + lane]; tot += sv; off += (k < tg) ? sv : 0.f; }
        if (wave == 0) gamL[lane] = __expf(tot);
        float oa[8], ob[8], ok[8], orr[8];
#pragma unroll
        for (int i = 0; i < 8; ++i) { const int t = 8 * tg + i; const float cum = off + cs[i]; const float gam = __expf(cum), gin = __expf(-cum), gpr = __expf(cum - ld[i]);
            oa[i] = -gpr * kn[i]; ob[i] = kn[i] * av[i] * gin; ok[i] = km[i] * gin; orr[i] = gam * rs[i];
            At[t * LD + lane] = (bf16_t)f2bf(oa[i]); Bt[t * LD + lane] = (bf16_t)f2bf(ob[i]); Kt[t * LD + lane] = (bf16_t)f2bf(ok[i]); Rt[t * LD + lane] = (bf16_t)f2bf(orr[i]); }
        *(LAS u32x4*)(AtT + lane * LD + 8 * tg) = (u32x4){pk2(oa[0], oa[1]), pk2(oa[2], oa[3]), pk2(oa[4], oa[5]), pk2(oa[6], oa[7])};
        *(LAS u32x4*)(BtT + lane * LD + 8 * tg) = (u32x4){pk2(ob[0], ob[1]), pk2(ob[2], ob[3]), pk2(ob[4], ob[5]), pk2(ob[6], ob[7])};
        *(LAS u32x4*)(KtT + lane * LD + 8 * tg) = (u32x4){pk2(ok[0], ok[1]), pk2(ok[2], ok[3]), pk2(ok[4], ok[5]), pk2(ok[6], ok[7])};
        *(LAS u32x4*)(VT + lane * LD + 8 * tg) = (u32x4){pk2(vs[0], vs[1]), pk2(vs[2], vs[3]), pk2(vs[4], vs[5]), pk2(vs[6], vs[7])};
    }
    LDS_BARRIER();
    const f32x4 Z4 = (f32x4){0.f, 0.f, 0.f, 0.f};
    const int wq = wave >> 2, tj = wave & 3;
    { f32x4 res[10];
#pragma unroll
      for (int n_ = 0; n_ < 10; ++n_) { const int o = n_ >> 1, ti = wq + 2 * (n_ & 1);
          if (o == 0) res[n_] = maskT<2>(mm64(At, Bt, ti, tj, Z4, lane), ti, tj, lane);
          else if (o == 1) res[n_] = maskT<0>(mm64(Bt, At, ti, tj, Z4, lane), ti, tj, lane);
          else if (o == 2) res[n_] = maskT<0>(mm64(Kt, At, ti, tj, Z4, lane), ti, tj, lane);
          else if (o == 3) res[n_] = maskT<1>(mm64(Bt, Rt, ti, tj, Z4, lane), ti, tj, lane);
          else res[n_] = maskT<1>(mm64(Kt, Rt, ti, tj, Z4, lane), ti, tj, lane); }
#pragma unroll
      for (int n_ = 0; n_ < 10; ++n_) { const int o = n_ >> 1, ti = wq + 2 * (n_ & 1);
          if (o == 0) storeT(X1T, ti, tj, res[n_], lane);
          else if (o == 1) { storeT(X1, ti, tj, res[n_], lane); f32x4 v = res[n_]; const int rho = 16 * tj + r, kap = 16 * ti + 4 * g;
#pragma unroll
              for (int j = 0; j < 4; ++j) v[j] += (kap + j == rho) ? 1.0f : 0.f;
              storeT(Pb, ti, tj, v, lane); }
          else if (o == 2) storeT(Aak, ti, tj, res[n_], lane);
          else if (o == 3) storeT(Arb, ti, tj, res[n_], lane);
          else storeT(Ark, ti, tj, res[n_], lane); } }
    LDS_BARRIER();
    f32x4 pacc[2];
#pragma unroll
    for (int q = 0; q < 2; ++q) { const int ti = wq + 2 * q; const u32x2 w = *(const LAS u32x2*)(Pb + (16 * tj + r) * LD + 16 * ti + 4 * g);
        pacc[q] = (f32x4){bflo(w[0]), bfhi(w[0]), bflo(w[1]), bfhi(w[1])}; }
#pragma unroll 1
    for (int rnd = 0; rnd < 6; ++rnd) {
        LAS bf16_t* Xn = (rnd & 1) ? RB(6) : RB(0); LAS bf16_t* XnT = (rnd & 1) ? RB(8) : RB(1);
        LAS bf16_t* Yn = (rnd & 1) ? RB(0) : RB(6); LAS bf16_t* YnT = (rnd & 1) ? RB(1) : RB(8);
        LAS bf16_t* Pold = (rnd & 1) ? RB(5) : RB(10); LAS bf16_t* Pnew = (rnd & 1) ? RB(10) : RB(5);
        f32x4 sq[4];
        if (rnd < 5) {
#pragma unroll
            for (int n_ = 0; n_ < 4; ++n_) { const int ti = wq + 2 * (n_ & 1); sq[n_] = (n_ < 2) ? mm64(Xn, XnT, ti, tj, Z4, lane) : mm64(XnT, Xn, ti, tj, Z4, lane); } }
        if (rnd > 0) {
#pragma unroll
            for (int q = 0; q < 2; ++q) pacc[q] = mm64(XnT, Pold, wq + 2 * q, tj, pacc[q], lane); }
        if (rnd < 5) {
#pragma unroll
            for (int n_ = 0; n_ < 4; ++n_) storeT((n_ < 2) ? YnT : Yn, wq + 2 * (n_ & 1), tj, sq[n_], lane); }
        if (rnd > 0) {
#pragma unroll
            for (int q = 0; q < 2; ++q) storeT(Pnew, wq + 2 * q, tj, pacc[q], lane); }
        LDS_BARRIER();
    }
    LAS bf16_t* Tm = RB(10);
    LAS bf16_t* AhT = RB(0); LAS bf16_t* W1T = RB(1); LAS bf16_t* UlT = RB(6);
    { f32x4 res[4];
#pragma unroll
      for (int n_ = 0; n_ < 4; ++n_) { const int ti = wq + 2 * (n_ & 1); res[n_] = (n_ < 2) ? mm64(Tm, AtT, ti, tj, Z4, lane) : mm64(Aak, VT, ti, tj, Z4, lane); }
#pragma unroll
      for (int n_ = 0; n_ < 4; ++n_) storeT((n_ < 2) ? AhT : W1T, wq + 2 * (n_ & 1), tj, res[n_], lane); }
    LDS_BARRIER();
    { f32x4 res[2];
#pragma unroll
      for (int n_ = 0; n_ < 2; ++n_) res[n_] = mm64(Tm, W1T, wq + 2 * n_, tj, Z4, lane);
#pragma unroll
      for (int n_ = 0; n_ < 2; ++n_) storeT(UlT, wq + 2 * n_, tj, res[n_], lane); }
    LDS_BARRIER();
    bf16_t* gM = (bf16_t*)(C.ws + WS_RWM) + (size_t)ch * 4096; bf16_t* gNT = (bf16_t*)(C.ws + WS_RWNT) + (size_t)ch * 4096; bf16_t* gQ = (bf16_t*)(C.ws + WS_RWQH) + (size_t)ch * 4096; bf16_t* gY = (bf16_t*)(C.ws + WS_RWYL) + (size_t)ch * 4096;
#pragma unroll
    for (int n_ = 0; n_ < 8; ++n_) { const int o = n_ >> 1, ti = wq + 2 * (n_ & 1); const int rho = 16 * tj + r, kap = 16 * ti + 4 * g;
        if (o == 0) {
            const u32x2 w = *(const LAS u32x2*)(Rt + rho * LD + kap); f32x4 v = (f32x4){bflo(w[0]), bfhi(w[0]), bflo(w[1]), bfhi(w[1])};
            v = mm64(AhT, Arb, ti, tj, v, lane); *(u32x2*)(gQ + rho * 64 + kap) = (u32x2){pk2(v[0], v[1]), pk2(v[2], v[3])}; }
        else if (o == 1) {
            f32x4 v = mm64(UlT, Arb, ti, tj, Z4, lane); v = mm64(VT, Ark, ti, tj, v, lane); *(u32x2*)(gY + rho * 64 + kap) = (u32x2){pk2(v[0], v[1]), pk2(v[2], v[3])}; }
        else if (o == 2) {
            f32x4 v = mm64(AhT, BtT, ti, tj, Z4, lane); const float gl = gamL[rho];
#pragma unroll
            for (int j = 0; j < 4; ++j) v[j] = gl * (v[j] + ((kap + j == rho) ? 1.0f : 0.f));
            *(u32x2*)(gM + rho * 64 + kap) = (u32x2){pk2(v[0], v[1]), pk2(v[2], v[3])}; }
        else {
            f32x4 v = mm64(BtT, UlT, ti, tj, Z4, lane); v = mm64(KtT, VT, ti, tj, v, lane);
#pragma unroll
            for (int j = 0; j < 4; ++j) v[j] *= gamL[kap + j];
            *(u32x2*)(gNT + rho * 64 + kap) = (u32x2){pk2(v[0], v[1]), pk2(v[2], v[3])}; } }
    LDS_BARRIER();
#undef RB
}

__device__ __forceinline__ void mlb_unit(const Params& P, const Ctx& C, int l, int u) {
    const int tid = C.tid, wave = C.wave, lane = C.lane, r = lane & 15, g = lane >> 4;
    const int hh = u & 3, bcx = u >> 2, b = bcx >> 7, c = bcx & 127; const int tok0 = b * SEQ + c * 64; const int ch = (b * 4 + hh) * 128 + c;
    LAS unsigned char* L = C.lds;
    LAS bf16_t* Qs = (LAS bf16_t*)L; LAS bf16_t* Ks = (LAS bf16_t*)(L + BUFB); LAS bf16_t* KhT = (LAS bf16_t*)(L + 2 * BUFB); LAS bf16_t* Sm = (LAS bf16_t*)(L + 3 * BUFB); LAS bf16_t* VTe = (LAS bf16_t*)(L + 4 * BUFB);
    LAS float* vbc = (LAS float*)(L + 4 * BUFB + 80 * LD * 2); LAS float* vig = vbc + 64; LAS float* vmd = vig + 64; LAS float* vws = vmd + 64;
    const bf16_t* p = (const bf16_t*)(C.ws + WS_P);
    unsigned xr[19], vr[8];
    { const int cq = tid & 127, tg = tid >> 7, isk = cq >> 6, d = cq & 63; const int col = 2048 + isk * 256 + hh * 64 + d; const int t0 = 16 * tg; const bool okp = (c * 64 + t0 > 0);
#pragma unroll
      for (int k = 0; k < 19; ++k) xr[k] = p[(size_t)(tok0 + ((k < 3 && !okp) ? 0 : t0 + k - 3)) * NPROJ + col];
      const int v = tid & 63, sg = tid >> 6;
#pragma unroll
      for (int k = 0; k < 8; ++k) vr[k] = p[(size_t)(tok0 + 8 * sg + k) * NPROJ + 2560 + hh * 64 + v]; }
    if (wave == 0) { const float* pg = (const float*)(C.ws + WS_PG) + (size_t)(tok0 + lane) * 8; const float ig = pg[hh], f = pg[4 + hh];
        const float lf = fminf(f, 0.f) - __logf(1.0f + __expf(-fabsf(f)));
        float bcv = lf;
#pragma unroll
        for (int o = 1; o < 64; o <<= 1) { const float t = __shfl_up(bcv, o); bcv += (lane >= o) ? t : 0.f; }
        float pm = ig - bcv;
#pragma unroll
        for (int o = 1; o < 64; o <<= 1) { const float t = __shfl_up(pm, o); pm = (lane >= o) ? fmaxf(pm, t) : pm; }
        const float md = bcv + pm; const float bcL = __shfl(bcv, 63); const float as = bcL - bcv + ig; const float mloc = wave_max(as); const float ws = __expf(as - mloc);
        vbc[lane] = bcv; vig[lane] = ig; vmd[lane] = md; vws[lane] = ws;
        float* vec = (float*)(C.ws + WS_MLVEC) + ((size_t)ch * 64 + lane) * 2; vec[0] = bcv; vec[1] = md;
        if (lane == 0) { float* sc = (float*)(C.ws + WS_MLSC) + (size_t)ch * 2; sc[0] = bcL; sc[1] = mloc; } }
    LDS_BARRIER();
    { const int cq = tid & 127, tg = tid >> 7, isk = cq >> 6, d = cq & 63; const int col = 2048 + isk * 256 + hh * 64 + d; const int cw = isk * 256 + hh * 64 + d;
      const float* cwp = P.in[I_CONVW] + (size_t)l * 4 * 512; const float w0 = cwp[cw], w1 = cwp[512 + cw], w2 = cwp[1024 + cw], w3 = cwp[1536 + cw], cb = P.in[I_CONVB][l * 512 + cw];
      float xm3 = 0.f, xm2 = 0.f, xm1 = 0.f; const int t0 = 16 * tg;
      if (c * 64 + t0 > 0) { xm3 = bf2f((unsigned short)xr[0]); xm2 = bf2f((unsigned short)xr[1]); xm1 = bf2f((unsigned short)xr[2]); }
      float o16[16];
#pragma unroll
      for (int k = 0; k < 16; ++k) { const float x0 = bf2f((unsigned short)xr[k + 3]); const float y = w0 * xm3 + w1 * xm2 + w2 * xm1 + w3 * x0 + cb; const float s = y * sigmoidf_(y);
          o16[k] = isk ? s * 0.125f : s; xm3 = xm2; xm2 = xm1; xm1 = x0; }
      if (!isk) { bf16_t* gq = (bf16_t*)(C.ws + WS_MLQ) + (size_t)ch * 4096;
#pragma unroll
          for (int k = 0; k < 16; ++k) { const bf16_t v = (bf16_t)f2bf(o16[k]); Qs[(t0 + k) * LD + d] = v; gq[(t0 + k) * 64 + d] = v; } }
      else {
#pragma unroll
          for (int k = 0; k < 16; ++k) { Ks[(t0 + k) * LD + d] = (bf16_t)f2bf(o16[k]); o16[k] *= vws[t0 + k]; }
          *(LAS u32x4*)(KhT + d * LD + t0) = (u32x4){pk2(o16[0], o16[1]), pk2(o16[2], o16[3]), pk2(o16[4], o16[5]), pk2(o16[6], o16[7])};
          *(LAS u32x4*)(KhT + d * LD + t0 + 8) = (u32x4){pk2(o16[8], o16[9]), pk2(o16[10], o16[11]), pk2(o16[12], o16[13]), pk2(o16[14], o16[15])}; }
      { const int v = tid & 63, sg = tid >> 6; float vv[8];
#pragma unroll
        for (int k = 0; k < 8; ++k) vv[k] = bf2f((unsigned short)vr[k]);
        *(LAS u32x4*)(VTe + v * LD + 8 * sg) = (u32x4){pk2(vv[0], vv[1]), pk2(vv[2], vv[3]), pk2(vv[4], vv[5]), pk2(vv[6], vv[7])}; }
      if (tid < 128) { const int row = 64 + (tid >> 3), pc = tid & 7; const unsigned one2 = 0x3f803f80u; const unsigned val = (row == 64) ? one2 : 0u; *(LAS u32x4*)(VTe + row * LD + 8 * pc) = (u32x4){val, val, val, val}; }
    }
    LDS_BARRIER();
    const f32x4 Z4 = (f32x4){0.f, 0.f, 0.f, 0.f};
    bf16_t* gKL = (bf16_t*)(C.ws + WS_MLKL) + (size_t)ch * 5120; bf16_t* gNL = (bf16_t*)(C.ws + WS_MLNL) + (size_t)ch * 5120;
    for (int task = wave; task < 36; task += 8) {
        if (task < 16) { const int ti = task >> 2, tj = task & 3; f32x4 v = mm64(Ks, Qs, ti, tj, Z4, lane);
            const int rho = 16 * tj + r, kap = 16 * ti + 4 * g; const float bl = vbc[rho] - vmd[rho];
#pragma unroll
            for (int j = 0; j < 4; ++j) { const int s = kap + j; v[j] = (s <= rho) ? v[j] * __expf(bl - vbc[s] + vig[s]) : 0.f; }
            storeT(Sm, ti, tj, v, lane); }
        else { const int t2 = task - 16, ti = t2 / 5, tj = t2 % 5;
            const f32x4 v = mm64(KhT, VTe, ti, tj, Z4, lane); *(u32x2*)(gKL + (16 * tj + r) * 64 + 16 * ti + 4 * g) = (u32x2){pk2(v[0], v[1]), pk2(v[2], v[3])}; } }
    LDS_BARRIER();
    for (int task = wave; task < 20; task += 8) { const int ti = task >> 2, tj = task & 3; const f32x4 v = mm64(VTe, Sm, ti, tj, Z4, lane); *(u32x2*)(gNL + (16 * tj + r) * 80 + 16 * ti + 4 * g) = (u32x2){pk2(v[0], v[1]), pk2(v[2], v[3])}; }
    LDS_BARRIER();
}

__device__ __forceinline__ void rwkv_chain(const Ctx& C, int bh, int vh) {
    const int tid = C.tid, wave = C.wave, lane = C.lane, r = lane & 15, g = lane >> 4; const size_t ch0 = (size_t)bh * 128;
    LAS unsigned char* L = C.lds; LAS unsigned char* Mb = L; LAS unsigned char* Nb = L + 8 * BUFB; LAS unsigned char* Sb = Nb + 8 * (32 * LD * 2);
    static_assert(8 * BUFB + 8 * 32 * LD * 2 + 8 * 32 * 128 <= MISC_OFF, "chain LDS");
    const bf16_t* gM = (const bf16_t*)(C.ws + WS_RWM) + ch0 * 4096; const bf16_t* gN = (const bf16_t*)(C.ws + WS_RWNT) + ch0 * 4096 + (size_t)vh * 32 * 64; bf16_t* gS = (bf16_t*)(C.ws + WS_RWS) + ch0 * 4096;
    u32x4 pmA[8], pnA4[4];
#define CH_LOAD(pm, pn, nbx) do { const bf16_t* m_ = gM + (size_t)(nbx) * 8 * 4096; \
        _Pragma("unroll") for (int i = 0; i < 8; ++i) pm[i] = ((const u32x4*)m_)[tid + 512 * i]; \
        _Pragma("unroll") for (int i = 0; i < 4; ++i) { const int q = tid + 512 * i, chunk = q >> 8, within = q & 255; pn[i] = ((const u32x4*)(gN + ((size_t)(nbx) * 8 + chunk) * 4096))[within]; } } while (0)
#define CH_PUT(pm, pn) do { \
        _Pragma("unroll") for (int i = 0; i < 8; ++i) { const int q = tid + 512 * i, chunk = q >> 9, within = q & 511, row = within >> 3, pc = within & 7; *(LAS u32x4*)(Mb + chunk * BUFB + row * (LD * 2) + pc * 16) = pm[i]; } \
        _Pragma("unroll") for (int i = 0; i < 4; ++i) { const int q = tid + 512 * i, chunk = q >> 8, within = q & 255, row = within >> 3, pc = within & 7; *(LAS u32x4*)(Nb + chunk * (32 * LD * 2) + row * (LD * 2) + pc * 16) = pn[i]; } } while (0)
    CH_LOAD(pmA, pnA4, 0);
    f32x4 acc[4];
#pragma unroll
    for (int t = 0; t < 4; ++t) acc[t] = (f32x4){0.f, 0.f, 0.f, 0.f};
#define CH_FRAGS(cc_, mf_, nf_) do { const LAS unsigned char* mc = Mb + (cc_) * BUFB; const LAS unsigned char* nc = Nb + (cc_) * (32 * LD * 2); \
        _Pragma("unroll") for (int t = 0; t < 4; ++t) { nf_[t] = *(const LAS u32x2*)(nc + (16 * wave + r) * (LD * 2) + (16 * t + 4 * g) * 2); \
            const LAS unsigned char* mp = mc + (16 * t + r) * (LD * 2) + (4 * g) * 2; const u32x2 lo = *(const LAS u32x2*)mp, hi = *(const LAS u32x2*)(mp + 32); mf_[t] = (u32x4){lo[0], lo[1], hi[0], hi[1]}; } } while (0)
#define CH_ONE(cc_, mf_, nf_) do { \
            u32x4 m2[4]; { const LAS unsigned char* mc = Mb + (cc_) * BUFB; \
            _Pragma("unroll") for (int t = 0; t < 4; ++t) { const LAS unsigned char* mp = mc + (16 * t + r) * (LD * 2) + (32 + 4 * g) * 2; const u32x2 lo = *(const LAS u32x2*)mp, hi = *(const LAS u32x2*)(mp + 32); m2[t] = (u32x4){lo[0], lo[1], hi[0], hi[1]}; } } \
            u32x2 pk[4]; \
            _Pragma("unroll") for (int t = 0; t < 4; ++t) pk[t] = (u32x2){pk2(acc[t][0], acc[t][1]), pk2(acc[t][2], acc[t][3])}; \
            LAS unsigned char* sg = Sb + (cc_) * 4096 + (16 * wave + r) * 128 + (4 * g) * 2; \
            _Pragma("unroll") for (int t = 0; t < 4; ++t) *(LAS u32x2*)(sg + 32 * t) = pk[t]; \
            bf16x8 zb[2]; \
            _Pragma("unroll") for (int s = 0; s < 2; ++s) { const u32x4 z = (u32x4){pk[2 * s][0], pk[2 * s][1], pk[2 * s + 1][0], pk[2 * s + 1][1]}; zb[s] = __builtin_bit_cast(bf16x8, z); } \
            _Pragma("unroll") for (int t = 0; t < 4; ++t) { const u32x2 nw = nf_[t]; const f32x4 a0 = (f32x4){bflo(nw[0]), bfhi(nw[0]), bflo(nw[1]), bfhi(nw[1])}; \
                acc[t] = mfma16(__builtin_bit_cast(bf16x8, mf_[t]), zb[0], a0); } \
            _Pragma("unroll") for (int t = 0; t < 4; ++t) acc[t] = mfma16(__builtin_bit_cast(bf16x8, m2[t]), zb[1], acc[t]); } while (0)
#define CH_STEP(nbx) do { if (wave < 2) { u32x4 mf0[4], mf1[4]; u32x2 nf0[4], nf1[4]; CH_FRAGS(0, mf0, nf0); \
        _Pragma("unroll 1") for (int cc = 0; cc < 8; cc += 2) { \
            CH_FRAGS(cc + 1, mf1, nf1); CH_ONE(cc, mf0, nf0); \
            if (cc + 2 < 8) CH_FRAGS(cc + 2, mf0, nf0); CH_ONE(cc + 1, mf1, nf1); } } } while (0)
#define CH_SOUT(nbx) do { _Pragma("unroll") for (int i = 0; i < 4; ++i) { const int q = tid + 512 * i, chunk = q >> 8, within = q & 255, row = within >> 3, pc = within & 7; \
        const u32x4 v = *(const LAS u32x4*)(Sb + chunk * 4096 + row * 128 + pc * 16); *(u32x4*)(gS + ((size_t)(nbx) * 8 + chunk) * 4096 + (32 * vh + row) * 64 + pc * 8) = v; } } while (0)
    for (int nb = 0; nb < 16; ++nb) {
        LDS_BARRIER(); if (nb > 0) CH_SOUT(nb - 1); CH_PUT(pmA, pnA4); LDS_BARRIER();
        if (nb + 1 < 16) CH_LOAD(pmA, pnA4, nb + 1);
        CH_STEP(nb);
    }
    LDS_BARRIER(); CH_SOUT(15);
#undef CH_SOUT
#undef CH_LOAD
#undef CH_PUT
#undef CH_STEP
#undef CH_FRAGS
#undef CH_ONE
}
__device__ __forceinline__ void mlstm_cscan(const Ctx& C, int bh, int part) {
    const int tid = C.tid; const size_t ch0 = (size_t)bh * 128; const int e0 = 10 * (part * 128 + (tid & 127));
    const bf16_t* KL = (const bf16_t*)(C.ws + WS_MLKL) + ch0 * 5120 + e0; bf16_t* CT = (bf16_t*)(C.ws + WS_MLCT) + ch0 * 5120 + e0; float* MM = (float*)(C.ws + WS_MLM) + ch0; const float* SC = (const float*)(C.ws + WS_MLSC) + ch0 * 2;
    float st[10]; unsigned ring[8][5]; float m = 0.f;
    LAS float* scl = (LAS float*)C.lds; if (tid < 256) scl[tid] = SC[tid];
    __syncthreads();
    if (tid >= 128) return;
#pragma unroll
    for (int i = 0; i < 10; ++i) st[i] = 0.f;
#pragma unroll
    for (int k = 0; k < 8; ++k)
#pragma unroll
        for (int i = 0; i < 5; ++i) ring[k][i] = *(const unsigned*)(KL + (size_t)k * 5120 + 2 * i);
    for (int c0 = 0; c0 < 128; c0 += 8) {
#pragma unroll
        for (int k = 0; k < 8; ++k) { const int c = c0 + k; unsigned cur[5];
#pragma unroll
            for (int i = 0; i < 5; ++i) cur[i] = ring[k][i];
            if (c + 8 < 128) {
#pragma unroll
                for (int i = 0; i < 5; ++i) ring[k][i] = *(const unsigned*)(KL + (size_t)(c + 8) * 5120 + 2 * i); }
            const float bcL = scl[2 * c], mloc = scl[2 * c + 1];
            unsigned* ct = (unsigned*)(CT + (size_t)c * 5120);
#pragma unroll
            for (int i = 0; i < 5; ++i) ct[i] = pk2(st[2 * i], st[2 * i + 1]);
            if (tid == 0 && part == 0) MM[c] = m;
            const float mn = fmaxf(bcL + m, mloc); const float dec = __expf(bcL + m - mn), sc = __expf(mloc - mn); m = mn;
#pragma unroll
            for (int i = 0; i < 5; ++i) { st[2 * i] = dec * st[2 * i] + sc * bflo(cur[i]); st[2 * i + 1] = dec * st[2 * i + 1] + sc * bfhi(cur[i]); } }
    }
}

__device__ __forceinline__ void passd_unit(const Params& P, const Ctx& C, int l, int u) {
    const int wave = C.wave, lane = C.lane, r = lane & 15, g = lane >> 4; const int b = u >> 7, c = u & 127; const int tok0 = b * SEQ + c * 64;
    bf16_t* ymix = (bf16_t*)(C.ws + WS_YMIX);
    {
        bf16x8 qf[3][2], sf[3][4][2]; u32x2 yl[3][4], bo[3][4], gg[3][4];
#pragma unroll
        for (int n_ = 0; n_ < 3; ++n_) { const int task = wave + 8 * n_, h = task >> 2, tb = task & 3; const size_t ch = (size_t)(b * 6 + h) * 128 + c; const int t = 16 * tb + r; const int tok = tok0 + t;
            const bf16_t* gS = (const bf16_t*)(C.ws + WS_RWS) + ch * 4096; const bf16_t* gQ = (const bf16_t*)(C.ws + WS_RWQH) + ch * 4096 + t * 64 + 8 * g; const bf16_t* gY = (const bf16_t*)(C.ws + WS_RWYL) + ch * 4096 + t * 64 + 4 * g;
            const bf16_t* aux = (const bf16_t*)(C.ws + WS_RWAUX) + (size_t)tok * 768 + 64 * h + 4 * g;
            qf[n_][0] = *(const bf16x8*)gQ; qf[n_][1] = *(const bf16x8*)(gQ + 32);
#pragma unroll
            for (int ti = 0; ti < 4; ++ti) { const bf16_t* sp = gS + (16 * ti + r) * 64 + 8 * g; sf[n_][ti][0] = *(const bf16x8*)sp; sf[n_][ti][1] = *(const bf16x8*)(sp + 32);
                yl[n_][ti] = *(const u32x2*)(gY + 16 * ti); bo[n_][ti] = *(const u32x2*)(aux + 16 * ti); gg[n_][ti] = *(const u32x2*)(aux + RWD + 16 * ti); } }
#pragma unroll
        for (int n_ = 0; n_ < 3; ++n_) { const int task = wave + 8 * n_, h = task >> 2, tb = task & 3; const int t = 16 * tb + r; const int tok = tok0 + t;
            f32x4 y[4]; float s = 0.f;
#pragma unroll
            for (int ti = 0; ti < 4; ++ti) { const u32x2 yw = yl[n_][ti]; f32x4 a = (f32x4){bflo(yw[0]), bfhi(yw[0]), bflo(yw[1]), bfhi(yw[1])};
                a = mfma16(sf[n_][ti][0], qf[n_][0], a); a = mfma16(sf[n_][ti][1], qf[n_][1], a); y[ti] = a; s += (a[0] + a[1]) + (a[2] + a[3]); }
            s += __shfl_xor(s, 16); s += __shfl_xor(s, 32); const float mean = s * (1.f / 64.f); float s2 = 0.f;
#pragma unroll
            for (int ti = 0; ti < 4; ++ti) { y[ti] = y[ti] - mean; s2 += (y[ti][0] * y[ti][0] + y[ti][1] * y[ti][1]) + (y[ti][2] * y[ti][2] + y[ti][3] * y[ti][3]); }
            s2 += __shfl_xor(s2, 16); s2 += __shfl_xor(s2, 32); const float rstd = rsqrtf(s2 * (1.f / 64.f) + 64e-5f);
            bf16_t* yo = ymix + (size_t)tok * DM + 64 * h + 4 * g;
            const float* lw = P.in[I_LNW] + l * RWD + 64 * h + 4 * g; const float* lb = P.in[I_LNB] + l * RWD + 64 * h + 4 * g;
#pragma unroll
            for (int ti = 0; ti < 4; ++ti) { const u32x2 bo_ = bo[n_][ti], gg_ = gg[n_][ti]; const f32x4 w4 = *(const f32x4*)(lw + 16 * ti), b4 = *(const f32x4*)(lb + 16 * ti);
                const float o0 = (y[ti][0] * rstd * w4[0] + b4[0] + bflo(bo_[0])) * bflo(gg_[0]), o1 = (y[ti][1] * rstd * w4[1] + b4[1] + bfhi(bo_[0])) * bfhi(gg_[0]);
                const float o2 = (y[ti][2] * rstd * w4[2] + b4[2] + bflo(bo_[1])) * bflo(gg_[1]), o3 = (y[ti][3] * rstd * w4[3] + b4[3] + bfhi(bo_[1])) * bfhi(gg_[1]);
                *(u32x2*)(yo + 16 * ti) = (u32x2){pk2(o0, o1), pk2(o2, o3)}; } }
    }
    {
        bf16x8 qf[2][2], cf[2][5][2]; u32x2 nl[2][5], og[2][4]; float bcl[2], mdl[2], mcv[2];
#pragma unroll
        for (int n_ = 0; n_ < 2; ++n_) { const int task = wave + 8 * (n_ + 3), hh = (task - 24) >> 2, tb = task & 3; const size_t ch = (size_t)(b * 4 + hh) * 128 + c; const int t = 16 * tb + r; const int tok = tok0 + t;
            const bf16_t* gC = (const bf16_t*)(C.ws + WS_MLCT) + ch * 5120; const bf16_t* gQ = (const bf16_t*)(C.ws + WS_MLQ) + ch * 4096 + t * 64 + 8 * g; const bf16_t* gNL = (const bf16_t*)(C.ws + WS_MLNL) + ch * 5120 + t * 80 + 4 * g;
            const bf16_t* ogp = (const bf16_t*)(C.ws + WS_P) + (size_t)tok * NPROJ + 2816 + 64 * hh + 4 * g;
            qf[n_][0] = *(const bf16x8*)gQ; qf[n_][1] = *(const bf16x8*)(gQ + 32);
            const float* vec = (const float*)(C.ws + WS_MLVEC) + (ch * 64 + t) * 2; bcl[n_] = vec[0]; mdl[n_] = vec[1]; mcv[n_] = ((const float*)(C.ws + WS_MLM))[ch];
#pragma unroll
            for (int ti = 0; ti < 5; ++ti) { const bf16_t* cp = gC + (16 * ti + r) * 64 + 8 * g; cf[n_][ti][0] = *(const bf16x8*)cp; cf[n_][ti][1] = *(const bf16x8*)(cp + 32); nl[n_][ti] = *(const u32x2*)(gNL + 16 * ti); }
#pragma unroll
            for (int ti = 0; ti < 4; ++ti) og[n_][ti] = *(const u32x2*)(ogp + 16 * ti); }
#pragma unroll
        for (int n_ = 0; n_ < 2; ++n_) { const int task = wave + 8 * (n_ + 3), hh = (task - 24) >> 2, tb = task & 3; const int t = 16 * tb + r; const int tok = tok0 + t;
            const float mint = bcl[n_] + mcv[n_], mt = fmaxf(mint, mdl[n_]); const float inter = __expf(mint - mt), fl = __expf(mdl[n_] - mt);
            f32x4 y[5];
#pragma unroll
            for (int ti = 0; ti < 5; ++ti) { f32x4 a = (f32x4){0.f, 0.f, 0.f, 0.f};
                a = mfma16(cf[n_][ti][0], qf[n_][0], a); a = mfma16(cf[n_][ti][1], qf[n_][1], a); const u32x2 nw = nl[n_][ti]; const f32x4 nlv = (f32x4){bflo(nw[0]), bfhi(nw[0]), bflo(nw[1]), bfhi(nw[1])}; y[ti] = fl * nlv + inter * a; }
            const float nq = __shfl(y[4][0], r);
            const float inv = 1.0f / fmaxf(fabsf(nq), __expf(-mt));
            float s = 0.f;
#pragma unroll
            for (int ti = 0; ti < 4; ++ti) { y[ti] = y[ti] * inv; s += (y[ti][0] + y[ti][1]) + (y[ti][2] + y[ti][3]); }
            s += __shfl_xor(s, 16); s += __shfl_xor(s, 32); const float mean = s * (1.f / 64.f); float s2 = 0.f;
#pragma unroll
            for (int ti = 0; ti < 4; ++ti) { y[ti] = y[ti] - mean; s2 += (y[ti][0] * y[ti][0] + y[ti][1] * y[ti][1]) + (y[ti][2] * y[ti][2] + y[ti][3] * y[ti][3]); }
            s2 += __shfl_xor(s2, 16); s2 += __shfl_xor(s2, 32); const float rstd = rsqrtf(s2 * (1.f / 64.f) + 1e-6f);
            bf16_t* yo = ymix + (size_t)tok * DM + 768 + 64 * hh + 4 * g; const float* nw = P.in[I_MLNW] + l * 256 + 64 * hh + 4 * g;
#pragma unroll
            for (int ti = 0; ti < 4; ++ti) { const u32x2 oo = og[n_][ti]; const f32x4 w4 = *(const f32x4*)(nw + 16 * ti);
                const float o0 = y[ti][0] * rstd * w4[0] * sigmoidf_(bflo(oo[0])), o1 = y[ti][1] * rstd * w4[1] * sigmoidf_(bfhi(oo[0])), o2 = y[ti][2] * rstd * w4[2] * sigmoidf_(bflo(oo[1])), o3 = y[ti][3] * rstd * w4[3] * sigmoidf_(bfhi(oo[1]));
                *(u32x2*)(yo + 16 * ti) = (u32x2){pk2(o0, o1), pk2(o2, o3)}; } }
    }
}

__device__ __forceinline__ void ln1_router_phase(const Params& P, const Ctx& C, int l, int cnt_off) {
    const int tid = C.tid, wave = C.wave, lane = C.lane, r = lane & 15, g = lane >> 4;
    constexpr int HS = 1032;
    LAS bf16_t* hhi = (LAS bf16_t*)C.lds;
    LAS bf16_t* hlo = hhi + 16 * HS;
    LAS float* part = (LAS float*)(hlo + 16 * HS);
    LAS int* lcnt = (LAS int*)(part + 8 * 8 * 32);
    bf16x8 bh[4][2], bl[4][2];
#pragma unroll
    for (int ks = 0; ks < 4; ++ks)
#pragma unroll
        for (int nt = 0; nt < 2; ++nt) { const size_t off = ((size_t)l * NEXP + 16 * nt + r) * DM + 32 * (4 * wave + ks) + 8 * g;
            bh[ks][nt] = *(const bf16x8*)((const bf16_t*)(C.ws + WS_WRH) + off); bl[ks][nt] = *(const bf16x8*)((const bf16_t*)(C.ws + WS_WRL) + off); }
    for (int i = tid; i < 16 * HS; i += 512) { hhi[i] = 0; hlo[i] = 0; }
    if (tid < 32) lcnt[tid] = 0;
    { int* pdest = (int*)(C.ws + WS_PDEST); int* ptok = (int*)(C.ws + WS_PTOK); for (int i = C.blk * 512 + tid; i < POS_MAX; i += C.G * 512) { pdest[i] = -1; ptok[i] = 0; } }
    __syncthreads();
    const int tpb = (MTOK + C.G - 1) / C.G, tok_lo = C.blk * tpb, tok_hi = (tok_lo + tpb < MTOK) ? tok_lo + tpb : MTOK;
    const bf16_t* t1 = (const bf16_t*)(C.ws + WS_T1); bf16_t* hb = (bf16_t*)(C.ws + WS_HB);
    int* toke = (int*)(C.ws + WS_TOKE); float* tokg = (float*)(C.ws + WS_TOKG); int* toklr = (int*)(C.ws + WS_TOKLR);
    const f32x4* lw4 = (const f32x4*)(P.in[I_LN1W] + (size_t)l * DM) + lane; const f32x4* lb4 = (const f32x4*)(P.in[I_LN1B] + (size_t)l * DM) + lane;
    u32x2 vn[4], rn[4];
    { const int tok = tok_lo + wave; const size_t ro = (size_t)((tok < tok_hi) ? tok : tok_lo) * DM; const u32x2* xr = (const u32x2*)(t1 + ro) + lane; const u32x2* rr = (const u32x2*)(hb + ro) + lane;
#pragma unroll
      for (int j = 0; j < 4; ++j) { vn[j] = xr[64 * j]; rn[j] = rr[64 * j]; } }
    const float rbias = P.in[I_RB][l * NEXP + (lane & 31)];
    for (int base = tok_lo; base < tok_hi; base += 8) {
        const int tok = base + wave;
        f32x4 v[4];
#pragma unroll
        for (int j = 0; j < 4; ++j) v[j] = (f32x4){bflo(vn[j][0]), bfhi(vn[j][0]), bflo(vn[j][1]), bfhi(vn[j][1])} + DN_ALPHA * (f32x4){bflo(rn[j][0]), bfhi(rn[j][0]), bflo(rn[j][1]), bfhi(rn[j][1])};
        { const int tn = base + 8 + wave; const size_t ro = (size_t)((tn < tok_hi) ? tn : tok_lo) * DM; const u32x2* xr = (const u32x2*)(t1 + ro) + lane; const u32x2* rr = (const u32x2*)(hb + ro) + lane;
#pragma unroll
          for (int j = 0; j < 4; ++j) { vn[j] = xr[64 * j]; rn[j] = rr[64 * j]; } }
        if (tok < tok_hi) {
            float s = 0.f;
#pragma unroll
            for (int j = 0; j < 4; ++j) s += (v[j][0] + v[j][1]) + (v[j][2] + v[j][3]);
            const float mean = wave_sum(s) * (1.f / DM); float s2 = 0.f;
#pragma unroll
            for (int j = 0; j < 4; ++j) { v[j] = v[j] - mean; s2 += (v[j][0] * v[j][0] + v[j][1] * v[j][1]) + (v[j][2] * v[j][2] + v[j][3] * v[j][3]); }
            const float rstd = rsqrtf(wave_sum(s2) * (1.f / DM) + LN_EPS);
            u32x2* ob = (u32x2*)(hb + (size_t)tok * DM) + lane;
#pragma unroll
            for (int j = 0; j < 4; ++j) { const f32x4 y = v[j] * rstd * lw4[64 * j] + lb4[64 * j]; const u32x2 hi = (u32x2){pk2(y[0], y[1]), pk2(y[2], y[3])}; ob[64 * j] = hi;
                const u32x2 lo = (u32x2){pk2(y[0] - bflo(hi[0]), y[1] - bfhi(hi[0])), pk2(y[2] - bflo(hi[1]), y[3] - bfhi(hi[1]))};
                *(LAS u32x2*)(hhi + wave * HS + 4 * (lane + 64 * j)) = hi; *(LAS u32x2*)(hlo + wave * HS + 4 * (lane + 64 * j)) = lo; }
        }
        __syncthreads();
        { f32x4 acc[2]; acc[0] = (f32x4){0.f, 0.f, 0.f, 0.f}; acc[1] = acc[0];
#pragma unroll
          for (int ks = 0; ks < 4; ++ks) { const int ko = r * HS + 32 * (4 * wave + ks) + 8 * g; const bf16x8 ah = *(const LAS bf16x8*)(hhi + ko), al = *(const LAS bf16x8*)(hlo + ko);
#pragma unroll
              for (int nt = 0; nt < 2; ++nt) { acc[nt] = mfma16(ah, bh[ks][nt], acc[nt]); acc[nt] = mfma16(ah, bl[ks][nt], acc[nt]); acc[nt] = mfma16(al, bh[ks][nt], acc[nt]); } }
          if (g < 2) {
#pragma unroll
              for (int nt = 0; nt < 2; ++nt)
#pragma unroll
                  for (int j = 0; j < 4; ++j) part[(wave * 8 + 4 * g + j) * 32 + 16 * nt + r] = acc[nt][j]; } }
        __syncthreads();
        if (tok < tok_hi) { const int ee = lane & 31; float lg = rbias;
#pragma unroll
            for (int w8 = 0; w8 < 8; ++w8) lg += part[(w8 * 8 + wave) * 32 + ee];
            float bv[4]; int bi[4];
#pragma unroll
            for (int rd = 0; rd < 4; ++rd) { float mv = lg; int mi = ee;
#pragma unroll
                for (int o = 1; o < 32; o <<= 1) { const float ov = __shfl_xor(mv, o); const int oi = __shfl_xor(mi, o); const bool take = (ov > mv) || (ov == mv && oi < mi); mv = take ? ov : mv; mi = take ? oi : mi; }
                bv[rd] = mv; bi[rd] = mi; lg = (ee == mi) ? -__builtin_inff() : lg; }
            if (lane == 0) { const float e1 = __expf(bv[1] - bv[0]), e2 = __expf(bv[2] - bv[0]), e3 = __expf(bv[3] - bv[0]); const float inv = 1.0f / (1.0f + e1 + e2 + e3);
                const int l0 = __hip_atomic_fetch_add(&lcnt[bi[0]], 1, __ATOMIC_RELAXED, __HIP_MEMORY_SCOPE_WORKGROUP), l1 = __hip_atomic_fetch_add(&lcnt[bi[1]], 1, __ATOMIC_RELAXED, __HIP_MEMORY_SCOPE_WORKGROUP), l2 = __hip_atomic_fetch_add(&lcnt[bi[2]], 1, __ATOMIC_RELAXED, __HIP_MEMORY_SCOPE_WORKGROUP), l3 = __hip_atomic_fetch_add(&lcnt[bi[3]], 1, __ATOMIC_RELAXED, __HIP_MEMORY_SCOPE_WORKGROUP);
                *(int4*)(toke + tok * 4) = make_int4(bi[0], bi[1], bi[2], bi[3]); *(f32x4*)(tokg + tok * 4) = (f32x4){inv, e1 * inv, e2 * inv, e3 * inv}; *(int4*)(toklr + tok * 4) = make_int4(l0, l1, l2, l3); } }
        __syncthreads();
    }
    if (tid < 32) { unsigned* gc = (unsigned*)(C.ws + WS_CTL) + CW_CNT + cnt_off + l * 32 + tid;
        const unsigned bb = __hip_atomic_fetch_add(gc, (unsigned)lcnt[tid], __ATOMIC_RELAXED, __HIP_MEMORY_SCOPE_AGENT);
        ((int*)(C.ws + WS_BBASE))[C.blk * 32 + tid] = (int)bb; }
    __syncthreads();
}
__device__ __forceinline__ void permute_phase(const Params& P, const Ctx& C, int l) {
    const int tid = C.tid, wave = C.wave, lane = C.lane;
    LAS int* pst = (LAS int*)C.lds;
    if (tid == 0) { const unsigned* gc = (const unsigned*)(C.ws + WS_CTL) + CW_CNT + l * 32; int ps = 0;
        for (int e = 0; e < 32; ++e) { pst[e] = ps; ps += ((int)__hip_atomic_load(gc + e, __ATOMIC_RELAXED, __HIP_MEMORY_SCOPE_AGENT) + 255) & ~255; } }
    __syncthreads();
    const int tpb = (MTOK + C.G - 1) / C.G, tok_lo = C.blk * tpb, tok_hi = (tok_lo + tpb < MTOK) ? tok_lo + tpb : MTOK;
    const int* toke = (const int*)(C.ws + WS_TOKE); const float* tokg = (const float*)(C.ws + WS_TOKG); const int* toklr = (const int*)(C.ws + WS_TOKLR); const int* bbase = (const int*)(C.ws + WS_BBASE) + C.blk * 32;
    const bf16_t* hb = (const bf16_t*)(C.ws + WS_HB); bf16_t* xp = (bf16_t*)(C.ws + WS_XPERM); int* pdest = (int*)(C.ws + WS_PDEST); float* pgate = (float*)(C.ws + WS_PGATE);
    int* ptok = (int*)(C.ws + WS_PTOK);
    for (int a = tid; a < 4 * (tok_hi - tok_lo); a += 512) { const int tok = tok_lo + (a >> 2), as = tok * 4 + (a & 3);
        const int e = toke[as]; const int pos = pst[e] + bbase[e] + toklr[as];
        pdest[pos] = as; pgate[pos] = tokg[as]; ptok[pos] = tok; }
    __syncthreads();
}
__device__ __forceinline__ void build_tile_e(const Ctx& C, int l) {
    LAS int* te = (LAS int*)(C.lds + TILEE_OFF);
    if (C.tid == 0) { const unsigned* gc = (const unsigned*)(C.ws + WS_CTL) + CW_CNT + l * 32; int t = 0;
        for (int e = 0; e < 32; ++e) { const int nt = ((int)__hip_atomic_load(gc + e, __ATOMIC_RELAXED, __HIP_MEMORY_SCOPE_AGENT) + 255) >> 8; for (int k = 0; k < nt && t < NT_MAX; ++k) te[t++] = e; }
        for (; t < NT_MAX; ++t) te[t] = 0; }
    __syncthreads();
}
__device__ __forceinline__ void combine_ln2_phase(const Params& P, const Ctx& C, int l) {
    const int lane = C.lane; const int gw = C.blk * 8 + C.wave, NGW = C.G * 8;
    const bool last = (l == NLAYER - 1);
    LAS float* wg = (LAS float*)C.lds;
    if (!last) load_wg(wg, P.in[I_WIN] + (size_t)(l + 1) * DM * CIN, C.tid);
    const bf16_t* yb = (const bf16_t*)(C.ws + WS_YB);
    float* hf = P.out; bf16_t* hb = (bf16_t*)(C.ws + WS_HB); float* pg = (float*)(C.ws + WS_PG);
    const f32x4* lw4 = (const f32x4*)(P.in[I_LN2W] + (size_t)l * DM) + lane; const f32x4* lb4 = (const f32x4*)(P.in[I_LN2B] + (size_t)l * DM) + lane;
    u32x2 nh[4], ny[4][4];
    { const int tok = (gw < MTOK) ? gw : 0; const u32x2* xr = (const u32x2*)(hb + (size_t)tok * DM) + lane;
#pragma unroll
      for (int j = 0; j < 4; ++j) nh[j] = xr[64 * j];
#pragma unroll
      for (int sl = 0; sl < 4; ++sl) { const u32x2* yr = (const u32x2*)(yb + (size_t)(tok * 4 + sl) * DM) + lane;
#pragma unroll
          for (int j = 0; j < 4; ++j) ny[sl][j] = yr[64 * j]; } }
    for (int tok = gw; tok < MTOK; tok += NGW) {
        f32x4 v[4]; float s = 0.f;
#pragma unroll
        for (int j = 0; j < 4; ++j) { v[j] = (f32x4){bflo(nh[j][0]), bfhi(nh[j][0]), bflo(nh[j][1]), bfhi(nh[j][1])} * DN_ALPHA;
#pragma unroll
            for (int sl = 0; sl < 4; ++sl) { const u32x2 w = ny[sl][j]; v[j][0] += bflo(w[0]); v[j][1] += bfhi(w[0]); v[j][2] += bflo(w[1]); v[j][3] += bfhi(w[1]); } }
        { const int tn = (tok + NGW < MTOK) ? tok + NGW : tok; const u32x2* xr = (const u32x2*)(hb + (size_t)tn * DM) + lane;
#pragma unroll
          for (int j = 0; j < 4; ++j) nh[j] = xr[64 * j];
#pragma unroll
          for (int sl = 0; sl < 4; ++sl) { const u32x2* yr = (const u32x2*)(yb + (size_t)(tn * 4 + sl) * DM) + lane;
#pragma unroll
              for (int j = 0; j < 4; ++j) ny[sl][j] = yr[64 * j]; } }
#pragma unroll
        for (int j = 0; j < 4; ++j) s += (v[j][0] + v[j][1]) + (v[j][2] + v[j][3]);
        const float mean = wave_sum(s) * (1.f / DM); float s2 = 0.f;
#pragma unroll
        for (int j = 0; j < 4; ++j) { v[j] = v[j] - mean; s2 += (v[j][0] * v[j][0] + v[j][1] * v[j][1]) + (v[j][2] * v[j][2] + v[j][3] * v[j][3]); }
        const float rstd = rsqrtf(wave_sum(s2) * (1.f / DM) + LN_EPS);
#pragma unroll
        for (int j = 0; j < 4; ++j) v[j] = v[j] * rstd * lw4[64 * j] + lb4[64 * j];
        if (last) { f32x4* of = (f32x4*)(hf + (size_t)tok * DM) + lane;
#pragma unroll
            for (int j = 0; j < 4; ++j) of[64 * j] = v[j]; }
        if (!last) { u32x2* ob = (u32x2*)(hb + (size_t)tok * DM) + lane;
#pragma unroll
            for (int j = 0; j < 4; ++j) ob[64 * j] = (u32x2){pk2(v[j][0], v[j][1]), pk2(v[j][2], v[j][3])};
            gate_cols(v, wg, P.in[I_BIN] + (size_t)(l + 1) * CIN + NPROJ, pg + (size_t)tok * 8, lane); }
    }
}

typedef const __attribute__((address_space(4))) Params* CParamsPtr;
__device__ __forceinline__ const Params* kparams() {
    const unsigned long long a = (unsigned long long)__builtin_amdgcn_kernarg_segment_ptr(); unsigned lo = (unsigned)a, hi = (unsigned)(a >> 32);
    asm volatile("" : "+v"(lo), "+v"(hi));
    lo = __builtin_amdgcn_readfirstlane(lo); hi = __builtin_amdgcn_readfirstlane(hi);
    return (const Params*)(CParamsPtr)(((unsigned long long)hi << 32) | lo);
}
__device__ __forceinline__ Ctx make_ctx(const Params& P, LAS unsigned char* lds, int wv0) {
    Ctx C; C.lds = lds; unsigned ones_ = ~0u; asm volatile("" : "+s"(ones_)); int t_ = wv0 * 64 + (int)__builtin_amdgcn_mbcnt_hi(ones_, __builtin_amdgcn_mbcnt_lo(ones_, 0u)), b_ = blockIdx.x, g_ = gridDim.x; asm volatile("" : "+v"(t_), "+v"(b_), "+v"(g_)); b_ = __builtin_amdgcn_readfirstlane(b_); g_ = __builtin_amdgcn_readfirstlane(g_);
    C.tid = t_; C.lane = C.tid & 63; C.wave = __builtin_amdgcn_readfirstlane(C.tid >> 6); C.blk = b_; C.G = g_; C.ws = P.ws; return C; }
__global__ void __launch_bounds__(512, 2) hybrid_fwd(Params Punused) {
    extern __shared__ __attribute__((aligned(16))) unsigned char lds_raw[];
    LAS unsigned char* const lds = (LAS unsigned char*)lds_raw;
    const int wv0 = __builtin_amdgcn_readfirstlane((int)threadIdx.x >> 6);
    volatile LAS unsigned* MISC = (volatile LAS unsigned*)(lds + MISC_OFF);
    for (int u = threadIdx.x; u < (LDS_BYTES - MISC_OFF) / 4; u += 512) MISC[u] = 0u;
    __syncthreads();
    const int lo = __builtin_amdgcn_readfirstlane(kparams()->ph_lo), hi = __builtin_amdgcn_readfirstlane(kparams()->ph_hi);
    #define IS_T0 (wv0 == 0 && __builtin_amdgcn_mbcnt_hi(~0u, __builtin_amdgcn_mbcnt_lo(~0u, 0u)) == 0u)
    if (hi - lo > 1) (void)xcd_barrier_post((unsigned*)(kparams()->ws + WS_CTL) + CW_BAR, MISC + 8, IS_T0);
#ifndef PHMASK
#define PHMASK 0x7ff
#endif
#define PH_EN(k) (((PHMASK) >> (k)) & 1)
#define RUN(gid) ((gid) >= lo && (gid) < hi)
#define SEAM(gid) do { if ((gid) + 1 < hi) { XcdBarrier bar_; bar_.bar = (unsigned*)(kparams()->ws + WS_CTL) + CW_BAR; bar_.x = xb_xcc_id(); bar_.st = (volatile LAS unsigned*)(lds + MISC_OFF) + 8; xcd_barrier(bar_, IS_T0); if (DUPBAR) xcd_barrier(bar_, IS_T0); } } while (0)
#ifndef DUPMASK
#define DUPMASK 0
#endif
#ifndef DUPBAR
#define DUPBAR 0
#endif
#define DUP(k) for (int rep_ = 0; rep_ < 1 + (((DUPMASK) >> (k)) & 1); ++rep_)
#define PHASE_BEGIN const Params& P = *kparams(); const Ctx C = make_ctx(P, lds, wv0);
    if (PH_EN(0) && RUN(0)) { DUP(0) { PHASE_BEGIN p0_prologue(P, C); } SEAM(0); }
#pragma unroll 1
    for (int l = 0; l < NLAYER; ++l) {
        const int g0 = 1 + l * NPH;
        if (g0 + NPH <= lo || g0 >= hi) continue;
        if (PH_EN(1) && RUN(g0 + 0)) {
            DUP(1) { PHASE_BEGIN
            pg8::Gemm g{(const bf16_t*)(C.ws + WS_HB), (const bf16_t*)(C.ws + WS_WIN) + (size_t)l * NPROJ * DM, MTOK, NPROJ, DM}; pg8::StaticOrder S; S.init(MTOK, NPROJ, C.G, C.blk);
            pg8::EpiBf16b E{(bf16_t*)(C.ws + WS_P), NPROJ, P.in[I_BIN] + (size_t)l * CIN};
            pg8::gemm_phase<pg8::EpiBf16b, pg8::StaticOrder>(C.lds, g, S, E, nullptr, C.tid); }
            SEAM(g0 + 0); }
        if (PH_EN(2) && RUN(g0 + 1)) {
            DUP(2) { PHASE_BEGIN
            constexpr int NU_SWA = 512, NU_RW = NB * 128 * 6, NU_ML = NB * 128 * 4;
#ifndef DUP2
#define DUP2 0
#endif
            for (int rp = 0; rp < 1 + ((DUP2 >> 1) & 1); ++rp) for (int cb = C.blk; cb < NB * 128; cb += C.G)
                for (int hh_ = 0; hh_ < 6; ++hh_) { rwb_unit(P, C, l, cb * 6 + hh_, hh_ != 0); if (hh_ == 0) { asm volatile("s_waitcnt vmcnt(0)" ::: "memory"); __syncthreads(); } }
            for (int rp = 0; rp < 1 + ((DUP2 >> 2) & 1); ++rp) for (int u = C.blk; u < NU_ML; u += C.G) mlb_unit(P, C, l, u); }
            SEAM(g0 + 1); }
        if (PH_EN(3) && RUN(g0 + 2)) {
            DUP(3) { PHASE_BEGIN
            {
#ifndef P3DUP
#define P3DUP 0
#endif
                if (C.blk < 48) { for (int rp = 0; rp < 1 + (P3DUP & 1); ++rp) { rwkv_chain(C, C.blk >> 1, C.blk & 1); __syncthreads(); } } else if (C.blk < 112) { for (int rp = 0; rp < 1 + ((P3DUP >> 1) & 1); ++rp) { mlstm_cscan(C, (C.blk - 48) >> 2, (C.blk - 48) & 3); __syncthreads(); } }
                LAS int* qslot = (LAS int*)(C.lds + MISC_OFF + 64); unsigned* qctr = (unsigned*)(C.ws + WS_CTL) + CW_SWAQ + l * 64;
                for (;;) { __syncthreads();
                    if (C.tid == 0) *qslot = (int)__hip_atomic_fetch_add(qctr, 1u, __ATOMIC_RELAXED, __HIP_MEMORY_SCOPE_AGENT);
                    __syncthreads();
                    const int u = *qslot; if (u >= 512) break;
                    swa_unit(P, C, l, u); } } }
            SEAM(g0 + 2); }
        if (PH_EN(4) && RUN(g0 + 3)) {
            DUP(4) { PHASE_BEGIN
            for (int u = C.blk; u < NB * 128; u += C.G) passd_unit(P, C, l, u); }
            SEAM(g0 + 3); }
        if (PH_EN(5) && RUN(g0 + 4)) {
            DUP(5) { PHASE_BEGIN
            pg8::Gemm g{(const bf16_t*)(C.ws + WS_YMIX), (const bf16_t*)(C.ws + WS_WOUT) + (size_t)l * DM * DM, MTOK, DM, DM}; pg8::StaticOrder S; S.init(MTOK, DM, C.G, C.blk);
            pg8::EpiPlainBf16 E{(bf16_t*)(C.ws + WS_T1), DM};
            pg8::gemm_phase<pg8::EpiPlainBf16, pg8::StaticOrder>(C.lds, g, S, E, nullptr, C.tid); }
            SEAM(g0 + 4); }
        if (PH_EN(6) && RUN(g0 + 5)) { DUP(6) { PHASE_BEGIN ln1_router_phase(P, C, l, (rep_ + 1 < 1 + (((DUPMASK) >> 6) & 1)) ? 512 : 0); } SEAM(g0 + 5); }
        if (PH_EN(7) && RUN(g0 + 6)) { DUP(7) { PHASE_BEGIN permute_phase(P, C, l); } SEAM(g0 + 6); }
        if (PH_EN(8) && RUN(g0 + 7)) {
            DUP(8) { PHASE_BEGIN
            build_tile_e(C, l);
            pg8::Gemm g{(const bf16_t*)(C.ws + WS_HB), (const bf16_t*)(C.ws + WS_WUP) + (size_t)l * NEXP * NUP * DM, POS_MAX, NUP, DM};
            pg8::MoeOrder<8> S{(const LAS int*)(C.lds + TILEE_OFF), C.G, C.blk, (const int*)(C.ws + WS_PTOK)};
            pg8::EpiSwiglu E{(bf16_t*)(C.ws + WS_ACT), P.in[I_EBUP] + (size_t)l * NEXP * NUP};
            pg8::gemm_phase<pg8::EpiSwiglu, pg8::MoeOrder<8>, false, true>(C.lds, g, S, E, nullptr, C.tid); }
            SEAM(g0 + 7); }
        if (PH_EN(9) && RUN(g0 + 8)) {
            DUP(9) { PHASE_BEGIN
            build_tile_e(C, l);
            pg8::Gemm g{(const bf16_t*)(C.ws + WS_ACT), (const bf16_t*)(C.ws + WS_WDN) + (size_t)l * NEXP * DM * DEXP, POS_MAX, DM, DEXP};
            pg8::MoeOrder<4> S{(const LAS int*)(C.lds + TILEE_OFF), C.G, C.blk, nullptr};
            pg8::EpiDown E{(bf16_t*)(C.ws + WS_YB), P.in[I_EBDN] + (size_t)l * NEXP * DM, (const int*)(C.ws + WS_PDEST), (const float*)(C.ws + WS_PGATE)};
            pg8::gemm_phase<pg8::EpiDown, pg8::MoeOrder<4>>(C.lds, g, S, E, nullptr, C.tid); }
            SEAM(g0 + 8); }
        if (PH_EN(10) && RUN(g0 + 9)) { DUP(10) { PHASE_BEGIN combine_ln2_phase(P, C, l); } SEAM(g0 + 9); }
    }
#undef RUN
#undef SEAM
}

#ifndef MK_PER_PHASE
#define MK_PER_PHASE 0
#endif
extern "C" void kernel_launch(void* const* d_in, const int* in_sizes, int n_in, void* d_out, int out_size, void* d_ws, size_t ws_size, hipStream_t stream) {
    static int grid = 0;
    if (grid == 0) {
        if (n_in != 29 || out_size != MTOK * DM || ws_size < WS_END) { fprintf(stderr, "kernel_launch: unexpected shapes (n_in %d out %d ws %zu)\n", n_in, out_size, ws_size); grid = -1; return; }
        int dev = 0, cus = 0;
        if (hipGetDevice(&dev) != hipSuccess || hipDeviceGetAttribute(&cus, hipDeviceAttributeMultiprocessorCount, dev) != hipSuccess) { grid = -1; return; }
        if (hipFuncSetAttribute((const void*)hybrid_fwd, hipFuncAttributeMaxDynamicSharedMemorySize, LDS_BYTES) != hipSuccess) { fprintf(stderr, "kernel_launch: hipFuncSetAttribute failed\n"); grid = -1; return; }
        int per_cu = 0;
        if (hipOccupancyMaxActiveBlocksPerMultiprocessor(&per_cu, (const void*)hybrid_fwd, 512, LDS_BYTES) != hipSuccess || per_cu < 1) { fprintf(stderr, "kernel_launch: occupancy query says %d\n", per_cu); }
        (void)hipGetLastError();
        grid = cus;
    }
    if (grid < 0) return;
    (void)hipMemsetAsync((char*)d_ws + WS_CTL, 0, CTL_ZERO_BYTES, stream);
    Params p; memset(&p, 0, sizeof(p));
    for (int i = 0; i < 29; ++i) p.in[i] = (const float*)d_in[i];
    p.out = (float*)d_out; p.ws = (unsigned char*)d_ws;
#if MK_PER_PHASE
    for (int ph = 0; ph < NPHASE_TOTAL; ++ph) { p.ph_lo = ph; p.ph_hi = ph + 1; hipLaunchKernelGGL(hybrid_fwd, dim3(grid), dim3(512), LDS_BYTES, stream, p); }
#else
    p.ph_lo = 0; p.ph_hi = NPHASE_TOTAL;
    hipLaunchKernelGGL(hybrid_fwd, dim3(grid), dim3(512), LDS_BYTES, stream, p);
#endif
}
```

```cpp
#include <hip/hip_runtime.h>
#include <cstdio>
#include <cstdint>
#include <cstring>

#define GAS __attribute__((address_space(1)))
#define LAS __attribute__((address_space(3)))
typedef float f32x2 __attribute__((ext_vector_type(2)));
typedef unsigned u32x2 __attribute__((ext_vector_type(2)));

#ifndef PG8_SP2_DEFAULT
#define PG8_SP2_DEFAULT true
#endif
namespace pg8 {
constexpr int EPI_BTAB = 140288, EPI_DTAB = 138240, EPI_GTAB = 139264;
#define PG8_LAS __attribute__((address_space(3)))
typedef unsigned short bf16_t;
typedef short bf16x8 __attribute__((ext_vector_type(8)));
typedef float f32x4 __attribute__((ext_vector_type(4)));
typedef unsigned u32x4 __attribute__((ext_vector_type(4)));
constexpr int BM = 256, BK = 64, HALF = 128, HTB = HALF * BK * 2  , STAGE_BYTES = 8 * HTB, NXCD = 8, WGM = 8;

__host__ __device__ __forceinline__ int lds_byte(int r, int c) { const int st = (r >> 4) * 2 + (c >> 5), rr = r & 15, cc = c & 31, ob = rr * 64 + cc * 2; return st * 1024 + (ob ^ (((ob >> 9) & 1) << 5)); }
__host__ __device__ __forceinline__ void stage_rc(int b, int& R, int& C) { const int st = b / 1024, sb = b % 1024, swz = sb ^ (((sb >> 9) & 1) << 5); R = (st >> 1) * 16 + swz / 64; C = (st & 1) * 32 + (swz % 64) / 2; }
__host__ __device__ __forceinline__ int perm32(int rho) { const int n = rho >> 4, i = rho & 15; return 8 * (i >> 2) + 4 * n + (i & 3); }

struct Unit { int pm, pn; };
struct Gemm { const bf16_t* A; const bf16_t* Bt; int M, N, K; };

struct StaticOrder {
    int nM, nN, nwg, G, c;
    __host__ __device__ void init(int M, int N, int G_, int c_) { nM = M / BM; nN = N / BM; nwg = nM * nN; G = G_; c = c_; }
    __host__ __device__ bool next(int i, Unit& u) const {
        const long L = (long)i * G + c; if (L >= nwg) return false;
        int wgid = (int)L; { const int q = nwg / NXCD, r = nwg % NXCD, xcd = wgid % NXCD, off = wgid / NXCD; wgid = (xcd < r ? xcd * (q + 1) : r * (q + 1) + (xcd - r) * q) + off; }
        const int nig = WGM * nN, gid = wgid / nig, fm = gid * WGM, gsz = (nM - fm) < WGM ? (nM - fm) : WGM;
        u.pm = fm + ((wgid % nig) % gsz); u.pn = (wgid % nig) / gsz; return true;
    }
    __device__ __forceinline__ void a_ready(const Unit&) const {}
    __device__ __forceinline__ void done(const Unit&) const {}
};
template <int NN> struct MoeOrder {
    const PG8_LAS int* tile_e; int G, c; const int* rowtok;
    __device__ __forceinline__ bool next(int i, Unit& u) const {
        const int s = i * G + c; if (s >= 544 * NN) return false;
        constexpr int per = 8 * NN; const int a = s / per, r = s % per, b = r >> 3, x = r & 7;
        const int pm = 68 * x + a; u.pm = pm; u.pn = tile_e[pm] * NN + b; return true;
    }
    __device__ __forceinline__ void a_ready(const Unit&) const {}
    __device__ __forceinline__ void done(const Unit&) const {}
};

__device__ __forceinline__ unsigned cvt_pk_bf16(float lo, float hi) { unsigned r; asm volatile("v_cvt_pk_bf16_f32 %0, %1, %2" : "=v"(r) : "v"(lo), "v"(hi)); return r; }

struct EpiBf16b {
    static constexpr bool PERM = true, AFTER_DRAIN = false;
    bf16_t* O; int ldc; const float* bias;
    __device__ __forceinline__ void prefetch(PG8_LAS unsigned char* lds, const Unit& u, int wid, int lane) const {
        if (wid < 4) __builtin_amdgcn_global_load_lds((const unsigned*)(bias + u.pn * BM + 64 * wid + lane), (PG8_LAS unsigned*)(lds + EPI_BTAB + wid * 256), 4, 0, 0); }
    __device__ __forceinline__ void operator()(const f32x4 (&acc)[2][2][4][2], const Unit& u, int wr, int wc, int fr, int fq, PG8_LAS unsigned char* lds) const {
        const int row0 = u.pm * BM + wr * 64 + fr; const int col0 = u.pn * BM + wc * 32 + 8 * fq;
        const PG8_LAS float* bt = (const PG8_LAS float*)(lds + EPI_BTAB) + wc * 32 + 8 * fq;
        f32x4 bv[2][2];
#pragma unroll
        for (int bj = 0; bj < 2; ++bj)
#pragma unroll
            for (int n = 0; n < 2; ++n) bv[bj][n] = *(const PG8_LAS f32x4*)(bt + bj * HALF + 4 * n);
#pragma unroll
        for (int ai = 0; ai < 2; ++ai)
#pragma unroll
            for (int m = 0; m < 4; ++m) { bf16_t* rowp = O + (size_t)(row0 + ai * HALF + m * 16) * ldc + col0;
#pragma unroll
                for (int bj = 0; bj < 2; ++bj) { const f32x4 v0 = acc[ai][bj][m][0] + bv[bj][0], v1 = acc[ai][bj][m][1] + bv[bj][1];
                    u32x4 w; w.x = cvt_pk_bf16(v0[0], v0[1]); w.y = cvt_pk_bf16(v0[2], v0[3]); w.z = cvt_pk_bf16(v1[0], v1[1]); w.w = cvt_pk_bf16(v1[2], v1[3]);
                    *(u32x4*)(rowp + bj * HALF) = w; } }
    }
};
struct EpiPlainBf16 {
    static constexpr bool PERM = true, AFTER_DRAIN = false;
    bf16_t* O; int ldc;
    __device__ __forceinline__ void prefetch(PG8_LAS unsigned char*, const Unit&, int, int) const {}
    __device__ __forceinline__ void operator()(const f32x4 (&acc)[2][2][4][2], const Unit& u, int wr, int wc, int fr, int fq, PG8_LAS unsigned char*) const {
        const int row0 = u.pm * BM + wr * 64 + fr, col0 = u.pn * BM + wc * 32 + 8 * fq;
#pragma unroll
        for (int ai = 0; ai < 2; ++ai)
#pragma unroll
            for (int m = 0; m < 4; ++m) { bf16_t* rowp = O + (size_t)(row0 + ai * HALF + m * 16) * ldc + col0;
#pragma unroll
                for (int bj = 0; bj < 2; ++bj) { const f32x4 v0 = acc[ai][bj][m][0], v1 = acc[ai][bj][m][1];
                    u32x4 w; w.x = cvt_pk_bf16(v0[0], v0[1]); w.y = cvt_pk_bf16(v0[2], v0[3]); w.z = cvt_pk_bf16(v1[0], v1[1]); w.w = cvt_pk_bf16(v1[2], v1[3]);
                    *(u32x4*)(rowp + bj * HALF) = w; } }
    }
};
struct EpiSwiglu {
    static constexpr bool PERM = true, AFTER_DRAIN = false;
    bf16_t* O; const float* bias;
    __device__ __forceinline__ void prefetch(PG8_LAS unsigned char* lds, const Unit& u, int wid, int lane) const {
        if (wid < 4) __builtin_amdgcn_global_load_lds((const unsigned*)(bias + u.pn * BM + 64 * wid + lane), (PG8_LAS unsigned*)(lds + EPI_BTAB + wid * 256), 4, 0, 0); }
    __device__ __forceinline__ void operator()(const f32x4 (&acc)[2][2][4][2], const Unit& u, int wr, int wc, int fr, int fq, PG8_LAS unsigned char* lds) const {
        const int row0 = u.pm * BM + wr * 64 + fr;
        const int ocol0 = ((u.pn & 7) * BM + wc * 32 + 8 * fq) >> 1;
        const PG8_LAS float* bt = (const PG8_LAS float*)(lds + EPI_BTAB) + wc * 32 + 8 * fq;
        f32x4 bv[2][2];
#pragma unroll
        for (int bj = 0; bj < 2; ++bj)
#pragma unroll
            for (int n = 0; n < 2; ++n) bv[bj][n] = *(const PG8_LAS f32x4*)(bt + bj * HALF + 4 * n);
        const bool oddrow = (fq & 1) != 0;
#pragma unroll
        for (int ai = 0; ai < 2; ++ai)
#pragma unroll
            for (int m = 0; m < 4; ++m) { bf16_t* rowp = O + (size_t)(row0 + ai * HALF + m * 16) * 1024 + ocol0;
                u32x2 w[2];
#pragma unroll
                for (int bj = 0; bj < 2; ++bj) { const f32x4 v0 = acc[ai][bj][m][0] + bv[bj][0], v1 = acc[ai][bj][m][1] + bv[bj][1];
                    float o[4];
#pragma unroll
                    for (int q = 0; q < 4; ++q) { const float gl = (q < 2) ? v0[2 * q] : v1[2 * q - 4], li = (q < 2) ? v0[2 * q + 1] : v1[2 * q - 3];
                        const float hg = fminf(gl, 7.0f), hl = fminf(fmaxf(li, -7.0f), 7.0f);
                        o[q] = hg * (hl + 1.0f) * __builtin_amdgcn_rcpf(1.0f + __expf(-1.702f * hg)); }
                    w[bj].x = cvt_pk_bf16(o[0], o[1]); w[bj].y = cvt_pk_bf16(o[2], o[3]); }
                { auto sx = __builtin_amdgcn_permlane16_swap(w[0].x, w[1].x, false, false); w[0].x = sx[0]; w[1].x = sx[1];
                  auto sy = __builtin_amdgcn_permlane16_swap(w[0].y, w[1].y, false, false); w[0].y = sy[0]; w[1].y = sy[1]; }
                u32x4 wv; wv.x = w[0].x; wv.y = w[0].y; wv.z = w[1].x; wv.w = w[1].y;
                *(u32x4*)(rowp + (oddrow ? (HALF / 2) - 4 : 0)) = wv; }
    }
};
struct EpiDown {
    static constexpr bool PERM = true, AFTER_DRAIN = false;
    bf16_t* O; const float* bias; const int* dest; const float* gate;
    __device__ __forceinline__ void prefetch(PG8_LAS unsigned char* lds, const Unit& u, int wid, int lane) const {
        if (wid < 4) { __builtin_amdgcn_global_load_lds((const unsigned*)(bias + u.pn * BM + 64 * wid + lane), (PG8_LAS unsigned*)(lds + EPI_BTAB + wid * 256), 4, 0, 0);
                       __builtin_amdgcn_global_load_lds((const unsigned*)(dest + u.pm * BM + 64 * wid + lane), (PG8_LAS unsigned*)(lds + EPI_DTAB + wid * 256), 4, 0, 0); }
        else __builtin_amdgcn_global_load_lds((const unsigned*)(gate + u.pm * BM + 64 * (wid - 4) + lane), (PG8_LAS unsigned*)(lds + EPI_GTAB + (wid - 4) * 256), 4, 0, 0); }
    __device__ __forceinline__ void operator()(const f32x4 (&acc)[2][2][4][2], const Unit& u, int wr, int wc, int fr, int fq, PG8_LAS unsigned char* lds) const {
        const int rloc = wr * 64 + fr;
        const int ocol0 = (u.pn & 3) * BM + wc * 32 + 8 * fq;
        const PG8_LAS float* bt = (const PG8_LAS float*)(lds + EPI_BTAB) + wc * 32 + 8 * fq; const PG8_LAS int* dt = (const PG8_LAS int*)(lds + EPI_DTAB); const PG8_LAS float* gtb = (const PG8_LAS float*)(lds + EPI_GTAB);
#pragma unroll
        for (int ai = 0; ai < 2; ++ai)
#pragma unroll
            for (int m = 0; m < 4; ++m) { const int pl = rloc + ai * HALF + m * 16; const int d = dt[pl]; const float gt = gtb[pl];
                if (d >= 0) { bf16_t* rowp = O + (size_t)d * 1024 + ocol0;
#pragma unroll
                    for (int bj = 0; bj < 2; ++bj) { const f32x4 b0 = *(const PG8_LAS f32x4*)(bt + bj * HALF), b1 = *(const PG8_LAS f32x4*)(bt + bj * HALF + 4); const f32x4 v0 = (acc[ai][bj][m][0] + b0) * gt, v1 = (acc[ai][bj][m][1] + b1) * gt;
                        u32x4 w; w.x = cvt_pk_bf16(v0[0], v0[1]); w.y = cvt_pk_bf16(v0[2], v0[3]); w.z = cvt_pk_bf16(v1[0], v1[1]); w.w = cvt_pk_bf16(v1[2], v1[3]);
                        *(u32x4*)(rowp + bj * HALF) = w; } } }
    }
};

template <class Epi, class Sched, bool STAMP = false, bool GATHER = false, bool ALIGN_EPI = true, bool SP2 = PG8_SP2_DEFAULT>
__device__ __forceinline__ void gemm_phase(PG8_LAS unsigned char* lds, const Gemm g, const Sched& S, const Epi& E, unsigned long long* stamps, const int tid_in) {
    const int tid = tid_in, wid = __builtin_amdgcn_readfirstlane(tid >> 6), lane = tid & 63, wr = wid >> 2, wc = wid & 3, fr = lane & 15, fq = lane >> 4;
    const int K = g.K, nt = K / BK;
    int ts_lo = 0, ts_hi = 0, nts = 0; const unsigned long long rt_entry = STAMP ? (unsigned long long)wall_clock64() : 0ull;
#define PG8_STAMP() do { if (STAMP && wid == 0 && nts < 64) { const unsigned long long _c = (unsigned long long)clock64(); \
        ts_lo = (lane == nts) ? (int)(unsigned)_c : ts_lo; ts_hi = (lane == nts) ? (int)(unsigned)(_c >> 32) : ts_hi; ++nts; } } while (0)
    PG8_STAMP();
    unsigned voffA[2], voffB[2];
#pragma unroll
    for (int i = 0; i < 2; ++i) { int R, C; stage_rc(tid * 16 + i * 8192, R, C); const int Rb = Epi::PERM ? ((R & ~31) + perm32(R & 31)) : R;
        voffA[i] = (unsigned)(R * K + C) * 2u; voffB[i] = (unsigned)(Rb * K + C) * 2u; }
    unsigned gc[2][2], gn[2][2];
    PG8_LAS int* rowtab = (PG8_LAS int*)(lds + 137216);
    const size_t kstep = (size_t)(BK * 2);
    const size_t hstep = (size_t)HALF * K * 2;
    const size_t tstep = 2 * hstep;
    const unsigned ldsw = (unsigned)wid * 1024u;
    const int aoff = lds_byte(wr * 64 + fr, fq * 8), boff = lds_byte(wc * 32 + fr, fq * 8);
#define PG8_SA(b, h) (((b) * 2 + (h)) * HTB)
#define PG8_SB(b, h) ((4 + (b) * 2 + (h)) * HTB)
#define PG8_STAGE(bufoff, gbase, voff) do { _Pragma("unroll") for (int _i = 0; _i < 2; ++_i) \
        __builtin_amdgcn_global_load_lds((const unsigned*)((const char*)(gbase) + (voff)[_i]), (PG8_LAS unsigned*)(lds + (bufoff) + ldsw + _i * 8192), 16, 0, 0); } while (0)
#define PG8_LDA(dst, b, h) do { _Pragma("unroll") for (int m = 0; m < 4; ++m) _Pragma("unroll") for (int k = 0; k < 2; ++k) dst[m][k] = *(const PG8_LAS bf16x8*)(lds + PG8_SA(b, h) + aoff + m * 2048 + k * 1024); } while (0)
#define PG8_LDB(dst, b, h) do { _Pragma("unroll") for (int n = 0; n < 2; ++n) _Pragma("unroll") for (int k = 0; k < 2; ++k) dst[n][k] = *(const PG8_LAS bf16x8*)(lds + PG8_SB(b, h) + boff + n * 2048 + k * 1024); } while (0)
#define PG8_MMA(ai, bj, At, Bt) do { __builtin_amdgcn_s_setprio(1); _Pragma("unroll") for (int m = 0; m < 4; ++m) _Pragma("unroll") for (int n = 0; n < 2; ++n) _Pragma("unroll") for (int k = 0; k < 2; ++k) \
        acc[ai][bj][m][n] = __builtin_amdgcn_mfma_f32_16x16x32_bf16(Bt[n][k], At[m][k], acc[ai][bj][m][n], 0, 0, 0); __builtin_amdgcn_s_setprio(0); } while (0)
#define PG8_WAIT_V(n) asm volatile("s_waitcnt vmcnt(" #n ")" ::: "memory")
#define PG8_WAIT_L(n) asm volatile("s_waitcnt lgkmcnt(" #n ")" ::: "memory")
#define PG8_BAR __builtin_amdgcn_s_barrier()
#define PG8_SCHED __builtin_amdgcn_sched_barrier(0)
    Unit cur, nxt; int ui = 0;
    if (!S.next(0, cur)) return;
    f32x4 acc[2][2][4][2];
#pragma unroll
    for (int a = 0; a < 2; ++a)
#pragma unroll
        for (int b = 0; b < 2; ++b)
#pragma unroll
            for (int m = 0; m < 4; ++m)
#pragma unroll
                for (int n = 0; n < 2; ++n) acc[a][b][m][n] = (f32x4){0.f, 0.f, 0.f, 0.f};
    bf16x8 At[4][2], B0[2][2], B1[2][2];
    const char* cA = GATHER ? (const char*)g.A : (const char*)g.A + (size_t)cur.pm * tstep; const char* cB = (const char*)g.Bt + (size_t)cur.pn * tstep;
    if constexpr (GATHER) {
#pragma unroll
        for (int h = 0; h < 2; ++h)
#pragma unroll
            for (int i = 0; i < 2; ++i) { int R, C; stage_rc(tid * 16 + i * 8192, R, C); gc[h][i] = (unsigned)S.rowtok[256 * cur.pm + 128 * h + R] * (unsigned)(K * 2) + (unsigned)(C * 2); gn[h][i] = gc[h][i]; } }
    S.a_ready(cur);
    if constexpr (SP2) {
        PG8_STAGE(PG8_SB(0, 0), cB, voffB); PG8_STAGE(PG8_SB(0, 1), cB + hstep, voffB); if constexpr (GATHER) PG8_STAGE(PG8_SA(0, 0), cA, gc[0]); else PG8_STAGE(PG8_SA(0, 0), cA, voffA); if constexpr (GATHER) PG8_STAGE(PG8_SA(0, 1), cA, gc[1]); else PG8_STAGE(PG8_SA(0, 1), cA + hstep, voffA);
        if (wr == 1) PG8_BAR;
        PG8_WAIT_V(2); PG8_BAR;
        PG8_STAGE(PG8_SB(1, 0), cB + kstep, voffB); if constexpr (GATHER) PG8_STAGE(PG8_SA(1, 0), cA + kstep, gc[0]); else PG8_STAGE(PG8_SA(1, 0), cA + kstep, voffA); PG8_STAGE(PG8_SB(1, 1), cB + hstep + kstep, voffB);
        PG8_WAIT_V(6); PG8_BAR;
    } else {
    PG8_STAGE(PG8_SB(0, 0), cB, voffB); if constexpr (GATHER) PG8_STAGE(PG8_SA(0, 0), cA, gc[0]); else PG8_STAGE(PG8_SA(0, 0), cA, voffA); PG8_STAGE(PG8_SB(0, 1), cB + hstep, voffB); if constexpr (GATHER) PG8_STAGE(PG8_SA(0, 1), cA, gc[1]); else PG8_STAGE(PG8_SA(0, 1), cA + hstep, voffA);
    if (wr == 1) PG8_BAR;
    PG8_WAIT_V(4); PG8_BAR;
    PG8_STAGE(PG8_SB(1, 0), cB + kstep, voffB); if constexpr (GATHER) PG8_STAGE(PG8_SA(1, 0), cA + kstep, gc[0]); else PG8_STAGE(PG8_SA(1, 0), cA + kstep, voffA); PG8_STAGE(PG8_SB(1, 1), cB + hstep + kstep, voffB);
    PG8_WAIT_V(6); PG8_BAR;
    }
    PG8_STAMP();
    for (;;) {
        const bool has_next = S.next(ui + 1, nxt);
        const char* nA = GATHER ? cA : (has_next ? (const char*)g.A + (size_t)nxt.pm * tstep : cA); const char* nB = has_next ? (const char*)g.Bt + (size_t)nxt.pn * tstep : cB;
        for (int t = 0; t < nt; t += 2) {
            const bool last = (t == nt - 2);
            const char* a1 = cA + (size_t)(t + 1) * kstep;
            const char* a2 = last ? nA : cA + (size_t)(t + 2) * kstep; const char* b2 = last ? nB : cB + (size_t)(t + 2) * kstep;
            const char* a3 = a2 + kstep; const char* b3 = b2 + kstep;
            if (last && has_next) S.a_ready(nxt);
            if (t == nt - 4) { int ln_ = lane; asm volatile("" : "+v"(ln_)); E.prefetch(lds, cur, wid, ln_); }
            if constexpr (GATHER) {
                if (t == nt - 4 && has_next && wid < 4)
                    __builtin_amdgcn_global_load_lds((const unsigned*)(S.rowtok + 256 * nxt.pm + 64 * wid + lane), (PG8_LAS unsigned*)((PG8_LAS unsigned char*)rowtab + wid * 256), 4, 0, 0);
                if (last && has_next) { int tz = tid; asm volatile("" : "+v"(tz));
#pragma unroll
                    for (int h = 0; h < 2; ++h)
#pragma unroll
                        for (int i = 0; i < 2; ++i) { int R, C; stage_rc(tz * 16 + i * 8192, R, C); gn[h][i] = (unsigned)rowtab[128 * h + R] * (unsigned)(K * 2) + (unsigned)(C * 2); } } }
            unsigned g0x[2], g1x[2];
#pragma unroll
            for (int i = 0; i < 2; ++i) { g0x[i] = last ? gn[0][i] : gc[0][i]; g1x[i] = last ? gn[1][i] : gc[1][i]; }
            if constexpr (SP2) {
            PG8_LDB(B0, 0, 0); PG8_LDB(B1, 0, 1); PG8_SCHED; PG8_LDA(At, 0, 0); if constexpr (GATHER) PG8_STAGE(PG8_SA(1, 1), a1, gc[1]); else PG8_STAGE(PG8_SA(1, 1), a1 + hstep, voffA);
            PG8_WAIT_V(8); PG8_WAIT_L(0); PG8_BAR; PG8_MMA(0, 0, At, B0); PG8_MMA(0, 1, At, B1); PG8_BAR; PG8_SCHED;
            PG8_LDA(At, 0, 1); PG8_STAGE(PG8_SB(0, 0), b2, voffB); PG8_STAGE(PG8_SB(0, 1), b2 + hstep, voffB); if constexpr (GATHER) PG8_STAGE(PG8_SA(0, 0), a2, g0x); else PG8_STAGE(PG8_SA(0, 0), a2, voffA);
            PG8_WAIT_V(8); PG8_WAIT_L(0); PG8_BAR; PG8_MMA(1, 0, At, B0); PG8_MMA(1, 1, At, B1); PG8_BAR; PG8_SCHED;
            PG8_LDB(B0, 1, 0); PG8_LDB(B1, 1, 1); PG8_SCHED; PG8_LDA(At, 1, 0); if constexpr (GATHER) PG8_STAGE(PG8_SA(0, 1), a2, g1x); else PG8_STAGE(PG8_SA(0, 1), a2 + hstep, voffA);
            PG8_WAIT_V(8); PG8_WAIT_L(0); PG8_BAR; PG8_MMA(0, 0, At, B0); PG8_MMA(0, 1, At, B1); PG8_BAR; PG8_SCHED;
            PG8_LDA(At, 1, 1); PG8_STAGE(PG8_SB(1, 0), b3, voffB); PG8_STAGE(PG8_SB(1, 1), b3 + hstep, voffB); if constexpr (GATHER) PG8_STAGE(PG8_SA(1, 0), a3, g0x); else PG8_STAGE(PG8_SA(1, 0), a3, voffA);
            PG8_WAIT_V(8); PG8_WAIT_L(0); PG8_BAR; PG8_MMA(1, 0, At, B0); PG8_MMA(1, 1, At, B1); PG8_BAR; PG8_SCHED;
            } else {
            PG8_LDB(B0, 0, 0); PG8_SCHED; PG8_LDA(At, 0, 0); if constexpr (GATHER) PG8_STAGE(PG8_SA(1, 1), a1, gc[1]); else PG8_STAGE(PG8_SA(1, 1), a1 + hstep, voffA);
            PG8_WAIT_L(8); PG8_BAR; PG8_WAIT_L(0); PG8_MMA(0, 0, At, B0); PG8_BAR; PG8_SCHED;
            PG8_LDB(B1, 0, 1); PG8_STAGE(PG8_SB(0, 0), b2, voffB);
            PG8_BAR; PG8_WAIT_L(0); PG8_MMA(0, 1, At, B1); PG8_BAR;
            PG8_LDA(At, 0, 1); if constexpr (GATHER) PG8_STAGE(PG8_SA(0, 0), a2, g0x); else PG8_STAGE(PG8_SA(0, 0), a2, voffA);
            PG8_BAR; PG8_WAIT_L(0); PG8_MMA(1, 0, At, B0); PG8_BAR; PG8_SCHED;
            PG8_STAGE(PG8_SB(0, 1), b2 + hstep, voffB);
            PG8_WAIT_V(6); PG8_BAR; PG8_MMA(1, 1, At, B1); PG8_BAR;
            PG8_LDB(B0, 1, 0); PG8_SCHED; PG8_LDA(At, 1, 0); if constexpr (GATHER) PG8_STAGE(PG8_SA(0, 1), a2, g1x); else PG8_STAGE(PG8_SA(0, 1), a2 + hstep, voffA);
            PG8_WAIT_L(8); PG8_BAR; PG8_WAIT_L(0); PG8_MMA(0, 0, At, B0); PG8_BAR; PG8_SCHED;
            PG8_LDB(B1, 1, 1); PG8_STAGE(PG8_SB(1, 0), b3, voffB);
            PG8_BAR; PG8_WAIT_L(0); PG8_MMA(0, 1, At, B1); PG8_BAR;
            PG8_LDA(At, 1, 1); if constexpr (GATHER) PG8_STAGE(PG8_SA(1, 0), a3, g0x); else PG8_STAGE(PG8_SA(1, 0), a3, voffA);
            PG8_BAR; PG8_WAIT_L(0); PG8_MMA(1, 0, At, B0); PG8_BAR; PG8_SCHED;
            PG8_STAGE(PG8_SB(1, 1), b3 + hstep, voffB);
            PG8_WAIT_V(6); PG8_BAR; PG8_MMA(1, 1, At, B1); PG8_BAR;
            }
        }
        PG8_STAMP();
        if constexpr (ALIGN_EPI) { if (wr == 0) PG8_BAR; }
        if constexpr (!Epi::AFTER_DRAIN) { E(acc, cur, wr, wc, fr, fq, lds); S.done(cur); }
        PG8_STAMP();
        if (!has_next) break;
#pragma unroll
        for (int a = 0; a < 2; ++a)
#pragma unroll
            for (int b = 0; b < 2; ++b)
#pragma unroll
                for (int m = 0; m < 4; ++m)
#pragma unroll
                    for (int n = 0; n < 2; ++n) acc[a][b][m][n] = (f32x4){0.f, 0.f, 0.f, 0.f};
        cur = nxt; cA = nA; cB = nB; ++ui;
        if constexpr (GATHER) {
#pragma unroll
            for (int h = 0; h < 2; ++h)
#pragma unroll
                for (int i = 0; i < 2; ++i) gc[h][i] = gn[h][i]; }
        if constexpr (ALIGN_EPI) { if (wr == 1) PG8_BAR; }
    }
    PG8_WAIT_V(0);
    if constexpr (!ALIGN_EPI) { if (wr == 0) PG8_BAR; }
    PG8_BAR;
    if constexpr (Epi::AFTER_DRAIN) { E.fused(acc, cur, wr, wc, fr, fq, lds, wid, lane); S.done(cur); }
    PG8_STAMP();
    if (STAMP && wid == 0) { stamps[lane] = lane < nts ? (((unsigned long long)(unsigned)ts_hi << 32) | (unsigned)ts_lo) : 0ull;
        if (lane == 62) stamps[62] = rt_entry; if (lane == 63) stamps[63] = (unsigned long long)wall_clock64(); }
#undef PG8_STAMP
#undef PG8_SA
#undef PG8_SB
#undef PG8_STAGE
#undef PG8_LDA
#undef PG8_LDB
#undef PG8_MMA
#undef PG8_WAIT_V
#undef PG8_WAIT_L
#undef PG8_BAR
#undef PG8_SCHED
}
}
using pg8::bf16_t; using pg8::bf16x8; using pg8::f32x4; using pg8::u32x4;

constexpr int NB = 4, SEQ = 8192, MTOK = NB * SEQ, DM = 1024, NLAYER = 4, CIN = 3080, NPROJ = 3072, NEXP = 32, DEXP = 1024, NUP = 2048;
constexpr int RWD = 384, RW_COLS = 1408;
constexpr int NT_MAX = 544, POS_MAX = NT_MAX * 256;
constexpr float DN_ALPHA = 1.6817928305074290861f;
constexpr float LN_EPS = 1e-5f;
constexpr int NPH = 10;
constexpr int NPHASE_TOTAL = 1 + NLAYER * NPH;

constexpr size_t MiB = 1u << 20;
constexpr size_t WS_CTL = 0, CTL_ZERO_BYTES = 65536;
constexpr size_t WS_WIN = 1 * MiB;
constexpr size_t WS_WOUT = 25 * MiB;
constexpr size_t WS_WUP = 33 * MiB;
constexpr size_t WS_WDN = 545 * MiB;
constexpr size_t WS_ROPE = 801 * MiB;
constexpr size_t WS_HB = 803 * MiB;
constexpr size_t WS_HF = 867 * MiB;
constexpr size_t WS_H1F = 995 * MiB;
constexpr size_t WS_T1 = 1123 * MiB;
constexpr size_t WS_P = 1251 * MiB;
constexpr size_t WS_PG = 1443 * MiB;
constexpr size_t WS_YMIX = 1444 * MiB;
constexpr size_t WS_RWM = 1508 * MiB;
constexpr size_t WS_RWNT = 1532 * MiB;
constexpr size_t WS_RWQH = 1580 * MiB;
constexpr size_t WS_RWYL = 1604 * MiB;
constexpr size_t WS_RWS = 1652 * MiB;
constexpr size_t WS_RWAUX = 1676 * MiB;
constexpr size_t WS_MLQ = 1724 * MiB;
constexpr size_t WS_MLNL = 1740 * MiB;
constexpr size_t WS_MLVEC = 1780 * MiB;
constexpr size_t WS_MLSC = 1781 * MiB;
constexpr size_t WS_MLKL = 1782 * MiB;
constexpr size_t WS_MLCT = 1822 * MiB;
constexpr size_t WS_MLM = 1842 * MiB;
constexpr size_t WS_WUPT = 1843 * MiB;
constexpr size_t WS_AUPT = 1843 * MiB + 256 * 1024;
constexpr size_t WS_GUPT = 1843 * MiB + 512 * 1024;
constexpr size_t WS_LISCR = 1845 * MiB;
constexpr size_t WS_WRH = 1844 * MiB;
constexpr size_t WS_WRL = 1844 * MiB + 256 * 1024;
constexpr size_t WS_XPERM = 2021 * MiB;
constexpr size_t WS_ACT = 2293 * MiB;
constexpr size_t WS_YB = 2565 * MiB;
constexpr size_t WS_TOKE = 2821 * MiB;
constexpr size_t WS_TOKG = 2822 * MiB;
constexpr size_t WS_TOKLR = 2823 * MiB;
constexpr size_t WS_PDEST = 2824 * MiB;
constexpr size_t WS_PGATE = 2825 * MiB;
constexpr size_t WS_BBASE = 2826 * MiB;
constexpr size_t WS_PTOK = 2827 * MiB;
constexpr size_t WS_END = 2828 * MiB;
constexpr int CW_CNT = 1024;
constexpr int CW_SWAQ = 2048;
constexpr int CW_BAR = 4096;
constexpr int LDS_BYTES = 147456;
constexpr int MISC_OFF = 143360;
constexpr int TILEE_OFF = 133120;

#define LDS_WAIT() asm volatile("s_waitcnt lgkmcnt(0)" ::: "memory")
#define LDS_BARRIER() do { asm volatile("s_waitcnt lgkmcnt(0)" ::: "memory"); __builtin_amdgcn_s_barrier(); asm volatile("" ::: "memory"); } while (0)
#define VM_WAIT() asm volatile("s_waitcnt vmcnt(0)" ::: "memory")
__device__ __forceinline__ unsigned f2bf(float f) { unsigned u = __builtin_bit_cast(unsigned, f); return (u + 0x7fffu + ((u >> 16) & 1u)) >> 16; }
typedef __bf16 bf16v2_t __attribute__((ext_vector_type(2)));
__device__ __forceinline__ unsigned pk2(float lo, float hi) { const f32x2 v = (f32x2){lo, hi}; return __builtin_bit_cast(unsigned, __builtin_convertvector(v, bf16v2_t)); }
__device__ __forceinline__ float bf2f(unsigned short b) { return __builtin_bit_cast(float, ((unsigned)b) << 16); }
__device__ __forceinline__ float bflo(unsigned w) { return __builtin_bit_cast(float, w << 16); }
__device__ __forceinline__ float bfhi(unsigned w) { return __builtin_bit_cast(float, w & 0xffff0000u); }
template <int CTRL, int RMASK> __device__ __forceinline__ float dpp_add(float v) { return v + __builtin_bit_cast(float, __builtin_amdgcn_update_dpp(0, __builtin_bit_cast(int, v), CTRL, RMASK, 0xF, false)); }
__device__ __forceinline__ float wave_sum(float v) {
    v = dpp_add<0xB1, 0xF>(v); v = dpp_add<0x4E, 0xF>(v); v = dpp_add<0x141, 0xF>(v); v = dpp_add<0x140, 0xF>(v);
    v = dpp_add<0x142, 0xA>(v); v = dpp_add<0x143, 0xC>(v);
    return __builtin_bit_cast(float, __builtin_amdgcn_readlane(__builtin_bit_cast(int, v), 63));
}
template <int CTRL> __device__ __forceinline__ float dpp_mov(float x) { return __builtin_bit_cast(float, __builtin_amdgcn_update_dpp(0, __builtin_bit_cast(int, x), CTRL, 0xF, 0xF, true)); }
__device__ __forceinline__ float sum8(float x) { x += dpp_mov<0xB1>(x); x += dpp_mov<0x4E>(x); x += dpp_mov<0x141>(x); return x; }
__device__ __forceinline__ float sigmoidf_(float x) { return __builtin_amdgcn_rcpf(1.0f + __expf(-x)); }

#define XB_TMO      128
#define XB_XCNT(j)  (256  + 64 * (j))
#define XB_XSUB(j)  (1280 + 64 * (j))
#define XB_XGEN(j)  (2304 + 64 * (j))
#define XB_TOP      3328
#define XB_TOPGEN   3392
#define XCD_BAR_WORDS 3456
#define XB_SPIN_CAP (1u << 22)
__device__ __forceinline__ unsigned xb_ld(unsigned* p)              { return __hip_atomic_load(p, __ATOMIC_RELAXED, __HIP_MEMORY_SCOPE_AGENT); }
__device__ __forceinline__ unsigned xb_add(unsigned* p, unsigned v) { return __hip_atomic_fetch_add(p, v, __ATOMIC_RELAXED, __HIP_MEMORY_SCOPE_AGENT); }
__device__ __forceinline__ unsigned xb_xcc_id() { return (unsigned)__builtin_amdgcn_s_getreg((3 << 11) | 20) & 0xFu; }
#define XB_SPIN(cond, bar) do { unsigned _sp = 0; while (cond) { __builtin_amdgcn_s_sleep(1); \
    if ((++_sp & 255u) == 0u) { if (xb_ld(&(bar)[XB_TMO])) break; if (_sp > XB_SPIN_CAP) { atomicAdd(&(bar)[XB_TMO], 1u); break; } } } } while (0)

struct XcdBarrier {
    unsigned* bar; unsigned x;
    volatile LAS unsigned* st;
};

__device__ __forceinline__ XcdBarrier xcd_barrier_post(unsigned* bar, volatile LAS unsigned* st, bool t0  ) {
    XcdBarrier b; b.bar = bar; b.x = xb_xcc_id(); b.st = st;
    if (t0) (void)xb_add(&bar[XB_XCNT(b.x)], 1u);
    return b;
}
__device__ __forceinline__ void xcd_barrier_complete(unsigned* bar, unsigned x, unsigned& nloc, unsigned& nx) {
    const unsigned G = gridDim.x * gridDim.y * gridDim.z;
    unsigned sum, cnt, mine, sp = 0u;
    for (;;) {
        sum = 0u; cnt = 0u; mine = 0u;
#pragma unroll
        for (unsigned j = 0; j < 16; ++j) { const unsigned c = xb_ld(&bar[XB_XCNT(j)]); sum += c; cnt += (c > 0u) ? 1u : 0u; mine = (j == x) ? c : mine; }
        if (sum == G) break;
        __builtin_amdgcn_s_sleep(1);
        if ((++sp & 255u) == 0u) { if (xb_ld(&bar[XB_TMO])) break; if (sp > XB_SPIN_CAP) { atomicAdd(&bar[XB_TMO], 1u); break; } }
    }
    nloc = mine > 0u ? mine : 1u; nx = cnt > 0u ? cnt : 1u;
}

__device__ __forceinline__ void xcd_barrier(const XcdBarrier& b, bool t0  ) {
    asm volatile("s_waitcnt vmcnt(0)" ::: "memory");
    __syncthreads();
    if (t0) {
        unsigned* bar = b.bar;
        __builtin_amdgcn_s_waitcnt(0);
        unsigned nloc = b.st[0], nx = b.st[1];
        if (nloc == 0u) { xcd_barrier_complete(bar, b.x, nloc, nx); b.st[0] = nloc; b.st[1] = nx; }
        const unsigned old = xb_add(&bar[XB_XSUB(b.x)], 1u);
        const unsigned gen = old / nloc;
        if (old + 1u == (gen + 1u) * nloc) {
            __builtin_amdgcn_fence(__ATOMIC_RELEASE, "agent");
            asm volatile("s_waitcnt vmcnt(0)" ::: "memory");
            const unsigned og = xb_add(&bar[XB_TOP], 1u);
            const unsigned tg = og / nx;
            if (og + 1u == (tg + 1u) * nx) xb_add(&bar[XB_TOPGEN], 1u);
            else XB_SPIN(xb_ld(&bar[XB_TOPGEN]) == tg, bar);
            __builtin_amdgcn_fence(__ATOMIC_ACQUIRE, "agent");
            xb_add(&bar[XB_XGEN(b.x)], 1u);
            asm volatile("s_waitcnt vmcnt(0)" ::: "memory");
        } else {
            XB_SPIN(xb_ld(&bar[XB_XGEN(b.x)]) == gen, bar);
            __builtin_amdgcn_fence(__ATOMIC_ACQUIRE, "agent");
            asm volatile("s_waitcnt vmcnt(0)" ::: "memory");
        }
    }
    __syncthreads();
}
struct Params {
    const float* in[29];
    float* out; unsigned char* ws;
    int ph_lo, ph_hi;
    int pad0, pad1;
};
enum { I_X = 0, I_WIN, I_BIN, I_MU, I_WUP, I_W0, I_AUP, I_A0, I_GUP, I_KK, I_KA, I_RK, I_LNW, I_LNB, I_SINK, I_CONVW, I_CONVB, I_MLNW, I_WOUT,
       I_LN1W, I_LN1B, I_RW, I_RB, I_EWUP, I_EBUP, I_EWDN, I_EBDN, I_LN2W, I_LN2B };

struct Ctx {
    LAS unsigned char* lds; int tid, lane, wave, blk, G;
    unsigned char* ws;
};

__device__ __forceinline__ void tr_item(const float* W, int ldw, int K, bf16_t* WT, LAS float* scr, int kb, int nb, int lane) {
    const int k0 = 64 * kb, n0 = 32 * nb;
#pragma unroll 8
    for (int i = 0; i < 32; ++i) { const int kk = 2 * i + (lane >> 5); scr[kk * 33 + (lane & 31)] = __builtin_nontemporal_load(W + (size_t)(k0 + kk) * ldw + n0 + (lane & 31)); }
    LDS_WAIT();
    const int c = lane & 7;
#pragma unroll
    for (int j = 0; j < 4; ++j) { const int n = (lane >> 3) + 8 * j; const LAS float* s = scr + (8 * c) * 33 + n;
        u32x4 o; o.x = pk2(s[0 * 33], s[1 * 33]); o.y = pk2(s[2 * 33], s[3 * 33]); o.z = pk2(s[4 * 33], s[5 * 33]); o.w = pk2(s[6 * 33], s[7 * 33]);
        *(u32x4*)(WT + (size_t)(n0 + n) * K + k0 + 8 * c) = o; }
    LDS_WAIT();
}
__device__ __forceinline__ void gate_cols(const f32x4 (&v)[4], const LAS float* tab, const float* bg, float* pgrow, int lane) {
    float acc[8];
#pragma unroll
    for (int c = 0; c < 8; ++c) acc[c] = 0.f;
#pragma unroll
    for (int j = 0; j < 4; ++j)
#pragma unroll
        for (int q = 0; q < 4; ++q) { const LAS f32x4* tp = (const LAS f32x4*)(tab + ((j * 4 + q) * 64 + lane) * 8); const f32x4 a = tp[0], b = tp[1]; const float x = v[j][q];
            acc[0] += x * a[0]; acc[1] += x * a[1]; acc[2] += x * a[2]; acc[3] += x * a[3]; acc[4] += x * b[0]; acc[5] += x * b[1]; acc[6] += x * b[2]; acc[7] += x * b[3]; }
#pragma unroll
    for (int c = 0; c < 8; ++c) acc[c] = wave_sum(acc[c]);
    if (lane < 8) { float r = acc[0];
#pragma unroll
        for (int c = 1; c < 8; ++c) r = (lane == c) ? acc[c] : r;
        pgrow[lane] = r + bg[lane]; }
}
__device__ __forceinline__ void load_wg(LAS float* tab, const float* win_l, int tid) {
    for (int d = tid; d < DM; d += 512) { const int j = d >> 8, ln = (d >> 2) & 63, q = d & 3; const f32x4 a = *(const f32x4*)(win_l + (size_t)d * CIN + NPROJ), b = *(const f32x4*)(win_l + (size_t)d * CIN + NPROJ + 4);
        LAS f32x4* tp = (LAS f32x4*)(tab + ((j * 4 + q) * 64 + ln) * 8); tp[0] = a; tp[1] = b; }
    __syncthreads();
}
__device__ __forceinline__ void p0_prologue(const Params& P, const Ctx& C) {
    LAS float* scr = (LAS float*)(C.lds + C.wave * 16384);
    const int gw = C.blk * 8 + C.wave, NGW = C.G * 8;
    bf16_t* win_t = (bf16_t*)(C.ws + WS_WIN); bf16_t* wout_t = (bf16_t*)(C.ws + WS_WOUT); bf16_t* wup_t = (bf16_t*)(C.ws + WS_WUP); bf16_t* wdn_t = (bf16_t*)(C.ws + WS_WDN);
    constexpr int I_IN = 16 * 96, I_OUT = 16 * 32, I_UP = 16 * 64, I_DN = 16 * 32;
    constexpr int N1 = NLAYER * I_IN, N2 = NLAYER * I_OUT, N3 = NLAYER * NEXP * I_UP, N4 = NLAYER * NEXP * I_DN;
    for (int it = gw; it < N1 + N2 + N3 + N4; it += NGW) {
        int r = it;
        if (r < N1) { const int l = r / I_IN; r %= I_IN; tr_item(P.in[I_WIN] + (size_t)l * DM * CIN, CIN, DM, win_t + (size_t)l * NPROJ * DM, scr, r / 96, r % 96, C.lane); continue; } r -= N1;
        if (r < N2) { const int l = r / I_OUT; r %= I_OUT; tr_item(P.in[I_WOUT] + (size_t)l * DM * DM, DM, DM, wout_t + (size_t)l * DM * DM, scr, r / 32, r % 32, C.lane); continue; } r -= N2;
        if (r < N3) { const int le = r / I_UP; r %= I_UP; tr_item(P.in[I_EWUP] + (size_t)le * DM * NUP, NUP, DM, wup_t + (size_t)le * NUP * DM, scr, r / 64, r % 64, C.lane); continue; } r -= N3;
        { const int le = r / I_DN; r %= I_DN; tr_item(P.in[I_EWDN] + (size_t)le * DEXP * DM, DM, DEXP, wdn_t + (size_t)le * DM * DEXP, scr, r / 32, r % 32, C.lane); }
    }
    f32x2* rope = (f32x2*)(C.ws + WS_ROPE);
    for (int idx = C.blk * 512 + C.tid; idx < SEQ * 32; idx += C.G * 512) { const int t = idx >> 5, i = idx & 31;
        const float inv = powf(10000.0f, -(float)i / 32.0f); const float ang = (float)t * inv;
        const double rev = (double)ang * 0.15915494309189533577; const float fr = (float)(rev - __builtin_rint(rev));
        rope[idx] = (f32x2){__builtin_amdgcn_cosf(fr), __builtin_amdgcn_sinf(fr)}; }
    { bf16_t* wt = (bf16_t*)(C.ws + WS_WUPT); bf16_t* at = (bf16_t*)(C.ws + WS_AUPT); bf16_t* gt = (bf16_t*)(C.ws + WS_GUPT);
      for (int idx = C.blk * 512 + C.tid; idx < NLAYER * RWD * 64; idx += C.G * 512) { const int ll = idx / (RWD * 64), rem = idx % (RWD * 64), j = rem >> 6, i = rem & 63;
          wt[idx] = (bf16_t)f2bf(P.in[I_WUP][((size_t)ll * 64 + i) * RWD + j]); at[idx] = (bf16_t)f2bf(P.in[I_AUP][((size_t)ll * 64 + i) * RWD + j]); }
      for (int idx = C.blk * 512 + C.tid; idx < NLAYER * RWD * 128; idx += C.G * 512) { const int ll = idx / (RWD * 128), rem = idx % (RWD * 128), j = rem >> 7, i = rem & 127;
          gt[idx] = (bf16_t)f2bf(P.in[I_GUP][((size_t)ll * 128 + i) * RWD + j]); } }
    { bf16_t* wh = (bf16_t*)(C.ws + WS_WRH); bf16_t* wl = (bf16_t*)(C.ws + WS_WRL);
      for (int idx = C.blk * 512 + C.tid; idx < NLAYER * NEXP * DM; idx += C.G * 512) { const int ll = idx / (NEXP * DM), rem = idx % (NEXP * DM), e = rem >> 10, d = rem & 1023;
          const float w = P.in[I_RW][((size_t)ll * DM + d) * NEXP + e]; const unsigned hi = f2bf(w); const float lo = w - bflo(hi); wh[idx] = (bf16_t)hi; wl[idx] = (bf16_t)f2bf(lo); } }
    __syncthreads(); LAS float* wg = (LAS float*)C.lds; load_wg(wg, P.in[I_WIN], C.tid);
    bf16_t* hb = (bf16_t*)(C.ws + WS_HB); float* pg = (float*)(C.ws + WS_PG);
    for (int m = gw; m < MTOK; m += NGW) {
        const f32x4* xr = (const f32x4*)(P.in[I_X] + (size_t)m * DM) + C.lane; f32x4 v[4];
#pragma unroll
        for (int j = 0; j < 4; ++j) v[j] = xr[64 * j];
        u32x2* o8 = (u32x2*)(hb + (size_t)m * DM) + C.lane;
#pragma unroll
        for (int j = 0; j < 4; ++j) o8[64 * j] = (u32x2){pk2(v[j][0], v[j][1]), pk2(v[j][2], v[j][3])};
        gate_cols(v, wg, P.in[I_BIN] + NPROJ, pg + (size_t)m * 8, C.lane);
    }
}

constexpr int LD = 72;
constexpr int BUFB = 64 * LD * 2;
__device__ __forceinline__ f32x4 mfma16(bf16x8 a, bf16x8 b, f32x4 c) { return __builtin_amdgcn_mfma_f32_16x16x32_bf16(a, b, c, 0, 0, 0); }
constexpr int SWA_VLD = 264;
__device__ __forceinline__ void swa_unit(const Params& P, const Ctx& C, int l, int u) {
    const int tid = C.tid, wave = C.wave, lane = C.lane, r = lane & 15, g = lane >> 4; const int b = u >> 7, n = (u >> 1) & 63, hk = u & 1;
    LAS bf16_t* Ks = (LAS bf16_t*)C.lds; LAS bf16_t* VT = Ks + 256 * LD;
    const bf16_t* p = (const bf16_t*)(C.ws + WS_P); const f32x2* rope = (const f32x2*)(C.ws + WS_ROPE);
    const int t_base = n * 128 - 128;
#pragma unroll
    for (int it = 0; it < 2; ++it) { const int q = tid + 512 * it, row = q >> 2, c8 = q & 3; const int t = t_base + row;
        u32x4 o1 = (u32x4){0u, 0u, 0u, 0u}, o2 = o1;
        if (t >= 0) { const bf16_t* pr = p + (size_t)(b * SEQ + t) * NPROJ + 1792 + hk * 64 + 8 * c8; const u32x4 a1 = *(const u32x4*)pr, a2 = *(const u32x4*)(pr + 32);
            const f32x4* rp = (const f32x4*)(rope + t * 32 + 8 * c8); float y1[8], y2[8];
#pragma unroll
            for (int e = 0; e < 4; ++e) { const f32x4 cs = rp[e];
                const float x1a = bflo(a1[e]), x1b = bfhi(a1[e]), x2a = bflo(a2[e]), x2b = bfhi(a2[e]);
                y1[2 * e] = x1a * cs[0] - x2a * cs[1]; y2[2 * e] = x2a * cs[0] + x1a * cs[1]; y1[2 * e + 1] = x1b * cs[2] - x2b * cs[3]; y2[2 * e + 1] = x2b * cs[2] + x1b * cs[3]; }
            o1 = (u32x4){pk2(y1[0], y1[1]), pk2(y1[2], y1[3]), pk2(y1[4], y1[5]), pk2(y1[6], y1[7])}; o2 = (u32x4){pk2(y2[0], y2[1]), pk2(y2[2], y2[3]), pk2(y2[4], y2[5]), pk2(y2[6], y2[7])}; }
        *(LAS u32x4*)(Ks + row * LD + 8 * c8) = o1; *(LAS u32x4*)(Ks + row * LD + 32 + 8 * c8) = o2; }
    if (tid < 256) { const int kg = tid >> 3, c8 = tid & 7; u32x4 in[8];
#pragma unroll
        for (int k = 0; k < 8; ++k) { const int t = t_base + 8 * kg + k; in[k] = (t >= 0) ? *(const u32x4*)(p + (size_t)(b * SEQ + t) * NPROJ + 1920 + hk * 64 + 8 * c8) : (u32x4){0u, 0u, 0u, 0u}; }
#pragma unroll
        for (int d = 0; d < 8; ++d) { unsigned hv[8];
#pragma unroll
            for (int k = 0; k < 8; ++k) { const unsigned w = in[k][d >> 1]; hv[k] = (d & 1) ? (w >> 16) : (w & 0xffffu); }
            *(LAS u32x4*)(VT + (8 * c8 + d) * SWA_VLD + 8 * kg) = (u32x4){hv[0] | (hv[1] << 16), hv[2] | (hv[3] << 16), hv[4] | (hv[5] << 16), hv[6] | (hv[7] << 16)}; } }
    LDS_BARRIER();
    const int qi = 16 * wave + r, t = n * 128 + qi;
    const f32x4* rq = (const f32x4*)(rope + t * 32 + 8 * g);
#pragma unroll 1
    for (int gq = 0; gq < 3; ++gq) { const int hq = hk * 3 + gq; int wave = C.wave; asm volatile("" : "+s"(wave));
        bf16x8 qf0, qf1;
        { const bf16_t* pr = p + (size_t)(b * SEQ + t) * NPROJ + RW_COLS + hq * 64 + 8 * g; const u32x4 a1 = *(const u32x4*)pr, a2 = *(const u32x4*)(pr + 32); float y1[8], y2[8];
#pragma unroll
          for (int e = 0; e < 4; ++e) { const f32x4 cs = rq[e]; const float x1a = bflo(a1[e]), x1b = bfhi(a1[e]), x2a = bflo(a2[e]), x2b = bfhi(a2[e]);
              y1[2 * e] = (x1a * cs[0] - x2a * cs[1]) * 0.125f; y2[2 * e] = (x2a * cs[0] + x1a * cs[1]) * 0.125f; y1[2 * e + 1] = (x1b * cs[2] - x2b * cs[3]) * 0.125f; y2[2 * e + 1] = (x2b * cs[2] + x1b * cs[3]) * 0.125f; }
          const u32x4 w1 = (u32x4){pk2(y1[0], y1[1]), pk2(y1[2], y1[3]), pk2(y1[4], y1[5]), pk2(y1[6], y1[7])}, w2 = (u32x4){pk2(y2[0], y2[1]), pk2(y2[2], y2[3]), pk2(y2[4], y2[5]), pk2(y2[6], y2[7])};
          qf0 = __builtin_bit_cast(bf16x8, w1); qf1 = __builtin_bit_cast(bf16x8, w2); }
        f32x4 sc[10]; const float sink = P.in[I_SINK][l * 6 + hq]; float mx = sink;
        int qiv = qi; asm volatile("" : "+v"(qiv));
#pragma unroll
        for (int kt = 0; kt < 10; ++kt) { const int kb = 16 * (wave + kt); f32x4 a = (f32x4){0.f, 0.f, 0.f, 0.f};
            if (kb < 256) { const LAS bf16_t* kp = Ks + (kb + r) * LD + 8 * g; a = mfma16(*(const LAS bf16x8*)kp, qf0, a); a = mfma16(*(const LAS bf16x8*)(kp + 32), qf1, a); }
#pragma unroll
            for (int j = 0; j < 4; ++j) { const int kj = kb + 4 * g + j; const bool valid = (kj > qiv) && (kj <= qiv + 128) && (kj < 256) && ((n != 0) || (kj >= 128)); a[j] = valid ? a[j] : -__builtin_inff(); mx = fmaxf(mx, a[j]); }
            sc[kt] = a; }
        mx = fmaxf(mx, __shfl_xor(mx, 16)); mx = fmaxf(mx, __shfl_xor(mx, 32));
        float sum = 0.f;
#pragma unroll
        for (int kt = 0; kt < 10; ++kt) {
#pragma unroll
            for (int j = 0; j < 4; ++j) { const float e = __expf(sc[kt][j] - mx); sc[kt][j] = e; sum += e; } }
        sum += __shfl_xor(sum, 16); sum += __shfl_xor(sum, 32); sum += __expf(sink - mx);
        const float inv = 1.0f / sum;
        f32x4 o[4];
#pragma unroll
        for (int dt = 0; dt < 4; ++dt) o[dt] = (f32x4){0.f, 0.f, 0.f, 0.f};
#pragma unroll
        for (int s = 0; s < 5; ++s) { const int kb = 16 * (wave + 2 * s);
            if (kb < 256) { const u32x4 pw = (u32x4){pk2(sc[2 * s][0], sc[2 * s][1]), pk2(sc[2 * s][2], sc[2 * s][3]), pk2(sc[2 * s + 1][0], sc[2 * s + 1][1]), pk2(sc[2 * s + 1][2], sc[2 * s + 1][3])};
                const bf16x8 pf = __builtin_bit_cast(bf16x8, pw); const bool two = (kb + 16 < 256);
#pragma unroll
                for (int dt = 0; dt < 4; ++dt) { const LAS bf16_t* vp = VT + (16 * dt + r) * SWA_VLD + kb + 4 * g; const u32x2 lo = *(const LAS u32x2*)vp; u32x2 hi = (u32x2){0u, 0u}; if (two) hi = *(const LAS u32x2*)(vp + 16);
                    const u32x4 af = (u32x4){lo[0], lo[1], hi[0], hi[1]}; o[dt] = mfma16(__builtin_bit_cast(bf16x8, af), pf, o[dt]); } } }
        bf16_t* yr = (bf16_t*)(C.ws + WS_YMIX) + (size_t)(b * SEQ + t) * DM + RWD + hq * 64 + 4 * g;
#pragma unroll
        for (int dt = 0; dt < 4; ++dt) *(u32x2*)(yr + 16 * dt) = (u32x2){pk2(o[dt][0] * inv, o[dt][1] * inv), pk2(o[dt][2] * inv, o[dt][3] * inv)};
    }
    LDS_BARRIER();
}
__device__ __forceinline__ f32x4 mm64(const LAS bf16_t* X, const LAS bf16_t* Y, int ti, int tj, f32x4 acc, int lane) {
    const int r = lane & 15, g = lane >> 4;
    const LAS bf16_t* xp = X + (16 * ti + r) * LD + 8 * g; const LAS bf16_t* yp = Y + (16 * tj + r) * LD + 8 * g;
    acc = mfma16(*(const LAS bf16x8*)xp, *(const LAS bf16x8*)yp, acc);
    acc = mfma16(*(const LAS bf16x8*)(xp + 32), *(const LAS bf16x8*)(yp + 32), acc);
    return acc;
}
__device__ __forceinline__ void storeT(LAS bf16_t* D, int ti, int tj, f32x4 v, int lane) {
    const int r = lane & 15, g = lane >> 4;
    *(LAS u32x2*)(D + (16 * tj + r) * LD + 16 * ti + 4 * g) = (u32x2){pk2(v[0], v[1]), pk2(v[2], v[3])};
}
template <int MODE> __device__ __forceinline__ f32x4 maskT(f32x4 v, int ti, int tj, int lane) {
    const int rho = 16 * tj + (lane & 15), kap = 16 * ti + 4 * (lane >> 4);
#pragma unroll
    for (int j = 0; j < 4; ++j) { const bool keep = (MODE == 0) ? (kap + j < rho) : (MODE == 1) ? (kap + j <= rho) : (kap + j > rho); v[j] = keep ? v[j] : 0.f; }
    return v;
}
__device__ __forceinline__ float wave_max(float v) {
#pragma unroll
    for (int o = 1; o < 64; o <<= 1) v = fmaxf(v, __shfl_xor(v, o));
    return v;
}

__device__ __forceinline__ void rwb_unit(const Params& P, const Ctx& C, int l, int u, bool reuse) {
    const int tid = C.tid, wave = C.wave, lane = C.lane, r = lane & 15, g = lane >> 4;
    const int h = u % 6, bcx = u / 6, b = bcx >> 7, c = bcx & 127; const int tok0 = b * SEQ + c * 64; const int ch = (b * 6 + h) * 128 + c;
    LAS unsigned char* L = C.lds;
#define RB(i) ((LAS bf16_t*)(L + (i) * BUFB))
    LAS bf16_t* X1 = RB(0); LAS bf16_t* X1T = RB(1); LAS bf16_t* Aak = RB(2); LAS bf16_t* Arb = RB(3); LAS bf16_t* Ark = RB(4); LAS bf16_t* Pb = RB(5);
    LAS bf16_t* At = RB(6); LAS bf16_t* AtT = RB(7); LAS bf16_t* Bt = RB(8); LAS bf16_t* BtT = RB(9); LAS bf16_t* Kt = RB(10); LAS bf16_t* KtT = RB(11); LAS bf16_t* Rt = RB(12); LAS bf16_t* VT = RB(13);
    LAS float* XW = (LAS float*)L; LAS float* XA = XW + 64 * 65; LAS float* XG = XA + 64 * 65;
    LAS bf16_t* LI = (LAS bf16_t*)(L + 6 * BUFB);
    LAS float* segtot = (LAS float*)(L + 14 * BUFB); LAS float* gamL = segtot + 512;
    const bf16_t* p = (const bf16_t*)(C.ws + WS_P); const float* mu = P.in[I_MU] + l * RW_COLS;
    float cr9[9], ck9[9], cv9[9];
    { const int jc0 = 64 * h + lane;
#pragma unroll
      for (int i = 0; i < 9; ++i) { const int row = 8 * wave - 1 + i; const bool ok = (c * 64 + row >= 0); const bf16_t* q = p + (size_t)(tok0 + (ok ? row : 0)) * NPROJ;
          const float a_ = bf2f(q[jc0]), b_ = bf2f(q[RWD + jc0]), c_ = bf2f(q[2 * RWD + jc0]); cr9[i] = ok ? a_ : 0.f; ck9[i] = ok ? b_ : 0.f; cv9[i] = ok ? c_ : 0.f; } }
    bf16_t* liscr = (bf16_t*)(C.ws + WS_LISCR) + (size_t)C.blk * (64 * 264);
    if (!reuse) { u32x4 cu[4], pv[4]; f32x4 m0[4], m1[4];
#pragma unroll
      for (int i = 0; i < 4; ++i) { const int q = tid + 512 * i, t = q >> 5, c8 = q & 31; const bf16_t* src = p + (size_t)(tok0 + t) * NPROJ + 1152 + 8 * c8; const bool ok = (c * 64 + t > 0);
          cu[i] = *(const u32x4*)src; pv[i] = *(const u32x4*)(ok ? src - NPROJ : src); if (!ok) pv[i] = (u32x4){0u, 0u, 0u, 0u};
          m0[i] = *(const f32x4*)(mu + 1152 + 8 * c8); m1[i] = *(const f32x4*)(mu + 1152 + 8 * c8 + 4); }
#pragma unroll
      for (int i = 0; i < 4; ++i) { const int q = tid + 512 * i, t = q >> 5, c8 = q & 31; float x[8];
#pragma unroll
          for (int e = 0; e < 4; ++e) { const float c0 = bflo(cu[i][e]), c1 = bfhi(cu[i][e]), p0 = bflo(pv[i][e]), p1 = bfhi(pv[i][e]);
              const float mm0 = (e < 2) ? m0[i][2 * e] : m1[i][2 * e - 4], mm1 = (e < 2) ? m0[i][2 * e + 1] : m1[i][2 * e - 3];
              x[2 * e] = c0 + (p0 - c0) * mm0; x[2 * e + 1] = c1 + (p1 - c1) * mm1; }
          if (c8 < 8) {
#pragma unroll
              for (int e = 0; e < 8; ++e) x[e] = 1.0f - 2.0f * __builtin_amdgcn_rcpf(__expf(2.0f * x[e]) + 1.0f); }
          else if (c8 >= 16) {
#pragma unroll
              for (int e = 0; e < 8; ++e) x[e] = sigmoidf_(x[e]); }
          const u32x4 w = (u32x4){pk2(x[0], x[1]), pk2(x[2], x[3]), pk2(x[4], x[5]), pk2(x[6], x[7])};
          *(LAS u32x4*)(LI + t * 264 + 8 * c8) = w; *(u32x4*)(liscr + t * 264 + 8 * c8) = w; } }
    else {
#pragma unroll
      for (int i = 0; i < 4; ++i) { const int q = tid + 512 * i, t = q >> 5, c8 = q & 31; *(LAS u32x4*)(LI + t * 264 + 8 * c8) = *(const u32x4*)(liscr + t * 264 + 8 * c8); } }
    LDS_BARRIER();
    { bf16x8 bw[1][2], ba[1][2], bg[1][4];
      const int tj = wave & 3;
      const bf16_t* Ww = (const bf16_t*)(C.ws + WS_WUPT) + ((size_t)l * RWD + 64 * h + 16 * tj + r) * 64 + 8 * g;
      const bf16_t* Wa = (const bf16_t*)(C.ws + WS_AUPT) + ((size_t)l * RWD + 64 * h + 16 * tj + r) * 64 + 8 * g;
      const bf16_t* Wg = (const bf16_t*)(C.ws + WS_GUPT) + ((size_t)l * RWD + 64 * h + 16 * tj + r) * 128 + 8 * g;
#pragma unroll
      for (int ks = 0; ks < 2; ++ks) { bw[0][ks] = *(const bf16x8*)(Ww + 32 * ks); ba[0][ks] = *(const bf16x8*)(Wa + 32 * ks); }
#pragma unroll
      for (int ks = 0; ks < 4; ++ks) bg[0][ks] = *(const bf16x8*)(Wg + 32 * ks);
#pragma unroll
      for (int n = 0; n < 6; ++n) { const int o = n >> 1, ti = ((wave >> 2) + 2 * n) & 3; const int xoff = (o == 0) ? 0 : (o == 1) ? 64 : 128;
          const LAS bf16_t* xp = LI + (16 * ti + r) * 264 + xoff + 8 * g; f32x4 acc = (f32x4){0.f, 0.f, 0.f, 0.f};
          if (o == 0) { acc = mfma16(*(const LAS bf16x8*)xp, bw[0][0], acc); acc = mfma16(*(const LAS bf16x8*)(xp + 32), bw[0][1], acc); }
          else if (o == 1) { acc = mfma16(*(const LAS bf16x8*)xp, ba[0][0], acc); acc = mfma16(*(const LAS bf16x8*)(xp + 32), ba[0][1], acc); }
          else {
#pragma unroll
              for (int ks = 0; ks < 4; ++ks) acc = mfma16(*(const LAS bf16x8*)(xp + 32 * ks), bg[0][ks], acc); }
          LAS float* XO = (o == 0) ? XW : (o == 1) ? XA : XG;
#pragma unroll
          for (int j = 0; j < 4; ++j) XO[(16 * ti + 4 * g + j) * 65 + 16 * tj + r] = acc[j]; } }
    LDS_BARRIER();
    {
        const int jc = 64 * h + lane, tg = wave;
        const float w0 = P.in[I_W0][l * RWD + jc], a0 = P.in[I_A0][l * RWD + jc], kkc = P.in[I_KK][l * RWD + jc], kac = P.in[I_KA][l * RWD + jc], rkc = P.in[I_RK][l * RWD + jc];
        const float mur = mu[jc], muk = mu[RWD + jc], muv = mu[2 * RWD + jc];
        float pr = cr9[0], pk = ck9[0], pv = cv9[0];
        float ld[8], av[8], kn[8], km[8], rs[8], vs[8];
        bf16_t* aux = (bf16_t*)(C.ws + WS_RWAUX) + (size_t)(tok0 + 8 * tg) * 768;
#pragma unroll
        for (int i = 0; i < 8; ++i) { const int t = 8 * tg + i; const float cr = cr9[i + 1], ck = ck9[i + 1], cv = cv9[i + 1];
            rs[i] = cr + (pr - cr) * mur; const float ks = ck + (pk - ck) * muk; vs[i] = cv + (pv - cv) * muv; pr = cr; pk = ck; pv = cv;
            const float z = -(w0 + XW[t * 65 + lane]); const float sp = (z > 20.f) ? z : __logf(1.0f + __expf(z)); ld[i] = -__expf(-sp - 0.5f);
            const float a = sigmoidf_(a0 + XA[t * 65 + lane]); av[i] = a;
            const float kkv = ks * kkc; kn[i] = kkv * rsqrtf(fmaxf(wave_sum(kkv * kkv), 1e-24f));
            km[i] = ks * (1.0f + (a - 1.0f) * kac);
            const float dot = wave_sum(rs[i] * km[i] * rkc);
            aux[(size_t)i * 768 + jc] = (bf16_t)f2bf(dot * vs[i]); aux[(size_t)i * 768 + RWD + jc] = (bf16_t)f2bf(XG[t * 65 + lane]); }
        float cs[8]; cs[0] = ld[0];
#pragma unroll
        for (int i = 1; i < 8; ++i) cs[i] = cs[i - 1] + ld[i];
        segtot[tg * 64 + lane] = cs[7];
        LDS_BARRIER();
        float off = 0.f, tot = 0.f;
#pragma unroll
        for (int k = 0; k < 8; ++k) { const float sv = segtot[k * 64 + lane]; tot += sv; off += (k < tg) ? sv : 0.f; }
        if (wave == 0) gamL[lane] = __expf(tot);
        float oa[8], ob[8], ok[8], orr[8];
#pragma unroll
        for (int i = 0; i < 8; ++i) { const int t = 8 * tg + i; const float cum = off + cs[i]; const float gam = __expf(cum), gin = __expf(-cum), gpr = __expf(cum - ld[i]);
            oa[i] = -gpr * kn[i]; ob[i] = kn[i] * av[i] * gin; ok[i] = km[i] * gin; orr[i] = gam * rs[i];
            At[t * LD + lane] = (bf16_t)f2bf(oa[i]); Bt[t * LD + lane] = (bf16_t)f2bf(ob[i]); Kt[t * LD + lane] = (bf16_t)f2bf(ok[i]); Rt[t * LD + lane] = (bf16_t)f2bf(orr[i]); }
        *(LAS u32x4*)(AtT + lane * LD + 8 * tg) = (u32x4){pk2(oa[0], oa[1]), pk2(oa[2], oa[3]), pk2(oa[4], oa[5]), pk2(oa[6], oa[7])};
        *(LAS u32x4*)(BtT + lane * LD + 8 * tg) = (u32x4){pk2(ob[0], ob[1]), pk2(ob[2], ob[3]), pk2(ob[4], ob[5]), pk2(ob[6], ob[7])};
        *(LAS u32x4*)(KtT + lane * LD + 8 * tg) = (u32x4){pk2(ok[0], ok[1]), pk2(ok[2], ok[3]), pk2(ok[4], ok[5]), pk2(ok[6], ok[7])};
        *(LAS u32x4*)(VT + lane * LD + 8 * tg) = (u32x4){pk2(vs[0], vs[1]), pk2(vs[2], vs[3]), pk2(vs[4], vs[5]), pk2(vs[6], vs[7])};
    }
    LDS_BARRIER();
    const f32x4 Z4 = (f32x4){0.f, 0.f, 0.f, 0.f};
    const int wq = wave >> 2, tj = wave & 3;
    { f32x4 res[10];
#pragma unroll
      for (int n_ = 0; n_ < 10; ++n_) { const int o = n_ >> 1, ti = wq + 2 * (n_ & 1);
          if (o == 0) res[n_] = maskT<2>(mm64(At, Bt, ti, tj, Z4, lane), ti, tj, lane);
          else if (o == 1) res[n_] = maskT<0>(mm64(Bt, At, ti, tj, Z4, lane), ti, tj, lane);
          else if (o == 2) res[n_] = maskT<0>(mm64(Kt, At, ti, tj, Z4, lane), ti, tj, lane);
          else if (o == 3) res[n_] = maskT<1>(mm64(Bt, Rt, ti, tj, Z4, lane), ti, tj, lane);
          else res[n_] = maskT<1>(mm64(Kt, Rt, ti, tj, Z4, lane), ti, tj, lane); }
#pragma unroll
      for (int n_ = 0; n_ < 10; ++n_) { const int o = n_ >> 1, ti = wq + 2 * (n_ & 1);
          if (o == 0) storeT(X1T, ti, tj, res[n_], lane);
          else if (o == 1) { storeT(X1, ti, tj, res[n_], lane); f32x4 v = res[n_]; const int rho = 16 * tj + r, kap = 16 * ti + 4 * g;
#pragma unroll
              for (int j = 0; j < 4; ++j) v[j] += (kap + j == rho) ? 1.0f : 0.f;
              storeT(Pb, ti, tj, v, lane); }
          else if (o == 2) storeT(Aak, ti, tj, res[n_], lane);
          else if (o == 3) storeT(Arb, ti, tj, res[n_], lane);
          else storeT(Ark, ti, tj, res[n_], lane); } }
    LDS_BARRIER();
    f32x4 pacc[2];
#pragma unroll
    for (int q = 0; q < 2; ++q) { const int ti = wq + 2 * q; const u32x2 w = *(const LAS u32x2*)(Pb + (16 * tj + r) * LD + 16 * ti + 4 * g);
        pacc[q] = (f32x4){bflo(w[0]), bfhi(w[0]), bflo(w[1]), bfhi(w[1])}; }
#pragma unroll 1
    for (int rnd = 0; rnd < 6; ++rnd) {
        LAS bf16_t* Xn = (rnd & 1) ? RB(6) : RB(0); LAS bf16_t* XnT = (rnd & 1) ? RB(8) : RB(1);
        LAS bf16_t* Yn = (rnd & 1) ? RB(0) : RB(6); LAS bf16_t* YnT = (rnd & 1) ? RB(1) : RB(8);
        LAS bf16_t* Pold = (rnd & 1) ? RB(5) : RB(10); LAS bf16_t* Pnew = (rnd & 1) ? RB(10) : RB(5);
        f32x4 sq[4];
        if (rnd < 5) {
#pragma unroll
            for (int n_ = 0; n_ < 4; ++n_) { const int ti = wq + 2 * (n_ & 1); sq[n_] = (n_ < 2) ? mm64(Xn, XnT, ti, tj, Z4, lane) : mm64(XnT, Xn, ti, tj, Z4, lane); } }
        if (rnd > 0) {
#pragma unroll
            for (int q = 0; q < 2; ++q) pacc[q] = mm64(XnT, Pold, wq + 2 * q, tj, pacc[q], lane); }
        if (rnd < 5) {
#pragma unroll
            for (int n_ = 0; n_ < 4; ++n_) storeT((n_ < 2) ? YnT : Yn, wq + 2 * (n_ & 1), tj, sq[n_], lane); }
        if (rnd > 0) {
#pragma unroll
            for (int q = 0; q < 2; ++q) storeT(Pnew, wq + 2 * q, tj, pacc[q], lane); }
        LDS_BARRIER();
    }
    LAS bf16_t* Tm = RB(10);
    LAS bf16_t* AhT = RB(0); LAS bf16_t* W1T = RB(1); LAS bf16_t* UlT = RB(6);
    { f32x4 res[4];
#pragma unroll
      for (int n_ = 0; n_ < 4; ++n_) { const int ti = wq + 2 * (n_ & 1); res[n_] = (n_ < 2) ? mm64(Tm, AtT, ti, tj, Z4, lane) : mm64(Aak, VT, ti, tj, Z4, lane); }
#pragma unroll
      for (int n_ = 0; n_ < 4; ++n_) storeT((n_ < 2) ? AhT : W1T, wq + 2 * (n_ & 1), tj, res[n_], lane); }
    LDS_BARRIER();
    { f32x4 res[2];
#pragma unroll
      for (int n_ = 0; n_ < 2; ++n_) res[n_] = mm64(Tm, W1T, wq + 2 * n_, tj, Z4, lane);
#pragma unroll
      for (int n_ = 0; n_ < 2; ++n_) storeT(UlT, wq + 2 * n_, tj, res[n_], lane); }
    LDS_BARRIER();
    bf16_t* gM = (bf16_t*)(C.ws + WS_RWM) + (size_t)ch * 4096; bf16_t* gNT = (bf16_t*)(C.ws + WS_RWNT) + (size_t)ch * 4096; bf16_t* gQ = (bf16_t*)(C.ws + WS_RWQH) + (size_t)ch * 4096; bf16_t* gY = (bf16_t*)(C.ws + WS_RWYL) + (size_t)ch * 4096;
#pragma unroll
    for (int n_ = 0; n_ < 8; ++n_) { const int o = n_ >> 1, ti = wq + 2 * (n_ & 1); const int rho = 16 * tj + r, kap = 16 * ti + 4 * g;
        if (o == 0) {
            const u32x2 w = *(const LAS u32x2*)(Rt + rho * LD + kap); f32x4 v = (f32x4){bflo(w[0]), bfhi(w[0]), bflo(w[1]), bfhi(w[1])};
            v = mm64(AhT, Arb, ti, tj, v, lane); *(u32x2*)(gQ + rho * 64 + kap) = (u32x2){pk2(v[0], v[1]), pk2(v[2], v[3])}; }
        else if (o == 1) {
            f32x4 v = mm64(UlT, Arb, ti, tj, Z4, lane); v = mm64(VT, Ark, ti, tj, v, lane); *(u32x2*)(gY + rho * 64 + kap) = (u32x2){pk2(v[0], v[1]), pk2(v[2], v[3])}; }
        else if (o == 2) {
            f32x4 v = mm64(AhT, BtT, ti, tj, Z4, lane); const float gl = gamL[rho];
#pragma unroll
            for (int j = 0; j < 4; ++j) v[j] = gl * (v[j] + ((kap + j == rho) ? 1.0f : 0.f));
            *(u32x2*)(gM + rho * 64 + kap) = (u32x2){pk2(v[0], v[1]), pk2(v[2], v[3])}; }
        else {
            f32x4 v = mm64(BtT, UlT, ti, tj, Z4, lane); v = mm64(KtT, VT, ti, tj, v, lane);
#pragma unroll
            for (int j = 0; j < 4; ++j) v[j] *= gamL[kap + j];
            *(u32x2*)(gNT + rho * 64 + kap) = (u32x2){pk2(v[0], v[1]), pk2(v[2], v[3])}; } }
    LDS_BARRIER();
#undef RB
}

__device__ __forceinline__ void mlb_unit(const Params& P, const Ctx& C, int l, int u) {
    const int tid = C.tid, wave = C.wave, lane = C.lane, r = lane & 15, g = lane >> 4;
    const int hh = u & 3, bcx = u >> 2, b = bcx >> 7, c = bcx & 127; const int tok0 = b * SEQ + c * 64; const int ch = (b * 4 + hh) * 128 + c;
    LAS unsigned char* L = C.lds;
    LAS bf16_t* Qs = (LAS bf16_t*)L; LAS bf16_t* Ks = (LAS bf16_t*)(L + BUFB); LAS bf16_t* KhT = (LAS bf16_t*)(L + 2 * BUFB); LAS bf16_t* Sm = (LAS bf16_t*)(L + 3 * BUFB); LAS bf16_t* VTe = (LAS bf16_t*)(L + 4 * BUFB);
    LAS float* vbc = (LAS float*)(L + 4 * BUFB + 80 * LD * 2); LAS float* vig = vbc + 64; LAS float* vmd = vig + 64; LAS float* vws = vmd + 64;
    const bf16_t* p = (const bf16_t*)(C.ws + WS_P);
    unsigned xr[19], vr[8];
    { const int cq = tid & 127, tg = tid >> 7, isk = cq >> 6, d = cq & 63; const int col = 2048 + isk * 256 + hh * 64 + d; const int t0 = 16 * tg; const bool okp = (c * 64 + t0 > 0);
#pragma unroll
      for (int k = 0; k < 19; ++k) xr[k] = p[(size_t)(tok0 + ((k < 3 && !okp) ? 0 : t0 + k - 3)) * NPROJ + col];
      const int v = tid & 63, sg = tid >> 6;
#pragma unroll
      for (int k = 0; k < 8; ++k) vr[k] = p[(size_t)(tok0 + 8 * sg + k) * NPROJ + 2560 + hh * 64 + v]; }
    if (wave == 0) { const float* pg = (const float*)(C.ws + WS_PG) + (size_t)(tok0 + lane) * 8; const float ig = pg[hh], f = pg[4 + hh];
        const float lf = fminf(f, 0.f) - __logf(1.0f + __expf(-fabsf(f)));
        float bcv = lf;
#pragma unroll
        for (int o = 1; o < 64; o <<= 1) { const float t = __shfl_up(bcv, o); bcv += (lane >= o) ? t : 0.f; }
        float pm = ig - bcv;
#pragma unroll
        for (int o = 1; o < 64; o <<= 1) { const float t = __shfl_up(pm, o); pm = (lane >= o) ? fmaxf(pm, t) : pm; }
        const float md = bcv + pm; const float bcL = __shfl(bcv, 63); const float as = bcL - bcv + ig; const float mloc = wave_max(as); const float ws = __expf(as - mloc);
        vbc[lane] = bcv; vig[lane] = ig; vmd[lane] = md; vws[lane] = ws;
        float* vec = (float*)(C.ws + WS_MLVEC) + ((size_t)ch * 64 + lane) * 2; vec[0] = bcv; vec[1] = md;
        if (lane == 0) { float* sc = (float*)(C.ws + WS_MLSC) + (size_t)ch * 2; sc[0] = bcL; sc[1] = mloc; } }
    LDS_BARRIER();
    { const int cq = tid & 127, tg = tid >> 7, isk = cq >> 6, d = cq & 63; const int col = 2048 + isk * 256 + hh * 64 + d; const int cw = isk * 256 + hh * 64 + d;
      const float* cwp = P.in[I_CONVW] + (size_t)l * 4 * 512; const float w0 = cwp[cw], w1 = cwp[512 + cw], w2 = cwp[1024 + cw], w3 = cwp[1536 + cw], cb = P.in[I_CONVB][l * 512 + cw];
      float xm3 = 0.f, xm2 = 0.f, xm1 = 0.f; const int t0 = 16 * tg;
      if (c * 64 + t0 > 0) { xm3 = bf2f((unsigned short)xr[0]); xm2 = bf2f((unsigned short)xr[1]); xm1 = bf2f((unsigned short)xr[2]); }
      float o16[16];
#pragma unroll
      for (int k = 0; k < 16; ++k) { const float x0 = bf2f((unsigned short)xr[k + 3]); const float y = w0 * xm3 + w1 * xm2 + w2 * xm1 + w3 * x0 + cb; const float s = y * sigmoidf_(y);
          o16[k] = isk ? s * 0.125f : s; xm3 = xm2; xm2 = xm1; xm1 = x0; }
      if (!isk) { bf16_t* gq = (bf16_t*)(C.ws + WS_MLQ) + (size_t)ch * 4096;
#pragma unroll
          for (int k = 0; k < 16; ++k) { const bf16_t v = (bf16_t)f2bf(o16[k]); Qs[(t0 + k) * LD + d] = v; gq[(t0 + k) * 64 + d] = v; } }
      else {
#pragma unroll
          for (int k = 0; k < 16; ++k) { Ks[(t0 + k) * LD + d] = (bf16_t)f2bf(o16[k]); o16[k] *= vws[t0 + k]; }
          *(LAS u32x4*)(KhT + d * LD + t0) = (u32x4){pk2(o16[0], o16[1]), pk2(o16[2], o16[3]), pk2(o16[4], o16[5]), pk2(o16[6], o16[7])};
          *(LAS u32x4*)(KhT + d * LD + t0 + 8) = (u32x4){pk2(o16[8], o16[9]), pk2(o16[10], o16[11]), pk2(o16[12], o16[13]), pk2(o16[14], o16[15])}; }
      { const int v = tid & 63, sg = tid >> 6; float vv[8];
#pragma unroll
        for (int k = 0; k < 8; ++k) vv[k] = bf2f((unsigned short)vr[k]);
        *(LAS u32x4*)(VTe + v * LD + 8 * sg) = (u32x4){pk2(vv[0], vv[1]), pk2(vv[2], vv[3]), pk2(vv[4], vv[5]), pk2(vv[6], vv[7])}; }
      if (tid < 128) { const int row = 64 + (tid >> 3), pc = tid & 7; const unsigned one2 = 0x3f803f80u; const unsigned val = (row == 64) ? one2 : 0u; *(LAS u32x4*)(VTe + row * LD + 8 * pc) = (u32x4){val, val, val, val}; }
    }
    LDS_BARRIER();
    const f32x4 Z4 = (f32x4){0.f, 0.f, 0.f, 0.f};
    bf16_t* gKL = (bf16_t*)(C.ws + WS_MLKL) + (size_t)ch * 5120; bf16_t* gNL = (bf16_t*)(C.ws + WS_MLNL) + (size_t)ch * 5120;
    for (int task = wave; task < 36; task += 8) {
        if (task < 16) { const int ti = task >> 2, tj = task & 3; f32x4 v = mm64(Ks, Qs, ti, tj, Z4, lane);
            const int rho = 16 * tj + r, kap = 16 * ti + 4 * g; const float bl = vbc[rho] - vmd[rho];
#pragma unroll
            for (int j = 0; j < 4; ++j) { const int s = kap + j; v[j] = (s <= rho) ? v[j] * __expf(bl - vbc[s] + vig[s]) : 0.f; }
            storeT(Sm, ti, tj, v, lane); }
        else { const int t2 = task - 16, ti = t2 / 5, tj = t2 % 5;
            const f32x4 v = mm64(KhT, VTe, ti, tj, Z4, lane); *(u32x2*)(gKL + (16 * tj + r) * 64 + 16 * ti + 4 * g) = (u32x2){pk2(v[0], v[1]), pk2(v[2], v[3])}; } }
    LDS_BARRIER();
    for (int task = wave; task < 20; task += 8) { const int ti = task >> 2, tj = task & 3; const f32x4 v = mm64(VTe, Sm, ti, tj, Z4, lane); *(u32x2*)(gNL + (16 * tj + r) * 80 + 16 * ti + 4 * g) = (u32x2){pk2(v[0], v[1]), pk2(v[2], v[3])}; }
    LDS_BARRIER();
}

__device__ __forceinline__ void rwkv_chain(const Ctx& C, int bh, int vh) {
    const int tid = C.tid, wave = C.wave, lane = C.lane, r = lane & 15, g = lane >> 4; const size_t ch0 = (size_t)bh * 128;
    LAS unsigned char* L = C.lds; LAS unsigned char* Mb = L; LAS unsigned char* Nb = L + 8 * BUFB; LAS unsigned char* Sb = Nb + 8 * (32 * LD * 2);
    static_assert(8 * BUFB + 8 * 32 * LD * 2 + 8 * 32 * 128 <= MISC_OFF, "chain LDS");
    const bf16_t* gM = (const bf16_t*)(C.ws + WS_RWM) + ch0 * 4096; const bf16_t* gN = (const bf16_t*)(C.ws + WS_RWNT) + ch0 * 4096 + (size_t)vh * 32 * 64; bf16_t* gS = (bf16_t*)(C.ws + WS_RWS) + ch0 * 4096;
    u32x4 pmA[8], pnA4[4];
#define CH_LOAD(pm, pn, nbx) do { const bf16_t* m_ = gM + (size_t)(nbx) * 8 * 4096; \
        _Pragma("unroll") for (int i = 0; i < 8; ++i) pm[i] = ((const u32x4*)m_)[tid + 512 * i]; \
        _Pragma("unroll") for (int i = 0; i < 4; ++i) { const int q = tid + 512 * i, chunk = q >> 8, within = q & 255; pn[i] = ((const u32x4*)(gN + ((size_t)(nbx) * 8 + chunk) * 4096))[within]; } } while (0)
#define CH_PUT(pm, pn) do { \
        _Pragma("unroll") for (int i = 0; i < 8; ++i) { const int q = tid + 512 * i, chunk = q >> 9, within = q & 511, row = within >> 3, pc = within & 7; *(LAS u32x4*)(Mb + chunk * BUFB + row * (LD * 2) + pc * 16) = pm[i]; } \
        _Pragma("unroll") for (int i = 0; i < 4; ++i) { const int q = tid + 512 * i, chunk = q >> 8, within = q & 255, row = within >> 3, pc = within & 7; *(LAS u32x4*)(Nb + chunk * (32 * LD * 2) + row * (LD * 2) + pc * 16) = pn[i]; } } while (0)
    CH_LOAD(pmA, pnA4, 0);
    f32x4 acc[4];
#pragma unroll
    for (int t = 0; t < 4; ++t) acc[t] = (f32x4){0.f, 0.f, 0.f, 0.f};
#define CH_FRAGS(cc_, mf_, nf_) do { const LAS unsigned char* mc = Mb + (cc_) * BUFB; const LAS unsigned char* nc = Nb + (cc_) * (32 * LD * 2); \
        _Pragma("unroll") for (int t = 0; t < 4; ++t) { nf_[t] = *(const LAS u32x2*)(nc + (16 * wave + r) * (LD * 2) + (16 * t + 4 * g) * 2); \
            const LAS unsigned char* mp = mc + (16 * t + r) * (LD * 2) + (4 * g) * 2; const u32x2 lo = *(const LAS u32x2*)mp, hi = *(const LAS u32x2*)(mp + 32); mf_[t] = (u32x4){lo[0], lo[1], hi[0], hi[1]}; } } while (0)
#define CH_ONE(cc_, mf_, nf_) do { \
            u32x4 m2[4]; { const LAS unsigned char* mc = Mb + (cc_) * BUFB; \
            _Pragma("unroll") for (int t = 0; t < 4; ++t) { const LAS unsigned char* mp = mc + (16 * t + r) * (LD * 2) + (32 + 4 * g) * 2; const u32x2 lo = *(const LAS u32x2*)mp, hi = *(const LAS u32x2*)(mp + 32); m2[t] = (u32x4){lo[0], lo[1], hi[0], hi[1]}; } } \
            u32x2 pk[4]; \
            _Pragma("unroll") for (int t = 0; t < 4; ++t) pk[t] = (u32x2){pk2(acc[t][0], acc[t][1]), pk2(acc[t][2], acc[t][3])}; \
            LAS unsigned char* sg = Sb + (cc_) * 4096 + (16 * wave + r) * 128 + (4 * g) * 2; \
            _Pragma("unroll") for (int t = 0; t < 4; ++t) *(LAS u32x2*)(sg + 32 * t) = pk[t]; \
            bf16x8 zb[2]; \
            _Pragma("unroll") for (int s = 0; s < 2; ++s) { const u32x4 z = (u32x4){pk[2 * s][0], pk[2 * s][1], pk[2 * s + 1][0], pk[2 * s + 1][1]}; zb[s] = __builtin_bit_cast(bf16x8, z); } \
            _Pragma("unroll") for (int t = 0; t < 4; ++t) { const u32x2 nw = nf_[t]; const f32x4 a0 = (f32x4){bflo(nw[0]), bfhi(nw[0]), bflo(nw[1]), bfhi(nw[1])}; \
                acc[t] = mfma16(__builtin_bit_cast(bf16x8, mf_[t]), zb[0], a0); } \
            _Pragma("unroll") for (int t = 0; t < 4; ++t) acc[t] = mfma16(__builtin_bit_cast(bf16x8, m2[t]), zb[1], acc[t]); } while (0)
#define CH_STEP(nbx) do { if (wave < 2) { u32x4 mf0[4], mf1[4]; u32x2 nf0[4], nf1[4]; CH_FRAGS(0, mf0, nf0); \
        _Pragma("unroll 1") for (int cc = 0; cc < 8; cc += 2) { \
            CH_FRAGS(cc + 1, mf1, nf1); CH_ONE(cc, mf0, nf0); \
            if (cc + 2 < 8) CH_FRAGS(cc + 2, mf0, nf0); CH_ONE(cc + 1, mf1, nf1); } } } while (0)
#define CH_SOUT(nbx) do { _Pragma("unroll") for (int i = 0; i < 4; ++i) { const int q = tid + 512 * i, chunk = q >> 8, within = q & 255, row = within >> 3, pc = within & 7; \
        const u32x4 v = *(const LAS u32x4*)(Sb + chunk * 4096 + row * 128 + pc * 16); *(u32x4*)(gS + ((size_t)(nbx) * 8 + chunk) * 4096 + (32 * vh + row) * 64 + pc * 8) = v; } } while (0)
    for (int nb = 0; nb < 16; ++nb) {
        LDS_BARRIER(); if (nb > 0) CH_SOUT(nb - 1); CH_PUT(pmA, pnA4); LDS_BARRIER();
        if (nb + 1 < 16) CH_LOAD(pmA, pnA4, nb + 1);
        CH_STEP(nb);
    }
    LDS_BARRIER(); CH_SOUT(15);
#undef CH_SOUT
#undef CH_LOAD
#undef CH_PUT
#undef CH_STEP
#undef CH_FRAGS
#undef CH_ONE
}
__device__ __forceinline__ void mlstm_cscan(const Ctx& C, int bh, int part) {
    const int tid = C.tid; const size_t ch0 = (size_t)bh * 128; const int e0 = 10 * (part * 128 + (tid & 127));
    const bf16_t* KL = (const bf16_t*)(C.ws + WS_MLKL) + ch0 * 5120 + e0; bf16_t* CT = (bf16_t*)(C.ws + WS_MLCT) + ch0 * 5120 + e0; float* MM = (float*)(C.ws + WS_MLM) + ch0; const float* SC = (const float*)(C.ws + WS_MLSC) + ch0 * 2;
    float st[10]; unsigned ring[8][5]; float m = 0.f;
    LAS float* scl = (LAS float*)C.lds; if (tid < 256) scl[tid] = SC[tid];
    __syncthreads();
    if (tid >= 128) return;
#pragma unroll
    for (int i = 0; i < 10; ++i) st[i] = 0.f;
#pragma unroll
    for (int k = 0; k < 8; ++k)
#pragma unroll
        for (int i = 0; i < 5; ++i) ring[k][i] = *(const unsigned*)(KL + (size_t)k * 5120 + 2 * i);
    for (int c0 = 0; c0 < 128; c0 += 8) {
#pragma unroll
        for (int k = 0; k < 8; ++k) { const int c = c0 + k; unsigned cur[5];
#pragma unroll
            for (int i = 0; i < 5; ++i) cur[i] = ring[k][i];
            if (c + 8 < 128) {
#pragma unroll
                for (int i = 0; i < 5; ++i) ring[k][i] = *(const unsigned*)(KL + (size_t)(c + 8) * 5120 + 2 * i); }
            const float bcL = scl[2 * c], mloc = scl[2 * c + 1];
            unsigned* ct = (unsigned*)(CT + (size_t)c * 5120);
#pragma unroll
            for (int i = 0; i < 5; ++i) ct[i] = pk2(st[2 * i], st[2 * i + 1]);
            if (tid == 0 && part == 0) MM[c] = m;
            const float mn = fmaxf(bcL + m, mloc); const float dec = __expf(bcL + m - mn), sc = __expf(mloc - mn); m = mn;
#pragma unroll
            for (int i = 0; i < 5; ++i) { st[2 * i] = dec * st[2 * i] + sc * bflo(cur[i]); st[2 * i + 1] = dec * st[2 * i + 1] + sc * bfhi(cur[i]); } }
    }
}

__device__ __forceinline__ void passd_unit(const Params& P, const Ctx& C, int l, int u) {
    const int wave = C.wave, lane = C.lane, r = lane & 15, g = lane >> 4; const int b = u >> 7, c = u & 127; const int tok0 = b * SEQ + c * 64;
    bf16_t* ymix = (bf16_t*)(C.ws + WS_YMIX);
    {
        bf16x8 qf[3][2], sf[3][4][2]; u32x2 yl[3][4], bo[3][4], gg[3][4];
#pragma unroll
        for (int n_ = 0; n_ < 3; ++n_) { const int task = wave + 8 * n_, h = task >> 2, tb = task & 3; const size_t ch = (size_t)(b * 6 + h) * 128 + c; const int t = 16 * tb + r; const int tok = tok0 + t;
            const bf16_t* gS = (const bf16_t*)(C.ws + WS_RWS) + ch * 4096; const bf16_t* gQ = (const bf16_t*)(C.ws + WS_RWQH) + ch * 4096 + t * 64 + 8 * g; const bf16_t* gY = (const bf16_t*)(C.ws + WS_RWYL) + ch * 4096 + t * 64 + 4 * g;
            const bf16_t* aux = (const bf16_t*)(C.ws + WS_RWAUX) + (size_t)tok * 768 + 64 * h + 4 * g;
            qf[n_][0] = *(const bf16x8*)gQ; qf[n_][1] = *(const bf16x8*)(gQ + 32);
#pragma unroll
            for (int ti = 0; ti < 4; ++ti) { const bf16_t* sp = gS + (16 * ti + r) * 64 + 8 * g; sf[n_][ti][0] = *(const bf16x8*)sp; sf[n_][ti][1] = *(const bf16x8*)(sp + 32);
                yl[n_][ti] = *(const u32x2*)(gY + 16 * ti); bo[n_][ti] = *(const u32x2*)(aux + 16 * ti); gg[n_][ti] = *(const u32x2*)(aux + RWD + 16 * ti); } }
#pragma unroll
        for (int n_ = 0; n_ < 3; ++n_) { const int task = wave + 8 * n_, h = task >> 2, tb = task & 3; const int t = 16 * tb + r; const int tok = tok0 + t;
            f32x4 y[4]; float s = 0.f;
#pragma unroll
            for (int ti = 0; ti < 4; ++ti) { const u32x2 yw = yl[n_][ti]; f32x4 a = (f32x4){bflo(yw[0]), bfhi(yw[0]), bflo(yw[1]), bfhi(yw[1])};
                a = mfma16(sf[n_][ti][0], qf[n_][0], a); a = mfma16(sf[n_][ti][1], qf[n_][1], a); y[ti] = a; s += (a[0] + a[1]) + (a[2] + a[3]); }
            s += __shfl_xor(s, 16); s += __shfl_xor(s, 32); const float mean = s * (1.f / 64.f); float s2 = 0.f;
#pragma unroll
            for (int ti = 0; ti < 4; ++ti) { y[ti] = y[ti] - mean; s2 += (y[ti][0] * y[ti][0] + y[ti][1] * y[ti][1]) + (y[ti][2] * y[ti][2] + y[ti][3] * y[ti][3]); }
            s2 += __shfl_xor(s2, 16); s2 += __shfl_xor(s2, 32); const float rstd = rsqrtf(s2 * (1.f / 64.f) + 64e-5f);
            bf16_t* yo = ymix + (size_t)tok * DM + 64 * h + 4 * g;
            const float* lw = P.in[I_LNW] + l * RWD + 64 * h + 4 * g; const float* lb = P.in[I_LNB] + l * RWD + 64 * h + 4 * g;
#pragma unroll
            for (int ti = 0; ti < 4; ++ti) { const u32x2 bo_ = bo[n_][ti], gg_ = gg[n_][ti]; const f32x4 w4 = *(const f32x4*)(lw + 16 * ti), b4 = *(const f32x4*)(lb + 16 * ti);
                const float o0 = (y[ti][0] * rstd * w4[0] + b4[0] + bflo(bo_[0])) * bflo(gg_[0]), o1 = (y[ti][1] * rstd * w4[1] + b4[1] + bfhi(bo_[0])) * bfhi(gg_[0]);
                const float o2 = (y[ti][2] * rstd * w4[2] + b4[2] + bflo(bo_[1])) * bflo(gg_[1]), o3 = (y[ti][3] * rstd * w4[3] + b4[3] + bfhi(bo_[1])) * bfhi(gg_[1]);
                *(u32x2*)(yo + 16 * ti) = (u32x2){pk2(o0, o1), pk2(o2, o3)}; } }
    }
    {
        bf16x8 qf[2][2], cf[2][5][2]; u32x2 nl[2][5], og[2][4]; float bcl[2], mdl[2], mcv[2];
#pragma unroll
        for (int n_ = 0; n_ < 2; ++n_) { const int task = wave + 8 * (n_ + 3), hh = (task - 24) >> 2, tb = task & 3; const size_t ch = (size_t)(b * 4 + hh) * 128 + c; const int t = 16 * tb + r; const int tok = tok0 + t;
            const bf16_t* gC = (const bf16_t*)(C.ws + WS_MLCT) + ch * 5120; const bf16_t* gQ = (const bf16_t*)(C.ws + WS_MLQ) + ch * 4096 + t * 64 + 8 * g; const bf16_t* gNL = (const bf16_t*)(C.ws + WS_MLNL) + ch * 5120 + t * 80 + 4 * g;
            const bf16_t* ogp = (const bf16_t*)(C.ws + WS_P) + (size_t)tok * NPROJ + 2816 + 64 * hh + 4 * g;
            qf[n_][0] = *(const bf16x8*)gQ; qf[n_][1] = *(const bf16x8*)(gQ + 32);
            const float* vec = (const float*)(C.ws + WS_MLVEC) + (ch * 64 + t) * 2; bcl[n_] = vec[0]; mdl[n_] = vec[1]; mcv[n_] = ((const float*)(C.ws + WS_MLM))[ch];
#pragma unroll
            for (int ti = 0; ti < 5; ++ti) { const bf16_t* cp = gC + (16 * ti + r) * 64 + 8 * g; cf[n_][ti][0] = *(const bf16x8*)cp; cf[n_][ti][1] = *(const bf16x8*)(cp + 32); nl[n_][ti] = *(const u32x2*)(gNL + 16 * ti); }
#pragma unroll
            for (int ti = 0; ti < 4; ++ti) og[n_][ti] = *(const u32x2*)(ogp + 16 * ti); }
#pragma unroll
        for (int n_ = 0; n_ < 2; ++n_) { const int task = wave + 8 * (n_ + 3), hh = (task - 24) >> 2, tb = task & 3; const int t = 16 * tb + r; const int tok = tok0 + t;
            const float mint = bcl[n_] + mcv[n_], mt = fmaxf(mint, mdl[n_]); const float inter = __expf(mint - mt), fl = __expf(mdl[n_] - mt);
            f32x4 y[5];
#pragma unroll
            for (int ti = 0; ti < 5; ++ti) { f32x4 a = (f32x4){0.f, 0.f, 0.f, 0.f};
                a = mfma16(cf[n_][ti][0], qf[n_][0], a); a = mfma16(cf[n_][ti][1], qf[n_][1], a); const u32x2 nw = nl[n_][ti]; const f32x4 nlv = (f32x4){bflo(nw[0]), bfhi(nw[0]), bflo(nw[1]), bfhi(nw[1])}; y[ti] = fl * nlv + inter * a; }
            const float nq = __shfl(y[4][0], r);
            const float inv = 1.0f / fmaxf(fabsf(nq), __expf(-mt));
            float s = 0.f;
#pragma unroll
            for (int ti = 0; ti < 4; ++ti) { y[ti] = y[ti] * inv; s += (y[ti][0] + y[ti][1]) + (y[ti][2] + y[ti][3]); }
            s += __shfl_xor(s, 16); s += __shfl_xor(s, 32); const float mean = s * (1.f / 64.f); float s2 = 0.f;
#pragma unroll
            for (int ti = 0; ti < 4; ++ti) { y[ti] = y[ti] - mean; s2 += (y[ti][0] * y[ti][0] + y[ti][1] * y[ti][1]) + (y[ti][2] * y[ti][2] + y[ti][3] * y[ti][3]); }
            s2 += __shfl_xor(s2, 16); s2 += __shfl_xor(s2, 32); const float rstd = rsqrtf(s2 * (1.f / 64.f) + 1e-6f);
            bf16_t* yo = ymix + (size_t)tok * DM + 768 + 64 * hh + 4 * g; const float* nw = P.in[I_MLNW] + l * 256 + 64 * hh + 4 * g;
#pragma unroll
            for (int ti = 0; ti < 4; ++ti) { const u32x2 oo = og[n_][ti]; const f32x4 w4 = *(const f32x4*)(nw + 16 * ti);
                const float o0 = y[ti][0] * rstd * w4[0] * sigmoidf_(bflo(oo[0])), o1 = y[ti][1] * rstd * w4[1] * sigmoidf_(bfhi(oo[0])), o2 = y[ti][2] * rstd * w4[2] * sigmoidf_(bflo(oo[1])), o3 = y[ti][3] * rstd * w4[3] * sigmoidf_(bfhi(oo[1]));
                *(u32x2*)(yo + 16 * ti) = (u32x2){pk2(o0, o1), pk2(o2, o3)}; } }
    }
}

__device__ __forceinline__ void ln1_router_phase(const Params& P, const Ctx& C, int l, int cnt_off) {
    const int tid = C.tid, wave = C.wave, lane = C.lane, r = lane & 15, g = lane >> 4;
    constexpr int HS = 1032;
    LAS bf16_t* hhi = (LAS bf16_t*)C.lds;
    LAS bf16_t* hlo = hhi + 16 * HS;
    LAS float* part = (LAS float*)(hlo + 16 * HS);
    LAS int* lcnt = (LAS int*)(part + 8 * 8 * 32);
    bf16x8 bh[4][2], bl[4][2];
#pragma unroll
    for (int ks = 0; ks < 4; ++ks)
#pragma unroll
        for (int nt = 0; nt < 2; ++nt) { const size_t off = ((size_t)l * NEXP + 16 * nt + r) * DM + 32 * (4 * wave + ks) + 8 * g;
            bh[ks][nt] = *(const bf16x8*)((const bf16_t*)(C.ws + WS_WRH) + off); bl[ks][nt] = *(const bf16x8*)((const bf16_t*)(C.ws + WS_WRL) + off); }
    for (int i = tid; i < 16 * HS; i += 512) { hhi[i] = 0; hlo[i] = 0; }
    if (tid < 32) lcnt[tid] = 0;
    { int* pdest = (int*)(C.ws + WS_PDEST); int* ptok = (int*)(C.ws + WS_PTOK); for (int i = C.blk * 512 + tid; i < POS_MAX; i += C.G * 512) { pdest[i] = -1; ptok[i] = 0; } }
    __syncthreads();
    const int tpb = (MTOK + C.G - 1) / C.G, tok_lo = C.blk * tpb, tok_hi = (tok_lo + tpb < MTOK) ? tok_lo + tpb : MTOK;
    const bf16_t* t1 = (const bf16_t*)(C.ws + WS_T1); bf16_t* hb = (bf16_t*)(C.ws + WS_HB);
    int* toke = (int*)(C.ws + WS_TOKE); float* tokg = (float*)(C.ws + WS_TOKG); int* toklr = (int*)(C.ws + WS_TOKLR);
    const f32x4* lw4 = (const f32x4*)(P.in[I_LN1W] + (size_t)l * DM) + lane; const f32x4* lb4 = (const f32x4*)(P.in[I_LN1B] + (size_t)l * DM) + lane;
    u32x2 vn[4], rn[4];
    { const int tok = tok_lo + wave; const size_t ro = (size_t)((tok < tok_hi) ? tok : tok_lo) * DM; const u32x2* xr = (const u32x2*)(t1 + ro) + lane; const u32x2* rr = (const u32x2*)(hb + ro) + lane;
#pragma unroll
      for (int j = 0; j < 4; ++j) { vn[j] = xr[64 * j]; rn[j] = rr[64 * j]; } }
    const float rbias = P.in[I_RB][l * NEXP + (lane & 31)];
    for (int base = tok_lo; base < tok_hi; base += 8) {
        const int tok = base + wave;
        f32x4 v[4];
#pragma unroll
        for (int j = 0; j < 4; ++j) v[j] = (f32x4){bflo(vn[j][0]), bfhi(vn[j][0]), bflo(vn[j][1]), bfhi(vn[j][1])} + DN_ALPHA * (f32x4){bflo(rn[j][0]), bfhi(rn[j][0]), bflo(rn[j][1]), bfhi(rn[j][1])};
        { const int tn = base + 8 + wave; const size_t ro = (size_t)((tn < tok_hi) ? tn : tok_lo) * DM; const u32x2* xr = (const u32x2*)(t1 + ro) + lane; const u32x2* rr = (const u32x2*)(hb + ro) + lane;
#pragma unroll
          for (int j = 0; j < 4; ++j) { vn[j] = xr[64 * j]; rn[j] = rr[64 * j]; } }
        if (tok < tok_hi) {
            float s = 0.f;
#pragma unroll
            for (int j = 0; j < 4; ++j) s += (v[j][0] + v[j][1]) + (v[j][2] + v[j][3]);
            const float mean = wave_sum(s) * (1.f / DM); float s2 = 0.f;
#pragma unroll
            for (int j = 0; j < 4; ++j) { v[j] = v[j] - mean; s2 += (v[j][0] * v[j][0] + v[j][1] * v[j][1]) + (v[j][2] * v[j][2] + v[j][3] * v[j][3]); }
            const float rstd = rsqrtf(wave_sum(s2) * (1.f / DM) + LN_EPS);
            u32x2* ob = (u32x2*)(hb + (size_t)tok * DM) + lane;
#pragma unroll
            for (int j = 0; j < 4; ++j) { const f32x4 y = v[j] * rstd * lw4[64 * j] + lb4[64 * j]; const u32x2 hi = (u32x2){pk2(y[0], y[1]), pk2(y[2], y[3])}; ob[64 * j] = hi;
                const u32x2 lo = (u32x2){pk2(y[0] - bflo(hi[0]), y[1] - bfhi(hi[0])), pk2(y[2] - bflo(hi[1]), y[3] - bfhi(hi[1]))};
                *(LAS u32x2*)(hhi + wave * HS + 4 * (lane + 64 * j)) = hi; *(LAS u32x2*)(hlo + wave * HS + 4 * (lane + 64 * j)) = lo; }
        }
        __syncthreads();
        { f32x4 acc[2]; acc[0] = (f32x4){0.f, 0.f, 0.f, 0.f}; acc[1] = acc[0];
#pragma unroll
          for (int ks = 0; ks < 4; ++ks) { const int ko = r * HS + 32 * (4 * wave + ks) + 8 * g; const bf16x8 ah = *(const LAS bf16x8*)(hhi + ko), al = *(const LAS bf16x8*)(hlo + ko);
#pragma unroll
              for (int nt = 0; nt < 2; ++nt) { acc[nt] = mfma16(ah, bh[ks][nt], acc[nt]); acc[nt] = mfma16(ah, bl[ks][nt], acc[nt]); acc[nt] = mfma16(al, bh[ks][nt], acc[nt]); } }
          if (g < 2) {
#pragma unroll
              for (int nt = 0; nt < 2; ++nt)
#pragma unroll
                  for (int j = 0; j < 4; ++j) part[(wave * 8 + 4 * g + j) * 32 + 16 * nt + r] = acc[nt][j]; } }
        __syncthreads();
        if (tok < tok_hi) { const int ee = lane & 31; float lg = rbias;
#pragma unroll
            for (int w8 = 0; w8 < 8; ++w8) lg += part[(w8 * 8 + wave) * 32 + ee];
            float bv[4]; int bi[4];
#pragma unroll
            for (int rd = 0; rd < 4; ++rd) { float mv = lg; int mi = ee;
#pragma unroll
                for (int o = 1; o < 32; o <<= 1) { const float ov = __shfl_xor(mv, o); const int oi = __shfl_xor(mi, o); const bool take = (ov > mv) || (ov == mv && oi < mi); mv = take ? ov : mv; mi = take ? oi : mi; }
                bv[rd] = mv; bi[rd] = mi; lg = (ee == mi) ? -__builtin_inff() : lg; }
            if (lane == 0) { const float e1 = __expf(bv[1] - bv[0]), e2 = __expf(bv[2] - bv[0]), e3 = __expf(bv[3] - bv[0]); const float inv = 1.0f / (1.0f + e1 + e2 + e3);
                const int l0 = __hip_atomic_fetch_add(&lcnt[bi[0]], 1, __ATOMIC_RELAXED, __HIP_MEMORY_SCOPE_WORKGROUP), l1 = __hip_atomic_fetch_add(&lcnt[bi[1]], 1, __ATOMIC_RELAXED, __HIP_MEMORY_SCOPE_WORKGROUP), l2 = __hip_atomic_fetch_add(&lcnt[bi[2]], 1, __ATOMIC_RELAXED, __HIP_MEMORY_SCOPE_WORKGROUP), l3 = __hip_atomic_fetch_add(&lcnt[bi[3]], 1, __ATOMIC_RELAXED, __HIP_MEMORY_SCOPE_WORKGROUP);
                *(int4*)(toke + tok * 4) = make_int4(bi[0], bi[1], bi[2], bi[3]); *(f32x4*)(tokg + tok * 4) = (f32x4){inv, e1 * inv, e2 * inv, e3 * inv}; *(int4*)(toklr + tok * 4) = make_int4(l0, l1, l2, l3); } }
        __syncthreads();
    }
    if (tid < 32) { unsigned* gc = (unsigned*)(C.ws + WS_CTL) + CW_CNT + cnt_off + l * 32 + tid;
        const unsigned bb = __hip_atomic_fetch_add(gc, (unsigned)lcnt[tid], __ATOMIC_RELAXED, __HIP_MEMORY_SCOPE_AGENT);
        ((int*)(C.ws + WS_BBASE))[C.blk * 32 + tid] = (int)bb; }
    __syncthreads();
}
__device__ __forceinline__ void permute_phase(const Params& P, const Ctx& C, int l) {
    const int tid = C.tid, wave = C.wave, lane = C.lane;
    LAS int* pst = (LAS int*)C.lds;
    if (tid == 0) { const unsigned* gc = (const unsigned*)(C.ws + WS_CTL) + CW_CNT + l * 32; int ps = 0;
        for (int e = 0; e < 32; ++e) { pst[e] = ps; ps += ((int)__hip_atomic_load(gc + e, __ATOMIC_RELAXED, __HIP_MEMORY_SCOPE_AGENT) + 255) & ~255; } }
    __syncthreads();
    const int tpb = (MTOK + C.G - 1) / C.G, tok_lo = C.blk * tpb, tok_hi = (tok_lo + tpb < MTOK) ? tok_lo + tpb : MTOK;
    const int* toke = (const int*)(C.ws + WS_TOKE); const float* tokg = (const float*)(C.ws + WS_TOKG); const int* toklr = (const int*)(C.ws + WS_TOKLR); const int* bbase = (const int*)(C.ws + WS_BBASE) + C.blk * 32;
    const bf16_t* hb = (const bf16_t*)(C.ws + WS_HB); bf16_t* xp = (bf16_t*)(C.ws + WS_XPERM); int* pdest = (int*)(C.ws + WS_PDEST); float* pgate = (float*)(C.ws + WS_PGATE);
    int* ptok = (int*)(C.ws + WS_PTOK);
    for (int a = tid; a < 4 * (tok_hi - tok_lo); a += 512) { const int tok = tok_lo + (a >> 2), as = tok * 4 + (a & 3);
        const int e = toke[as]; const int pos = pst[e] + bbase[e] + toklr[as];
        pdest[pos] = as; pgate[pos] = tokg[as]; ptok[pos] = tok; }
    __syncthreads();
}
__device__ __forceinline__ void build_tile_e(const Ctx& C, int l) {
    LAS int* te = (LAS int*)(C.lds + TILEE_OFF);
    if (C.tid == 0) { const unsigned* gc = (const unsigned*)(C.ws + WS_CTL) + CW_CNT + l * 32; int t = 0;
        for (int e = 0; e < 32; ++e) { const int nt = ((int)__hip_atomic_load(gc + e, __ATOMIC_RELAXED, __HIP_MEMORY_SCOPE_AGENT) + 255) >> 8; for (int k = 0; k < nt && t < NT_MAX; ++k) te[t++] = e; }
        for (; t < NT_MAX; ++t) te[t] = 0; }
    __syncthreads();
}
__device__ __forceinline__ void combine_ln2_phase(const Params& P, const Ctx& C, int l) {
    const int lane = C.lane; const int gw = C.blk * 8 + C.wave, NGW = C.G * 8;
    const bool last = (l == NLAYER - 1);
    LAS float* wg = (LAS float*)C.lds;
    if (!last) load_wg(wg, P.in[I_WIN] + (size_t)(l + 1) * DM * CIN, C.tid);
    const bf16_t* yb = (const bf16_t*)(C.ws + WS_YB);
    float* hf = P.out; bf16_t* hb = (bf16_t*)(C.ws + WS_HB); float* pg = (float*)(C.ws + WS_PG);
    const f32x4* lw4 = (const f32x4*)(P.in[I_LN2W] + (size_t)l * DM) + lane; const f32x4* lb4 = (const f32x4*)(P.in[I_LN2B] + (size_t)l * DM) + lane;
    u32x2 nh[4], ny[4][4];
    { const int tok = (gw < MTOK) ? gw : 0; const u32x2* xr = (const u32x2*)(hb + (size_t)tok * DM) + lane;
#pragma unroll
      for (int j = 0; j < 4; ++j) nh[j] = xr[64 * j];
#pragma unroll
      for (int sl = 0; sl < 4; ++sl) { const u32x2* yr = (const u32x2*)(yb + (size_t)(tok * 4 + sl) * DM) + lane;
#pragma unroll
          for (int j = 0; j < 4; ++j) ny[sl][j] = yr[64 * j]; } }
    for (int tok = gw; tok < MTOK; tok += NGW) {
        f32x4 v[4]; float s = 0.f;
#pragma unroll
        for (int j = 0; j < 4; ++j) { v[j] = (f32x4){bflo(nh[j][0]), bfhi(nh[j][0]), bflo(nh[j][1]), bfhi(nh[j][1])} * DN_ALPHA;
#pragma unroll
            for (int sl = 0; sl < 4; ++sl) { const u32x2 w = ny[sl][j]; v[j][0] += bflo(w[0]); v[j][1] += bfhi(w[0]); v[j][2] += bflo(w[1]); v[j][3] += bfhi(w[1]); } }
        { const int tn = (tok + NGW < MTOK) ? tok + NGW : tok; const u32x2* xr = (const u32x2*)(hb + (size_t)tn * DM) + lane;
#pragma unroll
          for (int j = 0; j < 4; ++j) nh[j] = xr[64 * j];
#pragma unroll
          for (int sl = 0; sl < 4; ++sl) { const u32x2* yr = (const u32x2*)(yb + (size_t)(tn * 4 + sl) * DM) + lane;
#pragma unroll
              for (int j = 0; j < 4; ++j) ny[sl][j] = yr[64 * j]; } }
#pragma unroll
        for (int j = 0; j < 4; ++j) s += (v[j][0] + v[j][1]) + (v[j][2] + v[j][3]);
        const float mean = wave_sum(s) * (1.f / DM); float s2 = 0.f;
#pragma unroll
        for (int j = 0; j < 4; ++j) { v[j] = v[j] - mean; s2 += (v[j][0] * v[j][0] + v[j][1] * v[j][1]) + (v[j][2] * v[j][2] + v[j][3] * v[j][3]); }
        const float rstd = rsqrtf(wave_sum(s2) * (1.f / DM) + LN_EPS);
#pragma unroll
        for (int j = 0; j < 4; ++j) v[j] = v[j] * rstd * lw4[64 * j] + lb4[64 * j];
        if (last) { f32x4* of = (f32x4*)(hf + (size_t)tok * DM) + lane;
#pragma unroll
            for (int j = 0; j < 4; ++j) of[64 * j] = v[j]; }
        if (!last) { u32x2* ob = (u32x2*)(hb + (size_t)tok * DM) + lane;
#pragma unroll
            for (int j = 0; j < 4; ++j) ob[64 * j] = (u32x2){pk2(v[j][0], v[j][1]), pk2(v[j][2], v[j][3])};
            gate_cols(v, wg, P.in[I_BIN] + (size_t)(l + 1) * CIN + NPROJ, pg + (size_t)tok * 8, lane); }
    }
}

typedef const __attribute__((address_space(4))) Params* CParamsPtr;
__device__ __forceinline__ const Params* kparams() {
    const unsigned long long a = (unsigned long long)__builtin_amdgcn_kernarg_segment_ptr(); unsigned lo = (unsigned)a, hi = (unsigned)(a >> 32);
    asm volatile("" : "+v"(lo), "+v"(hi));
    lo = __builtin_amdgcn_readfirstlane(lo); hi = __builtin_amdgcn_readfirstlane(hi);
    return (const Params*)(CParamsPtr)(((unsigned long long)hi << 32) | lo);
}
__device__ __forceinline__ Ctx make_ctx(const Params& P, LAS unsigned char* lds, int wv0) {
    Ctx C; C.lds = lds; unsigned ones_ = ~0u; asm volatile("" : "+s"(ones_)); int t_ = wv0 * 64 + (int)__builtin_amdgcn_mbcnt_hi(ones_, __builtin_amdgcn_mbcnt_lo(ones_, 0u)), b_ = blockIdx.x, g_ = gridDim.x; asm volatile("" : "+v"(t_), "+v"(b_), "+v"(g_)); b_ = __builtin_amdgcn_readfirstlane(b_); g_ = __builtin_amdgcn_readfirstlane(g_);
    C.tid = t_; C.lane = C.tid & 63; C.wave = __builtin_amdgcn_readfirstlane(C.tid >> 6); C.blk = b_; C.G = g_; C.ws = P.ws; return C; }
__global__ void __launch_bounds__(512, 2) hybrid_fwd(Params Punused) {
    extern __shared__ __attribute__((aligned(16))) unsigned char lds_raw[];
    LAS unsigned char* const lds = (LAS unsigned char*)lds_raw;
    const int wv0 = __builtin_amdgcn_readfirstlane((int)threadIdx.x >> 6);
    volatile LAS unsigned* MISC = (volatile LAS unsigned*)(lds + MISC_OFF);
    for (int u = threadIdx.x; u < (LDS_BYTES - MISC_OFF) / 4; u += 512) MISC[u] = 0u;
    __syncthreads();
    const int lo = __builtin_amdgcn_readfirstlane(kparams()->ph_lo), hi = __builtin_amdgcn_readfirstlane(kparams()->ph_hi);
    #define IS_T0 (wv0 == 0 && __builtin_amdgcn_mbcnt_hi(~0u, __builtin_amdgcn_mbcnt_lo(~0u, 0u)) == 0u)
    if (hi - lo > 1) (void)xcd_barrier_post((unsigned*)(kparams()->ws + WS_CTL) + CW_BAR, MISC + 8, IS_T0);
#ifndef PHMASK
#define PHMASK 0x7ff
#endif
#define PH_EN(k) (((PHMASK) >> (k)) & 1)
#define RUN(gid) ((gid) >= lo && (gid) < hi)
#define SEAM(gid) do { if ((gid) + 1 < hi) { XcdBarrier bar_; bar_.bar = (unsigned*)(kparams()->ws + WS_CTL) + CW_BAR; bar_.x = xb_xcc_id(); bar_.st = (volatile LAS unsigned*)(lds + MISC_OFF) + 8; xcd_barrier(bar_, IS_T0); if (DUPBAR) xcd_barrier(bar_, IS_T0); } } while (0)
#ifndef DUPMASK
#define DUPMASK 0
#endif
#ifndef DUPBAR
#define DUPBAR 0
#endif
#define DUP(k) for (int rep_ = 0; rep_ < 1 + (((DUPMASK) >> (k)) & 1); ++rep_)
#define PHASE_BEGIN const Params& P = *kparams(); const Ctx C = make_ctx(P, lds, wv0);
    if (PH_EN(0) && RUN(0)) { DUP(0) { PHASE_BEGIN p0_prologue(P, C); } SEAM(0); }
#pragma unroll 1
    for (int l = 0; l < NLAYER; ++l) {
        const int g0 = 1 + l * NPH;
        if (g0 + NPH <= lo || g0 >= hi) continue;
        if (PH_EN(1) && RUN(g0 + 0)) {
            DUP(1) { PHASE_BEGIN
            pg8::Gemm g{(const bf16_t*)(C.ws + WS_HB), (const bf16_t*)(C.ws + WS_WIN) + (size_t)l * NPROJ * DM, MTOK, NPROJ, DM}; pg8::StaticOrder S; S.init(MTOK, NPROJ, C.G, C.blk);
            pg8::EpiBf16b E{(bf16_t*)(C.ws + WS_P), NPROJ, P.in[I_BIN] + (size_t)l * CIN};
            pg8::gemm_phase<pg8::EpiBf16b, pg8::StaticOrder>(C.lds, g, S, E, nullptr, C.tid); }
            SEAM(g0 + 0); }
        if (PH_EN(2) && RUN(g0 + 1)) {
            DUP(2) { PHASE_BEGIN
            constexpr int NU_SWA = 512, NU_RW = NB * 128 * 6, NU_ML = NB * 128 * 4;
#ifndef DUP2
#define DUP2 0
#endif
            for (int rp = 0; rp < 1 + ((DUP2 >> 1) & 1); ++rp) for (int cb = C.blk; cb < NB * 128; cb += C.G)
                for (int hh_ = 0; hh_ < 6; ++hh_) { rwb_unit(P, C, l, cb * 6 + hh_, hh_ != 0); if (hh_ == 0) { asm volatile("s_waitcnt vmcnt(0)" ::: "memory"); __syncthreads(); } }
            for (int rp = 0; rp < 1 + ((DUP2 >> 2) & 1); ++rp) for (int u = C.blk; u < NU_ML; u += C.G) mlb_unit(P, C, l, u); }
            SEAM(g0 + 1); }
        if (PH_EN(3) && RUN(g0 + 2)) {
            DUP(3) { PHASE_BEGIN
            {
#ifndef P3DUP
#define P3DUP 0
#endif
                if (C.blk < 48) { for (int rp = 0; rp < 1 + (P3DUP & 1); ++rp) { rwkv_chain(C, C.blk >> 1, C.blk & 1); __syncthreads(); } } else if (C.blk < 112) { for (int rp = 0; rp < 1 + ((P3DUP >> 1) & 1); ++rp) { mlstm_cscan(C, (C.blk - 48) >> 2, (C.blk - 48) & 3); __syncthreads(); } }
                LAS int* qslot = (LAS int*)(C.lds + MISC_OFF + 64); unsigned* qctr = (unsigned*)(C.ws + WS_CTL) + CW_SWAQ + l * 64;
                for (;;) { __syncthreads();
                    if (C.tid == 0) *qslot = (int)__hip_atomic_fetch_add(qctr, 1u, __ATOMIC_RELAXED, __HIP_MEMORY_SCOPE_AGENT);
                    __syncthreads();
                    const int u = *qslot; if (u >= 512) break;
                    swa_unit(P, C, l, u); } } }
            SEAM(g0 + 2); }
        if (PH_EN(4) && RUN(g0 + 3)) {
            DUP(4) { PHASE_BEGIN
            for (int u = C.blk; u < NB * 128; u += C.G) passd_unit(P, C, l, u); }
            SEAM(g0 + 3); }
        if (PH_EN(5) && RUN(g0 + 4)) {
            DUP(5) { PHASE_BEGIN
            pg8::Gemm g{(const bf16_t*)(C.ws + WS_YMIX), (const bf16_t*)(C.ws + WS_WOUT) + (size_t)l * DM * DM, MTOK, DM, DM}; pg8::StaticOrder S; S.init(MTOK, DM, C.G, C.blk);
            pg8::EpiPlainBf16 E{(bf16_t*)(C.ws + WS_T1), DM};
            pg8::gemm_phase<pg8::EpiPlainBf16, pg8::StaticOrder>(C.lds, g, S, E, nullptr, C.tid); }
            SEAM(g0 + 4); }
        if (PH_EN(6) && RUN(g0 + 5)) { DUP(6) { PHASE_BEGIN ln1_router_phase(P, C, l, (rep_ + 1 < 1 + (((DUPMASK) >> 6) & 1)) ? 512 : 0); } SEAM(g0 + 5); }
        if (PH_EN(7) && RUN(g0 + 6)) { DUP(7) { PHASE_BEGIN permute_phase(P, C, l); } SEAM(g0 + 6); }
        if (PH_EN(8) && RUN(g0 + 7)) {
            DUP(8) { PHASE_BEGIN
            build_tile_e(C, l);
            pg8::Gemm g{(const bf16_t*)(C.ws + WS_HB), (const bf16_t*)(C.ws + WS_WUP) + (size_t)l * NEXP * NUP * DM, POS_MAX, NUP, DM};
            pg8::MoeOrder<8> S{(const LAS int*)(C.lds + TILEE_OFF), C.G, C.blk, (const int*)(C.ws + WS_PTOK)};
            pg8::EpiSwiglu E{(bf16_t*)(C.ws + WS_ACT), P.in[I_EBUP] + (size_t)l * NEXP * NUP};
            pg8::gemm_phase<pg8::EpiSwiglu, pg8::MoeOrder<8>, false, true>(C.lds, g, S, E, nullptr, C.tid); }
            SEAM(g0 + 7); }
        if (PH_EN(9) && RUN(g0 + 8)) {
            DUP(9) { PHASE_BEGIN
            build_tile_e(C, l);
            pg8::Gemm g{(const bf16_t*)(C.ws + WS_ACT), (const bf16_t*)(C.ws + WS_WDN) + (size_t)l * NEXP * DM * DEXP, POS_MAX, DM, DEXP};
            pg8::MoeOrder<4> S{(const LAS int*)(C.lds + TILEE_OFF), C.G, C.blk, nullptr};
            pg8::EpiDown E{(bf16_t*)(C.ws + WS_YB), P.in[I_EBDN] + (size_t)l * NEXP * DM, (const int*)(C.ws + WS_PDEST), (const float*)(C.ws + WS_PGATE)};
            pg8::gemm_phase<pg8::EpiDown, pg8::MoeOrder<4>>(C.lds, g, S, E, nullptr, C.tid); }
            SEAM(g0 + 8); }
        if (PH_EN(10) && RUN(g0 + 9)) { DUP(10) { PHASE_BEGIN combine_ln2_phase(P, C, l); } SEAM(g0 + 9); }
    }
#undef RUN
#undef SEAM
}

#ifndef MK_PER_PHASE
#define MK_PER_PHASE 0
#endif
extern "C" void kernel_launch(void* const* d_in, const int* in_sizes, int n_in, void* d_out, int out_size, void* d_ws, size_t ws_size, hipStream_t stream) {
    static int grid = 0;
    if (grid == 0) {
        if (n_in != 29 || out_size != MTOK * DM || ws_size < WS_END) { fprintf(stderr, "kernel_launch: unexpected shapes (n_in %d out %d ws %zu)\n", n_in, out_size, ws_size); grid = -1; return; }
        int dev = 0, cus = 0;
        if (hipGetDevice(&dev) != hipSuccess || hipDeviceGetAttribute(&cus, hipDeviceAttributeMultiprocessorCount, dev) != hipSuccess) { grid = -1; return; }
        if (hipFuncSetAttribute((const void*)hybrid_fwd, hipFuncAttributeMaxDynamicSharedMemorySize, LDS_BYTES) != hipSuccess) { fprintf(stderr, "kernel_launch: hipFuncSetAttribute failed\n"); grid = -1; return; }
        int per_cu = 0;
        if (hipOccupancyMaxActiveBlocksPerMultiprocessor(&per_cu, (const void*)hybrid_fwd, 512, LDS_BYTES) != hipSuccess || per_cu < 1) { fprintf(stderr, "kernel_launch: occupancy query says %d\n", per_cu); }
        (void)hipGetLastError();
        grid = cus;
    }
    if (grid < 0) return;
    (void)hipMemsetAsync((char*)d_ws + WS_CTL, 0, CTL_ZERO_BYTES, stream);
    Params p; memset(&p, 0, sizeof(p));
    for (int i = 0; i < 29; ++i) p.in[i] = (const float*)d_in[i];
    p.out = (float*)d_out; p.ws = (unsigned char*)d_ws;
#if MK_PER_PHASE
    for (int ph = 0; ph < NPHASE_TOTAL; ++ph) { p.ph_lo = ph; p.ph_hi = ph + 1; hipLaunchKernelGGL(hybrid_fwd, dim3(grid), dim3(512), LDS_BYTES, stream, p); }
#else
    p.ph_lo = 0; p.ph_hi = NPHASE_TOTAL;
    hipLaunchKernelGGL(hybrid_fwd, dim3(grid), dim3(512), LDS_BYTES, stream, p);
#endif
}
```

```cpp
#include <hip/hip_runtime.h>
#include <cstdio>
#include <cstdint>
#include <cstring>

#define GAS __attribute__((address_space(1)))
#define LAS __attribute__((address_space(3)))
typedef float f32x2 __attribute__((ext_vector_type(2)));
typedef unsigned u32x2 __attribute__((ext_vector_type(2)));

#ifndef PG8_SP2_DEFAULT
#define PG8_SP2_DEFAULT true
#endif
namespace pg8 {
constexpr int EPI_BTAB = 140288, EPI_DTAB = 138240, EPI_GTAB = 139264;
#define PG8_LAS __attribute__((address_space(3)))
typedef unsigned short bf16_t;
typedef short bf16x8 __attribute__((ext_vector_type(8)));
typedef float f32x4 __attribute__((ext_vector_type(4)));
typedef unsigned u32x4 __attribute__((ext_vector_type(4)));
constexpr int BM = 256, BK = 64, HALF = 128, HTB = HALF * BK * 2  , STAGE_BYTES = 8 * HTB, NXCD = 8, WGM = 8;

__host__ __device__ __forceinline__ int lds_byte(int r, int c) { const int st = (r >> 4) * 2 + (c >> 5), rr = r & 15, cc = c & 31, ob = rr * 64 + cc * 2; return st * 1024 + (ob ^ (((ob >> 9) & 1) << 5)); }
__host__ __device__ __forceinline__ void stage_rc(int b, int& R, int& C) { const int st = b / 1024, sb = b % 1024, swz = sb ^ (((sb >> 9) & 1) << 5); R = (st >> 1) * 16 + swz / 64; C = (st & 1) * 32 + (swz % 64) / 2; }
__host__ __device__ __forceinline__ int perm32(int rho) { const int n = rho >> 4, i = rho & 15; return 8 * (i >> 2) + 4 * n + (i & 3); }

struct Unit { int pm, pn; };
struct Gemm { const bf16_t* A; const bf16_t* Bt; int M, N, K; };

struct StaticOrder {
    int nM, nN, nwg, G, c;
    __host__ __device__ void init(int M, int N, int G_, int c_) { nM = M / BM; nN = N / BM; nwg = nM * nN; G = G_; c = c_; }
    __host__ __device__ bool next(int i, Unit& u) const {
        const long L = (long)i * G + c; if (L >= nwg) return false;
        int wgid = (int)L; { const int q = nwg / NXCD, r = nwg % NXCD, xcd = wgid % NXCD, off = wgid / NXCD; wgid = (xcd < r ? xcd * (q + 1) : r * (q + 1) + (xcd - r) * q) + off; }
        const int nig = WGM * nN, gid = wgid / nig, fm = gid * WGM, gsz = (nM - fm) < WGM ? (nM - fm) : WGM;
        u.pm = fm + ((wgid % nig) % gsz); u.pn = (wgid % nig) / gsz; return true;
    }
    __device__ __forceinline__ void a_ready(const Unit&) const {}
    __device__ __forceinline__ void done(const Unit&) const {}
};
template <int NN> struct MoeOrder {
    const PG8_LAS int* tile_e; int G, c; const int* rowtok;
    __device__ __forceinline__ bool next(int i, Unit& u) const {
        const int s = i * G + c; if (s >= 544 * NN) return false;
        constexpr int per = 8 * NN; const int a = s / per, r = s % per, b = r >> 3, x = r & 7;
        const int pm = 68 * x + a; u.pm = pm; u.pn = tile_e[pm] * NN + b; return true;
    }
    __device__ __forceinline__ void a_ready(const Unit&) const {}
    __device__ __forceinline__ void done(const Unit&) const {}
};

__device__ __forceinline__ unsigned cvt_pk_bf16(float lo, float hi) { unsigned r; asm volatile("v_cvt_pk_bf16_f32 %0, %1, %2" : "=v"(r) : "v"(lo), "v"(hi)); return r; }

struct EpiBf16b {
    static constexpr bool PERM = true, AFTER_DRAIN = false;
    bf16_t* O; int ldc; const float* bias;
    __device__ __forceinline__ void prefetch(PG8_LAS unsigned char* lds, const Unit& u, int wid, int lane) const {
        if (wid < 4) __builtin_amdgcn_global_load_lds((const unsigned*)(bias + u.pn * BM + 64 * wid + lane), (PG8_LAS unsigned*)(lds + EPI_BTAB + wid * 256), 4, 0, 0); }
    __device__ __forceinline__ void operator()(const f32x4 (&acc)[2][2][4][2], const Unit& u, int wr, int wc, int fr, int fq, PG8_LAS unsigned char* lds) const {
        const int row0 = u.pm * BM + wr * 64 + fr; const int col0 = u.pn * BM + wc * 32 + 8 * fq;
        const PG8_LAS float* bt = (const PG8_LAS float*)(lds + EPI_BTAB) + wc * 32 + 8 * fq;
        f32x4 bv[2][2];
#pragma unroll
        for (int bj = 0; bj < 2; ++bj)
#pragma unroll
            for (int n = 0; n < 2; ++n) bv[bj][n] = *(const PG8_LAS f32x4*)(bt + bj * HALF + 4 * n);
#pragma unroll
        for (int ai = 0; ai < 2; ++ai)
#pragma unroll
            for (int m = 0; m < 4; ++m) { bf16_t* rowp = O + (size_t)(row0 + ai * HALF + m * 16) * ldc + col0;
#pragma unroll
                for (int bj = 0; bj < 2; ++bj) { const f32x4 v0 = acc[ai][bj][m][0] + bv[bj][0], v1 = acc[ai][bj][m][1] + bv[bj][1];
                    u32x4 w; w.x = cvt_pk_bf16(v0[0], v0[1]); w.y = cvt_pk_bf16(v0[2], v0[3]); w.z = cvt_pk_bf16(v1[0], v1[1]); w.w = cvt_pk_bf16(v1[2], v1[3]);
                    *(u32x4*)(rowp + bj * HALF) = w; } }
    }
};
struct EpiPlainBf16 {
    static constexpr bool PERM = true, AFTER_DRAIN = false;
    bf16_t* O; int ldc;
    __device__ __forceinline__ void prefetch(PG8_LAS unsigned char*, const Unit&, int, int) const {}
    __device__ __forceinline__ void operator()(const f32x4 (&acc)[2][2][4][2], const Unit& u, int wr, int wc, int fr, int fq, PG8_LAS unsigned char*) const {
        const int row0 = u.pm * BM + wr * 64 + fr, col0 = u.pn * BM + wc * 32 + 8 * fq;
#pragma unroll
        for (int ai = 0; ai < 2; ++ai)
#pragma unroll
            for (int m = 0; m < 4; ++m) { bf16_t* rowp = O + (size_t)(row0 + ai * HALF + m * 16) * ldc + col0;
#pragma unroll
                for (int bj = 0; bj < 2; ++bj) { const f32x4 v0 = acc[ai][bj][m][0], v1 = acc[ai][bj][m][1];
                    u32x4 w; w.x = cvt_pk_bf16(v0[0], v0[1]); w.y = cvt_pk_bf16(v0[2], v0[3]); w.z = cvt_pk_bf16(v1[0], v1[1]); w.w = cvt_pk_bf16(v1[2], v1[3]);
                    *(u32x4*)(rowp + bj * HALF) = w; } }
    }
};
struct EpiSwiglu {
    static constexpr bool PERM = true, AFTER_DRAIN = false;
    bf16_t* O; const float* bias;
    __device__ __forceinline__ void prefetch(PG8_LAS unsigned char* lds, const Unit& u, int wid, int lane) const {
        if (wid < 4) __builtin_amdgcn_global_load_lds((const unsigned*)(bias + u.pn * BM + 64 * wid + lane), (PG8_LAS unsigned*)(lds + EPI_BTAB + wid * 256), 4, 0, 0); }
    __device__ __forceinline__ void operator()(const f32x4 (&acc)[2][2][4][2], const Unit& u, int wr, int wc, int fr, int fq, PG8_LAS unsigned char* lds) const {
        const int row0 = u.pm * BM + wr * 64 + fr;
        const int ocol0 = ((u.pn & 7) * BM + wc * 32 + 8 * fq) >> 1;
        const PG8_LAS float* bt = (const PG8_LAS float*)(lds + EPI_BTAB) + wc * 32 + 8 * fq;
        f32x4 bv[2][2];
#pragma unroll
        for (int bj = 0; bj < 2; ++bj)
#pragma unroll
            for (int n = 0; n < 2; ++n) bv[bj][n] = *(const PG8_LAS f32x4*)(bt + bj * HALF + 4 * n);
        const bool oddrow = (fq & 1) != 0;
#pragma unroll
        for (int ai = 0; ai < 2; ++ai)
#pragma unroll
            for (int m = 0; m < 4; ++m) { bf16_t* rowp = O + (size_t)(row0 + ai * HALF + m * 16) * 1024 + ocol0;
                u32x2 w[2];
#pragma unroll
                for (int bj = 0; bj < 2; ++bj) { const f32x4 v0 = acc[ai][bj][m][0] + bv[bj][0], v1 = acc[ai][bj][m][1] + bv[bj][1];
                    float o[4];
#pragma unroll
                    for (int q = 0; q < 4; ++q) { const float gl = (q < 2) ? v0[2 * q] : v1[2 * q - 4], li = (q < 2) ? v0[2 * q + 1] : v1[2 * q - 3];
                        const float hg = fminf(gl, 7.0f), hl = fminf(fmaxf(li, -7.0f), 7.0f);
                        o[q] = hg * (hl + 1.0f) * __builtin_amdgcn_rcpf(1.0f + __expf(-1.702f * hg)); }
                    w[bj].x = cvt_pk_bf16(o[0], o[1]); w[bj].y = cvt_pk_bf16(o[2], o[3]); }
                { auto sx = __builtin_amdgcn_permlane16_swap(w[0].x, w[1].x, false, false); w[0].x = sx[0]; w[1].x = sx[1];
                  auto sy = __builtin_amdgcn_permlane16_swap(w[0].y, w[1].y, false, false); w[0].y = sy[0]; w[1].y = sy[1]; }
                u32x4 wv; wv.x = w[0].x; wv.y = w[0].y; wv.z = w[1].x; wv.w = w[1].y;
                *(u32x4*)(rowp + (oddrow ? (HALF / 2) - 4 : 0)) = wv; }
    }
};
struct EpiDown {
    static constexpr bool PERM = true, AFTER_DRAIN = false;
    bf16_t* O; const float* bias; const int* dest; const float* gate;
    __device__ __forceinline__ void prefetch(PG8_LAS unsigned char* lds, const Unit& u, int wid, int lane) const {
        if (wid < 4) { __builtin_amdgcn_global_load_lds((const unsigned*)(bias + u.pn * BM + 64 * wid + lane), (PG8_LAS unsigned*)(lds + EPI_BTAB + wid * 256), 4, 0, 0);
                       __builtin_amdgcn_global_load_lds((const unsigned*)(dest + u.pm * BM + 64 * wid + lane), (PG8_LAS unsigned*)(lds + EPI_DTAB + wid * 256), 4, 0, 0); }
        else __builtin_amdgcn_global_load_lds((const unsigned*)(gate + u.pm * BM + 64 * (wid - 4) + lane), (PG8_LAS unsigned*)(lds + EPI_GTAB + (wid - 4) * 256), 4, 0, 0); }
    __device__ __forceinline__ void operator()(const f32x4 (&acc)[2][2][4][2], const Unit& u, int wr, int wc, int fr, int fq, PG8_LAS unsigned char* lds) const {
        const int rloc = wr * 64 + fr;
        const int ocol0 = (u.pn & 3) * BM + wc * 32 + 8 * fq;
        const PG8_LAS float* bt = (const PG8_LAS float*)(lds + EPI_BTAB) + wc * 32 + 8 * fq; const PG8_LAS int* dt = (const PG8_LAS int*)(lds + EPI_DTAB); const PG8_LAS float* gtb = (const PG8_LAS float*)(lds + EPI_GTAB);
#pragma unroll
        for (int ai = 0; ai < 2; ++ai)
#pragma unroll
            for (int m = 0; m < 4; ++m) { const int pl = rloc + ai * HALF + m * 16; const int d = dt[pl]; const float gt = gtb[pl];
                if (d >= 0) { bf16_t* rowp = O + (size_t)d * 1024 + ocol0;
#pragma unroll
                    for (int bj = 0; bj < 2; ++bj) { const f32x4 b0 = *(const PG8_LAS f32x4*)(bt + bj * HALF), b1 = *(const PG8_LAS f32x4*)(bt + bj * HALF + 4); const f32x4 v0 = (acc[ai][bj][m][0] + b0) * gt, v1 = (acc[ai][bj][m][1] + b1) * gt;
                        u32x4 w; w.x = cvt_pk_bf16(v0[0], v0[1]); w.y = cvt_pk_bf16(v0[2], v0[3]); w.z = cvt_pk_bf16(v1[0], v1[1]); w.w = cvt_pk_bf16(v1[2], v1[3]);
                        *(u32x4*)(rowp + bj * HALF) = w; } } }
    }
};

template <class Epi, class Sched, bool STAMP = false, bool GATHER = false, bool ALIGN_EPI = true, bool SP2 = PG8_SP2_DEFAULT>
__device__ __forceinline__ void gemm_phase(PG8_LAS unsigned char* lds, const Gemm g, const Sched& S, const Epi& E, unsigned long long* stamps, const int tid_in) {
    const int tid = tid_in, wid = __builtin_amdgcn_readfirstlane(tid >> 6), lane = tid & 63, wr = wid >> 2, wc = wid & 3, fr = lane & 15, fq = lane >> 4;
    const int K = g.K, nt = K / BK;
    int ts_lo = 0, ts_hi = 0, nts = 0; const unsigned long long rt_entry = STAMP ? (unsigned long long)wall_clock64() : 0ull;
#define PG8_STAMP() do { if (STAMP && wid == 0 && nts < 64) { const unsigned long long _c = (unsigned long long)clock64(); \
        ts_lo = (lane == nts) ? (int)(unsigned)_c : ts_lo; ts_hi = (lane == nts) ? (int)(unsigned)(_c >> 32) : ts_hi; ++nts; } } while (0)
    PG8_STAMP();
    unsigned voffA[2], voffB[2];
#pragma unroll
    for (int i = 0; i < 2; ++i) { int R, C; stage_rc(tid * 16 + i * 8192, R, C); const int Rb = Epi::PERM ? ((R & ~31) + perm32(R & 31)) : R;
        voffA[i] = (unsigned)(R * K + C) * 2u; voffB[i] = (unsigned)(Rb * K + C) * 2u; }
    unsigned gc[2][2], gn[2][2];
    PG8_LAS int* rowtab = (PG8_LAS int*)(lds + 137216);
    const size_t kstep = (size_t)(BK * 2);
    const size_t hstep = (size_t)HALF * K * 2;
    const size_t tstep = 2 * hstep;
    const unsigned ldsw = (unsigned)wid * 1024u;
    const int aoff = lds_byte(wr * 64 + fr, fq * 8), boff = lds_byte(wc * 32 + fr, fq * 8);
#define PG8_SA(b, h) (((b) * 2 + (h)) * HTB)
#define PG8_SB(b, h) ((4 + (b) * 2 + (h)) * HTB)
#define PG8_STAGE(bufoff, gbase, voff) do { _Pragma("unroll") for (int _i = 0; _i < 2; ++_i) \
        __builtin_amdgcn_global_load_lds((const unsigned*)((const char*)(gbase) + (voff)[_i]), (PG8_LAS unsigned*)(lds + (bufoff) + ldsw + _i * 8192), 16, 0, 0); } while (0)
#define PG8_LDA(dst, b, h) do { _Pragma("unroll") for (int m = 0; m < 4; ++m) _Pragma("unroll") for (int k = 0; k < 2; ++k) dst[m][k] = *(const PG8_LAS bf16x8*)(lds + PG8_SA(b, h) + aoff + m * 2048 + k * 1024); } while (0)
#define PG8_LDB(dst, b, h) do { _Pragma("unroll") for (int n = 0; n < 2; ++n) _Pragma("unroll") for (int k = 0; k < 2; ++k) dst[n][k] = *(const PG8_LAS bf16x8*)(lds + PG8_SB(b, h) + boff + n * 2048 + k * 1024); } while (0)
#define PG8_MMA(ai, bj, At, Bt) do { __builtin_amdgcn_s_setprio(1); _Pragma("unroll") for (int m = 0; m < 4; ++m) _Pragma("unroll") for (int n = 0; n < 2; ++n) _Pragma("unroll") for (int k = 0; k < 2; ++k) \
        acc[ai][bj][m][n] = __builtin_amdgcn_mfma_f32_16x16x32_bf16(Bt[n][k], At[m][k], acc[ai][bj][m][n], 0, 0, 0); __builtin_amdgcn_s_setprio(0); } while (0)
#define PG8_WAIT_V(n) asm volatile("s_waitcnt vmcnt(" #n ")" ::: "memory")
#define PG8_WAIT_L(n) asm volatile("s_waitcnt lgkmcnt(" #n ")" ::: "memory")
#define PG8_BAR __builtin_amdgcn_s_barrier()
#define PG8_SCHED __builtin_amdgcn_sched_barrier(0)
    Unit cur, nxt; int ui = 0;
    if (!S.next(0, cur)) return;
    f32x4 acc[2][2][4][2];
#pragma unroll
    for (int a = 0; a < 2; ++a)
#pragma unroll
        for (int b = 0; b < 2; ++b)
#pragma unroll
            for (int m = 0; m < 4; ++m)
#pragma unroll
                for (int n = 0; n < 2; ++n) acc[a][b][m][n] = (f32x4){0.f, 0.f, 0.f, 0.f};
    bf16x8 At[4][2], B0[2][2], B1[2][2];
    const char* cA = GATHER ? (const char*)g.A : (const char*)g.A + (size_t)cur.pm * tstep; const char* cB = (const char*)g.Bt + (size_t)cur.pn * tstep;
    if constexpr (GATHER) {
#pragma unroll
        for (int h = 0; h < 2; ++h)
#pragma unroll
            for (int i = 0; i < 2; ++i) { int R, C; stage_rc(tid * 16 + i * 8192, R, C); gc[h][i] = (unsigned)S.rowtok[256 * cur.pm + 128 * h + R] * (unsigned)(K * 2) + (unsigned)(C * 2); gn[h][i] = gc[h][i]; } }
    S.a_ready(cur);
    if constexpr (SP2) {
        PG8_STAGE(PG8_SB(0, 0), cB, voffB); PG8_STAGE(PG8_SB(0, 1), cB + hstep, voffB); if constexpr (GATHER) PG8_STAGE(PG8_SA(0, 0), cA, gc[0]); else PG8_STAGE(PG8_SA(0, 0), cA, voffA); if constexpr (GATHER) PG8_STAGE(PG8_SA(0, 1), cA, gc[1]); else PG8_STAGE(PG8_SA(0, 1), cA + hstep, voffA);
        if (wr == 1) PG8_BAR;
        PG8_WAIT_V(2); PG8_BAR;
        PG8_STAGE(PG8_SB(1, 0), cB + kstep, voffB); if constexpr (GATHER) PG8_STAGE(PG8_SA(1, 0), cA + kstep, gc[0]); else PG8_STAGE(PG8_SA(1, 0), cA + kstep, voffA); PG8_STAGE(PG8_SB(1, 1), cB + hstep + kstep, voffB);
        PG8_WAIT_V(6); PG8_BAR;
    } else {
    PG8_STAGE(PG8_SB(0, 0), cB, voffB); if constexpr (GATHER) PG8_STAGE(PG8_SA(0, 0), cA, gc[0]); else PG8_STAGE(PG8_SA(0, 0), cA, voffA); PG8_STAGE(PG8_SB(0, 1), cB + hstep, voffB); if constexpr (GATHER) PG8_STAGE(PG8_SA(0, 1), cA, gc[1]); else PG8_STAGE(PG8_SA(0, 1), cA + hstep, voffA);
    if (wr == 1) PG8_BAR;
    PG8_WAIT_V(4); PG8_BAR;
    PG8_STAGE(PG8_SB(1, 0), cB + kstep, voffB); if constexpr (GATHER) PG8_STAGE(PG8_SA(1, 0), cA + kstep, gc[0]); else PG8_STAGE(PG8_SA(1, 0), cA + kstep, voffA); PG8_STAGE(PG8_SB(1, 1), cB + hstep + kstep, voffB);
    PG8_WAIT_V(6); PG8_BAR;
    }
    PG8_STAMP();
    for (;;) {
        const bool has_next = S.next(ui + 1, nxt);
        const char* nA = GATHER ? cA : (has_next ? (const char*)g.A + (size_t)nxt.pm * tstep : cA); const char* nB = has_next ? (const char*)g.Bt + (size_t)nxt.pn * tstep : cB;
        for (int t = 0; t < nt; t += 2) {
            const bool last = (t == nt - 2);
            const char* a1 = cA + (size_t)(t + 1) * kstep;
            const char* a2 = last ? nA : cA + (size_t)(t + 2) * kstep; const char* b2 = last ? nB : cB + (size_t)(t + 2) * kstep;
            const char* a3 = a2 + kstep; const char* b3 = b2 + kstep;
            if (last && has_next) S.a_ready(nxt);
            if (t == nt - 4) { int ln_ = lane; asm volatile("" : "+v"(ln_)); E.prefetch(lds, cur, wid, ln_); }
            if constexpr (GATHER) {
                if (t == nt - 4 && has_next && wid < 4)
                    __builtin_amdgcn_global_load_lds((const unsigned*)(S.rowtok + 256 * nxt.pm + 64 * wid + lane), (PG8_LAS unsigned*)((PG8_LAS unsigned char*)rowtab + wid * 256), 4, 0, 0);
                if (last && has_next) { int tz = tid; asm volatile("" : "+v"(tz));
#pragma unroll
                    for (int h = 0; h < 2; ++h)
#pragma unroll
                        for (int i = 0; i < 2; ++i) { int R, C; stage_rc(tz * 16 + i * 8192, R, C); gn[h][i] = (unsigned)rowtab[128 * h + R] * (unsigned)(K * 2) + (unsigned)(C * 2); } } }
            unsigned g0x[2], g1x[2];
#pragma unroll
            for (int i = 0; i < 2; ++i) { g0x[i] = last ? gn[0][i] : gc[0][i]; g1x[i] = last ? gn[1][i] : gc[1][i]; }
            if constexpr (SP2) {
            PG8_LDB(B0, 0, 0); PG8_LDB(B1, 0, 1); PG8_SCHED; PG8_LDA(At, 0, 0); if constexpr (GATHER) PG8_STAGE(PG8_SA(1, 1), a1, gc[1]); else PG8_STAGE(PG8_SA(1, 1), a1 + hstep, voffA);
            PG8_WAIT_V(8); PG8_WAIT_L(0); PG8_BAR; PG8_MMA(0, 0, At, B0); PG8_MMA(0, 1, At, B1); PG8_BAR; PG8_SCHED;
            PG8_LDA(At, 0, 1); PG8_STAGE(PG8_SB(0, 0), b2, voffB); PG8_STAGE(PG8_SB(0, 1), b2 + hstep, voffB); if constexpr (GATHER) PG8_STAGE(PG8_SA(0, 0), a2, g0x); else PG8_STAGE(PG8_SA(0, 0), a2, voffA);
            PG8_WAIT_V(8); PG8_WAIT_L(0); PG8_BAR; PG8_MMA(1, 0, At, B0); PG8_MMA(1, 1, At, B1); PG8_BAR; PG8_SCHED;
            PG8_LDB(B0, 1, 0); PG8_LDB(B1, 1, 1); PG8_SCHED; PG8_LDA(At, 1, 0); if constexpr (GATHER) PG8_STAGE(PG8_SA(0, 1), a2, g1x); else PG8_STAGE(PG8_SA(0, 1), a2 + hstep, voffA);
            PG8_WAIT_V(8); PG8_WAIT_L(0); PG8_BAR; PG8_MMA(0, 0, At, B0); PG8_MMA(0, 1, At, B1); PG8_BAR; PG8_SCHED;
            PG8_LDA(At, 1, 1); PG8_STAGE(PG8_SB(1, 0), b3, voffB); PG8_STAGE(PG8_SB(1, 1), b3 + hstep, voffB); if constexpr (GATHER) PG8_STAGE(PG8_SA(1, 0), a3, g0x); else PG8_STAGE(PG8_SA(1, 0), a3, voffA);
            PG8_WAIT_V(8); PG8_WAIT_L(0); PG8_BAR; PG8_MMA(1, 0, At, B0); PG8_MMA(1, 1, At, B1); PG8_BAR; PG8_SCHED;
            } else {
            PG8_LDB(B0, 0, 0); PG8_SCHED; PG8_LDA(At, 0, 0); if constexpr (GATHER) PG8_STAGE(PG8_SA(1, 1), a1, gc[1]); else PG8_STAGE(PG8_SA(1, 1), a1 + hstep, voffA);
            PG8_WAIT_L(8); PG8_BAR; PG8_WAIT_L(0); PG8_MMA(0, 0, At, B0); PG8_BAR; PG8_SCHED;
            PG8_LDB(B1, 0, 1); PG8_STAGE(PG8_SB(0, 0), b2, voffB);
            PG8_BAR; PG8_WAIT_L(0); PG8_MMA(0, 1, At, B1); PG8_BAR;
            PG8_LDA(At, 0, 1); if constexpr (GATHER) PG8_STAGE(PG8_SA(0, 0), a2, g0x); else PG8_STAGE(PG8_SA(0, 0), a2, voffA);
            PG8_BAR; PG8_WAIT_L(0); PG8_MMA(1, 0, At, B0); PG8_BAR; PG8_SCHED;
            PG8_STAGE(PG8_SB(0, 1), b2 + hstep, voffB);
            PG8_WAIT_V(6); PG8_BAR; PG8_MMA(1, 1, At, B1); PG8_BAR;
            PG8_LDB(B0, 1, 0); PG8_SCHED; PG8_LDA(At, 1, 0); if constexpr (GATHER) PG8_STAGE(PG8_SA(0, 1), a2, g1x); else PG8_STAGE(PG8_SA(0, 1), a2 + hstep, voffA);
            PG8_WAIT_L(8); PG8_BAR; PG8_WAIT_L(0); PG8_MMA(0, 0, At, B0); PG8_BAR; PG8_SCHED;
            PG8_LDB(B1, 1, 1); PG8_STAGE(PG8_SB(1, 0), b3, voffB);
            PG8_BAR; PG8_WAIT_L(0); PG8_MMA(0, 1, At, B1); PG8_BAR;
            PG8_LDA(At, 1, 1); if constexpr (GATHER) PG8_STAGE(PG8_SA(1, 0), a3, g0x); else PG8_STAGE(PG8_SA(1, 0), a3, voffA);
            PG8_BAR; PG8_WAIT_L(0); PG8_MMA(1, 0, At, B0); PG8_BAR; PG8_SCHED;
            PG8_STAGE(PG8_SB(1, 1), b3 + hstep, voffB);
            PG8_WAIT_V(6); PG8_BAR; PG8_MMA(1, 1, At, B1); PG8_BAR;
            }
        }
        PG8_STAMP();
        if constexpr (ALIGN_EPI) { if (wr == 0) PG8_BAR; }
        if constexpr (!Epi::AFTER_DRAIN) { E(acc, cur, wr, wc, fr, fq, lds); S.done(cur); }
        PG8_STAMP();
        if (!has_next) break;
#pragma unroll
        for (int a = 0; a < 2; ++a)
#pragma unroll
            for (int b = 0; b < 2; ++b)
#pragma unroll
                for (int m = 0; m < 4; ++m)
#pragma unroll
                    for (int n = 0; n < 2; ++n) acc[a][b][m][n] = (f32x4){0.f, 0.f, 0.f, 0.f};
        cur = nxt; cA = nA; cB = nB; ++ui;
        if constexpr (GATHER) {
#pragma unroll
            for (int h = 0; h < 2; ++h)
#pragma unroll
                for (int i = 0; i < 2; ++i) gc[h][i] = gn[h][i]; }
        if constexpr (ALIGN_EPI) { if (wr == 1) PG8_BAR; }
    }
    PG8_WAIT_V(0);
    if constexpr (!ALIGN_EPI) { if (wr == 0) PG8_BAR; }
    PG8_BAR;
    if constexpr (Epi::AFTER_DRAIN) { E.fused(acc, cur, wr, wc, fr, fq, lds, wid, lane); S.done(cur); }
    PG8_STAMP();
    if (STAMP && wid == 0) { stamps[lane] = lane < nts ? (((unsigned long long)(unsigned)ts_hi << 32) | (unsigned)ts_lo) : 0ull;
        if (lane == 62) stamps[62] = rt_entry; if (lane == 63) stamps[63] = (unsigned long long)wall_clock64(); }
#undef PG8_STAMP
#undef PG8_SA
#undef PG8_SB
#undef PG8_STAGE
#undef PG8_LDA
#undef PG8_LDB
#undef PG8_MMA
#undef PG8_WAIT_V
#undef PG8_WAIT_L
#undef PG8_BAR
#undef PG8_SCHED
}
}
using pg8::bf16_t; using pg8::bf16x8; using pg8::f32x4; using pg8::u32x4;

constexpr int NB = 4, SEQ = 8192, MTOK = NB * SEQ, DM = 1024, NLAYER = 4, CIN = 3080, NPROJ = 3072, NEXP = 32, DEXP = 1024, NUP = 2048;
constexpr int RWD = 384, RW_COLS = 1408;
constexpr int NT_MAX = 544, POS_MAX = NT_MAX * 256;
constexpr float DN_ALPHA = 1.6817928305074290861f;
constexpr float LN_EPS = 1e-5f;
constexpr int NPH = 10;
constexpr int NPHASE_TOTAL = 1 + NLAYER * NPH;

constexpr size_t MiB = 1u << 20;
constexpr size_t WS_CTL = 0, CTL_ZERO_BYTES = 65536;
constexpr size_t WS_WIN = 1 * MiB;
constexpr size_t WS_WOUT = 25 * MiB;
constexpr size_t WS_WUP = 33 * MiB;
constexpr size_t WS_WDN = 545 * MiB;
constexpr size_t WS_ROPE = 801 * MiB;
constexpr size_t WS_HB = 803 * MiB;
constexpr size_t WS_HF = 867 * MiB;
constexpr size_t WS_H1F = 995 * MiB;
constexpr size_t WS_T1 = 1123 * MiB;
constexpr size_t WS_P = 1251 * MiB;
constexpr size_t WS_PG = 1443 * MiB;
constexpr size_t WS_YMIX = 1444 * MiB;
constexpr size_t WS_RWM = 1508 * MiB;
constexpr size_t WS_RWNT = 1532 * MiB;
constexpr size_t WS_RWQH = 1580 * MiB;
constexpr size_t WS_RWYL = 1604 * MiB;
constexpr size_t WS_RWS = 1652 * MiB;
constexpr size_t WS_RWAUX = 1676 * MiB;
constexpr size_t WS_MLQ = 1724 * MiB;
constexpr size_t WS_MLNL = 1740 * MiB;
constexpr size_t WS_MLVEC = 1780 * MiB;
constexpr size_t WS_MLSC = 1781 * MiB;
constexpr size_t WS_MLKL = 1782 * MiB;
constexpr size_t WS_MLCT = 1822 * MiB;
constexpr size_t WS_MLM = 1842 * MiB;
constexpr size_t WS_WUPT = 1843 * MiB;
constexpr size_t WS_AUPT = 1843 * MiB + 256 * 1024;
constexpr size_t WS_GUPT = 1843 * MiB + 512 * 1024;
constexpr size_t WS_LISCR = 1845 * MiB;
constexpr size_t WS_WRH = 1844 * MiB;
constexpr size_t WS_WRL = 1844 * MiB + 256 * 1024;
constexpr size_t WS_XPERM = 2021 * MiB;
constexpr size_t WS_ACT = 2293 * MiB;
constexpr size_t WS_YB = 2565 * MiB;
constexpr size_t WS_TOKE = 2821 * MiB;
constexpr size_t WS_TOKG = 2822 * MiB;
constexpr size_t WS_TOKLR = 2823 * MiB;
constexpr size_t WS_PDEST = 2824 * MiB;
constexpr size_t WS_PGATE = 2825 * MiB;
constexpr size_t WS_BBASE = 2826 * MiB;
constexpr size_t WS_PTOK = 2827 * MiB;
constexpr size_t WS_END = 2828 * MiB;
constexpr int CW_CNT = 1024;
constexpr int CW_SWAQ = 2048;
constexpr int CW_BAR = 4096;
constexpr int LDS_BYTES = 147456;
constexpr int MISC_OFF = 143360;
constexpr int TILEE_OFF = 133120;

#define LDS_WAIT() asm volatile("s_waitcnt lgkmcnt(0)" ::: "memory")
#define LDS_BARRIER() do { asm volatile("s_waitcnt lgkmcnt(0)" ::: "memory"); __builtin_amdgcn_s_barrier(); asm volatile("" ::: "memory"); } while (0)
#define VM_WAIT() asm volatile("s_waitcnt vmcnt(0)" ::: "memory")
__device__ __forceinline__ unsigned f2bf(float f) { unsigned u = __builtin_bit_cast(unsigned, f); return (u + 0x7fffu + ((u >> 16) & 1u)) >> 16; }
typedef __bf16 bf16v2_t __attribute__((ext_vector_type(2)));
__device__ __forceinline__ unsigned pk2(float lo, float hi) { const f32x2 v = (f32x2){lo, hi}; return __builtin_bit_cast(unsigned, __builtin_convertvector(v, bf16v2_t)); }
__device__ __forceinline__ float bf2f(unsigned short b) { return __builtin_bit_cast(float, ((unsigned)b) << 16); }
__device__ __forceinline__ float bflo(unsigned w) { return __builtin_bit_cast(float, w << 16); }
__device__ __forceinline__ float bfhi(unsigned w) { return __builtin_bit_cast(float, w & 0xffff0000u); }
template <int CTRL, int RMASK> __device__ __forceinline__ float dpp_add(float v) { return v + __builtin_bit_cast(float, __builtin_amdgcn_update_dpp(0, __builtin_bit_cast(int, v), CTRL, RMASK, 0xF, false)); }
__device__ __forceinline__ float wave_sum(float v) {
    v = dpp_add<0xB1, 0xF>(v); v = dpp_add<0x4E, 0xF>(v); v = dpp_add<0x141, 0xF>(v); v = dpp_add<0x140, 0xF>(v);
    v = dpp_add<0x142, 0xA>(v); v = dpp_add<0x143, 0xC>(v);
    return __builtin_bit_cast(float, __builtin_amdgcn_readlane(__builtin_bit_cast(int, v), 63));
}
template <int CTRL> __device__ __forceinline__ float dpp_mov(float x) { return __builtin_bit_cast(float, __builtin_amdgcn_update_dpp(0, __builtin_bit_cast(int, x), CTRL, 0xF, 0xF, true)); }
__device__ __forceinline__ float sum8(float x) { x += dpp_mov<0xB1>(x); x += dpp_mov<0x4E>(x); x += dpp_mov<0x141>(x); return x; }
__device__ __forceinline__ float sigmoidf_(float x) { return __builtin_amdgcn_rcpf(1.0f + __expf(-x)); }

#define XB_TMO      128
#define XB_XCNT(j)  (256  + 64 * (j))
#define XB_XSUB(j)  (1280 + 64 * (j))
#define XB_XGEN(j)  (2304 + 64 * (j))
#define XB_TOP      3328
#define XB_TOPGEN   3392
#define XCD_BAR_WORDS 3456
#define XB_SPIN_CAP (1u << 22)
__device__ __forceinline__ unsigned xb_ld(unsigned* p)              { return __hip_atomic_load(p, __ATOMIC_RELAXED, __HIP_MEMORY_SCOPE_AGENT); }
__device__ __forceinline__ unsigned xb_add(unsigned* p, unsigned v) { return __hip_atomic_fetch_add(p, v, __ATOMIC_RELAXED, __HIP_MEMORY_SCOPE_AGENT); }
__device__ __forceinline__ unsigned xb_xcc_id() { return (unsigned)__builtin_amdgcn_s_getreg((3 << 11) | 20) & 0xFu; }
#define XB_SPIN(cond, bar) do { unsigned _sp = 0; while (cond) { __builtin_amdgcn_s_sleep(1); \
    if ((++_sp & 255u) == 0u) { if (xb_ld(&(bar)[XB_TMO])) break; if (_sp > XB_SPIN_CAP) { atomicAdd(&(bar)[XB_TMO], 1u); break; } } } } while (0)

struct XcdBarrier {
    unsigned* bar; unsigned x;
    volatile LAS unsigned* st;
};

__device__ __forceinline__ XcdBarrier xcd_barrier_post(unsigned* bar, volatile LAS unsigned* st, bool t0  ) {
    XcdBarrier b; b.bar = bar; b.x = xb_xcc_id(); b.st = st;
    if (t0) (void)xb_add(&bar[XB_XCNT(b.x)], 1u);
    return b;
}
__device__ __forceinline__ void xcd_barrier_complete(unsigned* bar, unsigned x, unsigned& nloc, unsigned& nx) {
    const unsigned G = gridDim.x * gridDim.y * gridDim.z;
    unsigned sum, cnt, mine, sp = 0u;
    for (;;) {
        sum = 0u; cnt = 0u; mine = 0u;
#pragma unroll
        for (unsigned j = 0; j < 16; ++j) { const unsigned c = xb_ld(&bar[XB_XCNT(j)]); sum += c; cnt += (c > 0u) ? 1u : 0u; mine = (j == x) ? c : mine; }
        if (sum == G) break;
        __builtin_amdgcn_s_sleep(1);
        if ((++sp & 255u) == 0u) { if (xb_ld(&bar[XB_TMO])) break; if (sp > XB_SPIN_CAP) { atomicAdd(&bar[XB_TMO], 1u); break; } }
    }
    nloc = mine > 0u ? mine : 1u; nx = cnt > 0u ? cnt : 1u;
}

__device__ __forceinline__ void xcd_barrier(const XcdBarrier& b, bool t0  ) {
    asm volatile("s_waitcnt vmcnt(0)" ::: "memory");
    __syncthreads();
    if (t0) {
        unsigned* bar = b.bar;
        __builtin_amdgcn_s_waitcnt(0);
        unsigned nloc = b.st[0], nx = b.st[1];
        if (nloc == 0u) { xcd_barrier_complete(bar, b.x, nloc, nx); b.st[0] = nloc; b.st[1] = nx; }
        const unsigned old = xb_add(&bar[XB_XSUB(b.x)], 1u);
        const unsigned gen = old / nloc;
        if (old + 1u == (gen + 1u) * nloc) {
            __builtin_amdgcn_fence(__ATOMIC_RELEASE, "agent");
            asm volatile("s_waitcnt vmcnt(0)" ::: "memory");
            const unsigned og = xb_add(&bar[XB_TOP], 1u);
            const unsigned tg = og / nx;
            if (og + 1u == (tg + 1u) * nx) xb_add(&bar[XB_TOPGEN], 1u);
            else XB_SPIN(xb_ld(&bar[XB_TOPGEN]) == tg, bar);
            __builtin_amdgcn_fence(__ATOMIC_ACQUIRE, "agent");
            xb_add(&bar[XB_XGEN(b.x)], 1u);
            asm volatile("s_waitcnt vmcnt(0)" ::: "memory");
        } else {
            XB_SPIN(xb_ld(&bar[XB_XGEN(b.x)]) == gen, bar);
            __builtin_amdgcn_fence(__ATOMIC_ACQUIRE, "agent");
            asm volatile("s_waitcnt vmcnt(0)" ::: "memory");
        }
    }
    __syncthreads();
}
struct Params {
    const float* in[29];
    float* out; unsigned char* ws;
    int ph_lo, ph_hi;
    int pad0, pad1;
};
enum { I_X = 0, I_WIN, I_BIN, I_MU, I_WUP, I_W0, I_AUP, I_A0, I_GUP, I_KK, I_KA, I_RK, I_LNW, I_LNB, I_SINK, I_CONVW, I_CONVB, I_MLNW, I_WOUT,
       I_LN1W, I_LN1B, I_RW, I_RB, I_EWUP, I_EBUP, I_EWDN, I_EBDN, I_LN2W, I_LN2B };

struct Ctx {
    LAS unsigned char* lds; int tid, lane, wave, blk, G;
    unsigned char* ws;
};

__device__ __forceinline__ void tr_item(const float* W, int ldw, int K, bf16_t* WT, LAS float* scr, int kb, int nb, int lane) {
    const int k0 = 64 * kb, n0 = 32 * nb;
#pragma unroll 8
    for (int i = 0; i < 32; ++i) { const int kk = 2 * i + (lane >> 5); scr[kk * 33 + (lane & 31)] = __builtin_nontemporal_load(W + (size_t)(k0 + kk) * ldw + n0 + (lane & 31)); }
    LDS_WAIT();
    const int c = lane & 7;
#pragma unroll
    for (int j = 0; j < 4; ++j) { const int n = (lane >> 3) + 8 * j; const LAS float* s = scr + (8 * c) * 33 + n;
        u32x4 o; o.x = pk2(s[0 * 33], s[1 * 33]); o.y = pk2(s[2 * 33], s[3 * 33]); o.z = pk2(s[4 * 33], s[5 * 33]); o.w = pk2(s[6 * 33], s[7 * 33]);
        *(u32x4*)(WT + (size_t)(n0 + n) * K + k0 + 8 * c) = o; }
    LDS_WAIT();
}
__device__ __forceinline__ void gate_cols(const f32x4 (&v)[4], const LAS float* tab, const float bgv  , float* pgrow, int lane) {
    float acc[8];
#pragma unroll
    for (int c = 0; c < 8; ++c) acc[c] = 0.f;
#pragma unroll
    for (int j = 0; j < 4; ++j)
#pragma unroll
        for (int q = 0; q < 4; ++q) { const LAS f32x4* tp = (const LAS f32x4*)(tab + ((j * 4 + q) * 64 + lane) * 8); const f32x4 a = tp[0], b = tp[1]; const float x = v[j][q];
            acc[0] += x * a[0]; acc[1] += x * a[1]; acc[2] += x * a[2]; acc[3] += x * a[3]; acc[4] += x * b[0]; acc[5] += x * b[1]; acc[6] += x * b[2]; acc[7] += x * b[3]; }
#pragma unroll
    for (int c = 0; c < 8; ++c) acc[c] = wave_sum(acc[c]);
    if (lane < 8) { float r = acc[0];
#pragma unroll
        for (int c = 1; c < 8; ++c) r = (lane == c) ? acc[c] : r;
        pgrow[lane] = r + bgv; }
}
__device__ __forceinline__ void load_wg(LAS float* tab, const float* win_l, int tid) {
    for (int d = tid; d < DM; d += 512) { const int j = d >> 8, ln = (d >> 2) & 63, q = d & 3; const f32x4 a = *(const f32x4*)(win_l + (size_t)d * CIN + NPROJ), b = *(const f32x4*)(win_l + (size_t)d * CIN + NPROJ + 4);
        LAS f32x4* tp = (LAS f32x4*)(tab + ((j * 4 + q) * 64 + ln) * 8); tp[0] = a; tp[1] = b; }
    __syncthreads();
}
__device__ __forceinline__ void p0_prologue(const Params& P, const Ctx& C) {
    LAS float* scr = (LAS float*)(C.lds + C.wave * 16384);
    const int gw = C.blk * 8 + C.wave, NGW = C.G * 8;
    bf16_t* win_t = (bf16_t*)(C.ws + WS_WIN); bf16_t* wout_t = (bf16_t*)(C.ws + WS_WOUT); bf16_t* wup_t = (bf16_t*)(C.ws + WS_WUP); bf16_t* wdn_t = (bf16_t*)(C.ws + WS_WDN);
    constexpr int I_IN = 16 * 96, I_OUT = 16 * 32, I_UP = 16 * 64, I_DN = 16 * 32;
    constexpr int N1 = NLAYER * I_IN, N2 = NLAYER * I_OUT, N3 = NLAYER * NEXP * I_UP, N4 = NLAYER * NEXP * I_DN;
    for (int it = gw; it < N1 + N2 + N3 + N4; it += NGW) {
        int r = it;
        if (r < N1) { const int l = r / I_IN; r %= I_IN; tr_item(P.in[I_WIN] + (size_t)l * DM * CIN, CIN, DM, win_t + (size_t)l * NPROJ * DM, scr, r / 96, r % 96, C.lane); continue; } r -= N1;
        if (r < N2) { const int l = r / I_OUT; r %= I_OUT; tr_item(P.in[I_WOUT] + (size_t)l * DM * DM, DM, DM, wout_t + (size_t)l * DM * DM, scr, r / 32, r % 32, C.lane); continue; } r -= N2;
        if (r < N3) { const int le = r / I_UP; r %= I_UP; tr_item(P.in[I_EWUP] + (size_t)le * DM * NUP, NUP, DM, wup_t + (size_t)le * NUP * DM, scr, r / 64, r % 64, C.lane); continue; } r -= N3;
        { const int le = r / I_DN; r %= I_DN; tr_item(P.in[I_EWDN] + (size_t)le * DEXP * DM, DM, DEXP, wdn_t + (size_t)le * DM * DEXP, scr, r / 32, r % 32, C.lane); }
    }
    f32x2* rope = (f32x2*)(C.ws + WS_ROPE);
    for (int idx = C.blk * 512 + C.tid; idx < SEQ * 32; idx += C.G * 512) { const int t = idx >> 5, i = idx & 31;
        const float inv = powf(10000.0f, -(float)i / 32.0f); const float ang = (float)t * inv;
        const double rev = (double)ang * 0.15915494309189533577; const float fr = (float)(rev - __builtin_rint(rev));
        rope[idx] = (f32x2){__builtin_amdgcn_cosf(fr), __builtin_amdgcn_sinf(fr)}; }
    { bf16_t* wt = (bf16_t*)(C.ws + WS_WUPT); bf16_t* at = (bf16_t*)(C.ws + WS_AUPT); bf16_t* gt = (bf16_t*)(C.ws + WS_GUPT);
      for (int idx = C.blk * 512 + C.tid; idx < NLAYER * RWD * 64; idx += C.G * 512) { const int ll = idx / (RWD * 64), rem = idx % (RWD * 64), j = rem >> 6, i = rem & 63;
          wt[idx] = (bf16_t)f2bf(P.in[I_WUP][((size_t)ll * 64 + i) * RWD + j]); at[idx] = (bf16_t)f2bf(P.in[I_AUP][((size_t)ll * 64 + i) * RWD + j]); }
      for (int idx = C.blk * 512 + C.tid; idx < NLAYER * RWD * 128; idx += C.G * 512) { const int ll = idx / (RWD * 128), rem = idx % (RWD * 128), j = rem >> 7, i = rem & 127;
          gt[idx] = (bf16_t)f2bf(P.in[I_GUP][((size_t)ll * 128 + i) * RWD + j]); } }
    { bf16_t* wh = (bf16_t*)(C.ws + WS_WRH); bf16_t* wl = (bf16_t*)(C.ws + WS_WRL);
      for (int idx = C.blk * 512 + C.tid; idx < NLAYER * NEXP * DM; idx += C.G * 512) { const int ll = idx / (NEXP * DM), rem = idx % (NEXP * DM), e = rem >> 10, d = rem & 1023;
          const float w = P.in[I_RW][((size_t)ll * DM + d) * NEXP + e]; const unsigned hi = f2bf(w); const float lo = w - bflo(hi); wh[idx] = (bf16_t)hi; wl[idx] = (bf16_t)f2bf(lo); } }
    __syncthreads(); LAS float* wg = (LAS float*)C.lds; load_wg(wg, P.in[I_WIN], C.tid);
    bf16_t* hb = (bf16_t*)(C.ws + WS_HB); float* pg = (float*)(C.ws + WS_PG);
    const float bgv0 = P.in[I_BIN][NPROJ + (C.lane & 7)];
    for (int m = gw; m < MTOK; m += NGW) {
        const f32x4* xr = (const f32x4*)(P.in[I_X] + (size_t)m * DM) + C.lane; f32x4 v[4];
#pragma unroll
        for (int j = 0; j < 4; ++j) v[j] = xr[64 * j];
        u32x2* o8 = (u32x2*)(hb + (size_t)m * DM) + C.lane;
#pragma unroll
        for (int j = 0; j < 4; ++j) o8[64 * j] = (u32x2){pk2(v[j][0], v[j][1]), pk2(v[j][2], v[j][3])};
        gate_cols(v, wg, bgv0, pg + (size_t)m * 8, C.lane);
    }
}

constexpr int LD = 72;
constexpr int BUFB = 64 * LD * 2;
__device__ __forceinline__ f32x4 mfma16(bf16x8 a, bf16x8 b, f32x4 c) { return __builtin_amdgcn_mfma_f32_16x16x32_bf16(a, b, c, 0, 0, 0); }
constexpr int SWA_VLD = 264;
__device__ __forceinline__ void swa_unit(const Params& P, const Ctx& C, int l, int u) {
    const int tid = C.tid, wave = C.wave, lane = C.lane, r = lane & 15, g = lane >> 4; const int b = u >> 7, n = (u >> 1) & 63, hk = u & 1;
    LAS bf16_t* Ks = (LAS bf16_t*)C.lds; LAS bf16_t* VT = Ks + 256 * LD;
    const bf16_t* p = (const bf16_t*)(C.ws + WS_P); const f32x2* rope = (const f32x2*)(C.ws + WS_ROPE);
    const int t_base = n * 128 - 128;
#pragma unroll
    for (int it = 0; it < 2; ++it) { const int q = tid + 512 * it, row = q >> 2, c8 = q & 3; const int t = t_base + row;
        u32x4 o1 = (u32x4){0u, 0u, 0u, 0u}, o2 = o1;
        if (t >= 0) { const bf16_t* pr = p + (size_t)(b * SEQ + t) * NPROJ + 1792 + hk * 64 + 8 * c8; const u32x4 a1 = *(const u32x4*)pr, a2 = *(const u32x4*)(pr + 32);
            const f32x4* rp = (const f32x4*)(rope + t * 32 + 8 * c8); float y1[8], y2[8];
#pragma unroll
            for (int e = 0; e < 4; ++e) { const f32x4 cs = rp[e];
                const float x1a = bflo(a1[e]), x1b = bfhi(a1[e]), x2a = bflo(a2[e]), x2b = bfhi(a2[e]);
                y1[2 * e] = x1a * cs[0] - x2a * cs[1]; y2[2 * e] = x2a * cs[0] + x1a * cs[1]; y1[2 * e + 1] = x1b * cs[2] - x2b * cs[3]; y2[2 * e + 1] = x2b * cs[2] + x1b * cs[3]; }
            o1 = (u32x4){pk2(y1[0], y1[1]), pk2(y1[2], y1[3]), pk2(y1[4], y1[5]), pk2(y1[6], y1[7])}; o2 = (u32x4){pk2(y2[0], y2[1]), pk2(y2[2], y2[3]), pk2(y2[4], y2[5]), pk2(y2[6], y2[7])}; }
        *(LAS u32x4*)(Ks + row * LD + 8 * c8) = o1; *(LAS u32x4*)(Ks + row * LD + 32 + 8 * c8) = o2; }
    if (tid < 256) { const int kg = tid >> 3, c8 = tid & 7; u32x4 in[8];
#pragma unroll
        for (int k = 0; k < 8; ++k) { const int t = t_base + 8 * kg + k; in[k] = (t >= 0) ? *(const u32x4*)(p + (size_t)(b * SEQ + t) * NPROJ + 1920 + hk * 64 + 8 * c8) : (u32x4){0u, 0u, 0u, 0u}; }
#pragma unroll
        for (int d = 0; d < 8; ++d) { unsigned hv[8];
#pragma unroll
            for (int k = 0; k < 8; ++k) { const unsigned w = in[k][d >> 1]; hv[k] = (d & 1) ? (w >> 16) : (w & 0xffffu); }
            *(LAS u32x4*)(VT + (8 * c8 + d) * SWA_VLD + 8 * kg) = (u32x4){hv[0] | (hv[1] << 16), hv[2] | (hv[3] << 16), hv[4] | (hv[5] << 16), hv[6] | (hv[7] << 16)}; } }
    LDS_BARRIER();
    const int qi = 16 * wave + r, t = n * 128 + qi;
    const f32x4* rq = (const f32x4*)(rope + t * 32 + 8 * g);
#pragma unroll 1
    for (int gq = 0; gq < 3; ++gq) { const int hq = hk * 3 + gq; int wave = C.wave; asm volatile("" : "+s"(wave));
        bf16x8 qf0, qf1;
        { const bf16_t* pr = p + (size_t)(b * SEQ + t) * NPROJ + RW_COLS + hq * 64 + 8 * g; const u32x4 a1 = *(const u32x4*)pr, a2 = *(const u32x4*)(pr + 32); float y1[8], y2[8];
#pragma unroll
          for (int e = 0; e < 4; ++e) { const f32x4 cs = rq[e]; const float x1a = bflo(a1[e]), x1b = bfhi(a1[e]), x2a = bflo(a2[e]), x2b = bfhi(a2[e]);
              y1[2 * e] = (x1a * cs[0] - x2a * cs[1]) * 0.125f; y2[2 * e] = (x2a * cs[0] + x1a * cs[1]) * 0.125f; y1[2 * e + 1] = (x1b * cs[2] - x2b * cs[3]) * 0.125f; y2[2 * e + 1] = (x2b * cs[2] + x1b * cs[3]) * 0.125f; }
          const u32x4 w1 = (u32x4){pk2(y1[0], y1[1]), pk2(y1[2], y1[3]), pk2(y1[4], y1[5]), pk2(y1[6], y1[7])}, w2 = (u32x4){pk2(y2[0], y2[1]), pk2(y2[2], y2[3]), pk2(y2[4], y2[5]), pk2(y2[6], y2[7])};
          qf0 = __builtin_bit_cast(bf16x8, w1); qf1 = __builtin_bit_cast(bf16x8, w2); }
        f32x4 sc[10]; const float sink = P.in[I_SINK][l * 6 + hq]; float mx = sink;
        int qiv = qi; asm volatile("" : "+v"(qiv));
#pragma unroll
        for (int kt = 0; kt < 10; ++kt) { const int kb = 16 * (wave + kt); f32x4 a = (f32x4){0.f, 0.f, 0.f, 0.f};
            if (kb < 256) { const LAS bf16_t* kp = Ks + (kb + r) * LD + 8 * g; a = mfma16(*(const LAS bf16x8*)kp, qf0, a); a = mfma16(*(const LAS bf16x8*)(kp + 32), qf1, a); }
#pragma unroll
            for (int j = 0; j < 4; ++j) { const int kj = kb + 4 * g + j; const bool valid = (kj > qiv) && (kj <= qiv + 128) && (kj < 256) && ((n != 0) || (kj >= 128)); a[j] = valid ? a[j] : -__builtin_inff(); mx = fmaxf(mx, a[j]); }
            sc[kt] = a; }
        mx = fmaxf(mx, __shfl_xor(mx, 16)); mx = fmaxf(mx, __shfl_xor(mx, 32));
        float sum = 0.f;
#pragma unroll
        for (int kt = 0; kt < 10; ++kt) {
#pragma unroll
            for (int j = 0; j < 4; ++j) { const float e = __expf(sc[kt][j] - mx); sc[kt][j] = e; sum += e; } }
        sum += __shfl_xor(sum, 16); sum += __shfl_xor(sum, 32); sum += __expf(sink - mx);
        const float inv = 1.0f / sum;
        f32x4 o[4];
#pragma unroll
        for (int dt = 0; dt < 4; ++dt) o[dt] = (f32x4){0.f, 0.f, 0.f, 0.f};
#pragma unroll
        for (int s = 0; s < 5; ++s) { const int kb = 16 * (wave + 2 * s);
            if (kb < 256) { const u32x4 pw = (u32x4){pk2(sc[2 * s][0], sc[2 * s][1]), pk2(sc[2 * s][2], sc[2 * s][3]), pk2(sc[2 * s + 1][0], sc[2 * s + 1][1]), pk2(sc[2 * s + 1][2], sc[2 * s + 1][3])};
                const bf16x8 pf = __builtin_bit_cast(bf16x8, pw); const bool two = (kb + 16 < 256);
#pragma unroll
                for (int dt = 0; dt < 4; ++dt) { const LAS bf16_t* vp = VT + (16 * dt + r) * SWA_VLD + kb + 4 * g; const u32x2 lo = *(const LAS u32x2*)vp; u32x2 hi = (u32x2){0u, 0u}; if (two) hi = *(const LAS u32x2*)(vp + 16);
                    const u32x4 af = (u32x4){lo[0], lo[1], hi[0], hi[1]}; o[dt] = mfma16(__builtin_bit_cast(bf16x8, af), pf, o[dt]); } } }
        bf16_t* yr = (bf16_t*)(C.ws + WS_YMIX) + (size_t)(b * SEQ + t) * DM + RWD + hq * 64 + 4 * g;
#pragma unroll
        for (int dt = 0; dt < 4; ++dt) *(u32x2*)(yr + 16 * dt) = (u32x2){pk2(o[dt][0] * inv, o[dt][1] * inv), pk2(o[dt][2] * inv, o[dt][3] * inv)};
    }
    LDS_BARRIER();
}
__device__ __forceinline__ f32x4 mm64(const LAS bf16_t* X, const LAS bf16_t* Y, int ti, int tj, f32x4 acc, int lane) {
    const int r = lane & 15, g = lane >> 4;
    const LAS bf16_t* xp = X + (16 * ti + r) * LD + 8 * g; const LAS bf16_t* yp = Y + (16 * tj + r) * LD + 8 * g;
    acc = mfma16(*(const LAS bf16x8*)xp, *(const LAS bf16x8*)yp, acc);
    acc = mfma16(*(const LAS bf16x8*)(xp + 32), *(const LAS bf16x8*)(yp + 32), acc);
    return acc;
}
__device__ __forceinline__ void storeT(LAS bf16_t* D, int ti, int tj, f32x4 v, int lane) {
    const int r = lane & 15, g = lane >> 4;
    *(LAS u32x2*)(D + (16 * tj + r) * LD + 16 * ti + 4 * g) = (u32x2){pk2(v[0], v[1]), pk2(v[2], v[3])};
}
template <int MODE> __device__ __forceinline__ f32x4 maskT(f32x4 v, int ti, int tj, int lane) {
    const int rho = 16 * tj + (lane & 15), kap = 16 * ti + 4 * (lane >> 4);
#pragma unroll
    for (int j = 0; j < 4; ++j) { const bool keep = (MODE == 0) ? (kap + j < rho) : (MODE == 1) ? (kap + j <= rho) : (kap + j > rho); v[j] = keep ? v[j] : 0.f; }
    return v;
}
__device__ __forceinline__ float wave_max(float v) {
#pragma unroll
    for (int o = 1; o < 64; o <<= 1) v = fmaxf(v, __shfl_xor(v, o));
    return v;
}

__device__ __forceinline__ void rwb_unit(const Params& P, const Ctx& C, int l, int u, bool reuse) {
    const int tid = C.tid, wave = C.wave, lane = C.lane, r = lane & 15, g = lane >> 4;
    const int h = u % 6, bcx = u / 6, b = bcx >> 7, c = bcx & 127; const int tok0 = b * SEQ + c * 64; const int ch = (b * 6 + h) * 128 + c;
    LAS unsigned char* L = C.lds;
#define RB(i) ((LAS bf16_t*)(L + (i) * BUFB))
    LAS bf16_t* X1 = RB(0); LAS bf16_t* X1T = RB(1); LAS bf16_t* Aak = RB(2); LAS bf16_t* Arb = RB(3); LAS bf16_t* Ark = RB(4); LAS bf16_t* Pb = RB(5);
    LAS bf16_t* At = RB(6); LAS bf16_t* AtT = RB(7); LAS bf16_t* Bt = RB(8); LAS bf16_t* BtT = RB(9); LAS bf16_t* Kt = RB(10); LAS bf16_t* KtT = RB(11); LAS bf16_t* Rt = RB(12); LAS bf16_t* VT = RB(13);
    LAS float* XW = (LAS float*)L; LAS float* XA = XW + 64 * 65; LAS float* XG = XA + 64 * 65;
    LAS bf16_t* LI = (LAS bf16_t*)(L + 6 * BUFB);
    LAS float* segtot = (LAS float*)(L + 14 * BUFB); LAS float* gamL = segtot + 512;
    const bf16_t* p = (const bf16_t*)(C.ws + WS_P); const float* mu = P.in[I_MU] + l * RW_COLS;
    float cr9[9], ck9[9], cv9[9];
    { const int jc0 = 64 * h + lane;
#pragma unroll
      for (int i = 0; i < 9; ++i) { const int row = 8 * wave - 1 + i; const bool ok = (c * 64 + row >= 0); const bf16_t* q = p + (size_t)(tok0 + (ok ? row : 0)) * NPROJ;
          const float a_ = bf2f(q[jc0]), b_ = bf2f(q[RWD + jc0]), c_ = bf2f(q[2 * RWD + jc0]); cr9[i] = ok ? a_ : 0.f; ck9[i] = ok ? b_ : 0.f; cv9[i] = ok ? c_ : 0.f; } }
    bf16_t* liscr = (bf16_t*)(C.ws + WS_LISCR) + (size_t)C.blk * (64 * 264);
    if (!reuse) { u32x4 cu[4], pv[4]; f32x4 m0[4], m1[4];
#pragma unroll
      for (int i = 0; i < 4; ++i) { const int q = tid + 512 * i, t = q >> 5, c8 = q & 31; const bf16_t* src = p + (size_t)(tok0 + t) * NPROJ + 1152 + 8 * c8; const bool ok = (c * 64 + t > 0);
          cu[i] = *(const u32x4*)src; pv[i] = *(const u32x4*)(ok ? src - NPROJ : src); if (!ok) pv[i] = (u32x4){0u, 0u, 0u, 0u};
          m0[i] = *(const f32x4*)(mu + 1152 + 8 * c8); m1[i] = *(const f32x4*)(mu + 1152 + 8 * c8 + 4); }
#pragma unroll
      for (int i = 0; i < 4; ++i) { const int q = tid + 512 * i, t = q >> 5, c8 = q & 31; float x[8];
#pragma unroll
          for (int e = 0; e < 4; ++e) { const float c0 = bflo(cu[i][e]), c1 = bfhi(cu[i][e]), p0 = bflo(pv[i][e]), p1 = bfhi(pv[i][e]);
              const float mm0 = (e < 2) ? m0[i][2 * e] : m1[i][2 * e - 4], mm1 = (e < 2) ? m0[i][2 * e + 1] : m1[i][2 * e - 3];
              x[2 * e] = c0 + (p0 - c0) * mm0; x[2 * e + 1] = c1 + (p1 - c1) * mm1; }
          if (c8 < 8) {
#pragma unroll
              for (int e = 0; e < 8; ++e) x[e] = 1.0f - 2.0f * __builtin_amdgcn_rcpf(__expf(2.0f * x[e]) + 1.0f); }
          else if (c8 >= 16) {
#pragma unroll
              for (int e = 0; e < 8; ++e) x[e] = sigmoidf_(x[e]); }
          const u32x4 w = (u32x4){pk2(x[0], x[1]), pk2(x[2], x[3]), pk2(x[4], x[5]), pk2(x[6], x[7])};
          *(LAS u32x4*)(LI + t * 264 + 8 * c8) = w; *(u32x4*)(liscr + t * 264 + 8 * c8) = w; } }
    else {
#pragma unroll
      for (int i = 0; i < 4; ++i) { const int q = tid + 512 * i, t = q >> 5, c8 = q & 31; *(LAS u32x4*)(LI + t * 264 + 8 * c8) = *(const u32x4*)(liscr + t * 264 + 8 * c8); } }
    LDS_BARRIER();
    { bf16x8 bw[1][2], ba[1][2], bg[1][4];
      const int tj = wave & 3;
      const bf16_t* Ww = (const bf16_t*)(C.ws + WS_WUPT) + ((size_t)l * RWD + 64 * h + 16 * tj + r) * 64 + 8 * g;
      const bf16_t* Wa = (const bf16_t*)(C.ws + WS_AUPT) + ((size_t)l * RWD + 64 * h + 16 * tj + r) * 64 + 8 * g;
      const bf16_t* Wg = (const bf16_t*)(C.ws + WS_GUPT) + ((size_t)l * RWD + 64 * h + 16 * tj + r) * 128 + 8 * g;
#pragma unroll
      for (int ks = 0; ks < 2; ++ks) { bw[0][ks] = *(const bf16x8*)(Ww + 32 * ks); ba[0][ks] = *(const bf16x8*)(Wa + 32 * ks); }
#pragma unroll
      for (int ks = 0; ks < 4; ++ks) bg[0][ks] = *(const bf16x8*)(Wg + 32 * ks);
#pragma unroll
      for (int n = 0; n < 6; ++n) { const int o = n >> 1, ti = ((wave >> 2) + 2 * n) & 3; const int xoff = (o == 0) ? 0 : (o == 1) ? 64 : 128;
          const LAS bf16_t* xp = LI + (16 * ti + r) * 264 + xoff + 8 * g; f32x4 acc = (f32x4){0.f, 0.f, 0.f, 0.f};
          if (o == 0) { acc = mfma16(*(const LAS bf16x8*)xp, bw[0][0], acc); acc = mfma16(*(const LAS bf16x8*)(xp + 32), bw[0][1], acc); }
          else if (o == 1) { acc = mfma16(*(const LAS bf16x8*)xp, ba[0][0], acc); acc = mfma16(*(const LAS bf16x8*)(xp + 32), ba[0][1], acc); }
          else {
#pragma unroll
              for (int ks = 0; ks < 4; ++ks) acc = mfma16(*(const LAS bf16x8*)(xp + 32 * ks), bg[0][ks], acc); }
          LAS float* XO = (o == 0) ? XW : (o == 1) ? XA : XG;
#pragma unroll
          for (int j = 0; j < 4; ++j) XO[(16 * ti + 4 * g + j) * 65 + 16 * tj + r] = acc[j]; } }
    LDS_BARRIER();
    {
        const int jc = 64 * h + lane, tg = wave;
        const float w0 = P.in[I_W0][l * RWD + jc], a0 = P.in[I_A0][l * RWD + jc], kkc = P.in[I_KK][l * RWD + jc], kac = P.in[I_KA][l * RWD + jc], rkc = P.in[I_RK][l * RWD + jc];
        const float mur = mu[jc], muk = mu[RWD + jc], muv = mu[2 * RWD + jc];
        float pr = cr9[0], pk = ck9[0], pv = cv9[0];
        float ld[8], av[8], kn[8], km[8], rs[8], vs[8];
        bf16_t* aux = (bf16_t*)(C.ws + WS_RWAUX) + (size_t)(tok0 + 8 * tg) * 768;
#pragma unroll
        for (int i = 0; i < 8; ++i) { const int t = 8 * tg + i; const float cr = cr9[i + 1], ck = ck9[i + 1], cv = cv9[i + 1];
            rs[i] = cr + (pr - cr) * mur; const float ks = ck + (pk - ck) * muk; vs[i] = cv + (pv - cv) * muv; pr = cr; pk = ck; pv = cv;
            const float z = -(w0 + XW[t * 65 + lane]); const float sp = (z > 20.f) ? z : __logf(1.0f + __expf(z)); ld[i] = -__expf(-sp - 0.5f);
            const float a = sigmoidf_(a0 + XA[t * 65 + lane]); av[i] = a;
            const float kkv = ks * kkc; kn[i] = kkv * rsqrtf(fmaxf(wave_sum(kkv * kkv), 1e-24f));
            km[i] = ks * (1.0f + (a - 1.0f) * kac);
            const float dot = wave_sum(rs[i] * km[i] * rkc);
            aux[(size_t)i * 768 + jc] = (bf16_t)f2bf(dot * vs[i]); aux[(size_t)i * 768 + RWD + jc] = (bf16_t)f2bf(XG[t * 65 + lane]); }
        float cs[8]; cs[0] = ld[0];
#pragma unroll
        for (int i = 1; i < 8; ++i) cs[i] = cs[i - 1] + ld[i];
        segtot[tg * 64 + lane] = cs[7];
        LDS_BARRIER();
        float off = 0.f, tot = 0.f;
#pragma unroll
        for (int k = 0; k < 8; ++k) { const float sv = segtot[k * 64 + lane]; tot += sv; off += (k < tg) ? sv : 0.f; }
        if (wave == 0) gamL[lane] = __expf(tot);
        float oa[8], ob[8], ok[8], orr[8];
#pragma unroll
        for (int i = 0; i < 8; ++i) { const int t = 8 * tg + i; const float cum = off + cs[i]; const float gam = __expf(cum), gin = __expf(-cum), gpr = __expf(cum - ld[i]);
            oa[i] = -gpr * kn[i]; ob[i] = kn[i] * av[i] * gin; ok[i] = km[i] * gin; orr[i] = gam * rs[i];
            At[t * LD + lane] = (bf16_t)f2bf(oa[i]); Bt[t * LD + lane] = (bf16_t)f2bf(ob[i]); Kt[t * LD + lane] = (bf16_t)f2bf(ok[i]); Rt[t * LD + lane] = (bf16_t)f2bf(orr[i]); }
        *(LAS u32x4*)(AtT + lane * LD + 8 * tg) = (u32x4){pk2(oa[0], oa[1]), pk2(oa[2], oa[3]), pk2(oa[4], oa[5]), pk2(oa[6], oa[7])};
        *(LAS u32x4*)(BtT + lane * LD + 8 * tg) = (u32x4){pk2(ob[0], ob[1]), pk2(ob[2], ob[3]), pk2(ob[4], ob[5]), pk2(ob[6], ob[7])};
        *(LAS u32x4*)(KtT + lane * LD + 8 * tg) = (u32x4){pk2(ok[0], ok[1]), pk2(ok[2], ok[3]), pk2(ok[4], ok[5]), pk2(ok[6], ok[7])};
        *(LAS u32x4*)(VT + lane * LD + 8 * tg) = (u32x4){pk2(vs[0], vs[1]), pk2(vs[2], vs[3]), pk2(vs[4], vs[5]), pk2(vs[6], vs[7])};
    }
    LDS_BARRIER();
    const f32x4 Z4 = (f32x4){0.f, 0.f, 0.f, 0.f};
    const int wq = wave >> 2, tj = wave & 3;
    { f32x4 res[10];
#pragma unroll
      for (int n_ = 0; n_ < 10; ++n_) { const int o = n_ >> 1, ti = wq + 2 * (n_ & 1);
          if (o == 0) res[n_] = maskT<2>(mm64(At, Bt, ti, tj, Z4, lane), ti, tj, lane);
          else if (o == 1) res[n_] = maskT<0>(mm64(Bt, At, ti, tj, Z4, lane), ti, tj, lane);
          else if (o == 2) res[n_] = maskT<0>(mm64(Kt, At, ti, tj, Z4, lane), ti, tj, lane);
          else if (o == 3) res[n_] = maskT<1>(mm64(Bt, Rt, ti, tj, Z4, lane), ti, tj, lane);
          else res[n_] = maskT<1>(mm64(Kt, Rt, ti, tj, Z4, lane), ti, tj, lane); }
#pragma unroll
      for (int n_ = 0; n_ < 10; ++n_) { const int o = n_ >> 1, ti = wq + 2 * (n_ & 1);
          if (o == 0) storeT(X1T, ti, tj, res[n_], lane);
          else if (o == 1) { storeT(X1, ti, tj, res[n_], lane); f32x4 v = res[n_]; const int rho = 16 * tj + r, kap = 16 * ti + 4 * g;
#pragma unroll
              for (int j = 0; j < 4; ++j) v[j] += (kap + j == rho) ? 1.0f : 0.f;
              storeT(Pb, ti, tj, v, lane); }
          else if (o == 2) storeT(Aak, ti, tj, res[n_], lane);
          else if (o == 3) storeT(Arb, ti, tj, res[n_], lane);
          else storeT(Ark, ti, tj, res[n_], lane); } }
    LDS_BARRIER();
    f32x4 pacc[2];
#pragma unroll
    for (int q = 0; q < 2; ++q) { const int ti = wq + 2 * q; const u32x2 w = *(const LAS u32x2*)(Pb + (16 * tj + r) * LD + 16 * ti + 4 * g);
        pacc[q] = (f32x4){bflo(w[0]), bfhi(w[0]), bflo(w[1]), bfhi(w[1])}; }
#pragma unroll 1
    for (int rnd = 0; rnd < 6; ++rnd) {
        LAS bf16_t* Xn = (rnd & 1) ? RB(6) : RB(0); LAS bf16_t* XnT = (rnd & 1) ? RB(8) : RB(1);
        LAS bf16_t* Yn = (rnd & 1) ? RB(0) : RB(6); LAS bf16_t* YnT = (rnd & 1) ? RB(1) : RB(8);
        LAS bf16_t* Pold = (rnd & 1) ? RB(5) : RB(10); LAS bf16_t* Pnew = (rnd & 1) ? RB(10) : RB(5);
        f32x4 sq[4];
        if (rnd < 5) {
#pragma unroll
            for (int n_ = 0; n_ < 4; ++n_) { const int ti = wq + 2 * (n_ & 1); sq[n_] = (n_ < 2) ? mm64(Xn, XnT, ti, tj, Z4, lane) : mm64(XnT, Xn, ti, tj, Z4, lane); } }
        if (rnd > 0) {
#pragma unroll
            for (int q = 0; q < 2; ++q) pacc[q] = mm64(XnT, Pold, wq + 2 * q, tj, pacc[q], lane); }
        if (rnd < 5) {
#pragma unroll
            for (int n_ = 0; n_ < 4; ++n_) storeT((n_ < 2) ? YnT : Yn, wq + 2 * (n_ & 1), tj, sq[n_], lane); }
        if (rnd > 0) {
#pragma unroll
            for (int q = 0; q < 2; ++q) storeT(Pnew, wq + 2 * q, tj, pacc[q], lane); }
        LDS_BARRIER();
    }
    LAS bf16_t* Tm = RB(10);
    LAS bf16_t* AhT = RB(0); LAS bf16_t* W1T = RB(1); LAS bf16_t* UlT = RB(6);
    { f32x4 res[4];
#pragma unroll
      for (int n_ = 0; n_ < 4; ++n_) { const int ti = wq + 2 * (n_ & 1); res[n_] = (n_ < 2) ? mm64(Tm, AtT, ti, tj, Z4, lane) : mm64(Aak, VT, ti, tj, Z4, lane); }
#pragma unroll
      for (int n_ = 0; n_ < 4; ++n_) storeT((n_ < 2) ? AhT : W1T, wq + 2 * (n_ & 1), tj, res[n_], lane); }
    LDS_BARRIER();
    { f32x4 res[2];
#pragma unroll
      for (int n_ = 0; n_ < 2; ++n_) res[n_] = mm64(Tm, W1T, wq + 2 * n_, tj, Z4, lane);
#pragma unroll
      for (int n_ = 0; n_ < 2; ++n_) storeT(UlT, wq + 2 * n_, tj, res[n_], lane); }
    LDS_BARRIER();
    bf16_t* gM = (bf16_t*)(C.ws + WS_RWM) + (size_t)ch * 4096; bf16_t* gNT = (bf16_t*)(C.ws + WS_RWNT) + (size_t)ch * 4096; bf16_t* gQ = (bf16_t*)(C.ws + WS_RWQH) + (size_t)ch * 4096; bf16_t* gY = (bf16_t*)(C.ws + WS_RWYL) + (size_t)ch * 4096;
#pragma unroll
    for (int n_ = 0; n_ < 8; ++n_) { const int o = n_ >> 1, ti = wq + 2 * (n_ & 1); const int rho = 16 * tj + r, kap = 16 * ti + 4 * g;
        if (o == 0) {
            const u32x2 w = *(const LAS u32x2*)(Rt + rho * LD + kap); f32x4 v = (f32x4){bflo(w[0]), bfhi(w[0]), bflo(w[1]), bfhi(w[1])};
            v = mm64(AhT, Arb, ti, tj, v, lane); *(u32x2*)(gQ + rho * 64 + kap) = (u32x2){pk2(v[0], v[1]), pk2(v[2], v[3])}; }
        else if (o == 1) {
            f32x4 v = mm64(UlT, Arb, ti, tj, Z4, lane); v = mm64(VT, Ark, ti, tj, v, lane); *(u32x2*)(gY + rho * 64 + kap) = (u32x2){pk2(v[0], v[1]), pk2(v[2], v[3])}; }
        else if (o == 2) {
            f32x4 v = mm64(AhT, BtT, ti, tj, Z4, lane); const float gl = gamL[rho];
#pragma unroll
            for (int j = 0; j < 4; ++j) v[j] = gl * (v[j] + ((kap + j == rho) ? 1.0f : 0.f));
            *(u32x2*)(gM + rho * 64 + kap) = (u32x2){pk2(v[0], v[1]), pk2(v[2], v[3])}; }
        else {
            f32x4 v = mm64(BtT, UlT, ti, tj, Z4, lane); v = mm64(KtT, VT, ti, tj, v, lane);
#pragma unroll
            for (int j = 0; j < 4; ++j) v[j] *= gamL[kap + j];
            *(u32x2*)(gNT + rho * 64 + kap) = (u32x2){pk2(v[0], v[1]), pk2(v[2], v[3])}; } }
    LDS_BARRIER();
#undef RB
}

__device__ __forceinline__ void mlb_unit(const Params& P, const Ctx& C, int l, int u) {
    const int tid = C.tid, wave = C.wave, lane = C.lane, r = lane & 15, g = lane >> 4;
    const int hh = u & 3, bcx = u >> 2, b = bcx >> 7, c = bcx & 127; const int tok0 = b * SEQ + c * 64; const int ch = (b * 4 + hh) * 128 + c;
    LAS unsigned char* L = C.lds;
    LAS bf16_t* Qs = (LAS bf16_t*)L; LAS bf16_t* Ks = (LAS bf16_t*)(L + BUFB); LAS bf16_t* KhT = (LAS bf16_t*)(L + 2 * BUFB); LAS bf16_t* Sm = (LAS bf16_t*)(L + 3 * BUFB); LAS bf16_t* VTe = (LAS bf16_t*)(L + 4 * BUFB);
    LAS float* vbc = (LAS float*)(L + 4 * BUFB + 80 * LD * 2); LAS float* vig = vbc + 64; LAS float* vmd = vig + 64; LAS float* vws = vmd + 64;
    const bf16_t* p = (const bf16_t*)(C.ws + WS_P);
    unsigned xr[19], vr[8];
    { const int cq = tid & 127, tg = tid >> 7, isk = cq >> 6, d = cq & 63; const int col = 2048 + isk * 256 + hh * 64 + d; const int t0 = 16 * tg; const bool okp = (c * 64 + t0 > 0);
#pragma unroll
      for (int k = 0; k < 19; ++k) xr[k] = p[(size_t)(tok0 + ((k < 3 && !okp) ? 0 : t0 + k - 3)) * NPROJ + col];
      const int v = tid & 63, sg = tid >> 6;
#pragma unroll
      for (int k = 0; k < 8; ++k) vr[k] = p[(size_t)(tok0 + 8 * sg + k) * NPROJ + 2560 + hh * 64 + v]; }
    if (wave == 0) { const float* pg = (const float*)(C.ws + WS_PG) + (size_t)(tok0 + lane) * 8; const float ig = pg[hh], f = pg[4 + hh];
        const float lf = fminf(f, 0.f) - __logf(1.0f + __expf(-fabsf(f)));
        float bcv = lf;
#pragma unroll
        for (int o = 1; o < 64; o <<= 1) { const float t = __shfl_up(bcv, o); bcv += (lane >= o) ? t : 0.f; }
        float pm = ig - bcv;
#pragma unroll
        for (int o = 1; o < 64; o <<= 1) { const float t = __shfl_up(pm, o); pm = (lane >= o) ? fmaxf(pm, t) : pm; }
        const float md = bcv + pm; const float bcL = __shfl(bcv, 63); const float as = bcL - bcv + ig; const float mloc = wave_max(as); const float ws = __expf(as - mloc);
        vbc[lane] = bcv; vig[lane] = ig; vmd[lane] = md; vws[lane] = ws;
        float* vec = (float*)(C.ws + WS_MLVEC) + ((size_t)ch * 64 + lane) * 2; vec[0] = bcv; vec[1] = md;
        if (lane == 0) { float* sc = (float*)(C.ws + WS_MLSC) + (size_t)ch * 2; sc[0] = bcL; sc[1] = mloc; } }
    LDS_BARRIER();
    { const int cq = tid & 127, tg = tid >> 7, isk = cq >> 6, d = cq & 63; const int col = 2048 + isk * 256 + hh * 64 + d; const int cw = isk * 256 + hh * 64 + d;
      const float* cwp = P.in[I_CONVW] + (size_t)l * 4 * 512; const float w0 = cwp[cw], w1 = cwp[512 + cw], w2 = cwp[1024 + cw], w3 = cwp[1536 + cw], cb = P.in[I_CONVB][l * 512 + cw];
      float xm3 = 0.f, xm2 = 0.f, xm1 = 0.f; const int t0 = 16 * tg;
      if (c * 64 + t0 > 0) { xm3 = bf2f((unsigned short)xr[0]); xm2 = bf2f((unsigned short)xr[1]); xm1 = bf2f((unsigned short)xr[2]); }
      float o16[16];
#pragma unroll
      for (int k = 0; k < 16; ++k) { const float x0 = bf2f((unsigned short)xr[k + 3]); const float y = w0 * xm3 + w1 * xm2 + w2 * xm1 + w3 * x0 + cb; const float s = y * sigmoidf_(y);
          o16[k] = isk ? s * 0.125f : s; xm3 = xm2; xm2 = xm1; xm1 = x0; }
      if (!isk) { bf16_t* gq = (bf16_t*)(C.ws + WS_MLQ) + (size_t)ch * 4096;
#pragma unroll
          for (int k = 0; k < 16; ++k) { const bf16_t v = (bf16_t)f2bf(o16[k]); Qs[(t0 + k) * LD + d] = v; gq[(t0 + k) * 64 + d] = v; } }
      else {
#pragma unroll
          for (int k = 0; k < 16; ++k) { Ks[(t0 + k) * LD + d] = (bf16_t)f2bf(o16[k]); o16[k] *= vws[t0 + k]; }
          *(LAS u32x4*)(KhT + d * LD + t0) = (u32x4){pk2(o16[0], o16[1]), pk2(o16[2], o16[3]), pk2(o16[4], o16[5]), pk2(o16[6], o16[7])};
          *(LAS u32x4*)(KhT + d * LD + t0 + 8) = (u32x4){pk2(o16[8], o16[9]), pk2(o16[10], o16[11]), pk2(o16[12], o16[13]), pk2(o16[14], o16[15])}; }
      { const int v = tid & 63, sg = tid >> 6; float vv[8];
#pragma unroll
        for (int k = 0; k < 8; ++k) vv[k] = bf2f((unsigned short)vr[k]);
        *(LAS u32x4*)(VTe + v * LD + 8 * sg) = (u32x4){pk2(vv[0], vv[1]), pk2(vv[2], vv[3]), pk2(vv[4], vv[5]), pk2(vv[6], vv[7])}; }
      if (tid < 128) { const int row = 64 + (tid >> 3), pc = tid & 7; const unsigned one2 = 0x3f803f80u; const unsigned val = (row == 64) ? one2 : 0u; *(LAS u32x4*)(VTe + row * LD + 8 * pc) = (u32x4){val, val, val, val}; }
    }
    LDS_BARRIER();
    const f32x4 Z4 = (f32x4){0.f, 0.f, 0.f, 0.f};
    bf16_t* gKL = (bf16_t*)(C.ws + WS_MLKL) + (size_t)ch * 5120; bf16_t* gNL = (bf16_t*)(C.ws + WS_MLNL) + (size_t)ch * 5120;
    for (int task = wave; task < 36; task += 8) {
        if (task < 16) { const int ti = task >> 2, tj = task & 3; f32x4 v = mm64(Ks, Qs, ti, tj, Z4, lane);
            const int rho = 16 * tj + r, kap = 16 * ti + 4 * g; const float bl = vbc[rho] - vmd[rho];
#pragma unroll
            for (int j = 0; j < 4; ++j) { const int s = kap + j; v[j] = (s <= rho) ? v[j] * __expf(bl - vbc[s] + vig[s]) : 0.f; }
            storeT(Sm, ti, tj, v, lane); }
        else { const int t2 = task - 16, ti = t2 / 5, tj = t2 % 5;
            const f32x4 v = mm64(KhT, VTe, ti, tj, Z4, lane); *(u32x2*)(gKL + (16 * tj + r) * 64 + 16 * ti + 4 * g) = (u32x2){pk2(v[0], v[1]), pk2(v[2], v[3])}; } }
    LDS_BARRIER();
    for (int task = wave; task < 20; task += 8) { const int ti = task >> 2, tj = task & 3; const f32x4 v = mm64(VTe, Sm, ti, tj, Z4, lane); *(u32x2*)(gNL + (16 * tj + r) * 80 + 16 * ti + 4 * g) = (u32x2){pk2(v[0], v[1]), pk2(v[2], v[3])}; }
    LDS_BARRIER();
}

__device__ __forceinline__ void rwkv_chain(const Ctx& C, int bh, int vh) {
    const int tid = C.tid, wave = C.wave, lane = C.lane, r = lane & 15, g = lane >> 4; const size_t ch0 = (size_t)bh * 128;
    LAS unsigned char* L = C.lds; LAS unsigned char* Mb = L; LAS unsigned char* Nb = L + 8 * BUFB; LAS unsigned char* Sb = Nb + 8 * (32 * LD * 2);
    static_assert(8 * BUFB + 8 * 32 * LD * 2 + 8 * 32 * 128 <= MISC_OFF, "chain LDS");
    const bf16_t* gM = (const bf16_t*)(C.ws + WS_RWM) + ch0 * 4096; const bf16_t* gN = (const bf16_t*)(C.ws + WS_RWNT) + ch0 * 4096 + (size_t)vh * 32 * 64; bf16_t* gS = (bf16_t*)(C.ws + WS_RWS) + ch0 * 4096;
    u32x4 pmA[8], pnA4[4];
#define CH_LOAD(pm, pn, nbx) do { const bf16_t* m_ = gM + (size_t)(nbx) * 8 * 4096; \
        _Pragma("unroll") for (int i = 0; i < 8; ++i) pm[i] = ((const u32x4*)m_)[tid + 512 * i]; \
        _Pragma("unroll") for (int i = 0; i < 4; ++i) { const int q = tid + 512 * i, chunk = q >> 8, within = q & 255; pn[i] = ((const u32x4*)(gN + ((size_t)(nbx) * 8 + chunk) * 4096))[within]; } } while (0)
#define CH_PUT(pm, pn) do { \
        _Pragma("unroll") for (int i = 0; i < 8; ++i) { const int q = tid + 512 * i, chunk = q >> 9, within = q & 511, row = within >> 3, pc = within & 7; *(LAS u32x4*)(Mb + chunk * BUFB + row * (LD * 2) + pc * 16) = pm[i]; } \
        _Pragma("unroll") for (int i = 0; i < 4; ++i) { const int q = tid + 512 * i, chunk = q >> 8, within = q & 255, row = within >> 3, pc = within & 7; *(LAS u32x4*)(Nb + chunk * (32 * LD * 2) + row * (LD * 2) + pc * 16) = pn[i]; } } while (0)
    CH_LOAD(pmA, pnA4, 0);
    f32x4 acc[4];
#pragma unroll
    for (int t = 0; t < 4; ++t) acc[t] = (f32x4){0.f, 0.f, 0.f, 0.f};
#define CH_FRAGS(cc_, mf_, nf_) do { const LAS unsigned char* mc = Mb + (cc_) * BUFB; const LAS unsigned char* nc = Nb + (cc_) * (32 * LD * 2); \
        _Pragma("unroll") for (int t = 0; t < 4; ++t) { nf_[t] = *(const LAS u32x2*)(nc + (16 * wave + r) * (LD * 2) + (16 * t + 4 * g) * 2); \
            const LAS unsigned char* mp = mc + (16 * t + r) * (LD * 2) + (4 * g) * 2; const u32x2 lo = *(const LAS u32x2*)mp, hi = *(const LAS u32x2*)(mp + 32); mf_[t] = (u32x4){lo[0], lo[1], hi[0], hi[1]}; } } while (0)
#define CH_ONE(cc_, mf_, nf_) do { \
            u32x4 m2[4]; { const LAS unsigned char* mc = Mb + (cc_) * BUFB; \
            _Pragma("unroll") for (int t = 0; t < 4; ++t) { const LAS unsigned char* mp = mc + (16 * t + r) * (LD * 2) + (32 + 4 * g) * 2; const u32x2 lo = *(const LAS u32x2*)mp, hi = *(const LAS u32x2*)(mp + 32); m2[t] = (u32x4){lo[0], lo[1], hi[0], hi[1]}; } } \
            u32x2 pk[4]; \
            _Pragma("unroll") for (int t = 0; t < 4; ++t) pk[t] = (u32x2){pk2(acc[t][0], acc[t][1]), pk2(acc[t][2], acc[t][3])}; \
            LAS unsigned char* sg = Sb + (cc_) * 4096 + (16 * wave + r) * 128 + (4 * g) * 2; \
            _Pragma("unroll") for (int t = 0; t < 4; ++t) *(LAS u32x2*)(sg + 32 * t) = pk[t]; \
            bf16x8 zb[2]; \
            _Pragma("unroll") for (int s = 0; s < 2; ++s) { const u32x4 z = (u32x4){pk[2 * s][0], pk[2 * s][1], pk[2 * s + 1][0], pk[2 * s + 1][1]}; zb[s] = __builtin_bit_cast(bf16x8, z); } \
            _Pragma("unroll") for (int t = 0; t < 4; ++t) { const u32x2 nw = nf_[t]; const f32x4 a0 = (f32x4){bflo(nw[0]), bfhi(nw[0]), bflo(nw[1]), bfhi(nw[1])}; \
                acc[t] = mfma16(__builtin_bit_cast(bf16x8, mf_[t]), zb[0], a0); } \
            _Pragma("unroll") for (int t = 0; t < 4; ++t) acc[t] = mfma16(__builtin_bit_cast(bf16x8, m2[t]), zb[1], acc[t]); } while (0)
#define CH_STEP(nbx) do { if (wave < 2) { u32x4 mf0[4], mf1[4]; u32x2 nf0[4], nf1[4]; CH_FRAGS(0, mf0, nf0); \
        _Pragma("unroll 1") for (int cc = 0; cc < 8; cc += 2) { \
            CH_FRAGS(cc + 1, mf1, nf1); CH_ONE(cc, mf0, nf0); \
            if (cc + 2 < 8) CH_FRAGS(cc + 2, mf0, nf0); CH_ONE(cc + 1, mf1, nf1); } } } while (0)
#define CH_SOUT(nbx) do { _Pragma("unroll") for (int i = 0; i < 4; ++i) { const int q = tid + 512 * i, chunk = q >> 8, within = q & 255, row = within >> 3, pc = within & 7; \
        const u32x4 v = *(const LAS u32x4*)(Sb + chunk * 4096 + row * 128 + pc * 16); *(u32x4*)(gS + ((size_t)(nbx) * 8 + chunk) * 4096 + (32 * vh + row) * 64 + pc * 8) = v; } } while (0)
    for (int nb = 0; nb < 16; ++nb) {
        LDS_BARRIER(); if (nb > 0) CH_SOUT(nb - 1); CH_PUT(pmA, pnA4); LDS_BARRIER();
        if (nb + 1 < 16) CH_LOAD(pmA, pnA4, nb + 1);
        CH_STEP(nb);
    }
    LDS_BARRIER(); CH_SOUT(15);
#undef CH_SOUT
#undef CH_LOAD
#undef CH_PUT
#undef CH_STEP
#undef CH_FRAGS
#undef CH_ONE
}
__device__ __forceinline__ void mlstm_cscan(const Ctx& C, int bh, int part) {
    const int tid = C.tid; const size_t ch0 = (size_t)bh * 128; const int e0 = 10 * (part * 128 + (tid & 127));
    const bf16_t* KL = (const bf16_t*)(C.ws + WS_MLKL) + ch0 * 5120 + e0; bf16_t* CT = (bf16_t*)(C.ws + WS_MLCT) + ch0 * 5120 + e0; float* MM = (float*)(C.ws + WS_MLM) + ch0; const float* SC = (const float*)(C.ws + WS_MLSC) + ch0 * 2;
    float st[10]; unsigned ring[8][5]; float m = 0.f;
    LAS float* scl = (LAS float*)C.lds; if (tid < 256) scl[tid] = SC[tid];
    __syncthreads();
    if (tid >= 128) return;
#pragma unroll
    for (int i = 0; i < 10; ++i) st[i] = 0.f;
#pragma unroll
    for (int k = 0; k < 8; ++k)
#pragma unroll
        for (int i = 0; i < 5; ++i) ring[k][i] = *(const unsigned*)(KL + (size_t)k * 5120 + 2 * i);
    for (int c0 = 0; c0 < 128; c0 += 8) {
#pragma unroll
        for (int k = 0; k < 8; ++k) { const int c = c0 + k; unsigned cur[5];
#pragma unroll
            for (int i = 0; i < 5; ++i) cur[i] = ring[k][i];
            if (c + 8 < 128) {
#pragma unroll
                for (int i = 0; i < 5; ++i) ring[k][i] = *(const unsigned*)(KL + (size_t)(c + 8) * 5120 + 2 * i); }
            const float bcL = scl[2 * c], mloc = scl[2 * c + 1];
            unsigned* ct = (unsigned*)(CT + (size_t)c * 5120);
#pragma unroll
            for (int i = 0; i < 5; ++i) ct[i] = pk2(st[2 * i], st[2 * i + 1]);
            if (tid == 0 && part == 0) MM[c] = m;
            const float mn = fmaxf(bcL + m, mloc); const float dec = __expf(bcL + m - mn), sc = __expf(mloc - mn); m = mn;
#pragma unroll
            for (int i = 0; i < 5; ++i) { st[2 * i] = dec * st[2 * i] + sc * bflo(cur[i]); st[2 * i + 1] = dec * st[2 * i + 1] + sc * bfhi(cur[i]); } }
    }
}

__device__ __forceinline__ void passd_unit(const Params& P, const Ctx& C, int l, int u) {
    const int wave = C.wave, lane = C.lane, r = lane & 15, g = lane >> 4; const int b = u >> 7, c = u & 127; const int tok0 = b * SEQ + c * 64;
    bf16_t* ymix = (bf16_t*)(C.ws + WS_YMIX);
    {
        bf16x8 qf[3][2], sf[3][4][2]; u32x2 yl[3][4], bo[3][4], gg[3][4];
#pragma unroll
        for (int n_ = 0; n_ < 3; ++n_) { const int task = wave + 8 * n_, h = task >> 2, tb = task & 3; const size_t ch = (size_t)(b * 6 + h) * 128 + c; const int t = 16 * tb + r; const int tok = tok0 + t;
            const bf16_t* gS = (const bf16_t*)(C.ws + WS_RWS) + ch * 4096; const bf16_t* gQ = (const bf16_t*)(C.ws + WS_RWQH) + ch * 4096 + t * 64 + 8 * g; const bf16_t* gY = (const bf16_t*)(C.ws + WS_RWYL) + ch * 4096 + t * 64 + 4 * g;
            const bf16_t* aux = (const bf16_t*)(C.ws + WS_RWAUX) + (size_t)tok * 768 + 64 * h + 4 * g;
            qf[n_][0] = *(const bf16x8*)gQ; qf[n_][1] = *(const bf16x8*)(gQ + 32);
#pragma unroll
            for (int ti = 0; ti < 4; ++ti) { const bf16_t* sp = gS + (16 * ti + r) * 64 + 8 * g; sf[n_][ti][0] = *(const bf16x8*)sp; sf[n_][ti][1] = *(const bf16x8*)(sp + 32);
                yl[n_][ti] = *(const u32x2*)(gY + 16 * ti); bo[n_][ti] = *(const u32x2*)(aux + 16 * ti); gg[n_][ti] = *(const u32x2*)(aux + RWD + 16 * ti); } }
#pragma unroll
        for (int n_ = 0; n_ < 3; ++n_) { const int task = wave + 8 * n_, h = task >> 2, tb = task & 3; const int t = 16 * tb + r; const int tok = tok0 + t;
            f32x4 y[4]; float s = 0.f;
#pragma unroll
            for (int ti = 0; ti < 4; ++ti) { const u32x2 yw = yl[n_][ti]; f32x4 a = (f32x4){bflo(yw[0]), bfhi(yw[0]), bflo(yw[1]), bfhi(yw[1])};
                a = mfma16(sf[n_][ti][0], qf[n_][0], a); a = mfma16(sf[n_][ti][1], qf[n_][1], a); y[ti] = a; s += (a[0] + a[1]) + (a[2] + a[3]); }
            s += __shfl_xor(s, 16); s += __shfl_xor(s, 32); const float mean = s * (1.f / 64.f); float s2 = 0.f;
#pragma unroll
            for (int ti = 0; ti < 4; ++ti) { y[ti] = y[ti] - mean; s2 += (y[ti][0] * y[ti][0] + y[ti][1] * y[ti][1]) + (y[ti][2] * y[ti][2] + y[ti][3] * y[ti][3]); }
            s2 += __shfl_xor(s2, 16); s2 += __shfl_xor(s2, 32); const float rstd = rsqrtf(s2 * (1.f / 64.f) + 64e-5f);
            bf16_t* yo = ymix + (size_t)tok * DM + 64 * h + 4 * g;
            const float* lw = P.in[I_LNW] + l * RWD + 64 * h + 4 * g; const float* lb = P.in[I_LNB] + l * RWD + 64 * h + 4 * g;
#pragma unroll
            for (int ti = 0; ti < 4; ++ti) { const u32x2 bo_ = bo[n_][ti], gg_ = gg[n_][ti]; const f32x4 w4 = *(const f32x4*)(lw + 16 * ti), b4 = *(const f32x4*)(lb + 16 * ti);
                const float o0 = (y[ti][0] * rstd * w4[0] + b4[0] + bflo(bo_[0])) * bflo(gg_[0]), o1 = (y[ti][1] * rstd * w4[1] + b4[1] + bfhi(bo_[0])) * bfhi(gg_[0]);
                const float o2 = (y[ti][2] * rstd * w4[2] + b4[2] + bflo(bo_[1])) * bflo(gg_[1]), o3 = (y[ti][3] * rstd * w4[3] + b4[3] + bfhi(bo_[1])) * bfhi(gg_[1]);
                *(u32x2*)(yo + 16 * ti) = (u32x2){pk2(o0, o1), pk2(o2, o3)}; } }
    }
    {
        bf16x8 qf[2][2], cf[2][5][2]; u32x2 nl[2][5], og[2][4]; float bcl[2], mdl[2], mcv[2];
#pragma unroll
        for (int n_ = 0; n_ < 2; ++n_) { const int task = wave + 8 * (n_ + 3), hh = (task - 24) >> 2, tb = task & 3; const size_t ch = (size_t)(b * 4 + hh) * 128 + c; const int t = 16 * tb + r; const int tok = tok0 + t;
            const bf16_t* gC = (const bf16_t*)(C.ws + WS_MLCT) + ch * 5120; const bf16_t* gQ = (const bf16_t*)(C.ws + WS_MLQ) + ch * 4096 + t * 64 + 8 * g; const bf16_t* gNL = (const bf16_t*)(C.ws + WS_MLNL) + ch * 5120 + t * 80 + 4 * g;
            const bf16_t* ogp = (const bf16_t*)(C.ws + WS_P) + (size_t)tok * NPROJ + 2816 + 64 * hh + 4 * g;
            qf[n_][0] = *(const bf16x8*)gQ; qf[n_][1] = *(const bf16x8*)(gQ + 32);
            const float* vec = (const float*)(C.ws + WS_MLVEC) + (ch * 64 + t) * 2; bcl[n_] = vec[0]; mdl[n_] = vec[1]; mcv[n_] = ((const float*)(C.ws + WS_MLM))[ch];
#pragma unroll
            for (int ti = 0; ti < 5; ++ti) { const bf16_t* cp = gC + (16 * ti + r) * 64 + 8 * g; cf[n_][ti][0] = *(const bf16x8*)cp; cf[n_][ti][1] = *(const bf16x8*)(cp + 32); nl[n_][ti] = *(const u32x2*)(gNL + 16 * ti); }
#pragma unroll
            for (int ti = 0; ti < 4; ++ti) og[n_][ti] = *(const u32x2*)(ogp + 16 * ti); }
#pragma unroll
        for (int n_ = 0; n_ < 2; ++n_) { const int task = wave + 8 * (n_ + 3), hh = (task - 24) >> 2, tb = task & 3; const int t = 16 * tb + r; const int tok = tok0 + t;
            const float mint = bcl[n_] + mcv[n_], mt = fmaxf(mint, mdl[n_]); const float inter = __expf(mint - mt), fl = __expf(mdl[n_] - mt);
            f32x4 y[5];
#pragma unroll
            for (int ti = 0; ti < 5; ++ti) { f32x4 a = (f32x4){0.f, 0.f, 0.f, 0.f};
                a = mfma16(cf[n_][ti][0], qf[n_][0], a); a = mfma16(cf[n_][ti][1], qf[n_][1], a); const u32x2 nw = nl[n_][ti]; const f32x4 nlv = (f32x4){bflo(nw[0]), bfhi(nw[0]), bflo(nw[1]), bfhi(nw[1])}; y[ti] = fl * nlv + inter * a; }
            const float nq = __shfl(y[4][0], r);
            const float inv = 1.0f / fmaxf(fabsf(nq), __expf(-mt));
            float s = 0.f;
#pragma unroll
            for (int ti = 0; ti < 4; ++ti) { y[ti] = y[ti] * inv; s += (y[ti][0] + y[ti][1]) + (y[ti][2] + y[ti][3]); }
            s += __shfl_xor(s, 16); s += __shfl_xor(s, 32); const float mean = s * (1.f / 64.f); float s2 = 0.f;
#pragma unroll
            for (int ti = 0; ti < 4; ++ti) { y[ti] = y[ti] - mean; s2 += (y[ti][0] * y[ti][0] + y[ti][1] * y[ti][1]) + (y[ti][2] * y[ti][2] + y[ti][3] * y[ti][3]); }
            s2 += __shfl_xor(s2, 16); s2 += __shfl_xor(s2, 32); const float rstd = rsqrtf(s2 * (1.f / 64.f) + 1e-6f);
            bf16_t* yo = ymix + (size_t)tok * DM + 768 + 64 * hh + 4 * g; const float* nw = P.in[I_MLNW] + l * 256 + 64 * hh + 4 * g;
#pragma unroll
            for (int ti = 0; ti < 4; ++ti) { const u32x2 oo = og[n_][ti]; const f32x4 w4 = *(const f32x4*)(nw + 16 * ti);
                const float o0 = y[ti][0] * rstd * w4[0] * sigmoidf_(bflo(oo[0])), o1 = y[ti][1] * rstd * w4[1] * sigmoidf_(bfhi(oo[0])), o2 = y[ti][2] * rstd * w4[2] * sigmoidf_(bflo(oo[1])), o3 = y[ti][3] * rstd * w4[3] * sigmoidf_(bfhi(oo[1]));
                *(u32x2*)(yo + 16 * ti) = (u32x2){pk2(o0, o1), pk2(o2, o3)}; } }
    }
}

__device__ __forceinline__ void ln1_router_phase(const Params& P, const Ctx& C, int l, int cnt_off) {
    const int tid = C.tid, wave = C.wave, lane = C.lane, r = lane & 15, g = lane >> 4;
    constexpr int HS = 1032;
    LAS bf16_t* hhi = (LAS bf16_t*)C.lds;
    LAS bf16_t* hlo = hhi + 16 * HS;
    LAS float* part = (LAS float*)(hlo + 16 * HS);
    LAS int* lcnt = (LAS int*)(part + 8 * 8 * 32);
    bf16x8 bh[4][2], bl[4][2];
#pragma unroll
    for (int ks = 0; ks < 4; ++ks)
#pragma unroll
        for (int nt = 0; nt < 2; ++nt) { const size_t off = ((size_t)l * NEXP + 16 * nt + r) * DM + 32 * (4 * wave + ks) + 8 * g;
            bh[ks][nt] = *(const bf16x8*)((const bf16_t*)(C.ws + WS_WRH) + off); bl[ks][nt] = *(const bf16x8*)((const bf16_t*)(C.ws + WS_WRL) + off); }
    for (int i = tid; i < 16 * HS; i += 512) { hhi[i] = 0; hlo[i] = 0; }
    if (tid < 32) lcnt[tid] = 0;
    { int* pdest = (int*)(C.ws + WS_PDEST); int* ptok = (int*)(C.ws + WS_PTOK); for (int i = C.blk * 512 + tid; i < POS_MAX; i += C.G * 512) { pdest[i] = -1; ptok[i] = 0; } }
    __syncthreads();
    const int tpb = (MTOK + C.G - 1) / C.G, tok_lo = C.blk * tpb, tok_hi = (tok_lo + tpb < MTOK) ? tok_lo + tpb : MTOK;
    const bf16_t* t1 = (const bf16_t*)(C.ws + WS_T1); bf16_t* hb = (bf16_t*)(C.ws + WS_HB);
    int* toke = (int*)(C.ws + WS_TOKE); float* tokg = (float*)(C.ws + WS_TOKG); int* toklr = (int*)(C.ws + WS_TOKLR);
    const f32x4* lw4 = (const f32x4*)(P.in[I_LN1W] + (size_t)l * DM) + lane; const f32x4* lb4 = (const f32x4*)(P.in[I_LN1B] + (size_t)l * DM) + lane;
    u32x2 vn[4], rn[4];
    { const int tok = tok_lo + wave; const size_t ro = (size_t)((tok < tok_hi) ? tok : tok_lo) * DM; const u32x2* xr = (const u32x2*)(t1 + ro) + lane; const u32x2* rr = (const u32x2*)(hb + ro) + lane;
#pragma unroll
      for (int j = 0; j < 4; ++j) { vn[j] = xr[64 * j]; rn[j] = rr[64 * j]; } }
    const float rbias = P.in[I_RB][l * NEXP + (lane & 31)];
    f32x4 lwr[4], lbr[4];
#pragma unroll
    for (int j = 0; j < 4; ++j) { lwr[j] = lw4[64 * j]; lbr[j] = lb4[64 * j]; }
    for (int base = tok_lo; base < tok_hi; base += 8) {
        const int tok = base + wave;
        f32x4 v[4];
#pragma unroll
        for (int j = 0; j < 4; ++j) v[j] = (f32x4){bflo(vn[j][0]), bfhi(vn[j][0]), bflo(vn[j][1]), bfhi(vn[j][1])} + DN_ALPHA * (f32x4){bflo(rn[j][0]), bfhi(rn[j][0]), bflo(rn[j][1]), bfhi(rn[j][1])};
        { const int tn = base + 8 + wave; const size_t ro = (size_t)((tn < tok_hi) ? tn : tok_lo) * DM; const u32x2* xr = (const u32x2*)(t1 + ro) + lane; const u32x2* rr = (const u32x2*)(hb + ro) + lane;
#pragma unroll
          for (int j = 0; j < 4; ++j) { vn[j] = xr[64 * j]; rn[j] = rr[64 * j]; } }
        if (tok < tok_hi) {
            float s = 0.f;
#pragma unroll
            for (int j = 0; j < 4; ++j) s += (v[j][0] + v[j][1]) + (v[j][2] + v[j][3]);
            const float mean = wave_sum(s) * (1.f / DM); float s2 = 0.f;
#pragma unroll
            for (int j = 0; j < 4; ++j) { v[j] = v[j] - mean; s2 += (v[j][0] * v[j][0] + v[j][1] * v[j][1]) + (v[j][2] * v[j][2] + v[j][3] * v[j][3]); }
            const float rstd = rsqrtf(wave_sum(s2) * (1.f / DM) + LN_EPS);
            u32x2* ob = (u32x2*)((cnt_off ? (bf16_t*)(C.ws + WS_HF) : hb) + (size_t)tok * DM) + lane;
#pragma unroll
            for (int j = 0; j < 4; ++j) { const f32x4 y = v[j] * rstd * lwr[j] + lbr[j]; const u32x2 hi = (u32x2){pk2(y[0], y[1]), pk2(y[2], y[3])}; ob[64 * j] = hi;
                const u32x2 lo = (u32x2){pk2(y[0] - bflo(hi[0]), y[1] - bfhi(hi[0])), pk2(y[2] - bflo(hi[1]), y[3] - bfhi(hi[1]))};
                *(LAS u32x2*)(hhi + wave * HS + 4 * (lane + 64 * j)) = hi; *(LAS u32x2*)(hlo + wave * HS + 4 * (lane + 64 * j)) = lo; }
        }
        LDS_BARRIER();
        { f32x4 acc[2]; acc[0] = (f32x4){0.f, 0.f, 0.f, 0.f}; acc[1] = acc[0];
#pragma unroll
          for (int ks = 0; ks < 4; ++ks) { const int ko = r * HS + 32 * (4 * wave + ks) + 8 * g; const bf16x8 ah = *(const LAS bf16x8*)(hhi + ko), al = *(const LAS bf16x8*)(hlo + ko);
#pragma unroll
              for (int nt = 0; nt < 2; ++nt) { acc[nt] = mfma16(ah, bh[ks][nt], acc[nt]); acc[nt] = mfma16(ah, bl[ks][nt], acc[nt]); acc[nt] = mfma16(al, bh[ks][nt], acc[nt]); } }
          if (g < 2) {
#pragma unroll
              for (int nt = 0; nt < 2; ++nt)
#pragma unroll
                  for (int j = 0; j < 4; ++j) part[(wave * 8 + 4 * g + j) * 32 + 16 * nt + r] = acc[nt][j]; } }
        LDS_BARRIER();
        if (tok < tok_hi) { const int ee = lane & 31; float lg = rbias;
#pragma unroll
            for (int w8 = 0; w8 < 8; ++w8) lg += part[(w8 * 8 + wave) * 32 + ee];
            float bv[4]; int bi[4];
#pragma unroll
            for (int rd = 0; rd < 4; ++rd) { float mv = lg; int mi = ee;
#define AM_STEP(CTRL) { const float ov = dpp_mov<CTRL>(mv); const int oi = __builtin_bit_cast(int, dpp_mov<CTRL>(__builtin_bit_cast(float, mi))); const bool take = (ov > mv) || (ov == mv && oi < mi); mv = take ? ov : mv; mi = take ? oi : mi; }
                AM_STEP(0xB1) AM_STEP(0x4E) AM_STEP(0x141) AM_STEP(0x140)
#undef AM_STEP
                { const float m0 = __builtin_bit_cast(float, __builtin_amdgcn_readlane(__builtin_bit_cast(int, mv), 0)), m1 = __builtin_bit_cast(float, __builtin_amdgcn_readlane(__builtin_bit_cast(int, mv), 16));
                  const int i0 = __builtin_amdgcn_readlane(mi, 0), i1 = __builtin_amdgcn_readlane(mi, 16); const bool take = (m1 > m0) || (m1 == m0 && i1 < i0); mv = take ? m1 : m0; mi = take ? i1 : i0; }
                bv[rd] = mv; bi[rd] = mi; lg = (ee == mi) ? -__builtin_inff() : lg; }
            if (lane == 0) { const float e1 = __expf(bv[1] - bv[0]), e2 = __expf(bv[2] - bv[0]), e3 = __expf(bv[3] - bv[0]); const float inv = 1.0f / (1.0f + e1 + e2 + e3);
                const int l0 = __hip_atomic_fetch_add(&lcnt[bi[0]], 1, __ATOMIC_RELAXED, __HIP_MEMORY_SCOPE_WORKGROUP), l1 = __hip_atomic_fetch_add(&lcnt[bi[1]], 1, __ATOMIC_RELAXED, __HIP_MEMORY_SCOPE_WORKGROUP), l2 = __hip_atomic_fetch_add(&lcnt[bi[2]], 1, __ATOMIC_RELAXED, __HIP_MEMORY_SCOPE_WORKGROUP), l3 = __hip_atomic_fetch_add(&lcnt[bi[3]], 1, __ATOMIC_RELAXED, __HIP_MEMORY_SCOPE_WORKGROUP);
                *(int4*)(toke + tok * 4) = make_int4(bi[0], bi[1], bi[2], bi[3]); *(f32x4*)(tokg + tok * 4) = (f32x4){inv, e1 * inv, e2 * inv, e3 * inv}; *(int4*)(toklr + tok * 4) = make_int4(l0, l1, l2, l3); } }
        LDS_BARRIER();
    }
    if (tid < 32) { unsigned* gc = (unsigned*)(C.ws + WS_CTL) + CW_CNT + cnt_off + l * 32 + tid;
        const unsigned bb = __hip_atomic_fetch_add(gc, (unsigned)lcnt[tid], __ATOMIC_RELAXED, __HIP_MEMORY_SCOPE_AGENT);
        ((int*)(C.ws + WS_BBASE))[C.blk * 32 + tid] = (int)bb; }
    __syncthreads();
}
__device__ __forceinline__ void permute_phase(const Params& P, const Ctx& C, int l) {
    const int tid = C.tid, wave = C.wave, lane = C.lane;
    LAS int* pst = (LAS int*)C.lds;
    if (tid == 0) { const unsigned* gc = (const unsigned*)(C.ws + WS_CTL) + CW_CNT + l * 32; int ps = 0;
        for (int e = 0; e < 32; ++e) { pst[e] = ps; ps += ((int)__hip_atomic_load(gc + e, __ATOMIC_RELAXED, __HIP_MEMORY_SCOPE_AGENT) + 255) & ~255; } }
    __syncthreads();
    const int tpb = (MTOK + C.G - 1) / C.G, tok_lo = C.blk * tpb, tok_hi = (tok_lo + tpb < MTOK) ? tok_lo + tpb : MTOK;
    const int* toke = (const int*)(C.ws + WS_TOKE); const float* tokg = (const float*)(C.ws + WS_TOKG); const int* toklr = (const int*)(C.ws + WS_TOKLR); const int* bbase = (const int*)(C.ws + WS_BBASE) + C.blk * 32;
    const bf16_t* hb = (const bf16_t*)(C.ws + WS_HB); bf16_t* xp = (bf16_t*)(C.ws + WS_XPERM); int* pdest = (int*)(C.ws + WS_PDEST); float* pgate = (float*)(C.ws + WS_PGATE);
    int* ptok = (int*)(C.ws + WS_PTOK);
    for (int a = tid; a < 4 * (tok_hi - tok_lo); a += 512) { const int tok = tok_lo + (a >> 2), as = tok * 4 + (a & 3);
        const int e = toke[as]; const int pos = pst[e] + bbase[e] + toklr[as];
        pdest[pos] = as; pgate[pos] = tokg[as]; ptok[pos] = tok; }
    __syncthreads();
}
__device__ __forceinline__ void build_tile_e(const Ctx& C, int l) {
    LAS int* te = (LAS int*)(C.lds + TILEE_OFF);
    if (C.tid == 0) { const unsigned* gc = (const unsigned*)(C.ws + WS_CTL) + CW_CNT + l * 32; int t = 0;
        for (int e = 0; e < 32; ++e) { const int nt = ((int)__hip_atomic_load(gc + e, __ATOMIC_RELAXED, __HIP_MEMORY_SCOPE_AGENT) + 255) >> 8; for (int k = 0; k < nt && t < NT_MAX; ++k) te[t++] = e; }
        for (; t < NT_MAX; ++t) te[t] = 0; }
    __syncthreads();
}
__device__ __forceinline__ void combine_ln2_phase(const Params& P, const Ctx& C, int l, int dummy = 0) {
    const int lane = C.lane; const int gw = C.blk * 8 + C.wave, NGW = C.G * 8;
    const bool last = (l == NLAYER - 1);
    LAS float* wg = (LAS float*)C.lds;
    if (!last) load_wg(wg, P.in[I_WIN] + (size_t)(l + 1) * DM * CIN, C.tid);
    const bf16_t* yb = (const bf16_t*)(C.ws + WS_YB);
    float* hf = P.out; bf16_t* hb = (bf16_t*)(C.ws + WS_HB); float* pg = (float*)(C.ws + WS_PG);
    const f32x4* lw4 = (const f32x4*)(P.in[I_LN2W] + (size_t)l * DM) + lane; const f32x4* lb4 = (const f32x4*)(P.in[I_LN2B] + (size_t)l * DM) + lane;
    u32x2 nh[4], ny[4][4];
    f32x4 lwr[4], lbr[4];
    const float bgv = last ? 0.f : P.in[I_BIN][(size_t)(l + 1) * CIN + NPROJ + (lane & 7)];
#pragma unroll
    for (int j = 0; j < 4; ++j) { lwr[j] = lw4[64 * j]; lbr[j] = lb4[64 * j]; }
    { const int tok = (gw < MTOK) ? gw : 0; const u32x2* xr = (const u32x2*)(hb + (size_t)tok * DM) + lane;
#pragma unroll
      for (int j = 0; j < 4; ++j) nh[j] = xr[64 * j];
#pragma unroll
      for (int sl = 0; sl < 4; ++sl) { const u32x2* yr = (const u32x2*)(yb + (size_t)(tok * 4 + sl) * DM) + lane;
#pragma unroll
          for (int j = 0; j < 4; ++j) ny[sl][j] = yr[64 * j]; } }
    for (int tok = gw; tok < MTOK; tok += NGW) {
        f32x4 v[4]; float s = 0.f;
#pragma unroll
        for (int j = 0; j < 4; ++j) { v[j] = (f32x4){bflo(nh[j][0]), bfhi(nh[j][0]), bflo(nh[j][1]), bfhi(nh[j][1])} * DN_ALPHA;
#pragma unroll
            for (int sl = 0; sl < 4; ++sl) { const u32x2 w = ny[sl][j]; v[j][0] += bflo(w[0]); v[j][1] += bfhi(w[0]); v[j][2] += bflo(w[1]); v[j][3] += bfhi(w[1]); } }
        { const int tn = (tok + NGW < MTOK) ? tok + NGW : tok; const u32x2* xr = (const u32x2*)(hb + (size_t)tn * DM) + lane;
#pragma unroll
          for (int j = 0; j < 4; ++j) nh[j] = xr[64 * j];
#pragma unroll
          for (int sl = 0; sl < 4; ++sl) { const u32x2* yr = (const u32x2*)(yb + (size_t)(tn * 4 + sl) * DM) + lane;
#pragma unroll
              for (int j = 0; j < 4; ++j) ny[sl][j] = yr[64 * j]; } }
#pragma unroll
        for (int j = 0; j < 4; ++j) s += (v[j][0] + v[j][1]) + (v[j][2] + v[j][3]);
        const float mean = wave_sum(s) * (1.f / DM); float s2 = 0.f;
#pragma unroll
        for (int j = 0; j < 4; ++j) { v[j] = v[j] - mean; s2 += (v[j][0] * v[j][0] + v[j][1] * v[j][1]) + (v[j][2] * v[j][2] + v[j][3] * v[j][3]); }
        const float rstd = rsqrtf(wave_sum(s2) * (1.f / DM) + LN_EPS);
#pragma unroll
        for (int j = 0; j < 4; ++j) v[j] = v[j] * rstd * lwr[j] + lbr[j];
        if (last) { f32x4* of = (f32x4*)(hf + (size_t)tok * DM) + lane;
#pragma unroll
            for (int j = 0; j < 4; ++j) of[64 * j] = v[j]; }
        if (!last) { u32x2* ob = (u32x2*)((dummy ? (bf16_t*)(C.ws + WS_HF) : hb) + (size_t)tok * DM) + lane;
#pragma unroll
            for (int j = 0; j < 4; ++j) ob[64 * j] = (u32x2){pk2(v[j][0], v[j][1]), pk2(v[j][2], v[j][3])};
            gate_cols(v, wg, bgv, pg + (size_t)tok * 8, lane); }
    }
}

typedef const __attribute__((address_space(4))) Params* CParamsPtr;
__device__ __forceinline__ const Params* kparams() {
    const unsigned long long a = (unsigned long long)__builtin_amdgcn_kernarg_segment_ptr(); unsigned lo = (unsigned)a, hi = (unsigned)(a >> 32);
    asm volatile("" : "+v"(lo), "+v"(hi));
    lo = __builtin_amdgcn_readfirstlane(lo); hi = __builtin_amdgcn_readfirstlane(hi);
    return (const Params*)(CParamsPtr)(((unsigned long long)hi << 32) | lo);
}
__device__ __forceinline__ Ctx make_ctx(const Params& P, LAS unsigned char* lds, int wv0) {
    Ctx C; C.lds = lds; unsigned ones_ = ~0u; asm volatile("" : "+s"(ones_)); int t_ = wv0 * 64 + (int)__builtin_amdgcn_mbcnt_hi(ones_, __builtin_amdgcn_mbcnt_lo(ones_, 0u)), b_ = blockIdx.x, g_ = gridDim.x; asm volatile("" : "+v"(t_), "+v"(b_), "+v"(g_)); b_ = __builtin_amdgcn_readfirstlane(b_); g_ = __builtin_amdgcn_readfirstlane(g_);
    C.tid = t_; C.lane = C.tid & 63; C.wave = __builtin_amdgcn_readfirstlane(C.tid >> 6); C.blk = b_; C.G = g_; C.ws = P.ws; return C; }
__global__ void __launch_bounds__(512, 2) hybrid_fwd(Params Punused) {
    extern __shared__ __attribute__((aligned(16))) unsigned char lds_raw[];
    LAS unsigned char* const lds = (LAS unsigned char*)lds_raw;
    const int wv0 = __builtin_amdgcn_readfirstlane((int)threadIdx.x >> 6);
    volatile LAS unsigned* MISC = (volatile LAS unsigned*)(lds + MISC_OFF);
    for (int u = threadIdx.x; u < (LDS_BYTES - MISC_OFF) / 4; u += 512) MISC[u] = 0u;
    __syncthreads();
    const int lo = __builtin_amdgcn_readfirstlane(kparams()->ph_lo), hi = __builtin_amdgcn_readfirstlane(kparams()->ph_hi);
    #define IS_T0 (wv0 == 0 && __builtin_amdgcn_mbcnt_hi(~0u, __builtin_amdgcn_mbcnt_lo(~0u, 0u)) == 0u)
    if (hi - lo > 1) (void)xcd_barrier_post((unsigned*)(kparams()->ws + WS_CTL) + CW_BAR, MISC + 8, IS_T0);
#ifndef PHMASK
#define PHMASK 0x7ff
#endif
#define PH_EN(k) (((PHMASK) >> (k)) & 1)
#define RUN(gid) ((gid) >= lo && (gid) < hi)
#define SEAM(gid) do { if ((gid) + 1 < hi) { XcdBarrier bar_; bar_.bar = (unsigned*)(kparams()->ws + WS_CTL) + CW_BAR; bar_.x = xb_xcc_id(); bar_.st = (volatile LAS unsigned*)(lds + MISC_OFF) + 8; xcd_barrier(bar_, IS_T0); if (DUPBAR) xcd_barrier(bar_, IS_T0); } } while (0)
#ifndef DUPMASK
#define DUPMASK 0
#endif
#ifndef DUPBAR
#define DUPBAR 0
#endif
#define DUP(k) for (int rep_ = 0; rep_ < 1 + (((DUPMASK) >> (k)) & 1); ++rep_)
#define PHASE_BEGIN const Params& P = *kparams(); const Ctx C = make_ctx(P, lds, wv0);
    if (PH_EN(0) && RUN(0)) { DUP(0) { PHASE_BEGIN p0_prologue(P, C); } SEAM(0); }
#pragma unroll 1
    for (int l = 0; l < NLAYER; ++l) {
        const int g0 = 1 + l * NPH;
        if (g0 + NPH <= lo || g0 >= hi) continue;
        if (PH_EN(1) && RUN(g0 + 0)) {
            DUP(1) { PHASE_BEGIN
            pg8::Gemm g{(const bf16_t*)(C.ws + WS_HB), (const bf16_t*)(C.ws + WS_WIN) + (size_t)l * NPROJ * DM, MTOK, NPROJ, DM}; pg8::StaticOrder S; S.init(MTOK, NPROJ, C.G, C.blk);
            pg8::EpiBf16b E{(bf16_t*)(C.ws + WS_P), NPROJ, P.in[I_BIN] + (size_t)l * CIN};
            pg8::gemm_phase<pg8::EpiBf16b, pg8::StaticOrder>(C.lds, g, S, E, nullptr, C.tid); }
            SEAM(g0 + 0); }
        if (PH_EN(2) && RUN(g0 + 1)) {
            DUP(2) { PHASE_BEGIN
            constexpr int NU_SWA = 512, NU_RW = NB * 128 * 6, NU_ML = NB * 128 * 4;
#ifndef DUP2
#define DUP2 0
#endif
            for (int rp = 0; rp < 1 + ((DUP2 >> 1) & 1); ++rp) for (int cb = C.blk; cb < NB * 128; cb += C.G)
                for (int hh_ = 0; hh_ < 6; ++hh_) { rwb_unit(P, C, l, cb * 6 + hh_, hh_ != 0); if (hh_ == 0) { asm volatile("s_waitcnt vmcnt(0)" ::: "memory"); __syncthreads(); } }
            for (int rp = 0; rp < 1 + ((DUP2 >> 2) & 1); ++rp) for (int u = C.blk; u < NU_ML; u += C.G) mlb_unit(P, C, l, u); }
            SEAM(g0 + 1); }
        if (PH_EN(3) && RUN(g0 + 2)) {
            DUP(3) { PHASE_BEGIN
            {
#ifndef P3DUP
#define P3DUP 0
#endif
                if (C.blk < 48) { for (int rp = 0; rp < 1 + (P3DUP & 1); ++rp) { rwkv_chain(C, C.blk >> 1, C.blk & 1); __syncthreads(); } } else if (C.blk < 112) { for (int rp = 0; rp < 1 + ((P3DUP >> 1) & 1); ++rp) { mlstm_cscan(C, (C.blk - 48) >> 2, (C.blk - 48) & 3); __syncthreads(); } }
#ifndef SWADUP
#define SWADUP 0
#endif
                LAS int* qslot = (LAS int*)(C.lds + MISC_OFF + 64);
                for (int rq = 0; rq < 1 + SWADUP; ++rq) { unsigned* qctr = (unsigned*)(C.ws + WS_CTL) + CW_SWAQ + l * 64 + rq * 32;
                for (;;) { __syncthreads();
                    if (C.tid == 0) *qslot = (int)__hip_atomic_fetch_add(qctr, 1u, __ATOMIC_RELAXED, __HIP_MEMORY_SCOPE_AGENT);
                    __syncthreads();
                    const int u = *qslot; if (u >= 512) break;
                    swa_unit(P, C, l, u); } } } }
            SEAM(g0 + 2); }
        if (PH_EN(4) && RUN(g0 + 3)) {
            DUP(4) { PHASE_BEGIN
            for (int u = C.blk; u < NB * 128; u += C.G) passd_unit(P, C, l, u); }
            SEAM(g0 + 3); }
        if (PH_EN(5) && RUN(g0 + 4)) {
            DUP(5) { PHASE_BEGIN
            pg8::Gemm g{(const bf16_t*)(C.ws + WS_YMIX), (const bf16_t*)(C.ws + WS_WOUT) + (size_t)l * DM * DM, MTOK, DM, DM}; pg8::StaticOrder S; S.init(MTOK, DM, C.G, C.blk);
            pg8::EpiPlainBf16 E{(bf16_t*)(C.ws + WS_T1), DM};
            pg8::gemm_phase<pg8::EpiPlainBf16, pg8::StaticOrder>(C.lds, g, S, E, nullptr, C.tid); }
            SEAM(g0 + 4); }
        if (PH_EN(6) && RUN(g0 + 5)) { DUP(6) { PHASE_BEGIN ln1_router_phase(P, C, l, (rep_ + 1 < 1 + (((DUPMASK) >> 6) & 1)) ? 512 : 0); } SEAM(g0 + 5); }
        if (PH_EN(7) && RUN(g0 + 6)) { DUP(7) { PHASE_BEGIN permute_phase(P, C, l); } SEAM(g0 + 6); }
        if (PH_EN(8) && RUN(g0 + 7)) {
            DUP(8) { PHASE_BEGIN
            build_tile_e(C, l);
            pg8::Gemm g{(const bf16_t*)(C.ws + WS_HB), (const bf16_t*)(C.ws + WS_WUP) + (size_t)l * NEXP * NUP * DM, POS_MAX, NUP, DM};
            pg8::MoeOrder<8> S{(const LAS int*)(C.lds + TILEE_OFF), C.G, C.blk, (const int*)(C.ws + WS_PTOK)};
            pg8::EpiSwiglu E{(bf16_t*)(C.ws + WS_ACT), P.in[I_EBUP] + (size_t)l * NEXP * NUP};
            pg8::gemm_phase<pg8::EpiSwiglu, pg8::MoeOrder<8>, false, true>(C.lds, g, S, E, nullptr, C.tid); }
            SEAM(g0 + 7); }
        if (PH_EN(9) && RUN(g0 + 8)) {
            DUP(9) { PHASE_BEGIN
            build_tile_e(C, l);
            pg8::Gemm g{(const bf16_t*)(C.ws + WS_ACT), (const bf16_t*)(C.ws + WS_WDN) + (size_t)l * NEXP * DM * DEXP, POS_MAX, DM, DEXP};
            pg8::MoeOrder<4> S{(const LAS int*)(C.lds + TILEE_OFF), C.G, C.blk, nullptr};
            pg8::EpiDown E{(bf16_t*)(C.ws + WS_YB), P.in[I_EBDN] + (size_t)l * NEXP * DM, (const int*)(C.ws + WS_PDEST), (const float*)(C.ws + WS_PGATE)};
            pg8::gemm_phase<pg8::EpiDown, pg8::MoeOrder<4>>(C.lds, g, S, E, nullptr, C.tid); }
            SEAM(g0 + 8); }
        if (PH_EN(10) && RUN(g0 + 9)) { DUP(10) { PHASE_BEGIN combine_ln2_phase(P, C, l, (rep_ + 1 < 1 + (((DUPMASK) >> 10) & 1)) ? 1 : 0); } SEAM(g0 + 9); }
    }
#undef RUN
#undef SEAM
}

#ifndef MK_PER_PHASE
#define MK_PER_PHASE 0
#endif
extern "C" void kernel_launch(void* const* d_in, const int* in_sizes, int n_in, void* d_out, int out_size, void* d_ws, size_t ws_size, hipStream_t stream) {
    static int grid = 0;
    if (grid == 0) {
        if (n_in != 29 || out_size != MTOK * DM || ws_size < WS_END) { fprintf(stderr, "kernel_launch: unexpected shapes (n_in %d out %d ws %zu)\n", n_in, out_size, ws_size); grid = -1; return; }
        int dev = 0, cus = 0;
        if (hipGetDevice(&dev) != hipSuccess || hipDeviceGetAttribute(&cus, hipDeviceAttributeMultiprocessorCount, dev) != hipSuccess) { grid = -1; return; }
        if (hipFuncSetAttribute((const void*)hybrid_fwd, hipFuncAttributeMaxDynamicSharedMemorySize, LDS_BYTES) != hipSuccess) { fprintf(stderr, "kernel_launch: hipFuncSetAttribute failed\n"); grid = -1; return; }
        int per_cu = 0;
        if (hipOccupancyMaxActiveBlocksPerMultiprocessor(&per_cu, (const void*)hybrid_fwd, 512, LDS_BYTES) != hipSuccess || per_cu < 1) { fprintf(stderr, "kernel_launch: occupancy query says %d\n", per_cu); }
        (void)hipGetLastError();
        grid = cus;
    }
    if (grid < 0) return;
    (void)hipMemsetAsync((char*)d_ws + WS_CTL, 0, CTL_ZERO_BYTES, stream);
    Params p; memset(&p, 0, sizeof(p));
    for (int i = 0; i < 29; ++i) p.in[i] = (const float*)d_in[i];
    p.out = (float*)d_out; p.ws = (unsigned char*)d_ws;
#if MK_PER_PHASE
    for (int ph = 0; ph < NPHASE_TOTAL; ++ph) { p.ph_lo = ph; p.ph_hi = ph + 1; hipLaunchKernelGGL(hybrid_fwd, dim3(grid), dim3(512), LDS_BYTES, stream, p); }
#else
    p.ph_lo = 0; p.ph_hi = NPHASE_TOTAL;
    hipLaunchKernelGGL(hybrid_fwd, dim3(grid), dim3(512), LDS_BYTES, stream, p);
#endif
}
```

```cpp
#include <hip/hip_runtime.h>
#include <cstdio>
#include <cstdint>
#include <cstring>

#define GAS __attribute__((address_space(1)))
#define LAS __attribute__((address_space(3)))
typedef float f32x2 __attribute__((ext_vector_type(2)));
typedef unsigned u32x2 __attribute__((ext_vector_type(2)));

#ifndef PG8_SP2_DEFAULT
#define PG8_SP2_DEFAULT true
#endif
namespace pg8 {
constexpr int EPI_BTAB = 140288, EPI_DTAB = 138240, EPI_GTAB = 139264;
#define PG8_LAS __attribute__((address_space(3)))
typedef unsigned short bf16_t;
typedef short bf16x8 __attribute__((ext_vector_type(8)));
typedef float f32x4 __attribute__((ext_vector_type(4)));
typedef unsigned u32x4 __attribute__((ext_vector_type(4)));
constexpr int BM = 256, BK = 64, HALF = 128, HTB = HALF * BK * 2  , STAGE_BYTES = 8 * HTB, NXCD = 8, WGM = 8;

__host__ __device__ __forceinline__ int lds_byte(int r, int c) { const int st = (r >> 4) * 2 + (c >> 5), rr = r & 15, cc = c & 31, ob = rr * 64 + cc * 2; return st * 1024 + (ob ^ (((ob >> 9) & 1) << 5)); }
__host__ __device__ __forceinline__ void stage_rc(int b, int& R, int& C) { const int st = b / 1024, sb = b % 1024, swz = sb ^ (((sb >> 9) & 1) << 5); R = (st >> 1) * 16 + swz / 64; C = (st & 1) * 32 + (swz % 64) / 2; }
__host__ __device__ __forceinline__ int perm32(int rho) { const int n = rho >> 4, i = rho & 15; return 8 * (i >> 2) + 4 * n + (i & 3); }

struct Unit { int pm, pn; };
struct Gemm { const bf16_t* A; const bf16_t* Bt; int M, N, K; };

struct StaticOrder {
    int nM, nN, nwg, G, c;
    __host__ __device__ void init(int M, int N, int G_, int c_) { nM = M / BM; nN = N / BM; nwg = nM * nN; G = G_; c = c_; }
    __host__ __device__ bool next(int i, Unit& u) const {
        const long L = (long)i * G + c; if (L >= nwg) return false;
        int wgid = (int)L; { const int q = nwg / NXCD, r = nwg % NXCD, xcd = wgid % NXCD, off = wgid / NXCD; wgid = (xcd < r ? xcd * (q + 1) : r * (q + 1) + (xcd - r) * q) + off; }
        const int nig = WGM * nN, gid = wgid / nig, fm = gid * WGM, gsz = (nM - fm) < WGM ? (nM - fm) : WGM;
        u.pm = fm + ((wgid % nig) % gsz); u.pn = (wgid % nig) / gsz; return true;
    }
    __device__ __forceinline__ void a_ready(const Unit&) const {}
    __device__ __forceinline__ void done(const Unit&) const {}
};
template <int NN> struct MoeOrder {
    const PG8_LAS int* tile_e; int G, c; const int* rowtok;
    __device__ __forceinline__ bool next(int i, Unit& u) const {
        const int s = i * G + c; if (s >= 544 * NN) return false;
        constexpr int per = 8 * NN; const int a = s / per, r = s % per, b = r >> 3, x = r & 7;
        const int pm = 68 * x + a; u.pm = pm; u.pn = tile_e[pm] * NN + b; return true;
    }
    __device__ __forceinline__ void a_ready(const Unit&) const {}
    __device__ __forceinline__ void done(const Unit&) const {}
};

__device__ __forceinline__ unsigned cvt_pk_bf16(float lo, float hi) { unsigned r; asm volatile("v_cvt_pk_bf16_f32 %0, %1, %2" : "=v"(r) : "v"(lo), "v"(hi)); return r; }

struct EpiBf16b {
    static constexpr bool PERM = true, AFTER_DRAIN = false;
    bf16_t* O; int ldc; const float* bias;
    __device__ __forceinline__ void prefetch(PG8_LAS unsigned char* lds, const Unit& u, int wid, int lane) const {
        if (wid < 4) __builtin_amdgcn_global_load_lds((const unsigned*)(bias + u.pn * BM + 64 * wid + lane), (PG8_LAS unsigned*)(lds + EPI_BTAB + wid * 256), 4, 0, 0); }
    __device__ __forceinline__ void operator()(const f32x4 (&acc)[2][2][4][2], const Unit& u, int wr, int wc, int fr, int fq, PG8_LAS unsigned char* lds) const {
        const int row0 = u.pm * BM + wr * 64 + fr; const int col0 = u.pn * BM + wc * 32 + 8 * fq;
        const PG8_LAS float* bt = (const PG8_LAS float*)(lds + EPI_BTAB) + wc * 32 + 8 * fq;
        f32x4 bv[2][2];
#pragma unroll
        for (int bj = 0; bj < 2; ++bj)
#pragma unroll
            for (int n = 0; n < 2; ++n) bv[bj][n] = *(const PG8_LAS f32x4*)(bt + bj * HALF + 4 * n);
#pragma unroll
        for (int ai = 0; ai < 2; ++ai)
#pragma unroll
            for (int m = 0; m < 4; ++m) { bf16_t* rowp = O + (size_t)(row0 + ai * HALF + m * 16) * ldc + col0;
#pragma unroll
                for (int bj = 0; bj < 2; ++bj) { const f32x4 v0 = acc[ai][bj][m][0] + bv[bj][0], v1 = acc[ai][bj][m][1] + bv[bj][1];
                    u32x4 w; w.x = cvt_pk_bf16(v0[0], v0[1]); w.y = cvt_pk_bf16(v0[2], v0[3]); w.z = cvt_pk_bf16(v1[0], v1[1]); w.w = cvt_pk_bf16(v1[2], v1[3]);
                    *(u32x4*)(rowp + bj * HALF) = w; } }
    }
};
struct EpiPlainBf16 {
    static constexpr bool PERM = true, AFTER_DRAIN = false;
    bf16_t* O; int ldc;
    __device__ __forceinline__ void prefetch(PG8_LAS unsigned char*, const Unit&, int, int) const {}
    __device__ __forceinline__ void operator()(const f32x4 (&acc)[2][2][4][2], const Unit& u, int wr, int wc, int fr, int fq, PG8_LAS unsigned char*) const {
        const int row0 = u.pm * BM + wr * 64 + fr, col0 = u.pn * BM + wc * 32 + 8 * fq;
#pragma unroll
        for (int ai = 0; ai < 2; ++ai)
#pragma unroll
            for (int m = 0; m < 4; ++m) { bf16_t* rowp = O + (size_t)(row0 + ai * HALF + m * 16) * ldc + col0;
#pragma unroll
                for (int bj = 0; bj < 2; ++bj) { const f32x4 v0 = acc[ai][bj][m][0], v1 = acc[ai][bj][m][1];
                    u32x4 w; w.x = cvt_pk_bf16(v0[0], v0[1]); w.y = cvt_pk_bf16(v0[2], v0[3]); w.z = cvt_pk_bf16(v1[0], v1[1]); w.w = cvt_pk_bf16(v1[2], v1[3]);
                    *(u32x4*)(rowp + bj * HALF) = w; } }
    }
};
struct EpiSwiglu {
    static constexpr bool PERM = true, AFTER_DRAIN = false;
    bf16_t* O; const float* bias;
    __device__ __forceinline__ void prefetch(PG8_LAS unsigned char* lds, const Unit& u, int wid, int lane) const {
        if (wid < 4) __builtin_amdgcn_global_load_lds((const unsigned*)(bias + u.pn * BM + 64 * wid + lane), (PG8_LAS unsigned*)(lds + EPI_BTAB + wid * 256), 4, 0, 0); }
    __device__ __forceinline__ void operator()(const f32x4 (&acc)[2][2][4][2], const Unit& u, int wr, int wc, int fr, int fq, PG8_LAS unsigned char* lds) const {
        const int row0 = u.pm * BM + wr * 64 + fr;
        const int ocol0 = ((u.pn & 7) * BM + wc * 32 + 8 * fq) >> 1;
        const PG8_LAS float* bt = (const PG8_LAS float*)(lds + EPI_BTAB) + wc * 32 + 8 * fq;
        f32x4 bv[2][2];
#pragma unroll
        for (int bj = 0; bj < 2; ++bj)
#pragma unroll
            for (int n = 0; n < 2; ++n) bv[bj][n] = *(const PG8_LAS f32x4*)(bt + bj * HALF + 4 * n);
        const bool oddrow = (fq & 1) != 0;
#pragma unroll
        for (int ai = 0; ai < 2; ++ai)
#pragma unroll
            for (int m = 0; m < 4; ++m) { bf16_t* rowp = O + (size_t)(row0 + ai * HALF + m * 16) * 1024 + ocol0;
                u32x2 w[2];
#pragma unroll
                for (int bj = 0; bj < 2; ++bj) { const f32x4 v0 = acc[ai][bj][m][0] + bv[bj][0], v1 = acc[ai][bj][m][1] + bv[bj][1];
                    float o[4];
#pragma unroll
                    for (int q = 0; q < 4; ++q) { const float gl = (q < 2) ? v0[2 * q] : v1[2 * q - 4], li = (q < 2) ? v0[2 * q + 1] : v1[2 * q - 3];
                        const float hg = fminf(gl, 7.0f), hl = fminf(fmaxf(li, -7.0f), 7.0f);
                        o[q] = hg * (hl + 1.0f) * __builtin_amdgcn_rcpf(1.0f + __expf(-1.702f * hg)); }
                    w[bj].x = cvt_pk_bf16(o[0], o[1]); w[bj].y = cvt_pk_bf16(o[2], o[3]); }
                { auto sx = __builtin_amdgcn_permlane16_swap(w[0].x, w[1].x, false, false); w[0].x = sx[0]; w[1].x = sx[1];
                  auto sy = __builtin_amdgcn_permlane16_swap(w[0].y, w[1].y, false, false); w[0].y = sy[0]; w[1].y = sy[1]; }
                u32x4 wv; wv.x = w[0].x; wv.y = w[0].y; wv.z = w[1].x; wv.w = w[1].y;
                *(u32x4*)(rowp + (oddrow ? (HALF / 2) - 4 : 0)) = wv; }
    }
};
struct EpiDown {
    static constexpr bool PERM = true, AFTER_DRAIN = false;
    bf16_t* O; const float* bias; const int* dest; const float* gate;
    __device__ __forceinline__ void prefetch(PG8_LAS unsigned char* lds, const Unit& u, int wid, int lane) const {
        if (wid < 4) { __builtin_amdgcn_global_load_lds((const unsigned*)(bias + u.pn * BM + 64 * wid + lane), (PG8_LAS unsigned*)(lds + EPI_BTAB + wid * 256), 4, 0, 0);
                       __builtin_amdgcn_global_load_lds((const unsigned*)(dest + u.pm * BM + 64 * wid + lane), (PG8_LAS unsigned*)(lds + EPI_DTAB + wid * 256), 4, 0, 0); }
        else __builtin_amdgcn_global_load_lds((const unsigned*)(gate + u.pm * BM + 64 * (wid - 4) + lane), (PG8_LAS unsigned*)(lds + EPI_GTAB + (wid - 4) * 256), 4, 0, 0); }
    __device__ __forceinline__ void operator()(const f32x4 (&acc)[2][2][4][2], const Unit& u, int wr, int wc, int fr, int fq, PG8_LAS unsigned char* lds) const {
        const int rloc = wr * 64 + fr;
        const int ocol0 = (u.pn & 3) * BM + wc * 32 + 8 * fq;
        const PG8_LAS float* bt = (const PG8_LAS float*)(lds + EPI_BTAB) + wc * 32 + 8 * fq; const PG8_LAS int* dt = (const PG8_LAS int*)(lds + EPI_DTAB); const PG8_LAS float* gtb = (const PG8_LAS float*)(lds + EPI_GTAB);
#pragma unroll
        for (int ai = 0; ai < 2; ++ai)
#pragma unroll
            for (int m = 0; m < 4; ++m) { const int pl = rloc + ai * HALF + m * 16; const int d = dt[pl]; const float gt = gtb[pl];
                if (d >= 0) { bf16_t* rowp = O + (size_t)d * 1024 + ocol0;
#pragma unroll
                    for (int bj = 0; bj < 2; ++bj) { const f32x4 b0 = *(const PG8_LAS f32x4*)(bt + bj * HALF), b1 = *(const PG8_LAS f32x4*)(bt + bj * HALF + 4); const f32x4 v0 = (acc[ai][bj][m][0] + b0) * gt, v1 = (acc[ai][bj][m][1] + b1) * gt;
                        u32x4 w; w.x = cvt_pk_bf16(v0[0], v0[1]); w.y = cvt_pk_bf16(v0[2], v0[3]); w.z = cvt_pk_bf16(v1[0], v1[1]); w.w = cvt_pk_bf16(v1[2], v1[3]);
                        *(u32x4*)(rowp + bj * HALF) = w; } } }
    }
};

template <class Epi, class Sched, bool STAMP = false, bool GATHER = false, bool ALIGN_EPI = true, bool SP2 = PG8_SP2_DEFAULT>
__device__ __forceinline__ void gemm_phase(PG8_LAS unsigned char* lds, const Gemm g, const Sched& S, const Epi& E, unsigned long long* stamps, const int tid_in) {
    const int tid = tid_in, wid = __builtin_amdgcn_readfirstlane(tid >> 6), lane = tid & 63, wr = wid >> 2, wc = wid & 3, fr = lane & 15, fq = lane >> 4;
    const int K = g.K, nt = K / BK;
    int ts_lo = 0, ts_hi = 0, nts = 0; const unsigned long long rt_entry = STAMP ? (unsigned long long)wall_clock64() : 0ull;
#define PG8_STAMP() do { if (STAMP && wid == 0 && nts < 64) { const unsigned long long _c = (unsigned long long)clock64(); \
        ts_lo = (lane == nts) ? (int)(unsigned)_c : ts_lo; ts_hi = (lane == nts) ? (int)(unsigned)(_c >> 32) : ts_hi; ++nts; } } while (0)
    PG8_STAMP();
    unsigned voffA[2], voffB[2];
#pragma unroll
    for (int i = 0; i < 2; ++i) { int R, C; stage_rc(tid * 16 + i * 8192, R, C); const int Rb = Epi::PERM ? ((R & ~31) + perm32(R & 31)) : R;
        voffA[i] = (unsigned)(R * K + C) * 2u; voffB[i] = (unsigned)(Rb * K + C) * 2u; }
    unsigned gc[2][2], gn[2][2];
    PG8_LAS int* rowtab = (PG8_LAS int*)(lds + 137216);
    const size_t kstep = (size_t)(BK * 2);
    const size_t hstep = (size_t)HALF * K * 2;
    const size_t tstep = 2 * hstep;
    const unsigned ldsw = (unsigned)wid * 1024u;
    const int aoff = lds_byte(wr * 64 + fr, fq * 8), boff = lds_byte(wc * 32 + fr, fq * 8);
#define PG8_SA(b, h) (((b) * 2 + (h)) * HTB)
#define PG8_SB(b, h) ((4 + (b) * 2 + (h)) * HTB)
#define PG8_STAGE(bufoff, gbase, voff) do { _Pragma("unroll") for (int _i = 0; _i < 2; ++_i) \
        __builtin_amdgcn_global_load_lds((const unsigned*)((const char*)(gbase) + (voff)[_i]), (PG8_LAS unsigned*)(lds + (bufoff) + ldsw + _i * 8192), 16, 0, 0); } while (0)
#define PG8_LDA(dst, b, h) do { _Pragma("unroll") for (int m = 0; m < 4; ++m) _Pragma("unroll") for (int k = 0; k < 2; ++k) dst[m][k] = *(const PG8_LAS bf16x8*)(lds + PG8_SA(b, h) + aoff + m * 2048 + k * 1024); } while (0)
#define PG8_LDB(dst, b, h) do { _Pragma("unroll") for (int n = 0; n < 2; ++n) _Pragma("unroll") for (int k = 0; k < 2; ++k) dst[n][k] = *(const PG8_LAS bf16x8*)(lds + PG8_SB(b, h) + boff + n * 2048 + k * 1024); } while (0)
#define PG8_MMA(ai, bj, At, Bt) do { __builtin_amdgcn_s_setprio(1); _Pragma("unroll") for (int m = 0; m < 4; ++m) _Pragma("unroll") for (int n = 0; n < 2; ++n) _Pragma("unroll") for (int k = 0; k < 2; ++k) \
        acc[ai][bj][m][n] = __builtin_amdgcn_mfma_f32_16x16x32_bf16(Bt[n][k], At[m][k], acc[ai][bj][m][n], 0, 0, 0); __builtin_amdgcn_s_setprio(0); } while (0)
#define PG8_WAIT_V(n) asm volatile("s_waitcnt vmcnt(" #n ")" ::: "memory")
#define PG8_WAIT_L(n) asm volatile("s_waitcnt lgkmcnt(" #n ")" ::: "memory")
#define PG8_BAR __builtin_amdgcn_s_barrier()
#define PG8_SCHED __builtin_amdgcn_sched_barrier(0)
    Unit cur, nxt; int ui = 0;
    if (!S.next(0, cur)) return;
    f32x4 acc[2][2][4][2];
#pragma unroll
    for (int a = 0; a < 2; ++a)
#pragma unroll
        for (int b = 0; b < 2; ++b)
#pragma unroll
            for (int m = 0; m < 4; ++m)
#pragma unroll
                for (int n = 0; n < 2; ++n) acc[a][b][m][n] = (f32x4){0.f, 0.f, 0.f, 0.f};
    bf16x8 At[4][2], B0[2][2], B1[2][2];
    const char* cA = GATHER ? (const char*)g.A : (const char*)g.A + (size_t)cur.pm * tstep; const char* cB = (const char*)g.Bt + (size_t)cur.pn * tstep;
    if constexpr (GATHER) {
#pragma unroll
        for (int h = 0; h < 2; ++h)
#pragma unroll
            for (int i = 0; i < 2; ++i) { int R, C; stage_rc(tid * 16 + i * 8192, R, C); gc[h][i] = (unsigned)S.rowtok[256 * cur.pm + 128 * h + R] * (unsigned)(K * 2) + (unsigned)(C * 2); gn[h][i] = gc[h][i]; } }
    S.a_ready(cur);
    if constexpr (SP2) {
        PG8_STAGE(PG8_SB(0, 0), cB, voffB); PG8_STAGE(PG8_SB(0, 1), cB + hstep, voffB); if constexpr (GATHER) PG8_STAGE(PG8_SA(0, 0), cA, gc[0]); else PG8_STAGE(PG8_SA(0, 0), cA, voffA); if constexpr (GATHER) PG8_STAGE(PG8_SA(0, 1), cA, gc[1]); else PG8_STAGE(PG8_SA(0, 1), cA + hstep, voffA);
        if (wr == 1) PG8_BAR;
        PG8_WAIT_V(2); PG8_BAR;
        PG8_STAGE(PG8_SB(1, 0), cB + kstep, voffB); if constexpr (GATHER) PG8_STAGE(PG8_SA(1, 0), cA + kstep, gc[0]); else PG8_STAGE(PG8_SA(1, 0), cA + kstep, voffA); PG8_STAGE(PG8_SB(1, 1), cB + hstep + kstep, voffB);
        PG8_WAIT_V(6); PG8_BAR;
    } else {
    PG8_STAGE(PG8_SB(0, 0), cB, voffB); if constexpr (GATHER) PG8_STAGE(PG8_SA(0, 0), cA, gc[0]); else PG8_STAGE(PG8_SA(0, 0), cA, voffA); PG8_STAGE(PG8_SB(0, 1), cB + hstep, voffB); if constexpr (GATHER) PG8_STAGE(PG8_SA(0, 1), cA, gc[1]); else PG8_STAGE(PG8_SA(0, 1), cA + hstep, voffA);
    if (wr == 1) PG8_BAR;
    PG8_WAIT_V(4); PG8_BAR;
    PG8_STAGE(PG8_SB(1, 0), cB + kstep, voffB); if constexpr (GATHER) PG8_STAGE(PG8_SA(1, 0), cA + kstep, gc[0]); else PG8_STAGE(PG8_SA(1, 0), cA + kstep, voffA); PG8_STAGE(PG8_SB(1, 1), cB + hstep + kstep, voffB);
    PG8_WAIT_V(6); PG8_BAR;
    }
    PG8_STAMP();
    for (;;) {
        const bool has_next = S.next(ui + 1, nxt);
        const char* nA = GATHER ? cA : (has_next ? (const char*)g.A + (size_t)nxt.pm * tstep : cA); const char* nB = has_next ? (const char*)g.Bt + (size_t)nxt.pn * tstep : cB;
        for (int t = 0; t < nt; t += 2) {
            const bool last = (t == nt - 2);
            const char* a1 = cA + (size_t)(t + 1) * kstep;
            const char* a2 = last ? nA : cA + (size_t)(t + 2) * kstep; const char* b2 = last ? nB : cB + (size_t)(t + 2) * kstep;
            const char* a3 = a2 + kstep; const char* b3 = b2 + kstep;
            if (last && has_next) S.a_ready(nxt);
            if (t == nt - 4) { int ln_ = lane; asm volatile("" : "+v"(ln_)); E.prefetch(lds, cur, wid, ln_); }
            if constexpr (GATHER) {
                if (t == nt - 4 && has_next && wid < 4)
                    __builtin_amdgcn_global_load_lds((const unsigned*)(S.rowtok + 256 * nxt.pm + 64 * wid + lane), (PG8_LAS unsigned*)((PG8_LAS unsigned char*)rowtab + wid * 256), 4, 0, 0);
                if (last && has_next) { int tz = tid; asm volatile("" : "+v"(tz));
#pragma unroll
                    for (int h = 0; h < 2; ++h)
#pragma unroll
                        for (int i = 0; i < 2; ++i) { int R, C; stage_rc(tz * 16 + i * 8192, R, C); gn[h][i] = (unsigned)rowtab[128 * h + R] * (unsigned)(K * 2) + (unsigned)(C * 2); } } }
            unsigned g0x[2], g1x[2];
#pragma unroll
            for (int i = 0; i < 2; ++i) { g0x[i] = last ? gn[0][i] : gc[0][i]; g1x[i] = last ? gn[1][i] : gc[1][i]; }
            if constexpr (SP2) {
            PG8_LDB(B0, 0, 0); PG8_LDB(B1, 0, 1); PG8_SCHED; PG8_LDA(At, 0, 0); if constexpr (GATHER) PG8_STAGE(PG8_SA(1, 1), a1, gc[1]); else PG8_STAGE(PG8_SA(1, 1), a1 + hstep, voffA);
            PG8_WAIT_V(8); PG8_WAIT_L(0); PG8_BAR; PG8_MMA(0, 0, At, B0); PG8_MMA(0, 1, At, B1); PG8_BAR; PG8_SCHED;
            PG8_LDA(At, 0, 1); PG8_STAGE(PG8_SB(0, 0), b2, voffB); PG8_STAGE(PG8_SB(0, 1), b2 + hstep, voffB); if constexpr (GATHER) PG8_STAGE(PG8_SA(0, 0), a2, g0x); else PG8_STAGE(PG8_SA(0, 0), a2, voffA);
            PG8_WAIT_V(8); PG8_WAIT_L(0); PG8_BAR; PG8_MMA(1, 0, At, B0); PG8_MMA(1, 1, At, B1); PG8_BAR; PG8_SCHED;
            PG8_LDB(B0, 1, 0); PG8_LDB(B1, 1, 1); PG8_SCHED; PG8_LDA(At, 1, 0); if constexpr (GATHER) PG8_STAGE(PG8_SA(0, 1), a2, g1x); else PG8_STAGE(PG8_SA(0, 1), a2 + hstep, voffA);
            PG8_WAIT_V(8); PG8_WAIT_L(0); PG8_BAR; PG8_MMA(0, 0, At, B0); PG8_MMA(0, 1, At, B1); PG8_BAR; PG8_SCHED;
            PG8_LDA(At, 1, 1); PG8_STAGE(PG8_SB(1, 0), b3, voffB); PG8_STAGE(PG8_SB(1, 1), b3 + hstep, voffB); if constexpr (GATHER) PG8_STAGE(PG8_SA(1, 0), a3, g0x); else PG8_STAGE(PG8_SA(1, 0), a3, voffA);
            PG8_WAIT_V(8); PG8_WAIT_L(0); PG8_BAR; PG8_MMA(1, 0, At, B0); PG8_MMA(1, 1, At, B1); PG8_BAR; PG8_SCHED;
            } else {
            PG8_LDB(B0, 0, 0); PG8_SCHED; PG8_LDA(At, 0, 0); if constexpr (GATHER) PG8_STAGE(PG8_SA(1, 1), a1, gc[1]); else PG8_STAGE(PG8_SA(1, 1), a1 + hstep, voffA);
            PG8_WAIT_L(8); PG8_BAR; PG8_WAIT_L(0); PG8_MMA(0, 0, At, B0); PG8_BAR; PG8_SCHED;
            PG8_LDB(B1, 0, 1); PG8_STAGE(PG8_SB(0, 0), b2, voffB);
            PG8_BAR; PG8_WAIT_L(0); PG8_MMA(0, 1, At, B1); PG8_BAR;
            PG8_LDA(At, 0, 1); if constexpr (GATHER) PG8_STAGE(PG8_SA(0, 0), a2, g0x); else PG8_STAGE(PG8_SA(0, 0), a2, voffA);
            PG8_BAR; PG8_WAIT_L(0); PG8_MMA(1, 0, At, B0); PG8_BAR; PG8_SCHED;
            PG8_STAGE(PG8_SB(0, 1), b2 + hstep, voffB);
            PG8_WAIT_V(6); PG8_BAR; PG8_MMA(1, 1, At, B1); PG8_BAR;
            PG8_LDB(B0, 1, 0); PG8_SCHED; PG8_LDA(At, 1, 0); if constexpr (GATHER) PG8_STAGE(PG8_SA(0, 1), a2, g1x); else PG8_STAGE(PG8_SA(0, 1), a2 + hstep, voffA);
            PG8_WAIT_L(8); PG8_BAR; PG8_WAIT_L(0); PG8_MMA(0, 0, At, B0); PG8_BAR; PG8_SCHED;
            PG8_LDB(B1, 1, 1); PG8_STAGE(PG8_SB(1, 0), b3, voffB);
            PG8_BAR; PG8_WAIT_L(0); PG8_MMA(0, 1, At, B1); PG8_BAR;
            PG8_LDA(At, 1, 1); if constexpr (GATHER) PG8_STAGE(PG8_SA(1, 0), a3, g0x); else PG8_STAGE(PG8_SA(1, 0), a3, voffA);
            PG8_BAR; PG8_WAIT_L(0); PG8_MMA(1, 0, At, B0); PG8_BAR; PG8_SCHED;
            PG8_STAGE(PG8_SB(1, 1), b3 + hstep, voffB);
            PG8_WAIT_V(6); PG8_BAR; PG8_MMA(1, 1, At, B1); PG8_BAR;
            }
        }
        PG8_STAMP();
        if constexpr (ALIGN_EPI) { if (wr == 0) PG8_BAR; }
        if constexpr (!Epi::AFTER_DRAIN) { E(acc, cur, wr, wc, fr, fq, lds); S.done(cur); }
        PG8_STAMP();
        if (!has_next) break;
#pragma unroll
        for (int a = 0; a < 2; ++a)
#pragma unroll
            for (int b = 0; b < 2; ++b)
#pragma unroll
                for (int m = 0; m < 4; ++m)
#pragma unroll
                    for (int n = 0; n < 2; ++n) acc[a][b][m][n] = (f32x4){0.f, 0.f, 0.f, 0.f};
        cur = nxt; cA = nA; cB = nB; ++ui;
        if constexpr (GATHER) {
#pragma unroll
            for (int h = 0; h < 2; ++h)
#pragma unroll
                for (int i = 0; i < 2; ++i) gc[h][i] = gn[h][i]; }
        if constexpr (ALIGN_EPI) { if (wr == 1) PG8_BAR; }
    }
    PG8_WAIT_V(0);
    if constexpr (!ALIGN_EPI) { if (wr == 0) PG8_BAR; }
    PG8_BAR;
    if constexpr (Epi::AFTER_DRAIN) { E.fused(acc, cur, wr, wc, fr, fq, lds, wid, lane); S.done(cur); }
    PG8_STAMP();
    if (STAMP && wid == 0) { stamps[lane] = lane < nts ? (((unsigned long long)(unsigned)ts_hi << 32) | (unsigned)ts_lo) : 0ull;
        if (lane == 62) stamps[62] = rt_entry; if (lane == 63) stamps[63] = (unsigned long long)wall_clock64(); }
#undef PG8_STAMP
#undef PG8_SA
#undef PG8_SB
#undef PG8_STAGE
#undef PG8_LDA
#undef PG8_LDB
#undef PG8_MMA
#undef PG8_WAIT_V
#undef PG8_WAIT_L
#undef PG8_BAR
#undef PG8_SCHED
}
}
using pg8::bf16_t; using pg8::bf16x8; using pg8::f32x4; using pg8::u32x4;

constexpr int NB = 4, SEQ = 8192, MTOK = NB * SEQ, DM = 1024, NLAYER = 4, CIN = 3080, NPROJ = 3072, NEXP = 32, DEXP = 1024, NUP = 2048;
constexpr int RWD = 384, RW_COLS = 1408;
constexpr int NT_MAX = 544, POS_MAX = NT_MAX * 256;
constexpr float DN_ALPHA = 1.6817928305074290861f;
constexpr float LN_EPS = 1e-5f;
constexpr int NPH = 10;
constexpr int NPHASE_TOTAL = 1 + NLAYER * NPH;

constexpr size_t MiB = 1u << 20;
constexpr size_t WS_CTL = 0, CTL_ZERO_BYTES = 65536;
constexpr size_t WS_WIN = 1 * MiB;
constexpr size_t WS_WOUT = 25 * MiB;
constexpr size_t WS_WUP = 33 * MiB;
constexpr size_t WS_WDN = 545 * MiB;
constexpr size_t WS_ROPE = 801 * MiB;
constexpr size_t WS_HB = 803 * MiB;
constexpr size_t WS_HF = 867 * MiB;
constexpr size_t WS_H1F = 995 * MiB;
constexpr size_t WS_T1 = 1123 * MiB;
constexpr size_t WS_P = 1251 * MiB;
constexpr size_t WS_PG = 1443 * MiB;
constexpr size_t WS_YMIX = 1444 * MiB;
constexpr size_t WS_RWM = 1508 * MiB;
constexpr size_t WS_RWNT = 1532 * MiB;
constexpr size_t WS_RWQH = 1580 * MiB;
constexpr size_t WS_RWYL = 1604 * MiB;
constexpr size_t WS_RWS = 1652 * MiB;
constexpr size_t WS_RWAUX = 1676 * MiB;
constexpr size_t WS_MLQ = 1724 * MiB;
constexpr size_t WS_MLNL = 1740 * MiB;
constexpr size_t WS_MLVEC = 1780 * MiB;
constexpr size_t WS_MLSC = 1781 * MiB;
constexpr size_t WS_MLKL = 1782 * MiB;
constexpr size_t WS_MLCT = 1822 * MiB;
constexpr size_t WS_MLM = 1842 * MiB;
constexpr size_t WS_WUPT = 1843 * MiB;
constexpr size_t WS_AUPT = 1843 * MiB + 256 * 1024;
constexpr size_t WS_GUPT = 1843 * MiB + 512 * 1024;
constexpr size_t WS_LISCR = 1845 * MiB;
constexpr size_t WS_WRH = 1844 * MiB;
constexpr size_t WS_WRL = 1844 * MiB + 256 * 1024;
constexpr size_t WS_XPERM = 2021 * MiB;
constexpr size_t WS_ACT = 2293 * MiB;
constexpr size_t WS_YB = 2565 * MiB;
constexpr size_t WS_TOKE = 2821 * MiB;
constexpr size_t WS_TOKG = 2822 * MiB;
constexpr size_t WS_TOKLR = 2823 * MiB;
constexpr size_t WS_PDEST = 2824 * MiB;
constexpr size_t WS_PGATE = 2825 * MiB;
constexpr size_t WS_BBASE = 2826 * MiB;
constexpr size_t WS_PTOK = 2827 * MiB;
constexpr size_t WS_END = 2828 * MiB;
constexpr int CW_CNT = 1024;
constexpr int CW_SWAQ = 2048;
constexpr int CW_BAR = 4096;
constexpr int LDS_BYTES = 147456;
constexpr int MISC_OFF = 143360;
constexpr int TILEE_OFF = 133120;

#define LDS_WAIT() asm volatile("s_waitcnt lgkmcnt(0)" ::: "memory")
#define LDS_BARRIER() do { asm volatile("s_waitcnt lgkmcnt(0)" ::: "memory"); __builtin_amdgcn_s_barrier(); asm volatile("" ::: "memory"); } while (0)
#define VM_WAIT() asm volatile("s_waitcnt vmcnt(0)" ::: "memory")
__device__ __forceinline__ unsigned f2bf(float f) { unsigned u = __builtin_bit_cast(unsigned, f); return (u + 0x7fffu + ((u >> 16) & 1u)) >> 16; }
typedef __bf16 bf16v2_t __attribute__((ext_vector_type(2)));
__device__ __forceinline__ unsigned pk2(float lo, float hi) { const f32x2 v = (f32x2){lo, hi}; return __builtin_bit_cast(unsigned, __builtin_convertvector(v, bf16v2_t)); }
__device__ __forceinline__ float bf2f(unsigned short b) { return __builtin_bit_cast(float, ((unsigned)b) << 16); }
__device__ __forceinline__ float bflo(unsigned w) { return __builtin_bit_cast(float, w << 16); }
__device__ __forceinline__ float bfhi(unsigned w) { return __builtin_bit_cast(float, w & 0xffff0000u); }
template <int CTRL, int RMASK> __device__ __forceinline__ float dpp_add(float v) { return v + __builtin_bit_cast(float, __builtin_amdgcn_update_dpp(0, __builtin_bit_cast(int, v), CTRL, RMASK, 0xF, false)); }
__device__ __forceinline__ float wave_sum(float v) {
    v = dpp_add<0xB1, 0xF>(v); v = dpp_add<0x4E, 0xF>(v); v = dpp_add<0x141, 0xF>(v); v = dpp_add<0x140, 0xF>(v);
    v = dpp_add<0x142, 0xA>(v); v = dpp_add<0x143, 0xC>(v);
    return __builtin_bit_cast(float, __builtin_amdgcn_readlane(__builtin_bit_cast(int, v), 63));
}
template <int CTRL> __device__ __forceinline__ float dpp_mov(float x) { return __builtin_bit_cast(float, __builtin_amdgcn_update_dpp(0, __builtin_bit_cast(int, x), CTRL, 0xF, 0xF, true)); }
__device__ __forceinline__ float sum8(float x) { x += dpp_mov<0xB1>(x); x += dpp_mov<0x4E>(x); x += dpp_mov<0x141>(x); return x; }
__device__ __forceinline__ float sigmoidf_(float x) { return __builtin_amdgcn_rcpf(1.0f + __expf(-x)); }

#define XB_TMO      128
#define XB_XCNT(j)  (256  + 64 * (j))
#define XB_XSUB(j)  (1280 + 64 * (j))
#define XB_XGEN(j)  (2304 + 64 * (j))
#define XB_TOP      3328
#define XB_TOPGEN   3392
#define XCD_BAR_WORDS 3456
#define XB_SPIN_CAP (1u << 22)
__device__ __forceinline__ unsigned xb_ld(unsigned* p)              { return __hip_atomic_load(p, __ATOMIC_RELAXED, __HIP_MEMORY_SCOPE_AGENT); }
__device__ __forceinline__ unsigned xb_add(unsigned* p, unsigned v) { return __hip_atomic_fetch_add(p, v, __ATOMIC_RELAXED, __HIP_MEMORY_SCOPE_AGENT); }
__device__ __forceinline__ unsigned xb_xcc_id() { return (unsigned)__builtin_amdgcn_s_getreg((3 << 11) | 20) & 0xFu; }
#define XB_SPIN(cond, bar) do { unsigned _sp = 0; while (cond) { __builtin_amdgcn_s_sleep(1); \
    if ((++_sp & 255u) == 0u) { if (xb_ld(&(bar)[XB_TMO])) break; if (_sp > XB_SPIN_CAP) { atomicAdd(&(bar)[XB_TMO], 1u); break; } } } } while (0)

struct XcdBarrier {
    unsigned* bar; unsigned x;
    volatile LAS unsigned* st;
};

__device__ __forceinline__ XcdBarrier xcd_barrier_post(unsigned* bar, volatile LAS unsigned* st, bool t0  ) {
    XcdBarrier b; b.bar = bar; b.x = xb_xcc_id(); b.st = st;
    if (t0) (void)xb_add(&bar[XB_XCNT(b.x)], 1u);
    return b;
}
__device__ __forceinline__ void xcd_barrier_complete(unsigned* bar, unsigned x, unsigned& nloc, unsigned& nx) {
    const unsigned G = gridDim.x * gridDim.y * gridDim.z;
    unsigned sum, cnt, mine, sp = 0u;
    for (;;) {
        sum = 0u; cnt = 0u; mine = 0u;
#pragma unroll
        for (unsigned j = 0; j < 16; ++j) { const unsigned c = xb_ld(&bar[XB_XCNT(j)]); sum += c; cnt += (c > 0u) ? 1u : 0u; mine = (j == x) ? c : mine; }
        if (sum == G) break;
        __builtin_amdgcn_s_sleep(1);
        if ((++sp & 255u) == 0u) { if (xb_ld(&bar[XB_TMO])) break; if (sp > XB_SPIN_CAP) { atomicAdd(&bar[XB_TMO], 1u); break; } }
    }
    nloc = mine > 0u ? mine : 1u; nx = cnt > 0u ? cnt : 1u;
}

__device__ __forceinline__ void xcd_barrier(const XcdBarrier& b, bool t0  ) {
    asm volatile("s_waitcnt vmcnt(0)" ::: "memory");
    __syncthreads();
    if (t0) {
        unsigned* bar = b.bar;
        __builtin_amdgcn_s_waitcnt(0);
        unsigned nloc = b.st[0], nx = b.st[1];
        if (nloc == 0u) { xcd_barrier_complete(bar, b.x, nloc, nx); b.st[0] = nloc; b.st[1] = nx; }
        const unsigned old = xb_add(&bar[XB_XSUB(b.x)], 1u);
        const unsigned gen = old / nloc;
        if (old + 1u == (gen + 1u) * nloc) {
            __builtin_amdgcn_fence(__ATOMIC_RELEASE, "agent");
            asm volatile("s_waitcnt vmcnt(0)" ::: "memory");
            const unsigned og = xb_add(&bar[XB_TOP], 1u);
            const unsigned tg = og / nx;
            if (og + 1u == (tg + 1u) * nx) xb_add(&bar[XB_TOPGEN], 1u);
            else XB_SPIN(xb_ld(&bar[XB_TOPGEN]) == tg, bar);
            __builtin_amdgcn_fence(__ATOMIC_ACQUIRE, "agent");
            xb_add(&bar[XB_XGEN(b.x)], 1u);
            asm volatile("s_waitcnt vmcnt(0)" ::: "memory");
        } else {
            XB_SPIN(xb_ld(&bar[XB_XGEN(b.x)]) == gen, bar);
            __builtin_amdgcn_fence(__ATOMIC_ACQUIRE, "agent");
            asm volatile("s_waitcnt vmcnt(0)" ::: "memory");
        }
    }
    __syncthreads();
}
struct Params {
    const float* in[29];
    float* out; unsigned char* ws;
    int ph_lo, ph_hi;
    int pad0, pad1;
};
enum { I_X = 0, I_WIN, I_BIN, I_MU, I_WUP, I_W0, I_AUP, I_A0, I_GUP, I_KK, I_KA, I_RK, I_LNW, I_LNB, I_SINK, I_CONVW, I_CONVB, I_MLNW, I_WOUT,
       I_LN1W, I_LN1B, I_RW, I_RB, I_EWUP, I_EBUP, I_EWDN, I_EBDN, I_LN2W, I_LN2B };

struct Ctx {
    LAS unsigned char* lds; int tid, lane, wave, blk, G;
    unsigned char* ws;
};

__device__ __forceinline__ void tr_item(const float* W, int ldw, int K, bf16_t* WT, LAS float* scr, int kb, int nb, int lane) {
    const int k0 = 64 * kb, n0 = 32 * nb;
#pragma unroll 8
    for (int i = 0; i < 32; ++i) { const int kk = 2 * i + (lane >> 5); scr[kk * 33 + (lane & 31)] = __builtin_nontemporal_load(W + (size_t)(k0 + kk) * ldw + n0 + (lane & 31)); }
    LDS_WAIT();
    const int c = lane & 7;
#pragma unroll
    for (int j = 0; j < 4; ++j) { const int n = (lane >> 3) + 8 * j; const LAS float* s = scr + (8 * c) * 33 + n;
        u32x4 o; o.x = pk2(s[0 * 33], s[1 * 33]); o.y = pk2(s[2 * 33], s[3 * 33]); o.z = pk2(s[4 * 33], s[5 * 33]); o.w = pk2(s[6 * 33], s[7 * 33]);
        *(u32x4*)(WT + (size_t)(n0 + n) * K + k0 + 8 * c) = o; }
    LDS_WAIT();
}
__device__ __forceinline__ void gate_cols(const f32x4 (&v)[4], const LAS float* tab, const float bgv  , float* pgrow, int lane) {
    float acc[8];
#pragma unroll
    for (int c = 0; c < 8; ++c) acc[c] = 0.f;
#pragma unroll
    for (int j = 0; j < 4; ++j)
#pragma unroll
        for (int q = 0; q < 4; ++q) { const LAS f32x4* tp = (const LAS f32x4*)(tab + ((j * 4 + q) * 64 + lane) * 8); const f32x4 a = tp[0], b = tp[1]; const float x = v[j][q];
            acc[0] += x * a[0]; acc[1] += x * a[1]; acc[2] += x * a[2]; acc[3] += x * a[3]; acc[4] += x * b[0]; acc[5] += x * b[1]; acc[6] += x * b[2]; acc[7] += x * b[3]; }
#pragma unroll
    for (int c = 0; c < 8; ++c) acc[c] = wave_sum(acc[c]);
    if (lane < 8) { float r = acc[0];
#pragma unroll
        for (int c = 1; c < 8; ++c) r = (lane == c) ? acc[c] : r;
        pgrow[lane] = r + bgv; }
}
__device__ __forceinline__ void load_wg(LAS float* tab, const float* win_l, int tid) {
    for (int d = tid; d < DM; d += 512) { const int j = d >> 8, ln = (d >> 2) & 63, q = d & 3; const f32x4 a = *(const f32x4*)(win_l + (size_t)d * CIN + NPROJ), b = *(const f32x4*)(win_l + (size_t)d * CIN + NPROJ + 4);
        LAS f32x4* tp = (LAS f32x4*)(tab + ((j * 4 + q) * 64 + ln) * 8); tp[0] = a; tp[1] = b; }
    __syncthreads();
}
__device__ __forceinline__ void p0_prologue(const Params& P, const Ctx& C) {
    LAS float* scr = (LAS float*)(C.lds + C.wave * 16384);
    const int gw = C.blk * 8 + C.wave, NGW = C.G * 8;
    bf16_t* win_t = (bf16_t*)(C.ws + WS_WIN); bf16_t* wout_t = (bf16_t*)(C.ws + WS_WOUT); bf16_t* wup_t = (bf16_t*)(C.ws + WS_WUP); bf16_t* wdn_t = (bf16_t*)(C.ws + WS_WDN);
    constexpr int I_IN = 16 * 96, I_OUT = 16 * 32, I_UP = 16 * 64, I_DN = 16 * 32;
    constexpr int N1 = NLAYER * I_IN, N2 = NLAYER * I_OUT, N3 = NLAYER * NEXP * I_UP, N4 = NLAYER * NEXP * I_DN;
    for (int it = gw; it < N1 + N2 + N3 + N4; it += NGW) {
        int r = it;
        if (r < N1) { const int l = r / I_IN; r %= I_IN; tr_item(P.in[I_WIN] + (size_t)l * DM * CIN, CIN, DM, win_t + (size_t)l * NPROJ * DM, scr, r / 96, r % 96, C.lane); continue; } r -= N1;
        if (r < N2) { const int l = r / I_OUT; r %= I_OUT; tr_item(P.in[I_WOUT] + (size_t)l * DM * DM, DM, DM, wout_t + (size_t)l * DM * DM, scr, r / 32, r % 32, C.lane); continue; } r -= N2;
        if (r < N3) { const int le = r / I_UP; r %= I_UP; tr_item(P.in[I_EWUP] + (size_t)le * DM * NUP, NUP, DM, wup_t + (size_t)le * NUP * DM, scr, r / 64, r % 64, C.lane); continue; } r -= N3;
        { const int le = r / I_DN; r %= I_DN; tr_item(P.in[I_EWDN] + (size_t)le * DEXP * DM, DM, DEXP, wdn_t + (size_t)le * DM * DEXP, scr, r / 32, r % 32, C.lane); }
    }
    f32x2* rope = (f32x2*)(C.ws + WS_ROPE);
    for (int idx = C.blk * 512 + C.tid; idx < SEQ * 32; idx += C.G * 512) { const int t = idx >> 5, i = idx & 31;
        const float inv = powf(10000.0f, -(float)i / 32.0f); const float ang = (float)t * inv;
        const double rev = (double)ang * 0.15915494309189533577; const float fr = (float)(rev - __builtin_rint(rev));
        rope[idx] = (f32x2){__builtin_amdgcn_cosf(fr), __builtin_amdgcn_sinf(fr)}; }
    { bf16_t* wt = (bf16_t*)(C.ws + WS_WUPT); bf16_t* at = (bf16_t*)(C.ws + WS_AUPT); bf16_t* gt = (bf16_t*)(C.ws + WS_GUPT);
      for (int idx = C.blk * 512 + C.tid; idx < NLAYER * RWD * 64; idx += C.G * 512) { const int ll = idx / (RWD * 64), rem = idx % (RWD * 64), j = rem >> 6, i = rem & 63;
          wt[idx] = (bf16_t)f2bf(P.in[I_WUP][((size_t)ll * 64 + i) * RWD + j]); at[idx] = (bf16_t)f2bf(P.in[I_AUP][((size_t)ll * 64 + i) * RWD + j]); }
      for (int idx = C.blk * 512 + C.tid; idx < NLAYER * RWD * 128; idx += C.G * 512) { const int ll = idx / (RWD * 128), rem = idx % (RWD * 128), j = rem >> 7, i = rem & 127;
          gt[idx] = (bf16_t)f2bf(P.in[I_GUP][((size_t)ll * 128 + i) * RWD + j]); } }
    { bf16_t* wh = (bf16_t*)(C.ws + WS_WRH); bf16_t* wl = (bf16_t*)(C.ws + WS_WRL);
      for (int idx = C.blk * 512 + C.tid; idx < NLAYER * NEXP * DM; idx += C.G * 512) { const int ll = idx / (NEXP * DM), rem = idx % (NEXP * DM), e = rem >> 10, d = rem & 1023;
          const float w = P.in[I_RW][((size_t)ll * DM + d) * NEXP + e]; const unsigned hi = f2bf(w); const float lo = w - bflo(hi); wh[idx] = (bf16_t)hi; wl[idx] = (bf16_t)f2bf(lo); } }
    __syncthreads(); LAS float* wg = (LAS float*)C.lds; load_wg(wg, P.in[I_WIN], C.tid);
    bf16_t* hb = (bf16_t*)(C.ws + WS_HB); float* pg = (float*)(C.ws + WS_PG);
    const float bgv0 = P.in[I_BIN][NPROJ + (C.lane & 7)];
    for (int m = gw; m < MTOK; m += NGW) {
        const f32x4* xr = (const f32x4*)(P.in[I_X] + (size_t)m * DM) + C.lane; f32x4 v[4];
#pragma unroll
        for (int j = 0; j < 4; ++j) v[j] = xr[64 * j];
        u32x2* o8 = (u32x2*)(hb + (size_t)m * DM) + C.lane;
#pragma unroll
        for (int j = 0; j < 4; ++j) o8[64 * j] = (u32x2){pk2(v[j][0], v[j][1]), pk2(v[j][2], v[j][3])};
        gate_cols(v, wg, bgv0, pg + (size_t)m * 8, C.lane);
    }
}

constexpr int LD = 72;
constexpr int BUFB = 64 * LD * 2;
__device__ __forceinline__ f32x4 mfma16(bf16x8 a, bf16x8 b, f32x4 c) { return __builtin_amdgcn_mfma_f32_16x16x32_bf16(a, b, c, 0, 0, 0); }
constexpr int SWA_VLD = 264;
__device__ __forceinline__ void swa_unit(const Params& P, const Ctx& C, int l, int u) {
    const int tid = C.tid, wave = C.wave, lane = C.lane, r = lane & 15, g = lane >> 4; const int b = u >> 7, n = (u >> 1) & 63, hk = u & 1;
    LAS bf16_t* Ks = (LAS bf16_t*)C.lds; LAS bf16_t* VT = Ks + 256 * LD;
    const bf16_t* p = (const bf16_t*)(C.ws + WS_P); const f32x2* rope = (const f32x2*)(C.ws + WS_ROPE);
    const int t_base = n * 128 - 128;
    const int qi = 16 * wave + r, t = n * 128 + qi;
    const bf16_t* qrow = p + (size_t)(b * SEQ + t) * NPROJ + RW_COLS + hk * 192 + 8 * g;
    u32x4 qa1 = *(const u32x4*)qrow, qa2 = *(const u32x4*)(qrow + 32);
    f32x4 rqv[4];
    { const f32x4* rq = (const f32x4*)(rope + t * 32 + 8 * g);
#pragma unroll
      for (int e = 0; e < 4; ++e) rqv[e] = rq[e]; }
    const float sk0 = P.in[I_SINK][l * 6 + hk * 3], sk1 = P.in[I_SINK][l * 6 + hk * 3 + 1], sk2 = P.in[I_SINK][l * 6 + hk * 3 + 2];
#pragma unroll
    for (int it = 0; it < 2; ++it) { const int q = tid + 512 * it, row = q >> 2, c8 = q & 3; const int t = t_base + row;
        u32x4 o1 = (u32x4){0u, 0u, 0u, 0u}, o2 = o1;
        if (t >= 0) { const bf16_t* pr = p + (size_t)(b * SEQ + t) * NPROJ + 1792 + hk * 64 + 8 * c8; const u32x4 a1 = *(const u32x4*)pr, a2 = *(const u32x4*)(pr + 32);
            const f32x4* rp = (const f32x4*)(rope + t * 32 + 8 * c8); float y1[8], y2[8];
#pragma unroll
            for (int e = 0; e < 4; ++e) { const f32x4 cs = rp[e];
                const float x1a = bflo(a1[e]), x1b = bfhi(a1[e]), x2a = bflo(a2[e]), x2b = bfhi(a2[e]);
                y1[2 * e] = x1a * cs[0] - x2a * cs[1]; y2[2 * e] = x2a * cs[0] + x1a * cs[1]; y1[2 * e + 1] = x1b * cs[2] - x2b * cs[3]; y2[2 * e + 1] = x2b * cs[2] + x1b * cs[3]; }
            o1 = (u32x4){pk2(y1[0], y1[1]), pk2(y1[2], y1[3]), pk2(y1[4], y1[5]), pk2(y1[6], y1[7])}; o2 = (u32x4){pk2(y2[0], y2[1]), pk2(y2[2], y2[3]), pk2(y2[4], y2[5]), pk2(y2[6], y2[7])}; }
        *(LAS u32x4*)(Ks + row * LD + 8 * c8) = o1; *(LAS u32x4*)(Ks + row * LD + 32 + 8 * c8) = o2; }
    if (tid < 256) { const int kg = tid >> 3, c8 = tid & 7; u32x4 in[8];
#pragma unroll
        for (int k = 0; k < 8; ++k) { const int t = t_base + 8 * kg + k; in[k] = (t >= 0) ? *(const u32x4*)(p + (size_t)(b * SEQ + t) * NPROJ + 1920 + hk * 64 + 8 * c8) : (u32x4){0u, 0u, 0u, 0u}; }
#pragma unroll
        for (int d = 0; d < 8; ++d) { unsigned hv[8];
#pragma unroll
            for (int k = 0; k < 8; ++k) { const unsigned w = in[k][d >> 1]; hv[k] = (d & 1) ? (w >> 16) : (w & 0xffffu); }
            *(LAS u32x4*)(VT + (8 * c8 + d) * SWA_VLD + 8 * kg) = (u32x4){hv[0] | (hv[1] << 16), hv[2] | (hv[3] << 16), hv[4] | (hv[5] << 16), hv[6] | (hv[7] << 16)}; } }
    LDS_BARRIER();
#pragma unroll 1
    for (int gq = 0; gq < 3; ++gq) { const int hq = hk * 3 + gq; int wave = C.wave; asm volatile("" : "+s"(wave));
        bf16x8 qf0, qf1;
        { const u32x4 a1 = qa1, a2 = qa2; float y1[8], y2[8];
          if (gq < 2) { qa1 = *(const u32x4*)(qrow + 64 * (gq + 1)); qa2 = *(const u32x4*)(qrow + 64 * (gq + 1) + 32); }
#pragma unroll
          for (int e = 0; e < 4; ++e) { const f32x4 cs = rqv[e]; const float x1a = bflo(a1[e]), x1b = bfhi(a1[e]), x2a = bflo(a2[e]), x2b = bfhi(a2[e]);
              y1[2 * e] = (x1a * cs[0] - x2a * cs[1]) * 0.125f; y2[2 * e] = (x2a * cs[0] + x1a * cs[1]) * 0.125f; y1[2 * e + 1] = (x1b * cs[2] - x2b * cs[3]) * 0.125f; y2[2 * e + 1] = (x2b * cs[2] + x1b * cs[3]) * 0.125f; }
          const u32x4 w1 = (u32x4){pk2(y1[0], y1[1]), pk2(y1[2], y1[3]), pk2(y1[4], y1[5]), pk2(y1[6], y1[7])}, w2 = (u32x4){pk2(y2[0], y2[1]), pk2(y2[2], y2[3]), pk2(y2[4], y2[5]), pk2(y2[6], y2[7])};
          qf0 = __builtin_bit_cast(bf16x8, w1); qf1 = __builtin_bit_cast(bf16x8, w2); }
        f32x4 sc[10]; const float sink = (gq == 0) ? sk0 : (gq == 1) ? sk1 : sk2; float mx = sink;
        int qiv = qi; asm volatile("" : "+v"(qiv));
#pragma unroll
        for (int kt = 0; kt < 9; ++kt) { const int kb = 16 * (wave + kt); f32x4 a = (f32x4){0.f, 0.f, 0.f, 0.f};
            { const LAS bf16_t* kp = Ks + (kb + r) * LD + 8 * g; a = mfma16(*(const LAS bf16x8*)kp, qf0, a); a = mfma16(*(const LAS bf16x8*)(kp + 32), qf1, a); }
            if (kt == 0 || kt == 8) {
#pragma unroll
                for (int j = 0; j < 4; ++j) { const int kj = kb + 4 * g + j; const bool valid = (kj > qiv) && (kj <= qiv + 128) && ((n != 0) || (kj >= 128)); a[j] = valid ? a[j] : -__builtin_inff(); } }
            else { const bool tv = (n != 0) || (kb >= 128);
#pragma unroll
                for (int j = 0; j < 4; ++j) a[j] = tv ? a[j] : -__builtin_inff(); }
#pragma unroll
            for (int j = 0; j < 4; ++j) mx = fmaxf(mx, a[j]);
            sc[kt] = a; }
        mx = fmaxf(mx, __shfl_xor(mx, 16)); mx = fmaxf(mx, __shfl_xor(mx, 32));
        float sum = 0.f;
#pragma unroll
        for (int kt = 0; kt < 9; ++kt) {
#pragma unroll
            for (int j = 0; j < 4; ++j) { const float e = __expf(sc[kt][j] - mx); sc[kt][j] = e; sum += e; } }
        sc[9] = (f32x4){0.f, 0.f, 0.f, 0.f};
        sum += __shfl_xor(sum, 16); sum += __shfl_xor(sum, 32); sum += __expf(sink - mx);
        const float inv = 1.0f / sum;
        f32x4 o[4];
#pragma unroll
        for (int dt = 0; dt < 4; ++dt) o[dt] = (f32x4){0.f, 0.f, 0.f, 0.f};
#pragma unroll
        for (int s = 0; s < 5; ++s) { const int kb = 16 * (wave + 2 * s);
            if (kb < 256) { const u32x4 pw = (u32x4){pk2(sc[2 * s][0], sc[2 * s][1]), pk2(sc[2 * s][2], sc[2 * s][3]), pk2(sc[2 * s + 1][0], sc[2 * s + 1][1]), pk2(sc[2 * s + 1][2], sc[2 * s + 1][3])};
                const bf16x8 pf = __builtin_bit_cast(bf16x8, pw); const bool two = (s < 4) && (kb + 16 < 256);
#pragma unroll
                for (int dt = 0; dt < 4; ++dt) { const LAS bf16_t* vp = VT + (16 * dt + r) * SWA_VLD + kb + 4 * g; const u32x2 lo = *(const LAS u32x2*)vp; u32x2 hi = (u32x2){0u, 0u}; if (two) hi = *(const LAS u32x2*)(vp + 16);
                    const u32x4 af = (u32x4){lo[0], lo[1], hi[0], hi[1]}; o[dt] = mfma16(__builtin_bit_cast(bf16x8, af), pf, o[dt]); } } }
        bf16_t* yr = (bf16_t*)(C.ws + WS_YMIX) + (size_t)(b * SEQ + t) * DM + RWD + hq * 64 + 4 * g;
#pragma unroll
        for (int dt = 0; dt < 4; ++dt) *(u32x2*)(yr + 16 * dt) = (u32x2){pk2(o[dt][0] * inv, o[dt][1] * inv), pk2(o[dt][2] * inv, o[dt][3] * inv)};
    }
    LDS_BARRIER();
}
__device__ __forceinline__ f32x4 mm64(const LAS bf16_t* X, const LAS bf16_t* Y, int ti, int tj, f32x4 acc, int lane) {
    const int r = lane & 15, g = lane >> 4;
    const LAS bf16_t* xp = X + (16 * ti + r) * LD + 8 * g; const LAS bf16_t* yp = Y + (16 * tj + r) * LD + 8 * g;
    acc = mfma16(*(const LAS bf16x8*)xp, *(const LAS bf16x8*)yp, acc);
    acc = mfma16(*(const LAS bf16x8*)(xp + 32), *(const LAS bf16x8*)(yp + 32), acc);
    return acc;
}
__device__ __forceinline__ void storeT(LAS bf16_t* D, int ti, int tj, f32x4 v, int lane) {
    const int r = lane & 15, g = lane >> 4;
    *(LAS u32x2*)(D + (16 * tj + r) * LD + 16 * ti + 4 * g) = (u32x2){pk2(v[0], v[1]), pk2(v[2], v[3])};
}
template <int MODE> __device__ __forceinline__ f32x4 maskT(f32x4 v, int ti, int tj, int lane) {
    const int rho = 16 * tj + (lane & 15), kap = 16 * ti + 4 * (lane >> 4);
#pragma unroll
    for (int j = 0; j < 4; ++j) { const bool keep = (MODE == 0) ? (kap + j < rho) : (MODE == 1) ? (kap + j <= rho) : (kap + j > rho); v[j] = keep ? v[j] : 0.f; }
    return v;
}
__device__ __forceinline__ float wave_max(float v) {
#pragma unroll
    for (int o = 1; o < 64; o <<= 1) v = fmaxf(v, __shfl_xor(v, o));
    return v;
}

__device__ __forceinline__ void rwb_unit(const Params& P, const Ctx& C, int l, int u, bool reuse) {
    const int tid = C.tid, wave = C.wave, lane = C.lane, r = lane & 15, g = lane >> 4;
    const int h = u % 6, bcx = u / 6, b = bcx >> 7, c = bcx & 127; const int tok0 = b * SEQ + c * 64; const int ch = (b * 6 + h) * 128 + c;
    LAS unsigned char* L = C.lds;
#define RB(i) ((LAS bf16_t*)(L + (i) * BUFB))
    LAS bf16_t* X1 = RB(0); LAS bf16_t* X1T = RB(1); LAS bf16_t* Aak = RB(2); LAS bf16_t* Arb = RB(3); LAS bf16_t* Ark = RB(4); LAS bf16_t* Pb = RB(5);
    LAS bf16_t* At = RB(6); LAS bf16_t* AtT = RB(7); LAS bf16_t* Bt = RB(8); LAS bf16_t* BtT = RB(9); LAS bf16_t* Kt = RB(10); LAS bf16_t* KtT = RB(11); LAS bf16_t* Rt = RB(12); LAS bf16_t* VT = RB(13);
    LAS float* XW = (LAS float*)L; LAS float* XA = XW + 64 * 65; LAS float* XG = XA + 64 * 65;
    LAS bf16_t* LI = (LAS bf16_t*)(L + 6 * BUFB);
    LAS float* segtot = (LAS float*)(L + 14 * BUFB); LAS float* gamL = segtot + 512;
    const bf16_t* p = (const bf16_t*)(C.ws + WS_P); const float* mu = P.in[I_MU] + l * RW_COLS;
    float cr9[9], ck9[9], cv9[9];
    { const int jc0 = 64 * h + lane;
#pragma unroll
      for (int i = 0; i < 9; ++i) { const int row = 8 * wave - 1 + i; const bool ok = (c * 64 + row >= 0); const bf16_t* q = p + (size_t)(tok0 + (ok ? row : 0)) * NPROJ;
          const float a_ = bf2f(q[jc0]), b_ = bf2f(q[RWD + jc0]), c_ = bf2f(q[2 * RWD + jc0]); cr9[i] = ok ? a_ : 0.f; ck9[i] = ok ? b_ : 0.f; cv9[i] = ok ? c_ : 0.f; } }
    bf16_t* liscr = (bf16_t*)(C.ws + WS_LISCR) + (size_t)C.blk * (64 * 264);
    if (!reuse) { u32x4 cu[4], pv[4]; f32x4 m0[4], m1[4];
#pragma unroll
      for (int i = 0; i < 4; ++i) { const int q = tid + 512 * i, t = q >> 5, c8 = q & 31; const bf16_t* src = p + (size_t)(tok0 + t) * NPROJ + 1152 + 8 * c8; const bool ok = (c * 64 + t > 0);
          cu[i] = *(const u32x4*)src; pv[i] = *(const u32x4*)(ok ? src - NPROJ : src); if (!ok) pv[i] = (u32x4){0u, 0u, 0u, 0u};
          m0[i] = *(const f32x4*)(mu + 1152 + 8 * c8); m1[i] = *(const f32x4*)(mu + 1152 + 8 * c8 + 4); }
#pragma unroll
      for (int i = 0; i < 4; ++i) { const int q = tid + 512 * i, t = q >> 5, c8 = q & 31; float x[8];
#pragma unroll
          for (int e = 0; e < 4; ++e) { const float c0 = bflo(cu[i][e]), c1 = bfhi(cu[i][e]), p0 = bflo(pv[i][e]), p1 = bfhi(pv[i][e]);
              const float mm0 = (e < 2) ? m0[i][2 * e] : m1[i][2 * e - 4], mm1 = (e < 2) ? m0[i][2 * e + 1] : m1[i][2 * e - 3];
              x[2 * e] = c0 + (p0 - c0) * mm0; x[2 * e + 1] = c1 + (p1 - c1) * mm1; }
          if (c8 < 8) {
#pragma unroll
              for (int e = 0; e < 8; ++e) x[e] = 1.0f - 2.0f * __builtin_amdgcn_rcpf(__expf(2.0f * x[e]) + 1.0f); }
          else if (c8 >= 16) {
#pragma unroll
              for (int e = 0; e < 8; ++e) x[e] = sigmoidf_(x[e]); }
          const u32x4 w = (u32x4){pk2(x[0], x[1]), pk2(x[2], x[3]), pk2(x[4], x[5]), pk2(x[6], x[7])};
          *(LAS u32x4*)(LI + t * 264 + 8 * c8) = w; *(u32x4*)(liscr + t * 264 + 8 * c8) = w; } }
    else {
#pragma unroll
      for (int i = 0; i < 4; ++i) { const int q = tid + 512 * i, t = q >> 5, c8 = q & 31; *(LAS u32x4*)(LI + t * 264 + 8 * c8) = *(const u32x4*)(liscr + t * 264 + 8 * c8); } }
    LDS_BARRIER();
    { bf16x8 bw[1][2], ba[1][2], bg[1][4];
      const int tj = wave & 3;
      const bf16_t* Ww = (const bf16_t*)(C.ws + WS_WUPT) + ((size_t)l * RWD + 64 * h + 16 * tj + r) * 64 + 8 * g;
      const bf16_t* Wa = (const bf16_t*)(C.ws + WS_AUPT) + ((size_t)l * RWD + 64 * h + 16 * tj + r) * 64 + 8 * g;
      const bf16_t* Wg = (const bf16_t*)(C.ws + WS_GUPT) + ((size_t)l * RWD + 64 * h + 16 * tj + r) * 128 + 8 * g;
#pragma unroll
      for (int ks = 0; ks < 2; ++ks) { bw[0][ks] = *(const bf16x8*)(Ww + 32 * ks); ba[0][ks] = *(const bf16x8*)(Wa + 32 * ks); }
#pragma unroll
      for (int ks = 0; ks < 4; ++ks) bg[0][ks] = *(const bf16x8*)(Wg + 32 * ks);
#pragma unroll
      for (int n = 0; n < 6; ++n) { const int o = n >> 1, ti = ((wave >> 2) + 2 * n) & 3; const int xoff = (o == 0) ? 0 : (o == 1) ? 64 : 128;
          const LAS bf16_t* xp = LI + (16 * ti + r) * 264 + xoff + 8 * g; f32x4 acc = (f32x4){0.f, 0.f, 0.f, 0.f};
          if (o == 0) { acc = mfma16(*(const LAS bf16x8*)xp, bw[0][0], acc); acc = mfma16(*(const LAS bf16x8*)(xp + 32), bw[0][1], acc); }
          else if (o == 1) { acc = mfma16(*(const LAS bf16x8*)xp, ba[0][0], acc); acc = mfma16(*(const LAS bf16x8*)(xp + 32), ba[0][1], acc); }
          else {
#pragma unroll
              for (int ks = 0; ks < 4; ++ks) acc = mfma16(*(const LAS bf16x8*)(xp + 32 * ks), bg[0][ks], acc); }
          LAS float* XO = (o == 0) ? XW : (o == 1) ? XA : XG;
#pragma unroll
          for (int j = 0; j < 4; ++j) XO[(16 * ti + 4 * g + j) * 65 + 16 * tj + r] = acc[j]; } }
    LDS_BARRIER();
    {
        const int jc = 64 * h + lane, tg = wave;
        const float w0 = P.in[I_W0][l * RWD + jc], a0 = P.in[I_A0][l * RWD + jc], kkc = P.in[I_KK][l * RWD + jc], kac = P.in[I_KA][l * RWD + jc], rkc = P.in[I_RK][l * RWD + jc];
        const float mur = mu[jc], muk = mu[RWD + jc], muv = mu[2 * RWD + jc];
        float pr = cr9[0], pk = ck9[0], pv = cv9[0];
        float ld[8], av[8], kn[8], km[8], rs[8], vs[8];
        bf16_t* aux = (bf16_t*)(C.ws + WS_RWAUX) + (size_t)(tok0 + 8 * tg) * 768;
#pragma unroll
        for (int i = 0; i < 8; ++i) { const int t = 8 * tg + i; const float cr = cr9[i + 1], ck = ck9[i + 1], cv = cv9[i + 1];
            rs[i] = cr + (pr - cr) * mur; const float ks = ck + (pk - ck) * muk; vs[i] = cv + (pv - cv) * muv; pr = cr; pk = ck; pv = cv;
            const float z = -(w0 + XW[t * 65 + lane]); const float sp = (z > 20.f) ? z : __logf(1.0f + __expf(z)); ld[i] = -__expf(-sp - 0.5f);
            const float a = sigmoidf_(a0 + XA[t * 65 + lane]); av[i] = a;
            const float kkv = ks * kkc; kn[i] = kkv * rsqrtf(fmaxf(wave_sum(kkv * kkv), 1e-24f));
            km[i] = ks * (1.0f + (a - 1.0f) * kac);
            const float dot = wave_sum(rs[i] * km[i] * rkc);
            aux[(size_t)i * 768 + jc] = (bf16_t)f2bf(dot * vs[i]); aux[(size_t)i * 768 + RWD + jc] = (bf16_t)f2bf(XG[t * 65 + lane]); }
        float cs[8]; cs[0] = ld[0];
#pragma unroll
        for (int i = 1; i < 8; ++i) cs[i] = cs[i - 1] + ld[i];
        segtot[tg * 64 + lane] = cs[7];
        LDS_BARRIER();
        float off = 0.f, tot = 0.f;
#pragma unroll
        for (int k = 0; k < 8; ++k) { const float sv = segtot[k * 64 + lane]; tot += sv; off += (k < tg) ? sv : 0.f; }
        if (wave == 0) gamL[lane] = __expf(tot);
        float oa[8], ob[8], ok[8], orr[8];
#pragma unroll
        for (int i = 0; i < 8; ++i) { const int t = 8 * tg + i; const float cum = off + cs[i]; const float gam = __expf(cum), gin = __expf(-cum), gpr = __expf(cum - ld[i]);
            oa[i] = -gpr * kn[i]; ob[i] = kn[i] * av[i] * gin; ok[i] = km[i] * gin; orr[i] = gam * rs[i];
            At[t * LD + lane] = (bf16_t)f2bf(oa[i]); Bt[t * LD + lane] = (bf16_t)f2bf(ob[i]); Kt[t * LD + lane] = (bf16_t)f2bf(ok[i]); Rt[t * LD + lane] = (bf16_t)f2bf(orr[i]); }
        *(LAS u32x4*)(AtT + lane * LD + 8 * tg) = (u32x4){pk2(oa[0], oa[1]), pk2(oa[2], oa[3]), pk2(oa[4], oa[5]), pk2(oa[6], oa[7])};
        *(LAS u32x4*)(BtT + lane * LD + 8 * tg) = (u32x4){pk2(ob[0], ob[1]), pk2(ob[2], ob[3]), pk2(ob[4], ob[5]), pk2(ob[6], ob[7])};
        *(LAS u32x4*)(KtT + lane * LD + 8 * tg) = (u32x4){pk2(ok[0], ok[1]), pk2(ok[2], ok[3]), pk2(ok[4], ok[5]), pk2(ok[6], ok[7])};
        *(LAS u32x4*)(VT + lane * LD + 8 * tg) = (u32x4){pk2(vs[0], vs[1]), pk2(vs[2], vs[3]), pk2(vs[4], vs[5]), pk2(vs[6], vs[7])};
    }
    LDS_BARRIER();
    const f32x4 Z4 = (f32x4){0.f, 0.f, 0.f, 0.f};
    const int wq = wave >> 2, tj = wave & 3;
    { f32x4 res[10];
#pragma unroll
      for (int n_ = 0; n_ < 10; ++n_) { const int o = n_ >> 1, ti = wq + 2 * (n_ & 1);
          if (o == 0) res[n_] = maskT<2>(mm64(At, Bt, ti, tj, Z4, lane), ti, tj, lane);
          else if (o == 1) res[n_] = maskT<0>(mm64(Bt, At, ti, tj, Z4, lane), ti, tj, lane);
          else if (o == 2) res[n_] = maskT<0>(mm64(Kt, At, ti, tj, Z4, lane), ti, tj, lane);
          else if (o == 3) res[n_] = maskT<1>(mm64(Bt, Rt, ti, tj, Z4, lane), ti, tj, lane);
          else res[n_] = maskT<1>(mm64(Kt, Rt, ti, tj, Z4, lane), ti, tj, lane); }
#pragma unroll
      for (int n_ = 0; n_ < 10; ++n_) { const int o = n_ >> 1, ti = wq + 2 * (n_ & 1);
          if (o == 0) storeT(X1T, ti, tj, res[n_], lane);
          else if (o == 1) { storeT(X1, ti, tj, res[n_], lane); f32x4 v = res[n_]; const int rho = 16 * tj + r, kap = 16 * ti + 4 * g;
#pragma unroll
              for (int j = 0; j < 4; ++j) v[j] += (kap + j == rho) ? 1.0f : 0.f;
              storeT(Pb, ti, tj, v, lane); }
          else if (o == 2) storeT(Aak, ti, tj, res[n_], lane);
          else if (o == 3) storeT(Arb, ti, tj, res[n_], lane);
          else storeT(Ark, ti, tj, res[n_], lane); } }
    LDS_BARRIER();
    f32x4 pacc[2];
#pragma unroll
    for (int q = 0; q < 2; ++q) { const int ti = wq + 2 * q; const u32x2 w = *(const LAS u32x2*)(Pb + (16 * tj + r) * LD + 16 * ti + 4 * g);
        pacc[q] = (f32x4){bflo(w[0]), bfhi(w[0]), bflo(w[1]), bfhi(w[1])}; }
#pragma unroll 1
    for (int rnd = 0; rnd < 6; ++rnd) {
        LAS bf16_t* Xn = (rnd & 1) ? RB(6) : RB(0); LAS bf16_t* XnT = (rnd & 1) ? RB(8) : RB(1);
        LAS bf16_t* Yn = (rnd & 1) ? RB(0) : RB(6); LAS bf16_t* YnT = (rnd & 1) ? RB(1) : RB(8);
        LAS bf16_t* Pold = (rnd & 1) ? RB(5) : RB(10); LAS bf16_t* Pnew = (rnd & 1) ? RB(10) : RB(5);
        f32x4 sq[4];
        if (rnd < 5) {
#pragma unroll
            for (int n_ = 0; n_ < 4; ++n_) { const int ti = wq + 2 * (n_ & 1); sq[n_] = (n_ < 2) ? mm64(Xn, XnT, ti, tj, Z4, lane) : mm64(XnT, Xn, ti, tj, Z4, lane); } }
        if (rnd > 0) {
#pragma unroll
            for (int q = 0; q < 2; ++q) pacc[q] = mm64(XnT, Pold, wq + 2 * q, tj, pacc[q], lane); }
        if (rnd < 5) {
#pragma unroll
            for (int n_ = 0; n_ < 4; ++n_) storeT((n_ < 2) ? YnT : Yn, wq + 2 * (n_ & 1), tj, sq[n_], lane); }
        if (rnd > 0) {
#pragma unroll
            for (int q = 0; q < 2; ++q) storeT(Pnew, wq + 2 * q, tj, pacc[q], lane); }
        LDS_BARRIER();
    }
    LAS bf16_t* Tm = RB(10);
    LAS bf16_t* AhT = RB(0); LAS bf16_t* W1T = RB(1); LAS bf16_t* UlT = RB(6);
    { f32x4 res[4];
#pragma unroll
      for (int n_ = 0; n_ < 4; ++n_) { const int ti = wq + 2 * (n_ & 1); res[n_] = (n_ < 2) ? mm64(Tm, AtT, ti, tj, Z4, lane) : mm64(Aak, VT, ti, tj, Z4, lane); }
#pragma unroll
      for (int n_ = 0; n_ < 4; ++n_) storeT((n_ < 2) ? AhT : W1T, wq + 2 * (n_ & 1), tj, res[n_], lane); }
    LDS_BARRIER();
    { f32x4 res[2];
#pragma unroll
      for (int n_ = 0; n_ < 2; ++n_) res[n_] = mm64(Tm, W1T, wq + 2 * n_, tj, Z4, lane);
#pragma unroll
      for (int n_ = 0; n_ < 2; ++n_) storeT(UlT, wq + 2 * n_, tj, res[n_], lane); }
    LDS_BARRIER();
    bf16_t* gM = (bf16_t*)(C.ws + WS_RWM) + (size_t)ch * 4096; bf16_t* gNT = (bf16_t*)(C.ws + WS_RWNT) + (size_t)ch * 4096; bf16_t* gQ = (bf16_t*)(C.ws + WS_RWQH) + (size_t)ch * 4096; bf16_t* gY = (bf16_t*)(C.ws + WS_RWYL) + (size_t)ch * 4096;
#pragma unroll
    for (int n_ = 0; n_ < 8; ++n_) { const int o = n_ >> 1, ti = wq + 2 * (n_ & 1); const int rho = 16 * tj + r, kap = 16 * ti + 4 * g;
        if (o == 0) {
            const u32x2 w = *(const LAS u32x2*)(Rt + rho * LD + kap); f32x4 v = (f32x4){bflo(w[0]), bfhi(w[0]), bflo(w[1]), bfhi(w[1])};
            v = mm64(AhT, Arb, ti, tj, v, lane); *(u32x2*)(gQ + rho * 64 + kap) = (u32x2){pk2(v[0], v[1]), pk2(v[2], v[3])}; }
        else if (o == 1) {
            f32x4 v = mm64(UlT, Arb, ti, tj, Z4, lane); v = mm64(VT, Ark, ti, tj, v, lane); *(u32x2*)(gY + rho * 64 + kap) = (u32x2){pk2(v[0], v[1]), pk2(v[2], v[3])}; }
        else if (o == 2) {
            f32x4 v = mm64(AhT, BtT, ti, tj, Z4, lane); const float gl = gamL[rho];
#pragma unroll
            for (int j = 0; j < 4; ++j) v[j] = gl * (v[j] + ((kap + j == rho) ? 1.0f : 0.f));
            *(u32x2*)(gM + rho * 64 + kap) = (u32x2){pk2(v[0], v[1]), pk2(v[2], v[3])}; }
        else {
            f32x4 v = mm64(BtT, UlT, ti, tj, Z4, lane); v = mm64(KtT, VT, ti, tj, v, lane);
#pragma unroll
            for (int j = 0; j < 4; ++j) v[j] *= gamL[kap + j];
            *(u32x2*)(gNT + rho * 64 + kap) = (u32x2){pk2(v[0], v[1]), pk2(v[2], v[3])}; } }
    LDS_BARRIER();
#undef RB
}

__device__ __forceinline__ void mlb_unit(const Params& P, const Ctx& C, int l, int u) {
    const int tid = C.tid, wave = C.wave, lane = C.lane, r = lane & 15, g = lane >> 4;
    const int hh = u & 3, bcx = u >> 2, b = bcx >> 7, c = bcx & 127; const int tok0 = b * SEQ + c * 64; const int ch = (b * 4 + hh) * 128 + c;
    LAS unsigned char* L = C.lds;
    LAS bf16_t* Qs = (LAS bf16_t*)L; LAS bf16_t* Ks = (LAS bf16_t*)(L + BUFB); LAS bf16_t* KhT = (LAS bf16_t*)(L + 2 * BUFB); LAS bf16_t* Sm = (LAS bf16_t*)(L + 3 * BUFB); LAS bf16_t* VTe = (LAS bf16_t*)(L + 4 * BUFB);
    LAS float* vbc = (LAS float*)(L + 4 * BUFB + 80 * LD * 2); LAS float* vig = vbc + 64; LAS float* vmd = vig + 64; LAS float* vws = vmd + 64;
    const bf16_t* p = (const bf16_t*)(C.ws + WS_P);
    unsigned xr[19], vr[8];
    { const int cq = tid & 127, tg = tid >> 7, isk = cq >> 6, d = cq & 63; const int col = 2048 + isk * 256 + hh * 64 + d; const int t0 = 16 * tg; const bool okp = (c * 64 + t0 > 0);
#pragma unroll
      for (int k = 0; k < 19; ++k) xr[k] = p[(size_t)(tok0 + ((k < 3 && !okp) ? 0 : t0 + k - 3)) * NPROJ + col];
      const int v = tid & 63, sg = tid >> 6;
#pragma unroll
      for (int k = 0; k < 8; ++k) vr[k] = p[(size_t)(tok0 + 8 * sg + k) * NPROJ + 2560 + hh * 64 + v]; }
    if (wave == 0) { const float* pg = (const float*)(C.ws + WS_PG) + (size_t)(tok0 + lane) * 8; const float ig = pg[hh], f = pg[4 + hh];
        const float lf = fminf(f, 0.f) - __logf(1.0f + __expf(-fabsf(f)));
        float bcv = lf;
#pragma unroll
        for (int o = 1; o < 64; o <<= 1) { const float t = __shfl_up(bcv, o); bcv += (lane >= o) ? t : 0.f; }
        float pm = ig - bcv;
#pragma unroll
        for (int o = 1; o < 64; o <<= 1) { const float t = __shfl_up(pm, o); pm = (lane >= o) ? fmaxf(pm, t) : pm; }
        const float md = bcv + pm; const float bcL = __shfl(bcv, 63); const float as = bcL - bcv + ig; const float mloc = wave_max(as); const float ws = __expf(as - mloc);
        vbc[lane] = bcv; vig[lane] = ig; vmd[lane] = md; vws[lane] = ws;
        float* vec = (float*)(C.ws + WS_MLVEC) + ((size_t)ch * 64 + lane) * 2; vec[0] = bcv; vec[1] = md;
        if (lane == 0) { float* sc = (float*)(C.ws + WS_MLSC) + (size_t)ch * 2; sc[0] = bcL; sc[1] = mloc; } }
    LDS_BARRIER();
    { const int cq = tid & 127, tg = tid >> 7, isk = cq >> 6, d = cq & 63; const int col = 2048 + isk * 256 + hh * 64 + d; const int cw = isk * 256 + hh * 64 + d;
      const float* cwp = P.in[I_CONVW] + (size_t)l * 4 * 512; const float w0 = cwp[cw], w1 = cwp[512 + cw], w2 = cwp[1024 + cw], w3 = cwp[1536 + cw], cb = P.in[I_CONVB][l * 512 + cw];
      float xm3 = 0.f, xm2 = 0.f, xm1 = 0.f; const int t0 = 16 * tg;
      if (c * 64 + t0 > 0) { xm3 = bf2f((unsigned short)xr[0]); xm2 = bf2f((unsigned short)xr[1]); xm1 = bf2f((unsigned short)xr[2]); }
      float o16[16];
#pragma unroll
      for (int k = 0; k < 16; ++k) { const float x0 = bf2f((unsigned short)xr[k + 3]); const float y = w0 * xm3 + w1 * xm2 + w2 * xm1 + w3 * x0 + cb; const float s = y * sigmoidf_(y);
          o16[k] = isk ? s * 0.125f : s; xm3 = xm2; xm2 = xm1; xm1 = x0; }
      if (!isk) { bf16_t* gq = (bf16_t*)(C.ws + WS_MLQ) + (size_t)ch * 4096;
#pragma unroll
          for (int k = 0; k < 16; ++k) { const bf16_t v = (bf16_t)f2bf(o16[k]); Qs[(t0 + k) * LD + d] = v; gq[(t0 + k) * 64 + d] = v; } }
      else {
#pragma unroll
          for (int k = 0; k < 16; ++k) { Ks[(t0 + k) * LD + d] = (bf16_t)f2bf(o16[k]); o16[k] *= vws[t0 + k]; }
          *(LAS u32x4*)(KhT + d * LD + t0) = (u32x4){pk2(o16[0], o16[1]), pk2(o16[2], o16[3]), pk2(o16[4], o16[5]), pk2(o16[6], o16[7])};
          *(LAS u32x4*)(KhT + d * LD + t0 + 8) = (u32x4){pk2(o16[8], o16[9]), pk2(o16[10], o16[11]), pk2(o16[12], o16[13]), pk2(o16[14], o16[15])}; }
      { const int v = tid & 63, sg = tid >> 6; float vv[8];
#pragma unroll
        for (int k = 0; k < 8; ++k) vv[k] = bf2f((unsigned short)vr[k]);
        *(LAS u32x4*)(VTe + v * LD + 8 * sg) = (u32x4){pk2(vv[0], vv[1]), pk2(vv[2], vv[3]), pk2(vv[4], vv[5]), pk2(vv[6], vv[7])}; }
      if (tid < 128) { const int row = 64 + (tid >> 3), pc = tid & 7; const unsigned one2 = 0x3f803f80u; const unsigned val = (row == 64) ? one2 : 0u; *(LAS u32x4*)(VTe + row * LD + 8 * pc) = (u32x4){val, val, val, val}; }
    }
    LDS_BARRIER();
    const f32x4 Z4 = (f32x4){0.f, 0.f, 0.f, 0.f};
    bf16_t* gKL = (bf16_t*)(C.ws + WS_MLKL) + (size_t)ch * 5120; bf16_t* gNL = (bf16_t*)(C.ws + WS_MLNL) + (size_t)ch * 5120;
    for (int task = wave; task < 36; task += 8) {
        if (task < 16) { const int ti = task >> 2, tj = task & 3; f32x4 v = mm64(Ks, Qs, ti, tj, Z4, lane);
            const int rho = 16 * tj + r, kap = 16 * ti + 4 * g; const float bl = vbc[rho] - vmd[rho];
#pragma unroll
            for (int j = 0; j < 4; ++j) { const int s = kap + j; v[j] = (s <= rho) ? v[j] * __expf(bl - vbc[s] + vig[s]) : 0.f; }
            storeT(Sm, ti, tj, v, lane); }
        else { const int t2 = task - 16, ti = t2 / 5, tj = t2 % 5;
            const f32x4 v = mm64(KhT, VTe, ti, tj, Z4, lane); *(u32x2*)(gKL + (16 * tj + r) * 64 + 16 * ti + 4 * g) = (u32x2){pk2(v[0], v[1]), pk2(v[2], v[3])}; } }
    LDS_BARRIER();
    for (int task = wave; task < 20; task += 8) { const int ti = task >> 2, tj = task & 3; const f32x4 v = mm64(VTe, Sm, ti, tj, Z4, lane); *(u32x2*)(gNL + (16 * tj + r) * 80 + 16 * ti + 4 * g) = (u32x2){pk2(v[0], v[1]), pk2(v[2], v[3])}; }
    LDS_BARRIER();
}

__device__ __forceinline__ void rwkv_chain(const Ctx& C, int bh, int vh) {
    const int tid = C.tid, wave = C.wave, lane = C.lane, r = lane & 15, g = lane >> 4; const size_t ch0 = (size_t)bh * 128;
    LAS unsigned char* L = C.lds; LAS unsigned char* Mb = L; LAS unsigned char* Nb = L + 8 * BUFB; LAS unsigned char* Sb = Nb + 8 * (32 * LD * 2);
    static_assert(8 * BUFB + 8 * 32 * LD * 2 + 8 * 32 * 128 <= MISC_OFF, "chain LDS");
    const bf16_t* gM = (const bf16_t*)(C.ws + WS_RWM) + ch0 * 4096; const bf16_t* gN = (const bf16_t*)(C.ws + WS_RWNT) + ch0 * 4096 + (size_t)vh * 32 * 64; bf16_t* gS = (bf16_t*)(C.ws + WS_RWS) + ch0 * 4096;
    u32x4 pmA[8], pnA4[4];
#define CH_LOAD(pm, pn, nbx) do { const bf16_t* m_ = gM + (size_t)(nbx) * 8 * 4096; \
        _Pragma("unroll") for (int i = 0; i < 8; ++i) pm[i] = ((const u32x4*)m_)[tid + 512 * i]; \
        _Pragma("unroll") for (int i = 0; i < 4; ++i) { const int q = tid + 512 * i, chunk = q >> 8, within = q & 255; pn[i] = ((const u32x4*)(gN + ((size_t)(nbx) * 8 + chunk) * 4096))[within]; } } while (0)
#define CH_PUT(pm, pn) do { \
        _Pragma("unroll") for (int i = 0; i < 8; ++i) { const int q = tid + 512 * i, chunk = q >> 9, within = q & 511, row = within >> 3, pc = within & 7; *(LAS u32x4*)(Mb + chunk * BUFB + row * (LD * 2) + pc * 16) = pm[i]; } \
        _Pragma("unroll") for (int i = 0; i < 4; ++i) { const int q = tid + 512 * i, chunk = q >> 8, within = q & 255, row = within >> 3, pc = within & 7; *(LAS u32x4*)(Nb + chunk * (32 * LD * 2) + row * (LD * 2) + pc * 16) = pn[i]; } } while (0)
    CH_LOAD(pmA, pnA4, 0);
    f32x4 acc[4];
#pragma unroll
    for (int t = 0; t < 4; ++t) acc[t] = (f32x4){0.f, 0.f, 0.f, 0.f};
#define CH_FRAGS(cc_, mf_, nf_) do { const LAS unsigned char* mc = Mb + (cc_) * BUFB; const LAS unsigned char* nc = Nb + (cc_) * (32 * LD * 2); \
        _Pragma("unroll") for (int t = 0; t < 4; ++t) { nf_[t] = *(const LAS u32x2*)(nc + (16 * wave + r) * (LD * 2) + (16 * t + 4 * g) * 2); \
            const LAS unsigned char* mp = mc + (16 * t + r) * (LD * 2) + (4 * g) * 2; const u32x2 lo = *(const LAS u32x2*)mp, hi = *(const LAS u32x2*)(mp + 32); mf_[t] = (u32x4){lo[0], lo[1], hi[0], hi[1]}; } } while (0)
#define CH_ONE(cc_, mf_, nf_) do { \
            u32x4 m2[4]; { const LAS unsigned char* mc = Mb + (cc_) * BUFB; \
            _Pragma("unroll") for (int t = 0; t < 4; ++t) { const LAS unsigned char* mp = mc + (16 * t + r) * (LD * 2) + (32 + 4 * g) * 2; const u32x2 lo = *(const LAS u32x2*)mp, hi = *(const LAS u32x2*)(mp + 32); m2[t] = (u32x4){lo[0], lo[1], hi[0], hi[1]}; } } \
            u32x2 pk[4]; \
            _Pragma("unroll") for (int t = 0; t < 4; ++t) pk[t] = (u32x2){pk2(acc[t][0], acc[t][1]), pk2(acc[t][2], acc[t][3])}; \
            LAS unsigned char* sg = Sb + (cc_) * 4096 + (16 * wave + r) * 128 + (4 * g) * 2; \
            _Pragma("unroll") for (int t = 0; t < 4; ++t) *(LAS u32x2*)(sg + 32 * t) = pk[t]; \
            bf16x8 zb[2]; \
            _Pragma("unroll") for (int s = 0; s < 2; ++s) { const u32x4 z = (u32x4){pk[2 * s][0], pk[2 * s][1], pk[2 * s + 1][0], pk[2 * s + 1][1]}; zb[s] = __builtin_bit_cast(bf16x8, z); } \
            _Pragma("unroll") for (int t = 0; t < 4; ++t) { const u32x2 nw = nf_[t]; const f32x4 a0 = (f32x4){bflo(nw[0]), bfhi(nw[0]), bflo(nw[1]), bfhi(nw[1])}; \
                acc[t] = mfma16(__builtin_bit_cast(bf16x8, mf_[t]), zb[0], a0); } \
            _Pragma("unroll") for (int t = 0; t < 4; ++t) acc[t] = mfma16(__builtin_bit_cast(bf16x8, m2[t]), zb[1], acc[t]); } while (0)
#define CH_STEP(nbx) do { if (wave < 2) { u32x4 mf0[4], mf1[4]; u32x2 nf0[4], nf1[4]; CH_FRAGS(0, mf0, nf0); \
        _Pragma("unroll 1") for (int cc = 0; cc < 8; cc += 2) { \
            CH_FRAGS(cc + 1, mf1, nf1); CH_ONE(cc, mf0, nf0); \
            if (cc + 2 < 8) CH_FRAGS(cc + 2, mf0, nf0); CH_ONE(cc + 1, mf1, nf1); } } } while (0)
#define CH_SOUT(nbx) do { _Pragma("unroll") for (int i = 0; i < 4; ++i) { const int q = tid + 512 * i, chunk = q >> 8, within = q & 255, row = within >> 3, pc = within & 7; \
        const u32x4 v = *(const LAS u32x4*)(Sb + chunk * 4096 + row * 128 + pc * 16); *(u32x4*)(gS + ((size_t)(nbx) * 8 + chunk) * 4096 + (32 * vh + row) * 64 + pc * 8) = v; } } while (0)
    for (int nb = 0; nb < 16; ++nb) {
        LDS_BARRIER(); if (nb > 0) CH_SOUT(nb - 1); CH_PUT(pmA, pnA4); LDS_BARRIER();
        if (nb + 1 < 16) CH_LOAD(pmA, pnA4, nb + 1);
        CH_STEP(nb);
    }
    LDS_BARRIER(); CH_SOUT(15);
#undef CH_SOUT
#undef CH_LOAD
#undef CH_PUT
#undef CH_STEP
#undef CH_FRAGS
#undef CH_ONE
}
__device__ __forceinline__ void mlstm_cscan(const Ctx& C, int bh, int part) {
    const int tid = C.tid; const size_t ch0 = (size_t)bh * 128; const int e0 = 10 * (part * 128 + (tid & 127));
    const bf16_t* KL = (const bf16_t*)(C.ws + WS_MLKL) + ch0 * 5120 + e0; bf16_t* CT = (bf16_t*)(C.ws + WS_MLCT) + ch0 * 5120 + e0; float* MM = (float*)(C.ws + WS_MLM) + ch0; const float* SC = (const float*)(C.ws + WS_MLSC) + ch0 * 2;
    float st[10]; unsigned ring[8][5]; float m = 0.f;
    LAS float* scl = (LAS float*)C.lds; if (tid < 256) scl[tid] = SC[tid];
    __syncthreads();
    if (tid >= 128) return;
#pragma unroll
    for (int i = 0; i < 10; ++i) st[i] = 0.f;
#pragma unroll
    for (int k = 0; k < 8; ++k)
#pragma unroll
        for (int i = 0; i < 5; ++i) ring[k][i] = *(const unsigned*)(KL + (size_t)k * 5120 + 2 * i);
    for (int c0 = 0; c0 < 128; c0 += 8) {
#pragma unroll
        for (int k = 0; k < 8; ++k) { const int c = c0 + k; unsigned cur[5];
#pragma unroll
            for (int i = 0; i < 5; ++i) cur[i] = ring[k][i];
            if (c + 8 < 128) {
#pragma unroll
                for (int i = 0; i < 5; ++i) ring[k][i] = *(const unsigned*)(KL + (size_t)(c + 8) * 5120 + 2 * i); }
            const float bcL = scl[2 * c], mloc = scl[2 * c + 1];
            unsigned* ct = (unsigned*)(CT + (size_t)c * 5120);
#pragma unroll
            for (int i = 0; i < 5; ++i) ct[i] = pk2(st[2 * i], st[2 * i + 1]);
            if (tid == 0 && part == 0) MM[c] = m;
            const float mn = fmaxf(bcL + m, mloc); const float dec = __expf(bcL + m - mn), sc = __expf(mloc - mn); m = mn;
#pragma unroll
            for (int i = 0; i < 5; ++i) { st[2 * i] = dec * st[2 * i] + sc * bflo(cur[i]); st[2 * i + 1] = dec * st[2 * i + 1] + sc * bfhi(cur[i]); } }
    }
}

__device__ __forceinline__ void passd_unit(const Params& P, const Ctx& C, int l, int u) {
    const int wave = C.wave, lane = C.lane, r = lane & 15, g = lane >> 4; const int b = u >> 7, c = u & 127; const int tok0 = b * SEQ + c * 64;
    bf16_t* ymix = (bf16_t*)(C.ws + WS_YMIX);
    {
        bf16x8 qf[3][2], sf[3][4][2]; u32x2 yl[3][4], bo[3][4], gg[3][4];
#pragma unroll
        for (int n_ = 0; n_ < 3; ++n_) { const int task = wave + 8 * n_, h = task >> 2, tb = task & 3; const size_t ch = (size_t)(b * 6 + h) * 128 + c; const int t = 16 * tb + r; const int tok = tok0 + t;
            const bf16_t* gS = (const bf16_t*)(C.ws + WS_RWS) + ch * 4096; const bf16_t* gQ = (const bf16_t*)(C.ws + WS_RWQH) + ch * 4096 + t * 64 + 8 * g; const bf16_t* gY = (const bf16_t*)(C.ws + WS_RWYL) + ch * 4096 + t * 64 + 4 * g;
            const bf16_t* aux = (const bf16_t*)(C.ws + WS_RWAUX) + (size_t)tok * 768 + 64 * h + 4 * g;
            qf[n_][0] = *(const bf16x8*)gQ; qf[n_][1] = *(const bf16x8*)(gQ + 32);
#pragma unroll
            for (int ti = 0; ti < 4; ++ti) { const bf16_t* sp = gS + (16 * ti + r) * 64 + 8 * g; sf[n_][ti][0] = *(const bf16x8*)sp; sf[n_][ti][1] = *(const bf16x8*)(sp + 32);
                yl[n_][ti] = *(const u32x2*)(gY + 16 * ti); bo[n_][ti] = *(const u32x2*)(aux + 16 * ti); gg[n_][ti] = *(const u32x2*)(aux + RWD + 16 * ti); } }
#pragma unroll
        for (int n_ = 0; n_ < 3; ++n_) { const int task = wave + 8 * n_, h = task >> 2, tb = task & 3; const int t = 16 * tb + r; const int tok = tok0 + t;
            f32x4 y[4]; float s = 0.f;
#pragma unroll
            for (int ti = 0; ti < 4; ++ti) { const u32x2 yw = yl[n_][ti]; f32x4 a = (f32x4){bflo(yw[0]), bfhi(yw[0]), bflo(yw[1]), bfhi(yw[1])};
                a = mfma16(sf[n_][ti][0], qf[n_][0], a); a = mfma16(sf[n_][ti][1], qf[n_][1], a); y[ti] = a; s += (a[0] + a[1]) + (a[2] + a[3]); }
            s += __shfl_xor(s, 16); s += __shfl_xor(s, 32); const float mean = s * (1.f / 64.f); float s2 = 0.f;
#pragma unroll
            for (int ti = 0; ti < 4; ++ti) { y[ti] = y[ti] - mean; s2 += (y[ti][0] * y[ti][0] + y[ti][1] * y[ti][1]) + (y[ti][2] * y[ti][2] + y[ti][3] * y[ti][3]); }
            s2 += __shfl_xor(s2, 16); s2 += __shfl_xor(s2, 32); const float rstd = rsqrtf(s2 * (1.f / 64.f) + 64e-5f);
            bf16_t* yo = ymix + (size_t)tok * DM + 64 * h + 4 * g;
            const float* lw = P.in[I_LNW] + l * RWD + 64 * h + 4 * g; const float* lb = P.in[I_LNB] + l * RWD + 64 * h + 4 * g;
#pragma unroll
            for (int ti = 0; ti < 4; ++ti) { const u32x2 bo_ = bo[n_][ti], gg_ = gg[n_][ti]; const f32x4 w4 = *(const f32x4*)(lw + 16 * ti), b4 = *(const f32x4*)(lb + 16 * ti);
                const float o0 = (y[ti][0] * rstd * w4[0] + b4[0] + bflo(bo_[0])) * bflo(gg_[0]), o1 = (y[ti][1] * rstd * w4[1] + b4[1] + bfhi(bo_[0])) * bfhi(gg_[0]);
                const float o2 = (y[ti][2] * rstd * w4[2] + b4[2] + bflo(bo_[1])) * bflo(gg_[1]), o3 = (y[ti][3] * rstd * w4[3] + b4[3] + bfhi(bo_[1])) * bfhi(gg_[1]);
                *(u32x2*)(yo + 16 * ti) = (u32x2){pk2(o0, o1), pk2(o2, o3)}; } }
    }
    {
        bf16x8 qf[2][2], cf[2][5][2]; u32x2 nl[2][5], og[2][4]; float bcl[2], mdl[2], mcv[2];
#pragma unroll
        for (int n_ = 0; n_ < 2; ++n_) { const int task = wave + 8 * (n_ + 3), hh = (task - 24) >> 2, tb = task & 3; const size_t ch = (size_t)(b * 4 + hh) * 128 + c; const int t = 16 * tb + r; const int tok = tok0 + t;
            const bf16_t* gC = (const bf16_t*)(C.ws + WS_MLCT) + ch * 5120; const bf16_t* gQ = (const bf16_t*)(C.ws + WS_MLQ) + ch * 4096 + t * 64 + 8 * g; const bf16_t* gNL = (const bf16_t*)(C.ws + WS_MLNL) + ch * 5120 + t * 80 + 4 * g;
            const bf16_t* ogp = (const bf16_t*)(C.ws + WS_P) + (size_t)tok * NPROJ + 2816 + 64 * hh + 4 * g;
            qf[n_][0] = *(const bf16x8*)gQ; qf[n_][1] = *(const bf16x8*)(gQ + 32);
            const float* vec = (const float*)(C.ws + WS_MLVEC) + (ch * 64 + t) * 2; bcl[n_] = vec[0]; mdl[n_] = vec[1]; mcv[n_] = ((const float*)(C.ws + WS_MLM))[ch];
#pragma unroll
            for (int ti = 0; ti < 5; ++ti) { const bf16_t* cp = gC + (16 * ti + r) * 64 + 8 * g; cf[n_][ti][0] = *(const bf16x8*)cp; cf[n_][ti][1] = *(const bf16x8*)(cp + 32); nl[n_][ti] = *(const u32x2*)(gNL + 16 * ti); }
#pragma unroll
            for (int ti = 0; ti < 4; ++ti) og[n_][ti] = *(const u32x2*)(ogp + 16 * ti); }
#pragma unroll
        for (int n_ = 0; n_ < 2; ++n_) { const int task = wave + 8 * (n_ + 3), hh = (task - 24) >> 2, tb = task & 3; const int t = 16 * tb + r; const int tok = tok0 + t;
            const float mint = bcl[n_] + mcv[n_], mt = fmaxf(mint, mdl[n_]); const float inter = __expf(mint - mt), fl = __expf(mdl[n_] - mt);
            f32x4 y[5];
#pragma unroll
            for (int ti = 0; ti < 5; ++ti) { f32x4 a = (f32x4){0.f, 0.f, 0.f, 0.f};
                a = mfma16(cf[n_][ti][0], qf[n_][0], a); a = mfma16(cf[n_][ti][1], qf[n_][1], a); const u32x2 nw = nl[n_][ti]; const f32x4 nlv = (f32x4){bflo(nw[0]), bfhi(nw[0]), bflo(nw[1]), bfhi(nw[1])}; y[ti] = fl * nlv + inter * a; }
            const float nq = __shfl(y[4][0], r);
            const float inv = 1.0f / fmaxf(fabsf(nq), __expf(-mt));
            float s = 0.f;
#pragma unroll
            for (int ti = 0; ti < 4; ++ti) { y[ti] = y[ti] * inv; s += (y[ti][0] + y[ti][1]) + (y[ti][2] + y[ti][3]); }
            s += __shfl_xor(s, 16); s += __shfl_xor(s, 32); const float mean = s * (1.f / 64.f); float s2 = 0.f;
#pragma unroll
            for (int ti = 0; ti < 4; ++ti) { y[ti] = y[ti] - mean; s2 += (y[ti][0] * y[ti][0] + y[ti][1] * y[ti][1]) + (y[ti][2] * y[ti][2] + y[ti][3] * y[ti][3]); }
            s2 += __shfl_xor(s2, 16); s2 += __shfl_xor(s2, 32); const float rstd = rsqrtf(s2 * (1.f / 64.f) + 1e-6f);
            bf16_t* yo = ymix + (size_t)tok * DM + 768 + 64 * hh + 4 * g; const float* nw = P.in[I_MLNW] + l * 256 + 64 * hh + 4 * g;
#pragma unroll
            for (int ti = 0; ti < 4; ++ti) { const u32x2 oo = og[n_][ti]; const f32x4 w4 = *(const f32x4*)(nw + 16 * ti);
                const float o0 = y[ti][0] * rstd * w4[0] * sigmoidf_(bflo(oo[0])), o1 = y[ti][1] * rstd * w4[1] * sigmoidf_(bfhi(oo[0])), o2 = y[ti][2] * rstd * w4[2] * sigmoidf_(bflo(oo[1])), o3 = y[ti][3] * rstd * w4[3] * sigmoidf_(bfhi(oo[1]));
                *(u32x2*)(yo + 16 * ti) = (u32x2){pk2(o0, o1), pk2(o2, o3)}; } }
    }
}

__device__ __forceinline__ void ln1_router_phase(const Params& P, const Ctx& C, int l, int cnt_off) {
    const int tid = C.tid, wave = C.wave, lane = C.lane, r = lane & 15, g = lane >> 4;
    constexpr int HS = 1032;
    LAS bf16_t* hhi = (LAS bf16_t*)C.lds;
    LAS bf16_t* hlo = hhi + 16 * HS;
    LAS float* part = (LAS float*)(hlo + 16 * HS);
    LAS int* lcnt = (LAS int*)(part + 8 * 8 * 32);
    bf16x8 bh[4][2], bl[4][2];
#pragma unroll
    for (int ks = 0; ks < 4; ++ks)
#pragma unroll
        for (int nt = 0; nt < 2; ++nt) { const size_t off = ((size_t)l * NEXP + 16 * nt + r) * DM + 32 * (4 * wave + ks) + 8 * g;
            bh[ks][nt] = *(const bf16x8*)((const bf16_t*)(C.ws + WS_WRH) + off); bl[ks][nt] = *(const bf16x8*)((const bf16_t*)(C.ws + WS_WRL) + off); }
    for (int i = tid; i < 16 * HS; i += 512) { hhi[i] = 0; hlo[i] = 0; }
    if (tid < 32) lcnt[tid] = 0;
    { int* pdest = (int*)(C.ws + WS_PDEST); int* ptok = (int*)(C.ws + WS_PTOK); for (int i = C.blk * 512 + tid; i < POS_MAX; i += C.G * 512) { pdest[i] = -1; ptok[i] = 0; } }
    __syncthreads();
    const int tpb = (MTOK + C.G - 1) / C.G, tok_lo = C.blk * tpb, tok_hi = (tok_lo + tpb < MTOK) ? tok_lo + tpb : MTOK;
    const bf16_t* t1 = (const bf16_t*)(C.ws + WS_T1); bf16_t* hb = (bf16_t*)(C.ws + WS_HB);
    int* toke = (int*)(C.ws + WS_TOKE); float* tokg = (float*)(C.ws + WS_TOKG); int* toklr = (int*)(C.ws + WS_TOKLR);
    const f32x4* lw4 = (const f32x4*)(P.in[I_LN1W] + (size_t)l * DM) + lane; const f32x4* lb4 = (const f32x4*)(P.in[I_LN1B] + (size_t)l * DM) + lane;
    u32x2 vn[4], rn[4];
    { const int tok = tok_lo + wave; const size_t ro = (size_t)((tok < tok_hi) ? tok : tok_lo) * DM; const u32x2* xr = (const u32x2*)(t1 + ro) + lane; const u32x2* rr = (const u32x2*)(hb + ro) + lane;
#pragma unroll
      for (int j = 0; j < 4; ++j) { vn[j] = xr[64 * j]; rn[j] = rr[64 * j]; } }
    const float rbias = P.in[I_RB][l * NEXP + (lane & 31)];
    f32x4 lwr[4], lbr[4];
#pragma unroll
    for (int j = 0; j < 4; ++j) { lwr[j] = lw4[64 * j]; lbr[j] = lb4[64 * j]; }
    for (int base = tok_lo; base < tok_hi; base += 8) {
        const int tok = base + wave;
        f32x4 v[4];
#pragma unroll
        for (int j = 0; j < 4; ++j) v[j] = (f32x4){bflo(vn[j][0]), bfhi(vn[j][0]), bflo(vn[j][1]), bfhi(vn[j][1])} + DN_ALPHA * (f32x4){bflo(rn[j][0]), bfhi(rn[j][0]), bflo(rn[j][1]), bfhi(rn[j][1])};
        { const int tn = base + 8 + wave; const size_t ro = (size_t)((tn < tok_hi) ? tn : tok_lo) * DM; const u32x2* xr = (const u32x2*)(t1 + ro) + lane; const u32x2* rr = (const u32x2*)(hb + ro) + lane;
#pragma unroll
          for (int j = 0; j < 4; ++j) { vn[j] = xr[64 * j]; rn[j] = rr[64 * j]; } }
        if (tok < tok_hi) {
            float s = 0.f;
#pragma unroll
            for (int j = 0; j < 4; ++j) s += (v[j][0] + v[j][1]) + (v[j][2] + v[j][3]);
            const float mean = wave_sum(s) * (1.f / DM); float s2 = 0.f;
#pragma unroll
            for (int j = 0; j < 4; ++j) { v[j] = v[j] - mean; s2 += (v[j][0] * v[j][0] + v[j][1] * v[j][1]) + (v[j][2] * v[j][2] + v[j][3] * v[j][3]); }
            const float rstd = rsqrtf(wave_sum(s2) * (1.f / DM) + LN_EPS);
            u32x2* ob = (u32x2*)((cnt_off ? (bf16_t*)(C.ws + WS_HF) : hb) + (size_t)tok * DM) + lane;
#pragma unroll
            for (int j = 0; j < 4; ++j) { const f32x4 y = v[j] * rstd * lwr[j] + lbr[j]; const u32x2 hi = (u32x2){pk2(y[0], y[1]), pk2(y[2], y[3])}; ob[64 * j] = hi;
                const u32x2 lo = (u32x2){pk2(y[0] - bflo(hi[0]), y[1] - bfhi(hi[0])), pk2(y[2] - bflo(hi[1]), y[3] - bfhi(hi[1]))};
                *(LAS u32x2*)(hhi + wave * HS + 4 * (lane + 64 * j)) = hi; *(LAS u32x2*)(hlo + wave * HS + 4 * (lane + 64 * j)) = lo; }
        }
        LDS_BARRIER();
        { f32x4 acc[2]; acc[0] = (f32x4){0.f, 0.f, 0.f, 0.f}; acc[1] = acc[0];
#pragma unroll
          for (int ks = 0; ks < 4; ++ks) { const int ko = r * HS + 32 * (4 * wave + ks) + 8 * g; const bf16x8 ah = *(const LAS bf16x8*)(hhi + ko), al = *(const LAS bf16x8*)(hlo + ko);
#pragma unroll
              for (int nt = 0; nt < 2; ++nt) { acc[nt] = mfma16(ah, bh[ks][nt], acc[nt]); acc[nt] = mfma16(ah, bl[ks][nt], acc[nt]); acc[nt] = mfma16(al, bh[ks][nt], acc[nt]); } }
          if (g < 2) {
#pragma unroll
              for (int nt = 0; nt < 2; ++nt)
#pragma unroll
                  for (int j = 0; j < 4; ++j) part[(wave * 8 + 4 * g + j) * 32 + 16 * nt + r] = acc[nt][j]; } }
        LDS_BARRIER();
        if (tok < tok_hi) { const int ee = lane & 31; float lg = rbias;
#pragma unroll
            for (int w8 = 0; w8 < 8; ++w8) lg += part[(w8 * 8 + wave) * 32 + ee];
            float bv[4]; int bi[4];
#pragma unroll
            for (int rd = 0; rd < 4; ++rd) { float mv = lg; int mi = ee;
#define AM_STEP(CTRL) { const float ov = dpp_mov<CTRL>(mv); const int oi = __builtin_bit_cast(int, dpp_mov<CTRL>(__builtin_bit_cast(float, mi))); const bool take = (ov > mv) || (ov == mv && oi < mi); mv = take ? ov : mv; mi = take ? oi : mi; }
                AM_STEP(0xB1) AM_STEP(0x4E) AM_STEP(0x141) AM_STEP(0x140)
#undef AM_STEP
                { const float m0 = __builtin_bit_cast(float, __builtin_amdgcn_readlane(__builtin_bit_cast(int, mv), 0)), m1 = __builtin_bit_cast(float, __builtin_amdgcn_readlane(__builtin_bit_cast(int, mv), 16));
                  const int i0 = __builtin_amdgcn_readlane(mi, 0), i1 = __builtin_amdgcn_readlane(mi, 16); const bool take = (m1 > m0) || (m1 == m0 && i1 < i0); mv = take ? m1 : m0; mi = take ? i1 : i0; }
                bv[rd] = mv; bi[rd] = mi; lg = (ee == mi) ? -__builtin_inff() : lg; }
            if (lane == 0) { const float e1 = __expf(bv[1] - bv[0]), e2 = __expf(bv[2] - bv[0]), e3 = __expf(bv[3] - bv[0]); const float inv = 1.0f / (1.0f + e1 + e2 + e3);
                const int l0 = __hip_atomic_fetch_add(&lcnt[bi[0]], 1, __ATOMIC_RELAXED, __HIP_MEMORY_SCOPE_WORKGROUP), l1 = __hip_atomic_fetch_add(&lcnt[bi[1]], 1, __ATOMIC_RELAXED, __HIP_MEMORY_SCOPE_WORKGROUP), l2 = __hip_atomic_fetch_add(&lcnt[bi[2]], 1, __ATOMIC_RELAXED, __HIP_MEMORY_SCOPE_WORKGROUP), l3 = __hip_atomic_fetch_add(&lcnt[bi[3]], 1, __ATOMIC_RELAXED, __HIP_MEMORY_SCOPE_WORKGROUP);
                *(int4*)(toke + tok * 4) = make_int4(bi[0], bi[1], bi[2], bi[3]); *(f32x4*)(tokg + tok * 4) = (f32x4){inv, e1 * inv, e2 * inv, e3 * inv}; *(int4*)(toklr + tok * 4) = make_int4(l0, l1, l2, l3); } }
        LDS_BARRIER();
    }
    if (tid < 32) { unsigned* gc = (unsigned*)(C.ws + WS_CTL) + CW_CNT + cnt_off + l * 32 + tid;
        const unsigned bb = __hip_atomic_fetch_add(gc, (unsigned)lcnt[tid], __ATOMIC_RELAXED, __HIP_MEMORY_SCOPE_AGENT);
        ((int*)(C.ws + WS_BBASE))[C.blk * 32 + tid] = (int)bb; }
    __syncthreads();
}
__device__ __forceinline__ void permute_phase(const Params& P, const Ctx& C, int l) {
    const int tid = C.tid, wave = C.wave, lane = C.lane;
    LAS int* pst = (LAS int*)C.lds;
    if (tid == 0) { const unsigned* gc = (const unsigned*)(C.ws + WS_CTL) + CW_CNT + l * 32; int ps = 0;
        for (int e = 0; e < 32; ++e) { pst[e] = ps; ps += ((int)__hip_atomic_load(gc + e, __ATOMIC_RELAXED, __HIP_MEMORY_SCOPE_AGENT) + 255) & ~255; } }
    __syncthreads();
    const int tpb = (MTOK + C.G - 1) / C.G, tok_lo = C.blk * tpb, tok_hi = (tok_lo + tpb < MTOK) ? tok_lo + tpb : MTOK;
    const int* toke = (const int*)(C.ws + WS_TOKE); const float* tokg = (const float*)(C.ws + WS_TOKG); const int* toklr = (const int*)(C.ws + WS_TOKLR); const int* bbase = (const int*)(C.ws + WS_BBASE) + C.blk * 32;
    const bf16_t* hb = (const bf16_t*)(C.ws + WS_HB); bf16_t* xp = (bf16_t*)(C.ws + WS_XPERM); int* pdest = (int*)(C.ws + WS_PDEST); float* pgate = (float*)(C.ws + WS_PGATE);
    int* ptok = (int*)(C.ws + WS_PTOK);
    for (int a = tid; a < 4 * (tok_hi - tok_lo); a += 512) { const int tok = tok_lo + (a >> 2), as = tok * 4 + (a & 3);
        const int e = toke[as]; const int pos = pst[e] + bbase[e] + toklr[as];
        pdest[pos] = as; pgate[pos] = tokg[as]; ptok[pos] = tok; }
    __syncthreads();
}
__device__ __forceinline__ void build_tile_e(const Ctx& C, int l) {
    LAS int* te = (LAS int*)(C.lds + TILEE_OFF);
    if (C.tid == 0) { const unsigned* gc = (const unsigned*)(C.ws + WS_CTL) + CW_CNT + l * 32; int t = 0;
        for (int e = 0; e < 32; ++e) { const int nt = ((int)__hip_atomic_load(gc + e, __ATOMIC_RELAXED, __HIP_MEMORY_SCOPE_AGENT) + 255) >> 8; for (int k = 0; k < nt && t < NT_MAX; ++k) te[t++] = e; }
        for (; t < NT_MAX; ++t) te[t] = 0; }
    __syncthreads();
}
__device__ __forceinline__ void combine_ln2_phase(const Params& P, const Ctx& C, int l, int dummy = 0) {
    const int lane = C.lane; const int gw = C.blk * 8 + C.wave, NGW = C.G * 8;
    const bool last = (l == NLAYER - 1);
    LAS float* wg = (LAS float*)C.lds;
    if (!last) load_wg(wg, P.in[I_WIN] + (size_t)(l + 1) * DM * CIN, C.tid);
    const bf16_t* yb = (const bf16_t*)(C.ws + WS_YB);
    float* hf = P.out; bf16_t* hb = (bf16_t*)(C.ws + WS_HB); float* pg = (float*)(C.ws + WS_PG);
    const f32x4* lw4 = (const f32x4*)(P.in[I_LN2W] + (size_t)l * DM) + lane; const f32x4* lb4 = (const f32x4*)(P.in[I_LN2B] + (size_t)l * DM) + lane;
    u32x2 nh[4], ny[4][4];
    f32x4 lwr[4], lbr[4];
    const float bgv = last ? 0.f : P.in[I_BIN][(size_t)(l + 1) * CIN + NPROJ + (lane & 7)];
#pragma unroll
    for (int j = 0; j < 4; ++j) { lwr[j] = lw4[64 * j]; lbr[j] = lb4[64 * j]; }
    { const int tok = (gw < MTOK) ? gw : 0; const u32x2* xr = (const u32x2*)(hb + (size_t)tok * DM) + lane;
#pragma unroll
      for (int j = 0; j < 4; ++j) nh[j] = xr[64 * j];
#pragma unroll
      for (int sl = 0; sl < 4; ++sl) { const u32x2* yr = (const u32x2*)(yb + (size_t)(tok * 4 + sl) * DM) + lane;
#pragma unroll
          for (int j = 0; j < 4; ++j) ny[sl][j] = yr[64 * j]; } }
    for (int tok = gw; tok < MTOK; tok += NGW) {
        f32x4 v[4]; float s = 0.f;
#pragma unroll
        for (int j = 0; j < 4; ++j) { v[j] = (f32x4){bflo(nh[j][0]), bfhi(nh[j][0]), bflo(nh[j][1]), bfhi(nh[j][1])} * DN_ALPHA;
#pragma unroll
            for (int sl = 0; sl < 4; ++sl) { const u32x2 w = ny[sl][j]; v[j][0] += bflo(w[0]); v[j][1] += bfhi(w[0]); v[j][2] += bflo(w[1]); v[j][3] += bfhi(w[1]); } }
        { const int tn = (tok + NGW < MTOK) ? tok + NGW : tok; const u32x2* xr = (const u32x2*)(hb + (size_t)tn * DM) + lane;
#pragma unroll
          for (int j = 0; j < 4; ++j) nh[j] = xr[64 * j];
#pragma unroll
          for (int sl = 0; sl < 4; ++sl) { const u32x2* yr = (const u32x2*)(yb + (size_t)(tn * 4 + sl) * DM) + lane;
#pragma unroll
              for (int j = 0; j < 4; ++j) ny[sl][j] = yr[64 * j]; } }
#pragma unroll
        for (int j = 0; j < 4; ++j) s += (v[j][0] + v[j][1]) + (v[j][2] + v[j][3]);
        const float mean = wave_sum(s) * (1.f / DM); float s2 = 0.f;
#pragma unroll
        for (int j = 0; j < 4; ++j) { v[j] = v[j] - mean; s2 += (v[j][0] * v[j][0] + v[j][1] * v[j][1]) + (v[j][2] * v[j][2] + v[j][3] * v[j][3]); }
        const float rstd = rsqrtf(wave_sum(s2) * (1.f / DM) + LN_EPS);
#pragma unroll
        for (int j = 0; j < 4; ++j) v[j] = v[j] * rstd * lwr[j] + lbr[j];
        if (last) { f32x4* of = (f32x4*)(hf + (size_t)tok * DM) + lane;
#pragma unroll
            for (int j = 0; j < 4; ++j) of[64 * j] = v[j]; }
        if (!last) { u32x2* ob = (u32x2*)((dummy ? (bf16_t*)(C.ws + WS_HF) : hb) + (size_t)tok * DM) + lane;
#pragma unroll
            for (int j = 0; j < 4; ++j) ob[64 * j] = (u32x2){pk2(v[j][0], v[j][1]), pk2(v[j][2], v[j][3])};
            gate_cols(v, wg, bgv, pg + (size_t)tok * 8, lane); }
    }
}

typedef const __attribute__((address_space(4))) Params* CParamsPtr;
__device__ __forceinline__ const Params* kparams() {
    const unsigned long long a = (unsigned long long)__builtin_amdgcn_kernarg_segment_ptr(); unsigned lo = (unsigned)a, hi = (unsigned)(a >> 32);
    asm volatile("" : "+v"(lo), "+v"(hi));
    lo = __builtin_amdgcn_readfirstlane(lo); hi = __builtin_amdgcn_readfirstlane(hi);
    return (const Params*)(CParamsPtr)(((unsigned long long)hi << 32) | lo);
}
__device__ __forceinline__ Ctx make_ctx(const Params& P, LAS unsigned char* lds, int wv0) {
    Ctx C; C.lds = lds; unsigned ones_ = ~0u; asm volatile("" : "+s"(ones_)); int t_ = wv0 * 64 + (int)__builtin_amdgcn_mbcnt_hi(ones_, __builtin_amdgcn_mbcnt_lo(ones_, 0u)), b_ = blockIdx.x, g_ = gridDim.x; asm volatile("" : "+v"(t_), "+v"(b_), "+v"(g_)); b_ = __builtin_amdgcn_readfirstlane(b_); g_ = __builtin_amdgcn_readfirstlane(g_);
    C.tid = t_; C.lane = C.tid & 63; C.wave = __builtin_amdgcn_readfirstlane(C.tid >> 6); C.blk = b_; C.G = g_; C.ws = P.ws; return C; }
__global__ void __launch_bounds__(512, 2) hybrid_fwd(Params Punused) {
    extern __shared__ __attribute__((aligned(16))) unsigned char lds_raw[];
    LAS unsigned char* const lds = (LAS unsigned char*)lds_raw;
    const int wv0 = __builtin_amdgcn_readfirstlane((int)threadIdx.x >> 6);
    volatile LAS unsigned* MISC = (volatile LAS unsigned*)(lds + MISC_OFF);
    for (int u = threadIdx.x; u < (LDS_BYTES - MISC_OFF) / 4; u += 512) MISC[u] = 0u;
    __syncthreads();
    const int lo = __builtin_amdgcn_readfirstlane(kparams()->ph_lo), hi = __builtin_amdgcn_readfirstlane(kparams()->ph_hi);
    #define IS_T0 (wv0 == 0 && __builtin_amdgcn_mbcnt_hi(~0u, __builtin_amdgcn_mbcnt_lo(~0u, 0u)) == 0u)
    if (hi - lo > 1) (void)xcd_barrier_post((unsigned*)(kparams()->ws + WS_CTL) + CW_BAR, MISC + 8, IS_T0);
#ifndef PHMASK
#define PHMASK 0x7ff
#endif
#define PH_EN(k) (((PHMASK) >> (k)) & 1)
#define RUN(gid) ((gid) >= lo && (gid) < hi)
#define SEAM(gid) do { if ((gid) + 1 < hi) { XcdBarrier bar_; bar_.bar = (unsigned*)(kparams()->ws + WS_CTL) + CW_BAR; bar_.x = xb_xcc_id(); bar_.st = (volatile LAS unsigned*)(lds + MISC_OFF) + 8; xcd_barrier(bar_, IS_T0); if (DUPBAR) xcd_barrier(bar_, IS_T0); } } while (0)
#ifndef DUPMASK
#define DUPMASK 0
#endif
#ifndef DUPBAR
#define DUPBAR 0
#endif
#define DUP(k) for (int rep_ = 0; rep_ < 1 + (((DUPMASK) >> (k)) & 1); ++rep_)
#define PHASE_BEGIN const Params& P = *kparams(); const Ctx C = make_ctx(P, lds, wv0);
    if (PH_EN(0) && RUN(0)) { DUP(0) { PHASE_BEGIN p0_prologue(P, C); } SEAM(0); }
#pragma unroll 1
    for (int l = 0; l < NLAYER; ++l) {
        const int g0 = 1 + l * NPH;
        if (g0 + NPH <= lo || g0 >= hi) continue;
        if (PH_EN(1) && RUN(g0 + 0)) {
            DUP(1) { PHASE_BEGIN
            pg8::Gemm g{(const bf16_t*)(C.ws + WS_HB), (const bf16_t*)(C.ws + WS_WIN) + (size_t)l * NPROJ * DM, MTOK, NPROJ, DM}; pg8::StaticOrder S; S.init(MTOK, NPROJ, C.G, C.blk);
            pg8::EpiBf16b E{(bf16_t*)(C.ws + WS_P), NPROJ, P.in[I_BIN] + (size_t)l * CIN};
            pg8::gemm_phase<pg8::EpiBf16b, pg8::StaticOrder>(C.lds, g, S, E, nullptr, C.tid); }
            SEAM(g0 + 0); }
        if (PH_EN(2) && RUN(g0 + 1)) {
            DUP(2) { PHASE_BEGIN
            constexpr int NU_SWA = 512, NU_RW = NB * 128 * 6, NU_ML = NB * 128 * 4;
#ifndef DUP2
#define DUP2 0
#endif
            for (int rp = 0; rp < 1 + ((DUP2 >> 1) & 1); ++rp) for (int cb = C.blk; cb < NB * 128; cb += C.G)
                for (int hh_ = 0; hh_ < 6; ++hh_) { rwb_unit(P, C, l, cb * 6 + hh_, hh_ != 0); if (hh_ == 0) { asm volatile("s_waitcnt vmcnt(0)" ::: "memory"); __syncthreads(); } }
            for (int rp = 0; rp < 1 + ((DUP2 >> 2) & 1); ++rp) for (int u = C.blk; u < NU_ML; u += C.G) mlb_unit(P, C, l, u); }
            SEAM(g0 + 1); }
        if (PH_EN(3) && RUN(g0 + 2)) {
            DUP(3) { PHASE_BEGIN
            {
#ifndef P3DUP
#define P3DUP 0
#endif
                if (C.blk < 48) { for (int rp = 0; rp < 1 + (P3DUP & 1); ++rp) { rwkv_chain(C, C.blk >> 1, C.blk & 1); __syncthreads(); } } else if (C.blk < 112) { for (int rp = 0; rp < 1 + ((P3DUP >> 1) & 1); ++rp) { mlstm_cscan(C, (C.blk - 48) >> 2, (C.blk - 48) & 3); __syncthreads(); } }
#ifndef SWADUP
#define SWADUP 0
#endif
                LAS int* qslot = (LAS int*)(C.lds + MISC_OFF + 64);
                for (int rq = 0; rq < 1 + SWADUP; ++rq) { unsigned* qctr = (unsigned*)(C.ws + WS_CTL) + CW_SWAQ + l * 64 + rq * 32;
                for (;;) { __syncthreads();
                    if (C.tid == 0) *qslot = (int)__hip_atomic_fetch_add(qctr, 1u, __ATOMIC_RELAXED, __HIP_MEMORY_SCOPE_AGENT);
                    __syncthreads();
                    const int u = *qslot; if (u >= 512) break;
                    swa_unit(P, C, l, u); } } } }
            SEAM(g0 + 2); }
        if (PH_EN(4) && RUN(g0 + 3)) {
            DUP(4) { PHASE_BEGIN
            for (int u = C.blk; u < NB * 128; u += C.G) passd_unit(P, C, l, u); }
            SEAM(g0 + 3); }
        if (PH_EN(5) && RUN(g0 + 4)) {
            DUP(5) { PHASE_BEGIN
            pg8::Gemm g{(const bf16_t*)(C.ws + WS_YMIX), (const bf16_t*)(C.ws + WS_WOUT) + (size_t)l * DM * DM, MTOK, DM, DM}; pg8::StaticOrder S; S.init(MTOK, DM, C.G, C.blk);
            pg8::EpiPlainBf16 E{(bf16_t*)(C.ws + WS_T1), DM};
            pg8::gemm_phase<pg8::EpiPlainBf16, pg8::StaticOrder>(C.lds, g, S, E, nullptr, C.tid); }
            SEAM(g0 + 4); }
        if (PH_EN(6) && RUN(g0 + 5)) { DUP(6) { PHASE_BEGIN ln1_router_phase(P, C, l, (rep_ + 1 < 1 + (((DUPMASK) >> 6) & 1)) ? 512 : 0); } SEAM(g0 + 5); }
        if (PH_EN(7) && RUN(g0 + 6)) { DUP(7) { PHASE_BEGIN permute_phase(P, C, l); } SEAM(g0 + 6); }
        if (PH_EN(8) && RUN(g0 + 7)) {
            DUP(8) { PHASE_BEGIN
            build_tile_e(C, l);
            pg8::Gemm g{(const bf16_t*)(C.ws + WS_HB), (const bf16_t*)(C.ws + WS_WUP) + (size_t)l * NEXP * NUP * DM, POS_MAX, NUP, DM};
            pg8::MoeOrder<8> S{(const LAS int*)(C.lds + TILEE_OFF), C.G, C.blk, (const int*)(C.ws + WS_PTOK)};
            pg8::EpiSwiglu E{(bf16_t*)(C.ws + WS_ACT), P.in[I_EBUP] + (size_t)l * NEXP * NUP};
            pg8::gemm_phase<pg8::EpiSwiglu, pg8::MoeOrder<8>, false, true>(C.lds, g, S, E, nullptr, C.tid); }
            SEAM(g0 + 7); }
        if (PH_EN(9) && RUN(g0 + 8)) {
            DUP(9) { PHASE_BEGIN
            build_tile_e(C, l);
            pg8::Gemm g{(const bf16_t*)(C.ws + WS_ACT), (const bf16_t*)(C.ws + WS_WDN) + (size_t)l * NEXP * DM * DEXP, POS_MAX, DM, DEXP};
            pg8::MoeOrder<4> S{(const LAS int*)(C.lds + TILEE_OFF), C.G, C.blk, nullptr};
            pg8::EpiDown E{(bf16_t*)(C.ws + WS_YB), P.in[I_EBDN] + (size_t)l * NEXP * DM, (const int*)(C.ws + WS_PDEST), (const float*)(C.ws + WS_PGATE)};
            pg8::gemm_phase<pg8::EpiDown, pg8::MoeOrder<4>>(C.lds, g, S, E, nullptr, C.tid); }
            SEAM(g0 + 8); }
        if (PH_EN(10) && RUN(g0 + 9)) { DUP(10) { PHASE_BEGIN combine_ln2_phase(P, C, l, (rep_ + 1 < 1 + (((DUPMASK) >> 10) & 1)) ? 1 : 0); } SEAM(g0 + 9); }
    }
#undef RUN
#undef SEAM
}

#ifndef MK_PER_PHASE
#define MK_PER_PHASE 0
#endif
extern "C" void kernel_launch(void* const* d_in, const int* in_sizes, int n_in, void* d_out, int out_size, void* d_ws, size_t ws_size, hipStream_t stream) {
    static int grid = 0;
    if (grid == 0) {
        if (n_in != 29 || out_size != MTOK * DM || ws_size < WS_END) { fprintf(stderr, "kernel_launch: unexpected shapes (n_in %d out %d ws %zu)\n", n_in, out_size, ws_size); grid = -1; return; }
        int dev = 0, cus = 0;
        if (hipGetDevice(&dev) != hipSuccess || hipDeviceGetAttribute(&cus, hipDeviceAttributeMultiprocessorCount, dev) != hipSuccess) { grid = -1; return; }
        if (hipFuncSetAttribute((const void*)hybrid_fwd, hipFuncAttributeMaxDynamicSharedMemorySize, LDS_BYTES) != hipSuccess) { fprintf(stderr, "kernel_launch: hipFuncSetAttribute failed\n"); grid = -1; return; }
        int per_cu = 0;
        if (hipOccupancyMaxActiveBlocksPerMultiprocessor(&per_cu, (const void*)hybrid_fwd, 512, LDS_BYTES) != hipSuccess || per_cu < 1) { fprintf(stderr, "kernel_launch: occupancy query says %d\n", per_cu); }
        (void)hipGetLastError();
        grid = cus;
    }
    if (grid < 0) return;
    (void)hipMemsetAsync((char*)d_ws + WS_CTL, 0, CTL_ZERO_BYTES, stream);
    Params p; memset(&p, 0, sizeof(p));
    for (int i = 0; i < 29; ++i) p.in[i] = (const float*)d_in[i];
    p.out = (float*)d_out; p.ws = (unsigned char*)d_ws;
#if MK_PER_PHASE
    for (int ph = 0; ph < NPHASE_TOTAL; ++ph) { p.ph_lo = ph; p.ph_hi = ph + 1; hipLaunchKernelGGL(hybrid_fwd, dim3(grid), dim3(512), LDS_BYTES, stream, p); }
#else
    p.ph_lo = 0; p.ph_hi = NPHASE_TOTAL;
    hipLaunchKernelGGL(hybrid_fwd, dim3(grid), dim3(512), LDS_BYTES, stream, p);
#endif
}
```
